# Optimizing an MI355X kernel written in HIP

```python
import math
import jax, jax.numpy as jnp
from jax import lax
import numpy as np

D_MODEL = 4096
BATCH = 4
SEQ = 4096
DEPTH = 4

N_META = 16
BLOCK_Q = 128
EPS = 1e-6
FOX_HEADS = 16
FOX_DIM = 128
MLA_HEADS = 16
MLA_Q_RANK = 896
MLA_KV_RANK = 320
MLA_NOPE_DIM = 128
MLA_ROPE_DIM = 64
MLA_V_DIM = 128
ROPE_THETA = 10000.0
DIFF_HEAD_DIM = 128
DIFF_HEADS = D_MODEL // (2 * DIFF_HEAD_DIM)
REL_BUCKETS = 32
REL_MAX_DIST = 128
D_FF = ((8 * D_MODEL + 3 * 256 - 1) // (3 * 256)) * 256

N_EVEN = (DEPTH + 1) // 2
N_ODD = DEPTH // 2
EVEN_SPLITS = (FOX_HEADS * FOX_DIM, FOX_HEADS * FOX_DIM, FOX_HEADS * FOX_DIM, FOX_HEADS,
               MLA_Q_RANK, MLA_KV_RANK, MLA_ROPE_DIM)
EVEN_IN = sum(EVEN_SPLITS)
EVEN_OUT = FOX_HEADS * FOX_DIM + MLA_HEADS * MLA_V_DIM
DIFF_IN = 3 * DIFF_HEADS * 2 * DIFF_HEAD_DIM
DIFF_OUT = DIFF_HEADS * 2 * DIFF_HEAD_DIM

kernel_name = "fox_mla_diff_hybrid_trunk"


def rms_norm(x, g):
    xf = x.astype(jnp.float32)
    y = xf * lax.rsqrt(jnp.mean(xf * xf, axis=-1, keepdims=True) + EPS)
    return (y * g.astype(jnp.float32)).astype(x.dtype)


def to_heads(t, n, d):
    b, l, _ = t.shape
    return t.reshape(b, l, n, d).transpose(0, 2, 1, 3)


def from_heads(t):
    b, h, l, d = t.shape
    return t.transpose(0, 2, 1, 3).reshape(b, l, h * d)


def query_blocks(L):
    return [(0, N_META)] + [(lo, min(lo + BLOCK_Q, L)) for lo in range(N_META, L, BLOCK_Q)]


def causal_probs(q, k, lo, hi, scale, bias=None):
    logits = jnp.einsum("bhqd,bhkd->bhqk", q[:, :, lo:hi], k[:, :, :hi]).astype(jnp.float32) * scale
    if bias is not None:
        logits = logits + bias
    t = jnp.arange(lo, hi)[:, None]
    s = jnp.arange(hi)[None, :]
    logits = jnp.where(s <= t, logits, -jnp.inf)
    return jax.nn.softmax(logits, axis=-1)


def rope_tables(L):
    inv = ROPE_THETA ** (-jnp.arange(0, MLA_ROPE_DIM, 2, dtype=jnp.float32) / MLA_ROPE_DIM)
    ang = jnp.arange(L, dtype=jnp.float32)[:, None] * inv[None, :]
    return jnp.cos(ang), jnp.sin(ang)


def apply_rope(x, cos, sin):
    x1, x2 = jnp.split(x.astype(jnp.float32), 2, axis=-1)
    return jnp.concatenate([x1 * cos - x2 * sin, x1 * sin + x2 * cos], axis=-1).astype(x.dtype)


def t5_bucket(dist):
    max_exact = REL_BUCKETS // 2
    d = jnp.maximum(dist, 1).astype(jnp.float32)
    large = max_exact + (jnp.log(d / max_exact) / math.log(REL_MAX_DIST / max_exact)
                         * (REL_BUCKETS - max_exact)).astype(jnp.int32)
    large = jnp.minimum(large, REL_BUCKETS - 1)
    return jnp.where(dist < max_exact, dist, large)


def rel_bias_block(rel_bias, lo, hi):
    dist = jnp.maximum(jnp.arange(lo, hi)[:, None] - jnp.arange(hi)[None, :], 0)
    return rel_bias.astype(jnp.float32)[t5_bucket(dist)].transpose(2, 0, 1)[None]


def fox_mla_mixer(h, w_in, b_f, q_norm_g, kv_norm_g, w_uq, w_ukv, w_out):
    b, L, _ = h.shape
    offsets = [int(o) for o in np.cumsum(EVEN_SPLITS)[:-1]]
    proj = jnp.einsum("bld,de->ble", h, w_in)
    q_f, k_f, v_f, f_logit, c_q, c_kv, k_r = jnp.split(proj, offsets, axis=-1)
    qf = to_heads(q_f, FOX_HEADS, FOX_DIM)
    kf = to_heads(k_f, FOX_HEADS, FOX_DIM)
    vf = to_heads(v_f, FOX_HEADS, FOX_DIM)
    log_f = jax.nn.log_sigmoid(f_logit.astype(jnp.float32) + b_f.astype(jnp.float32))
    cum = jnp.cumsum(log_f, axis=1).transpose(0, 2, 1)
    cos, sin = rope_tables(L)
    q = to_heads(rms_norm(c_q, q_norm_g) @ w_uq, MLA_HEADS, MLA_NOPE_DIM + MLA_ROPE_DIM)
    q_m = jnp.concatenate([q[..., :MLA_NOPE_DIM], apply_rope(q[..., MLA_NOPE_DIM:], cos, sin)], axis=-1)
    kv = to_heads(rms_norm(c_kv, kv_norm_g) @ w_ukv, MLA_HEADS, MLA_NOPE_DIM + MLA_V_DIM)
    k_rope = apply_rope(k_r[:, None], cos, sin)
    k_m = jnp.concatenate([kv[..., :MLA_NOPE_DIM],
                           jnp.broadcast_to(k_rope, (b, MLA_HEADS, L, MLA_ROPE_DIM))], axis=-1)
    v_m = kv[..., MLA_NOPE_DIM:]
    fox_scale = FOX_DIM ** -0.5
    mla_scale = (MLA_NOPE_DIM + MLA_ROPE_DIM) ** -0.5
    outs = []
    for lo, hi in query_blocks(L):
        decay = cum[:, :, lo:hi, None] - cum[:, :, None, :hi]
        p_f = causal_probs(qf, kf, lo, hi, fox_scale, decay)
        o_f = jnp.einsum("bhqk,bhkd->bhqd", p_f.astype(vf.dtype), vf[:, :, :hi])
        p_m = causal_probs(q_m, k_m, lo, hi, mla_scale)
        o_m = jnp.einsum("bhqk,bhkd->bhqd", p_m.astype(v_m.dtype), v_m[:, :, :hi])
        outs.append(jnp.concatenate([o_f, o_m], axis=1))
    o = jnp.concatenate(outs, axis=2)
    return from_heads(o) @ w_out


def diff_mixer(h, w_in, lam, subln_g, w_out, rel_bias, lam_init):
    b, L, _ = h.shape
    q, k, v = jnp.split(jnp.einsum("bld,de->ble", h, w_in), 3, axis=-1)
    q = q.reshape(b, L, DIFF_HEADS, 2, DIFF_HEAD_DIM).transpose(0, 2, 3, 1, 4)
    k = k.reshape(b, L, DIFF_HEADS, 2, DIFF_HEAD_DIM).transpose(0, 2, 3, 1, 4)
    v = to_heads(v, DIFF_HEADS, 2 * DIFF_HEAD_DIM)
    lf = lam.astype(jnp.float32)
    lam_full = jnp.exp(jnp.sum(lf[0] * lf[1])) - jnp.exp(jnp.sum(lf[2] * lf[3])) + lam_init
    scale = DIFF_HEAD_DIM ** -0.5
    q1, q2, k1, k2 = q[:, :, 0], q[:, :, 1], k[:, :, 0], k[:, :, 1]
    outs = []
    for lo, hi in query_blocks(L):
        bias = rel_bias_block(rel_bias, lo, hi)
        p1 = causal_probs(q1, k1, lo, hi, scale, bias)
        p2 = causal_probs(q2, k2, lo, hi, scale, bias)
        a = p1 - lam_full * p2
        outs.append(jnp.einsum("bhqk,bhkd->bhqd", a.astype(v.dtype), v[:, :, :hi]))
    o = jnp.concatenate(outs, axis=2)
    o = rms_norm(o, subln_g) * (1.0 - lam_init)
    return from_heads(o) @ w_out


def swiglu(h, w_gate, w_up, w_down):
    return (jax.nn.silu(h @ w_gate) * (h @ w_up)) @ w_down


def setup_inputs(seed: int = 0) -> dict:
    key = jax.random.key(seed)
    ks = jax.random.split(key, 20)

    def normal(k, shape, scale):
        return jax.random.normal(k, shape, jnp.float32) * scale

    return {
        "x": normal(ks[0], (BATCH, SEQ, D_MODEL), 1.0),
        "meta_tokens": normal(ks[1], (N_META, D_MODEL), 1.0),
        "rel_bias": normal(ks[2], (REL_BUCKETS, DIFF_HEADS), 0.5),
        "ev_w_in": normal(ks[3], (N_EVEN, D_MODEL, EVEN_IN), D_MODEL ** -0.5),
        "ev_b_f": 3.0 + normal(ks[4], (N_EVEN, FOX_HEADS), 0.5),
        "ev_q_norm": 1.0 + normal(ks[5], (N_EVEN, MLA_Q_RANK), 0.02),
        "ev_kv_norm": 1.0 + normal(ks[6], (N_EVEN, MLA_KV_RANK), 0.02),
        "ev_w_uq": normal(ks[7], (N_EVEN, MLA_Q_RANK, MLA_HEADS * (MLA_NOPE_DIM + MLA_ROPE_DIM)), MLA_Q_RANK ** -0.5),
        "ev_w_ukv": normal(ks[8], (N_EVEN, MLA_KV_RANK, MLA_HEADS * (MLA_NOPE_DIM + MLA_V_DIM)), MLA_KV_RANK ** -0.5),
        "ev_w_out": normal(ks[9], (N_EVEN, EVEN_OUT, D_MODEL), EVEN_OUT ** -0.5),
        "od_w_in": normal(ks[10], (N_ODD, D_MODEL, DIFF_IN), D_MODEL ** -0.5),
        "od_lambda": normal(ks[11], (N_ODD, 4, DIFF_HEAD_DIM), 0.1),
        "od_subln": 1.0 + normal(ks[12], (N_ODD, 2 * DIFF_HEAD_DIM), 0.02),
        "od_w_out": normal(ks[13], (N_ODD, DIFF_OUT, D_MODEL), DIFF_OUT ** -0.5),
        "norm_g": 1.0 + normal(ks[14], (DEPTH, 4, D_MODEL), 0.02),
        "ffn_w_gate": normal(ks[15], (DEPTH, D_MODEL, D_FF), D_MODEL ** -0.5),
        "ffn_w_up": normal(ks[16], (DEPTH, D_MODEL, D_FF), D_MODEL ** -0.5),
        "ffn_w_down": normal(ks[17], (DEPTH, D_FF, D_MODEL), D_FF ** -0.5),
    }


def reference(x, meta_tokens, rel_bias, ev_w_in, ev_b_f, ev_q_norm, ev_kv_norm, ev_w_uq, ev_w_ukv,
              ev_w_out, od_w_in, od_lambda, od_subln, od_w_out, norm_g, ffn_w_gate, ffn_w_up, ffn_w_down):
    b = x.shape[0]
    meta = jnp.broadcast_to(meta_tokens[None].astype(x.dtype), (b, N_META, D_MODEL))
    hs = jnp.concatenate([meta, x], axis=1)
    for layer in range(DEPTH):
        g = norm_g[layer]
        i = layer // 2
        hn = rms_norm(hs, g[0])
        if layer % 2 == 0:
            m = fox_mla_mixer(hn, ev_w_in[i], ev_b_f[i], ev_q_norm[i], ev_kv_norm[i],
                              ev_w_uq[i], ev_w_ukv[i], ev_w_out[i])
        else:
            lam_init = 0.8 - 0.6 * math.exp(-0.3 * layer)
            m = diff_mixer(hn, od_w_in[i], od_lambda[i], od_subln[i], od_w_out[i], rel_bias, lam_init)
        hs = hs + rms_norm(m, g[1])
        f = swiglu(rms_norm(hs, g[2]), ffn_w_gate[layer], ffn_w_up[layer], ffn_w_down[layer])
        hs = hs + rms_norm(f, g[3])
    return hs[:, N_META:]
```

```cpp
#define MK_ONE_LAUNCH 1
#include <hip/hip_runtime.h>
#include <cstdio>
#include <cstdint>
#include <cmath>

#define LAS __attribute__((address_space(3)))
#define GAS __attribute__((address_space(1)))
typedef unsigned short bf16_t;
typedef short bf16x8 __attribute__((ext_vector_type(8)));
typedef short s16x4 __attribute__((ext_vector_type(4)));
typedef float f32x2 __attribute__((ext_vector_type(2)));
typedef float f32x4 __attribute__((ext_vector_type(4)));
typedef float f32x16 __attribute__((ext_vector_type(16)));
typedef unsigned u32x2 __attribute__((ext_vector_type(2)));
typedef unsigned u32x4 __attribute__((ext_vector_type(4)));
typedef int i32x4 __attribute__((ext_vector_type(4)));
typedef int i32x8 __attribute__((ext_vector_type(8)));

constexpr int DM = 4096, NB = 4, SEQ = 4096, NMETA = 16, DEPTH = 4;
constexpr int MREAL = NB * SEQ;
constexpr int META0 = MREAL;
constexpr int MUSED = MREAL + NMETA;
constexpr int MPAD = 16640;
constexpr int DFF = 11008;
constexpr int NPOS = NMETA + SEQ;
constexpr float EPS = 1e-6f;
constexpr int EV_N = 7680, EV_QF = 0, EV_KF = 2048, EV_VF = 4096, EV_CQ = 6144, EV_CKV = 7040, EV_KR = 7360, EV_FL = 7424;
constexpr int QRANK = 896, KVRANK = 320, KVK = 384;
constexpr int UQ_N = 3072, UKV_N = 4096, OD_N = 12288, GU_N = 2 * DFF;
constexpr int EV_SRC_N = 7440;
constexpr int AMAXP_LD = 352;
constexpr int LD_DM = 4160, LD_FF = 11072, LD_EV = 7744, LD_OD = 12352, LD_UQ = 3136, LD_UKV = 4160, LD_QR = 960, LD_KV = 448;

__device__ __forceinline__ unsigned cvt_pk_bf16(float lo, float hi) { unsigned r; asm volatile("v_cvt_pk_bf16_f32 %0, %1, %2" : "=v"(r) : "v"(lo), "v"(hi)); return r; }
__device__ __forceinline__ float bf_lo(unsigned w) { return __uint_as_float(w << 16); }
__device__ __forceinline__ float bf_hi(unsigned w) { return __uint_as_float(w & 0xffff0000u); }
__device__ __forceinline__ float wave_sum(float v) {
#pragma unroll
    for (int o = 1; o < 64; o <<= 1) v += __shfl_xor(v, o);
    return v;
}

__device__ __forceinline__ int opq_tid(int wave) {
    int l; asm volatile("v_mbcnt_lo_u32_b32 %0, -1, 0\n\tv_mbcnt_hi_u32_b32 %0, -1, %0" : "=v"(l));
    return (wave << 6) | l;
}

__device__ __forceinline__ int opq_s(int v) { asm volatile("" : "+s"(v)); return v; }

namespace pg8 {
#define PG8_LAS __attribute__((address_space(3)))
constexpr int RS_LDS_OFF = 131072;
constexpr int BM = 256, BK = 64, HALF = 128, HTB = HALF * BK * 2  , STAGE_BYTES = 8 * HTB, NXCD = 8, WGM = 8;

__host__ __device__ __forceinline__ int lds_byte(int r, int c) { const int st = (r >> 4) * 2 + (c >> 5), rr = r & 15, cc = c & 31, ob = rr * 64 + cc * 2; return st * 1024 + (ob ^ (((ob >> 9) & 1) << 5)); }
__host__ __device__ __forceinline__ void stage_rc(int b, int& R, int& C) { const int st = b / 1024, sb = b % 1024, swz = sb ^ (((sb >> 9) & 1) << 5); R = (st >> 1) * 16 + swz / 64; C = (st & 1) * 32 + (swz % 64) / 2; }
__host__ __device__ __forceinline__ int perm32(int rho) { const int n = rho >> 4, i = rho & 15; return 8 * (i >> 2) + 4 * n + (i & 3); }

struct Unit { int pm, pn, ko, ks; };
struct Gemm { const bf16_t* A; const bf16_t* Bt; int lda, ldb, K; };

struct StaticOrder {
    int nM, nN, nwg, G, c, wgm;
    __host__ __device__ void init(int M, int N, int G_, int c_, int wgm_ = WGM) { nM = M / BM; nN = N / BM; nwg = nM * nN; G = G_; c = c_; wgm = wgm_; }
    __host__ __device__ bool next(int i, Unit& u) const {
        const long L = (long)i * G + c; if (L >= nwg) return false;
        int wgid = (int)L; { const int q = nwg / NXCD, r = nwg % NXCD, xcd = wgid % NXCD, off = wgid / NXCD; wgid = (xcd < r ? xcd * (q + 1) : r * (q + 1) + (xcd - r) * q) + off; }
        const int nig = wgm * nN, gid = wgid / nig, fm = gid * wgm, gsz = (nM - fm) < wgm ? (nM - fm) : wgm;
        u.pm = fm + ((wgid % nig) % gsz); u.pn = (wgid % nig) / gsz; u.ko = 0; u.ks = 0; return true;
    }
    __device__ __forceinline__ void a_ready(const Unit&) const {}
    __device__ __forceinline__ void done(const Unit&) const {}
};
struct SplitKOrder {
    int pm, nN, nS, kslice, G, c;
    __host__ __device__ void init(int pm_, int N, int nS_, int kslice_, int G_, int c_) { pm = pm_; nN = N / BM; nS = nS_; kslice = kslice_; G = G_; c = c_; }
    __host__ __device__ bool next(int i, Unit& u) const {
        const int L = i * G + c; if (L >= nN * nS) return false;
        u.pm = pm; u.pn = L % nN; u.ks = L / nN; u.ko = u.ks * kslice; return true;
    }
    __device__ __forceinline__ void a_ready(const Unit&) const {}
    __device__ __forceinline__ void done(const Unit&) const {}
};

struct EpiCtx {
    bf16_t* O; int ldc;
    const float* rs;
    float* statq; float* statkv;
    float* flogT;
    const float* cosT; const float* sinT;
    float* statm;
    float* part;
    const float* cs;
    float* amaxp;
};
__device__ __forceinline__ int row_pos(int row) { return row < MREAL ? NMETA + (row & (SEQ - 1)) : row - META0; }
__device__ __forceinline__ void store8(bf16_t* p, f32x4 v0, f32x4 v1) {
    u32x4 w; w.x = cvt_pk_bf16(v0[0], v0[1]); w.y = cvt_pk_bf16(v0[2], v0[3]); w.z = cvt_pk_bf16(v1[0], v1[1]); w.w = cvt_pk_bf16(v1[2], v1[3]);
    *(u32x4*)p = w;
}
__device__ __forceinline__ float sel4(const float (&a)[4], int i) { return i == 0 ? a[0] : (i == 1 ? a[1] : (i == 2 ? a[2] : a[3])); }
__device__ __forceinline__ float sq8(f32x4 a, f32x4 b) { return (a[0] * a[0] + a[1] * a[1]) + (a[2] * a[2] + a[3] * a[3]) + (b[0] * b[0] + b[1] * b[1]) + (b[2] * b[2] + b[3] * b[3]); }
__device__ __forceinline__ float silu_mul(float g, float u) { return g * __builtin_amdgcn_rcpf(1.0f + __builtin_amdgcn_exp2f(-1.4426950408889634f * g)) * u; }

__device__ __forceinline__ void fwht32_lanes(f32x4& a, f32x4& b, float s16, float s32) {
    f32x4 t;
    t = (f32x4){a[0] + a[1], a[0] - a[1], a[2] + a[3], a[2] - a[3]}; a = (f32x4){t[0] + t[2], t[1] + t[3], t[0] - t[2], t[1] - t[3]};
    t = (f32x4){b[0] + b[1], b[0] - b[1], b[2] + b[3], b[2] - b[3]}; b = (f32x4){t[0] + t[2], t[1] + t[3], t[0] - t[2], t[1] - t[3]};
    t = a + b; b = a - b; a = t;
#pragma unroll
    for (int j = 0; j < 4; ++j) {
        auto r = __builtin_amdgcn_permlane16_swap(__float_as_uint(a[j]), __float_as_uint(a[j]), false, false); a[j] = __builtin_fmaf(s16, __uint_as_float(r[1]), __uint_as_float(r[0]));
        auto q = __builtin_amdgcn_permlane16_swap(__float_as_uint(b[j]), __float_as_uint(b[j]), false, false); b[j] = __builtin_fmaf(s16, __uint_as_float(q[1]), __uint_as_float(q[0])); }
#pragma unroll
    for (int j = 0; j < 4; ++j) {
        auto r = __builtin_amdgcn_permlane32_swap(__float_as_uint(a[j]), __float_as_uint(a[j]), false, false); a[j] = __builtin_fmaf(s32, __uint_as_float(r[1]), __uint_as_float(r[0]));
        auto q = __builtin_amdgcn_permlane32_swap(__float_as_uint(b[j]), __float_as_uint(b[j]), false, false); b[j] = __builtin_fmaf(s32, __uint_as_float(q[1]), __uint_as_float(q[0])); }
}
template <int MODE> struct Epi {
    static constexpr bool PERM = true, AFTER_DRAIN = false;
    EpiCtx c;
    static constexpr bool EVM = (MODE == 1 || MODE == 9), I8M = (MODE == 8 || MODE == 9 || MODE == 10), OUTM = (MODE == 4 || MODE == 10);
    static constexpr bool RS_LDS = (MODE == 0 || MODE == 1 || MODE == 5 || MODE == 7 || MODE == 8 || MODE == 9 || MODE == 10), CS_LDS = (MODE == 7 || MODE == 8 || MODE == 9 || MODE == 10);
    __device__ __forceinline__ void pre(const Unit& u, PG8_LAS unsigned char* slot, int wid) const {
        if constexpr (RS_LDS) { if (wid < 4) { int l; asm volatile("v_mbcnt_lo_u32_b32 %0, -1, 0\n\tv_mbcnt_hi_u32_b32 %0, -1, %0" : "=v"(l));
            const char* b = (const char*)(c.rs + u.pm * BM + wid * 64); asm volatile("" : "+s"(b));
            __builtin_amdgcn_global_load_lds((const unsigned*)(b + (unsigned)(l * 4)), (PG8_LAS unsigned*)(slot + wid * 256), 4, 0, 0); } }
        if constexpr (CS_LDS) { if (wid >= 4) { int l; asm volatile("v_mbcnt_lo_u32_b32 %0, -1, 0\n\tv_mbcnt_hi_u32_b32 %0, -1, %0" : "=v"(l));
            const char* b = (const char*)(c.cs + u.pn * BM + (wid - 4) * 64); asm volatile("" : "+s"(b));
            __builtin_amdgcn_global_load_lds((const unsigned*)(b + (unsigned)(l * 4)), (PG8_LAS unsigned*)(slot + 2048 + (wid - 4) * 256), 4, 0, 0); } }
    }
    __device__ __forceinline__ void operator()(const f32x4 (&acc)[2][2][4][2], const Unit& u, int wr, int wc, int fr, int fq, const PG8_LAS float* rsl) const {
        int pm_ = u.pm, pn_ = u.pn; asm volatile("" : "+s"(pm_), "+s"(pn_));
        if constexpr (MODE == 6) {
            if (wr == 0) { float* P = c.part + (unsigned)((u.ks * 16 + fr) * c.ldc + pn_ * BM + wc * 32 + 8 * fq);
#pragma unroll
                for (int bj = 0; bj < 2; ++bj) { *(f32x4*)(P + bj * HALF) = acc[0][bj][0][0]; *(f32x4*)(P + bj * HALF + 4) = acc[0][bj][0][1]; } }
            return;
        }
        const Unit uu{pm_, pn_};
        const int row0 = uu.pm * BM + wr * 64 + fr;
        float s[2][4];
#pragma unroll
        for (int ai = 0; ai < 2; ++ai)
#pragma unroll
            for (int m = 0; m < 4; ++m) {
                const int row = row0 + ai * HALF + m * 16;
                if constexpr (RS_LDS) s[ai][m] = rsl[ai * HALF + wr * 64 + m * 16 + fr];
                else if constexpr (MODE == 2) { const f32x4* q = (const f32x4*)(c.rs + (unsigned)(row * 32)); f32x4 t = q[0];
#pragma unroll
                    for (int k = 1; k < 7; ++k) t += q[k];
                    s[ai][m] = __builtin_amdgcn_rsqf(((t[0] + t[1]) + (t[2] + t[3])) * (1.0f / QRANK) + EPS); }
                else if constexpr (MODE == 3) { const f32x4* q = (const f32x4*)(c.rs + (unsigned)(row * 16)); const f32x4 t = q[0] + q[1]; const f32x2 t2 = *(const f32x2*)(q + 2);
                    s[ai][m] = __builtin_amdgcn_rsqf((((t[0] + t[1]) + (t[2] + t[3])) + (t2[0] + t2[1])) * (1.0f / KVRANK) + EPS); }
                else s[ai][m] = 1.0f;
            }
        if constexpr (MODE == 7) {
            const int col0 = uu.pn * HALF + wc * 32 + 8 * fq;
            const PG8_LAS float* csl = rsl + 512 + wc * 32 + 8 * fq;
            const f32x4 cg0 = *(const PG8_LAS f32x4*)csl, cg1 = *(const PG8_LAS f32x4*)(csl + 4), cu0 = *(const PG8_LAS f32x4*)(csl + HALF), cu1 = *(const PG8_LAS f32x4*)(csl + HALF + 4);
#pragma unroll
            for (int ai = 0; ai < 2; ++ai)
#pragma unroll
                for (int m = 0; m < 4; ++m) {
                    const int row = row0 + ai * HALF + m * 16; const float sc = s[ai][m];
                    const f32x4 g0 = __builtin_convertvector(__builtin_bit_cast(i32x4, acc[ai][0][m][0]), f32x4) * (cg0 * sc), g1 = __builtin_convertvector(__builtin_bit_cast(i32x4, acc[ai][0][m][1]), f32x4) * (cg1 * sc);
                    const f32x4 u0 = __builtin_convertvector(__builtin_bit_cast(i32x4, acc[ai][1][m][0]), f32x4) * (cu0 * sc), u1 = __builtin_convertvector(__builtin_bit_cast(i32x4, acc[ai][1][m][1]), f32x4) * (cu1 * sc);
                    f32x4 o0, o1;
#pragma unroll
                    for (int j = 0; j < 4; ++j) { o0[j] = silu_mul(g0[j], u0[j]); o1[j] = silu_mul(g1[j], u1[j]); }
                    store8(c.O + (unsigned)(row * c.ldc + col0), o0, o1);
                }
            return;
        } else if constexpr (MODE == 5) {
            const int col0 = uu.pn * HALF + wc * 32 + 8 * fq;
#pragma unroll
            for (int ai = 0; ai < 2; ++ai)
#pragma unroll
                for (int m = 0; m < 4; ++m) {
                    const int row = row0 + ai * HALF + m * 16; const float sc = s[ai][m];
                    const f32x4 g0 = acc[ai][0][m][0] * sc, g1 = acc[ai][0][m][1] * sc, u0 = acc[ai][1][m][0] * sc, u1 = acc[ai][1][m][1] * sc;
                    f32x4 o0, o1;
#pragma unroll
                    for (int j = 0; j < 4; ++j) { o0[j] = silu_mul(g0[j], u0[j]); o1[j] = silu_mul(g1[j], u1[j]); }
                    store8(c.O + (unsigned)(row * c.ldc + col0), o0, o1);
                }
            return;
        } else {
            float ssm[2][4];
            if constexpr (OUTM) {
#pragma unroll
                for (int ai = 0; ai < 2; ++ai)
#pragma unroll
                    for (int m = 0; m < 4; ++m) ssm[ai][m] = 0.f;
            }
#pragma unroll
            for (int bj = 0; bj < 2; ++bj) {
                const int gcol = uu.pn * BM + bj * HALF + wc * 32;
                const int col0 = gcol + 8 * fq;
                bool rope = false; int i0 = 0;
                if constexpr (EVM) { rope = (gcol >= EV_KR && gcol < EV_FL); i0 = (col0 - EV_KR) >> 1; }
                if constexpr (MODE == 2) { rope = (gcol >= 2048); i0 = ((col0 - 2048) & 63) >> 1; }
                f32x4 c0 = {1.f, 1.f, 1.f, 1.f}, c1 = c0;
                if constexpr (I8M) { const PG8_LAS float* csl = rsl + 512 + bj * HALF + wc * 32 + 8 * fq; c0 = *(const PG8_LAS f32x4*)csl; c1 = *(const PG8_LAS f32x4*)(csl + 4); }
                if ((EVM || MODE == 2) && rope) {
#pragma unroll
                    for (int ai = 0; ai < 2; ++ai)
#pragma unroll
                        for (int m = 0; m < 4; ++m) {
                            const int row = row0 + ai * HALF + m * 16; const float sc = s[ai][m]; const int pos = row_pos(row);
                            const f32x4 cs = *(const f32x4*)(c.cosT + (unsigned)(pos * 32 + i0)), sn = *(const f32x4*)(c.sinT + (unsigned)(pos * 32 + i0));
                            f32x4 x1, x2;
                            if constexpr (I8M) { x1 = __builtin_convertvector(__builtin_bit_cast(i32x4, acc[ai][bj][m][0]), f32x4) * (c0 * sc); x2 = __builtin_convertvector(__builtin_bit_cast(i32x4, acc[ai][bj][m][1]), f32x4) * (c1 * sc); }
                            else { x1 = acc[ai][bj][m][0] * sc; x2 = acc[ai][bj][m][1] * sc; }
                            store8(c.O + (unsigned)(row * c.ldc + col0), x1 * cs - x2 * sn, x1 * sn + x2 * cs);
                            asm volatile("" ::: "memory");
                        }
                } else {
                    float ss[2][4];
#pragma unroll
                    for (int ai = 0; ai < 2; ++ai)
#pragma unroll
                        for (int m = 0; m < 4; ++m) {
                            const int row = row0 + ai * HALF + m * 16; const float sc = s[ai][m];
                            f32x4 v0, v1;
                            if constexpr (I8M) { v0 = __builtin_convertvector(__builtin_bit_cast(i32x4, acc[ai][bj][m][0]), f32x4) * (c0 * sc); v1 = __builtin_convertvector(__builtin_bit_cast(i32x4, acc[ai][bj][m][1]), f32x4) * (c1 * sc); }
                            else { v0 = acc[ai][bj][m][0] * sc; v1 = acc[ai][bj][m][1] * sc; }
                            store8(c.O + (unsigned)(row * c.ldc + col0), v0, v1);
                            if constexpr (EVM) {
                                ss[ai][m] = sq8(v0, v1);
                                if (gcol == EV_FL && fq < 2) {
#pragma unroll
                                    for (int j = 0; j < 4; ++j) { c.flogT[(unsigned)((8 * fq + j) * MPAD + row)] = v0[j]; c.flogT[(unsigned)((8 * fq + 4 + j) * MPAD + row)] = v1[j]; }
                                }
                            }
                            if constexpr (OUTM) ssm[ai][m] += sq8(v0, v1);
                            asm volatile("" ::: "memory");
                        }
                    if constexpr (EVM) {
                        if (gcol >= EV_CQ && gcol < EV_KR) {
                            const bool isq = gcol < EV_CKV; float* tgt = isq ? c.statq : c.statkv; const int ld = isq ? 32 : 16, slot = (gcol - (isq ? EV_CQ : EV_CKV)) >> 5;
#pragma unroll
                            for (int ai = 0; ai < 2; ++ai) {
#pragma unroll
                                for (int m = 0; m < 4; ++m) { ss[ai][m] += __shfl_xor(ss[ai][m], 16); ss[ai][m] += __shfl_xor(ss[ai][m], 32); }
                                tgt[(unsigned)((row0 + ai * HALF + fq * 16) * ld + slot)] = sel4(ss[ai], fq);
                            }
                        }
                    }
                }
            }
            if constexpr (OUTM) {
#pragma unroll
                for (int ai = 0; ai < 2; ++ai) {
#pragma unroll
                    for (int m = 0; m < 4; ++m) { ssm[ai][m] += __shfl_xor(ssm[ai][m], 16); ssm[ai][m] += __shfl_xor(ssm[ai][m], 32); }
                    c.statm[(unsigned)((row0 + ai * HALF + fq * 16) * 64 + uu.pn * 4 + wc)] = sel4(ssm[ai], fq);
                }
            }
        }
    }
};
template <int DT> __device__ __forceinline__ f32x4 mma_k2(const bf16x8 (&b)[2], const bf16x8 (&a)[2], f32x4 c) {
    if constexpr (DT == 1) {
        typedef short s16x16 __attribute__((ext_vector_type(16)));
        const s16x16 bb = __builtin_shufflevector(b[0], b[1], 0, 1, 2, 3, 4, 5, 6, 7, 8, 9, 10, 11, 12, 13, 14, 15), aa = __builtin_shufflevector(a[0], a[1], 0, 1, 2, 3, 4, 5, 6, 7, 8, 9, 10, 11, 12, 13, 14, 15);
        return __builtin_amdgcn_mfma_scale_f32_16x16x128_f8f6f4(__builtin_bit_cast(i32x8, bb), __builtin_bit_cast(i32x8, aa), c, 0, 0, 0, 0, 0, 0);
    } else if constexpr (DT == 2) {
        i32x4 ci = __builtin_bit_cast(i32x4, c);
        ci = __builtin_amdgcn_mfma_i32_16x16x64_i8(__builtin_bit_cast(i32x4, b[0]), __builtin_bit_cast(i32x4, a[0]), ci, 0, 0, 0);
        ci = __builtin_amdgcn_mfma_i32_16x16x64_i8(__builtin_bit_cast(i32x4, b[1]), __builtin_bit_cast(i32x4, a[1]), ci, 0, 0, 0);
        return __builtin_bit_cast(f32x4, ci);
    } else {
        c = __builtin_amdgcn_mfma_f32_16x16x32_bf16(b[0], a[0], c, 0, 0, 0);
        return __builtin_amdgcn_mfma_f32_16x16x32_bf16(b[1], a[1], c, 0, 0, 0);
    }
}
template <class Epi, class Sched, bool ALIGN_EPI = false, bool SP2 = false, int DT = 0>
__device__ __forceinline__ void gemm_phase(PG8_LAS unsigned char* lds, const Gemm g, const Sched& S, const Epi& E, const int tid) {
    const int wid = __builtin_amdgcn_readfirstlane(tid >> 6), lane = tid & 63, wr = wid >> 2, wc = wid & 3, fr = lane & 15, fq = lane >> 4;
    const int K = g.K; int nt = K / BK; if (K < 1024) asm volatile("" : "+s"(nt));
    unsigned voffA[2], voffB[2];
#pragma unroll
    for (int i = 0; i < 2; ++i) { int R, C; stage_rc(tid * 16 + i * 8192, R, C); const int Rb = Epi::PERM ? ((R & ~31) + perm32(R & 31)) : R;
        voffA[i] = (unsigned)(R * g.lda + C) * 2u; voffB[i] = (unsigned)(Rb * g.ldb + C) * 2u; }
    const size_t kstep = (size_t)(BK * 2);
    const size_t hstepA = (size_t)HALF * g.lda * 2, hstepB = (size_t)HALF * g.ldb * 2;
    const size_t tstepA = 2 * hstepA, tstepB = 2 * hstepB;
    const unsigned ldsw = (unsigned)wid * 1024u;
    const int aoff = lds_byte(wr * 64 + fr, fq * 8), boff = lds_byte(wc * 32 + fr, fq * 8);
#define PG8_SA(b, h) (((b) * 2 + (h)) * HTB)
#define PG8_SB(b, h) ((4 + (b) * 2 + (h)) * HTB)
#define PG8_STAGE(bufoff, gbase, voff) do { const char* _b = (const char*)(gbase); asm volatile("" : "+s"(_b));     \
        _Pragma("unroll") for (int _i = 0; _i < 2; ++_i) { unsigned _v = (voff)[_i]; asm volatile("" : "+v"(_v)); \
        __builtin_amdgcn_global_load_lds((const unsigned*)(_b + _v), (PG8_LAS unsigned*)(lds + (bufoff) + ldsw + _i * 8192), 16, 0, 0); } } while (0)
#define PG8_LDA(dst, b, h) do { _Pragma("unroll") for (int m = 0; m < 4; ++m) _Pragma("unroll") for (int k = 0; k < 2; ++k) dst[m][k] = *(const PG8_LAS bf16x8*)(lds + PG8_SA(b, h) + aoff + m * 2048 + k * 1024); } while (0)
#define PG8_LDB(dst, b, h) do { _Pragma("unroll") for (int n = 0; n < 2; ++n) _Pragma("unroll") for (int k = 0; k < 2; ++k) dst[n][k] = *(const PG8_LAS bf16x8*)(lds + PG8_SB(b, h) + boff + n * 2048 + k * 1024); } while (0)
#define PG8_MMA(ai, bj, At, Bt) do { __builtin_amdgcn_s_setprio(1); _Pragma("unroll") for (int m = 0; m < 4; ++m) _Pragma("unroll") for (int n = 0; n < 2; ++n) \
        acc[ai][bj][m][n] = mma_k2<DT>(Bt[n], At[m], acc[ai][bj][m][n]); __builtin_amdgcn_s_setprio(0); } while (0)
#define PG8_WAIT_V(n) asm volatile("s_waitcnt vmcnt(" #n ")" ::: "memory")
#define PG8_WAIT_L(n) asm volatile("s_waitcnt lgkmcnt(" #n ")" ::: "memory")
#define PG8_BAR __builtin_amdgcn_s_barrier()
#define PG8_SCHED __builtin_amdgcn_sched_barrier(0)
    Unit cur, nxt; int ui = 0;
    if (!S.next(0, cur)) return;
    f32x4 acc[2][2][4][2];
#pragma unroll
    for (int a = 0; a < 2; ++a)
#pragma unroll
        for (int b = 0; b < 2; ++b)
#pragma unroll
            for (int m = 0; m < 4; ++m)
#pragma unroll
                for (int n = 0; n < 2; ++n) acc[a][b][m][n] = (f32x4){0.f, 0.f, 0.f, 0.f};
    bf16x8 At[4][2], B0[2][2], B1[2][2];
    const char* cA = (const char*)g.A + (size_t)cur.pm * tstepA + (size_t)cur.ko * 2; const char* cB = (const char*)g.Bt + (size_t)cur.pn * tstepB + (size_t)cur.ko * 2;
    S.a_ready(cur);
    E.pre(cur, lds + RS_LDS_OFF, wid);
    if constexpr (SP2) {
        PG8_STAGE(PG8_SB(0, 0), cB, voffB); PG8_STAGE(PG8_SB(0, 1), cB + hstepB, voffB); PG8_STAGE(PG8_SA(0, 0), cA, voffA); PG8_STAGE(PG8_SA(0, 1), cA + hstepA, voffA);
        if (wr == 1) PG8_BAR;
        PG8_WAIT_V(2); PG8_BAR;
        PG8_STAGE(PG8_SB(1, 0), cB + kstep, voffB); PG8_STAGE(PG8_SA(1, 0), cA + kstep, voffA); PG8_STAGE(PG8_SB(1, 1), cB + hstepB + kstep, voffB);
        PG8_WAIT_V(6); PG8_BAR;
    } else {
        PG8_STAGE(PG8_SB(0, 0), cB, voffB); PG8_STAGE(PG8_SA(0, 0), cA, voffA); PG8_STAGE(PG8_SB(0, 1), cB + hstepB, voffB); PG8_STAGE(PG8_SA(0, 1), cA + hstepA, voffA);
        if (wr == 1) PG8_BAR;
        PG8_WAIT_V(4); PG8_BAR;
        PG8_STAGE(PG8_SB(1, 0), cB + kstep, voffB); PG8_STAGE(PG8_SA(1, 0), cA + kstep, voffA); PG8_STAGE(PG8_SB(1, 1), cB + hstepB + kstep, voffB);
        PG8_WAIT_V(6); PG8_BAR;
    }
    for (;;) {
        const bool has_next = S.next(ui + 1, nxt);
        const char* nA = has_next ? (const char*)g.A + (size_t)nxt.pm * tstepA + (size_t)nxt.ko * 2 : cA; const char* nB = has_next ? (const char*)g.Bt + (size_t)nxt.pn * tstepB + (size_t)nxt.ko * 2 : cB;
        for (int t = 0; t < nt; t += 2) {
            const bool last = (t == nt - 2);
            const char* a1 = cA + (size_t)(t + 1) * kstep;
            const char* a2 = last ? nA : cA + (size_t)(t + 2) * kstep; const char* b2 = last ? nB : cB + (size_t)(t + 2) * kstep;
            const char* a3 = a2 + kstep; const char* b3 = b2 + kstep;
            if (last && has_next) { S.a_ready(nxt); E.pre(nxt, lds + RS_LDS_OFF + ((ui + 1) & 1) * 1024, wid); }
            if constexpr (SP2) {
            PG8_LDB(B0, 0, 0); PG8_LDB(B1, 0, 1); PG8_SCHED; PG8_LDA(At, 0, 0); PG8_STAGE(PG8_SA(1, 1), a1 + hstepA, voffA);
            PG8_WAIT_V(8); PG8_WAIT_L(0); PG8_BAR; PG8_MMA(0, 0, At, B0); PG8_MMA(0, 1, At, B1); PG8_BAR; PG8_SCHED;
            PG8_LDA(At, 0, 1); PG8_STAGE(PG8_SB(0, 0), b2, voffB); PG8_STAGE(PG8_SB(0, 1), b2 + hstepB, voffB); PG8_STAGE(PG8_SA(0, 0), a2, voffA);
            PG8_WAIT_V(8); PG8_WAIT_L(0); PG8_BAR; PG8_MMA(1, 0, At, B0); PG8_MMA(1, 1, At, B1); PG8_BAR; PG8_SCHED;
            PG8_LDB(B0, 1, 0); PG8_LDB(B1, 1, 1); PG8_SCHED; PG8_LDA(At, 1, 0); PG8_STAGE(PG8_SA(0, 1), a2 + hstepA, voffA);
            PG8_WAIT_V(8); PG8_WAIT_L(0); PG8_BAR; PG8_MMA(0, 0, At, B0); PG8_MMA(0, 1, At, B1); PG8_BAR; PG8_SCHED;
            PG8_LDA(At, 1, 1); PG8_STAGE(PG8_SB(1, 0), b3, voffB); PG8_STAGE(PG8_SB(1, 1), b3 + hstepB, voffB); PG8_STAGE(PG8_SA(1, 0), a3, voffA);
            PG8_WAIT_V(8); PG8_WAIT_L(0); PG8_BAR; PG8_MMA(1, 0, At, B0); PG8_MMA(1, 1, At, B1); PG8_BAR; PG8_SCHED;
            } else {
            PG8_LDB(B0, 0, 0); PG8_SCHED; PG8_LDA(At, 0, 0); PG8_STAGE(PG8_SA(1, 1), a1 + hstepA, voffA);
            PG8_WAIT_L(8); PG8_BAR; PG8_WAIT_L(0); PG8_MMA(0, 0, At, B0); PG8_BAR; PG8_SCHED;
            PG8_LDB(B1, 0, 1); PG8_STAGE(PG8_SB(0, 0), b2, voffB);
            PG8_BAR; PG8_WAIT_L(0); PG8_MMA(0, 1, At, B1); PG8_BAR;
            PG8_LDA(At, 0, 1); PG8_STAGE(PG8_SA(0, 0), a2, voffA);
            PG8_BAR; PG8_WAIT_L(0); PG8_MMA(1, 0, At, B0); PG8_BAR; PG8_SCHED;
            PG8_STAGE(PG8_SB(0, 1), b2 + hstepB, voffB);
            PG8_WAIT_V(6); PG8_BAR; PG8_MMA(1, 1, At, B1); PG8_BAR;
            PG8_LDB(B0, 1, 0); PG8_SCHED; PG8_LDA(At, 1, 0); PG8_STAGE(PG8_SA(0, 1), a2 + hstepA, voffA);
            PG8_WAIT_L(8); PG8_BAR; PG8_WAIT_L(0); PG8_MMA(0, 0, At, B0); PG8_BAR; PG8_SCHED;
            PG8_LDB(B1, 1, 1); PG8_STAGE(PG8_SB(1, 0), b3, voffB);
            PG8_BAR; PG8_WAIT_L(0); PG8_MMA(0, 1, At, B1); PG8_BAR;
            PG8_LDA(At, 1, 1); PG8_STAGE(PG8_SA(1, 0), a3, voffA);
            PG8_BAR; PG8_WAIT_L(0); PG8_MMA(1, 0, At, B0); PG8_BAR; PG8_SCHED;
            PG8_STAGE(PG8_SB(1, 1), b3 + hstepB, voffB);
            PG8_WAIT_V(6); PG8_BAR; PG8_MMA(1, 1, At, B1); PG8_BAR;
            }
        }
        if constexpr (ALIGN_EPI) { if (wr == 0) PG8_BAR; }
        if constexpr (!Epi::AFTER_DRAIN) { int l2; asm volatile("v_mbcnt_lo_u32_b32 %0, -1, 0\n\tv_mbcnt_hi_u32_b32 %0, -1, %0" : "=v"(l2));
            E(acc, cur, wr, wc, l2 & 15, l2 >> 4, (const PG8_LAS float*)(lds + RS_LDS_OFF + (ui & 1) * 1024)); S.done(cur); }
        if (!has_next) break;
#pragma unroll
        for (int a = 0; a < 2; ++a)
#pragma unroll
            for (int b = 0; b < 2; ++b)
#pragma unroll
                for (int m = 0; m < 4; ++m)
#pragma unroll
                    for (int n = 0; n < 2; ++n) acc[a][b][m][n] = (f32x4){0.f, 0.f, 0.f, 0.f};
        cur = nxt; cA = nA; cB = nB; ++ui;
        if constexpr (ALIGN_EPI) { if (wr == 1) PG8_BAR; }
    }
    PG8_WAIT_V(0);
    if constexpr (!ALIGN_EPI) { if (wr == 0) PG8_BAR; }
    PG8_BAR;
    if constexpr (Epi::AFTER_DRAIN) { E.fused(acc, cur, wr, wc, fr, fq, lds, wid, lane); S.done(cur); }
#undef PG8_SA
#undef PG8_SB
#undef PG8_STAGE
#undef PG8_LDA
#undef PG8_LDB
#undef PG8_MMA
#undef PG8_WAIT_V
#undef PG8_WAIT_L
#undef PG8_BAR
#undef PG8_SCHED
}
}
using pg8::sq8; using pg8::store8;

namespace att {
constexpr int SHM_V = 16384, SHM_K = 16384, SHM_K2 = 8192;
constexpr int OFF_V = 0, OFF_K = 2 * SHM_V, OFF_K2 = OFF_K + 2 * SHM_K, OFF_BIAS = OFF_K2 + 2 * SHM_K2, OFF_TBL = OFF_BIAS + 512, OFF_WS = OFF_TBL + 512, LDS_END = OFF_WS + 8 * 256;
constexpr float THR = 8.f;
#define KSWZ(row, colB) ((row) * 256 + ((colB) ^ (((row) & 15) << 4)))
#define K2SWZ(row, colB) ((row) * 128 + ((colB) ^ ((((row) >> 1) & 7) << 4)))
#define SBAR() __builtin_amdgcn_sched_barrier(0)
__device__ __forceinline__ int v_st(int k, int c) { const int kk = (k & ~0xC) | ((k & 4) << 1) | ((k & 8) >> 1); return ((kk >> 3) * 4 + (c >> 5)) * 512 + ((kk & 7) * 32 + (c & 31)) * 2; }
__device__ __forceinline__ int v_rd_base(int lane) { return ((lane & 3) << 3) | (((lane >> 2) & 3) << 6) | (((lane >> 4) & 1) << 5) | (((lane >> 5) & 1) << 8); }
constexpr int v_rd_off(int d0, int ks, int half) { return d0 * 512 + ks * 4096 + half * 2048; }
__device__ __forceinline__ int crow(int r, int hi) { return (r & 3) + 8 * (r >> 2) + 4 * hi; }

template <int MODE> struct Cfg { static constexpr float SCALE = (MODE == 1) ? 0.07216878364870322f : 0.08838834764831845f; static constexpr int DK = (MODE == 1) ? 192 : 128; };

__device__ __forceinline__ void mask_tile(f32x16& p0, f32x16& p1, int lim) {
    const float NEG = -__builtin_inff();
#pragma unroll
    for (int r = 0; r < 16; ++r) {
        const int c = (r & 3) + 8 * (r >> 2);
        if (c > lim) p0[r] = NEG;
        if (c + 32 > lim) p1[r] = NEG;
    }
}
__device__ __forceinline__ void t5_bias(f32x16& p0, f32x16& p1, const LAS float* tbl, int dd) {
#pragma unroll
    for (int g = 0; g < 4; ++g) {
#pragma unroll
        for (int j = 0; j < 4; ++j) { const int r = 4 * g + j, c = (r & 3) + 8 * (r >> 2);
            int i0 = dd - c; i0 = i0 < 0 ? 0 : (i0 > 127 ? 127 : i0);
            int i1 = dd - c - 32; i1 = i1 < 0 ? 0 : (i1 > 127 ? 127 : i1);
            p0[r] += tbl[i0]; p1[r] += tbl[i1]; }
        asm volatile("" ::: "memory");
    }
}
template <int MODE>
__device__ __forceinline__ void partialSM(f32x16& p0, f32x16& p1, float& m_reg, float& mn, float& alpha) {
    constexpr float SCALE = Cfg<MODE>::SCALE;
    float pmax = p0[0];
#pragma unroll
    for (int r = 1; r < 16; ++r) pmax = fmaxf(pmax, p0[r]);
#pragma unroll
    for (int r = 0; r < 16; ++r) pmax = fmaxf(pmax, p1[r]);
    { auto rr = __builtin_amdgcn_permlane32_swap(__float_as_uint(pmax), __float_as_uint(pmax), false, false);
      pmax = fmaxf(__uint_as_float(rr[0]), __uint_as_float(rr[1])); }
    constexpr float C2 = 1.4426950408889634f * SCALE;
    if (__builtin_expect(__all((pmax - m_reg) * SCALE <= THR), 1)) { mn = m_reg; alpha = 1.f; }
    else { mn = fmaxf(m_reg, pmax); alpha = __builtin_amdgcn_exp2f((m_reg - mn) * C2); m_reg = mn; }
    const float mnL = -mn * C2;
#pragma unroll
    for (int r = 0; r < 16; ++r) p0[r] = fmaf(p0[r], C2, mnL);
#pragma unroll
    for (int r = 0; r < 16; ++r) p1[r] = fmaf(p1[r], C2, mnL);
#pragma unroll
    for (int r = 0; r < 16; ++r) p0[r] = __builtin_amdgcn_exp2f(p0[r]);
}
__device__ __forceinline__ void finishSM(f32x16& p0, f32x16& p1, float alpha, float& l_reg, bf16x8& pa0, bf16x8& pa1, bf16x8& pa2, bf16x8& pa3) {
#pragma unroll
    for (int r = 0; r < 16; ++r) p1[r] = __builtin_amdgcn_exp2f(p1[r]);
    float ps = 0;
#pragma unroll
    for (int r = 0; r < 16; ++r) ps += p0[r];
#pragma unroll
    for (int r = 0; r < 16; ++r) ps += p1[r];
    { auto rr = __builtin_amdgcn_permlane32_swap(__float_as_uint(ps), __float_as_uint(ps), false, false);
      ps = __uint_as_float(rr[0]) + __uint_as_float(rr[1]); }
    l_reg = l_reg * alpha + ps;
#define PK4(P, B_, OUT) do { unsigned a0 = cvt_pk_bf16(P[B_+0], P[B_+1]), a1 = cvt_pk_bf16(P[B_+2], P[B_+3]);                          \
        unsigned b0 = cvt_pk_bf16(P[B_+4], P[B_+5]), b1 = cvt_pk_bf16(P[B_+6], P[B_+7]);                                             \
        auto r0 = __builtin_amdgcn_permlane32_swap(a0, b0, false, false); auto r1 = __builtin_amdgcn_permlane32_swap(a1, b1, false, false); \
        u32x4 w = {r0[0], r1[0], r0[1], r1[1]}; OUT = *reinterpret_cast<bf16x8*>(&w); } while (0)
    PK4(p0, 0, pa0); PK4(p0, 8, pa1); PK4(p1, 0, pa2); PK4(p1, 8, pa3);
#undef PK4
}
template <int MODE>
__device__ __forceinline__ void qkt(f32x16& p0, f32x16& p1, const LAS char* Kt, const LAS char* K2t, const LAS float* biasL, int r32, int hi, const bf16x8* qr) {
    if constexpr (MODE == 0) {
        const LAS f32x4* bl = (const LAS f32x4*)biasL;
#pragma unroll
        for (int g = 0; g < 4; ++g) { const f32x4 a = bl[2 * g + hi], b = bl[8 + 2 * g + hi];
#pragma unroll
            for (int j = 0; j < 4; ++j) { p0[4 * g + j] = a[j]; p1[4 * g + j] = b[j]; } }
    } else { p0 = f32x16{}; p1 = f32x16{}; }
    const int kg_ = ((r32 & 15) << 4) ^ (hi << 4);
    const LAS char* kr_ = Kt + r32 * 256;
    __builtin_amdgcn_s_setprio(1);
#pragma unroll
    for (int d0 = 0; d0 < 8; ++d0) { const LAS char* a = kr_ + (kg_ ^ (d0 << 5));
        const bf16x8 b0 = *reinterpret_cast<const LAS bf16x8*>(a);
        const bf16x8 b1 = *reinterpret_cast<const LAS bf16x8*>(a + 32 * 256);
        p0 = __builtin_amdgcn_mfma_f32_32x32x16_bf16(b0, qr[d0], p0, 0, 0, 0);
        p1 = __builtin_amdgcn_mfma_f32_32x32x16_bf16(b1, qr[d0], p1, 0, 0, 0); }
    if constexpr (MODE == 1) {
#pragma unroll
        for (int d0 = 0; d0 < 4; ++d0) { const LAS char* a = K2t + K2SWZ(r32, (d0 * 16 + hi * 8) * 2);
            const bf16x8 b0 = *reinterpret_cast<const LAS bf16x8*>(a);
            const bf16x8 b1 = *reinterpret_cast<const LAS bf16x8*>(a + 32 * 128);
            p0 = __builtin_amdgcn_mfma_f32_32x32x16_bf16(b0, qr[8 + d0], p0, 0, 0, 0);
            p1 = __builtin_amdgcn_mfma_f32_32x32x16_bf16(b1, qr[8 + d0], p1, 0, 0, 0); }
    }
    __builtin_amdgcn_s_setprio(0);
}
__device__ __forceinline__ void pv_tile(f32x16* o, unsigned vb0, bf16x8 pa0, bf16x8 pa1, bf16x8 pa2, bf16x8 pa3) {
#define TRRD(dst, off) asm volatile("ds_read_b64_tr_b16 %0, %1 offset:%2" : "=&v"(dst) : "v"(vb0), "i"(off) : "memory")
#define PV_D0(d0) do { s16x4 l0, l1, l2, l3, h0, h1, h2, h3; constexpr int b_ = v_rd_off(d0, 0, 0);     \
        TRRD(l0, b_); TRRD(h0, b_ + 2048); TRRD(l1, b_ + 4096); TRRD(h1, b_ + 6144); TRRD(l2, b_ + 8192); TRRD(h2, b_ + 10240); TRRD(l3, b_ + 12288); TRRD(h3, b_ + 14336); \
        asm volatile("s_waitcnt lgkmcnt(0)" ::: "memory"); SBAR();   \
        o[d0] = __builtin_amdgcn_mfma_f32_32x32x16_bf16(pa0, (bf16x8){l0[0], l0[1], l0[2], l0[3], h0[0], h0[1], h0[2], h0[3]}, o[d0], 0, 0, 0);   \
        o[d0] = __builtin_amdgcn_mfma_f32_32x32x16_bf16(pa1, (bf16x8){l1[0], l1[1], l1[2], l1[3], h1[0], h1[1], h1[2], h1[3]}, o[d0], 0, 0, 0);   \
        o[d0] = __builtin_amdgcn_mfma_f32_32x32x16_bf16(pa2, (bf16x8){l2[0], l2[1], l2[2], l2[3], h2[0], h2[1], h2[2], h2[3]}, o[d0], 0, 0, 0);   \
        o[d0] = __builtin_amdgcn_mfma_f32_32x32x16_bf16(pa3, (bf16x8){l3[0], l3[1], l3[2], l3[3], h3[0], h3[1], h3[2], h3[3]}, o[d0], 0, 0, 0); } while (0)
    __builtin_amdgcn_s_setprio(1);
    PV_D0(0); PV_D0(1); PV_D0(2); PV_D0(3);
    __builtin_amdgcn_s_setprio(0);
#undef PV_D0
#undef TRRD
}

struct PassArgs {
    const bf16_t* Q; const bf16_t* Q2; const bf16_t* K; const bf16_t* K2; const bf16_t* V; const float* cum;
    int ldq, ldq2, ldk, ldk2, ldv;
    int krow0;
    int qvp0;
    int NT;
    int shift0;
};
template <int MODE>
__device__ __forceinline__ void attn_pass(const PassArgs& a, LAS char* lds, f32x16 (&o)[4], const int tid) {
    constexpr int DK = Cfg<MODE>::DK;
    constexpr float SCALE = Cfg<MODE>::SCALE, INV_SCALE = 1.0f / SCALE;
    const int wid = __builtin_amdgcn_readfirstlane(tid >> 6), lane = tid & 63, r32 = lane & 31, hi = lane >> 5;
    bf16x8 qr[DK / 16];
    { const bf16_t* qp = a.Q + (size_t)(wid * 32 + r32) * a.ldq + hi * 8;
#pragma unroll
      for (int d0 = 0; d0 < 8; ++d0) qr[d0] = *(const bf16x8*)(qp + d0 * 16);
      if constexpr (MODE == 1) { const bf16_t* qp2 = a.Q2 + (size_t)(wid * 32 + r32) * a.ldq2 + hi * 8;
#pragma unroll
          for (int d0 = 0; d0 < 4; ++d0) qr[8 + d0] = *(const bf16x8*)(qp2 + d0 * 16); } }
    const int sr = tid >> 4, sc = (tid & 15) * 8, kws = KSWZ(sr, sc * 2), vst0 = v_st(sr, sc), vst1 = v_st(32 + sr, sc);
    const int sr2 = tid >> 3, sc2 = (tid & 7) * 8, k2ws = K2SWZ(sr2, sc2 * 2);
    bf16x8 st_k0, st_k1, st_v0, st_v1, st_k2; float st_b = 0.f;
#define TROW(t) ((t) == 0 ? META0 : a.krow0 + ((t) - 1) * 64)
#define ISSUE(t) do { const int tr_ = TROW(t); const size_t r0_ = (size_t)(tr_ + sr);                                             \
        st_k0 = *(const bf16x8*)(a.K + r0_ * a.ldk + sc); st_k1 = *(const bf16x8*)(a.K + (r0_ + 32) * a.ldk + sc);                 \
        st_v0 = *(const bf16x8*)(a.V + r0_ * a.ldv + sc); st_v1 = *(const bf16x8*)(a.V + (r0_ + 32) * a.ldv + sc);                 \
        if constexpr (MODE == 1) st_k2 = *(const bf16x8*)(a.K2 + (size_t)(tr_ + sr2) * a.ldk2 + sc2);                              \
        if constexpr (MODE == 0) { if (tid < 64) st_b = a.cum[tr_ + tid]; } } while (0)
#define WRITE(bf) do { *(LAS bf16x8*)(lds + OFF_K + (bf) * SHM_K + kws) = st_k0; *(LAS bf16x8*)(lds + OFF_K + (bf) * SHM_K + kws + 32 * 256) = st_k1;   \
        *(LAS bf16x8*)(lds + OFF_V + (bf) * SHM_V + vst0) = st_v0; *(LAS bf16x8*)(lds + OFF_V + (bf) * SHM_V + vst1) = st_v1;                        \
        if constexpr (MODE == 1) *(LAS bf16x8*)(lds + OFF_K2 + (bf) * SHM_K2 + k2ws) = st_k2;                                                       \
        if constexpr (MODE == 0) { if (tid < 64) ((LAS float*)(lds + OFF_BIAS + (bf) * 256))[tid] = -st_b * INV_SCALE; } } while (0)
    ISSUE(0);
    WRITE(0);
    __syncthreads();
    float m_reg = -1e30f, l_reg = 0.f;
#pragma unroll
    for (int d = 0; d < 4; ++d) o[d] = f32x16{};
    const int qlo = a.qvp0 + wid * 32, qv = qlo + r32;
    LAS float* li_l = (LAS float*)(lds + OFF_WS + wid * 256); LAS float* al_l = li_l + 32;
    const LAS float* tbl = (const LAS float*)(lds + OFF_TBL);
    const unsigned vbase = (unsigned)(uintptr_t)(lds + OFF_V) + (unsigned)v_rd_base(lane);
    const int NT = a.NT;
    for (int t = 0; t < NT; ++t) {
        const int cur = t & 1;
        if (t + 1 < NT) ISSUE(t + 1);
        const int kb = 64 * t;
        if (t == 0 || kb <= qlo + 31) {
        f32x16 p0, p1;
        qkt<MODE>(p0, p1, lds + OFF_K + cur * SHM_K, lds + OFF_K2 + cur * SHM_K2, (const LAS float*)(lds + OFF_BIAS + cur * 256), r32, hi, qr);
        if constexpr (MODE == 2) { const int sh = t == 0 ? a.shift0 : 0; if (qlo - sh - (kb + 63) <= 112) t5_bias(p0, p1, tbl, qv - kb - sh - 4 * hi); }
        if (t == 0 || kb + 63 > qlo) { int lim = qv - kb; const int tm = t == 0 ? 15 : 63; lim = (lim < tm ? lim : tm) - 4 * hi; mask_tile(p0, p1, lim); }
        float mn, alpha;
        partialSM<MODE>(p0, p1, m_reg, mn, alpha);
        if (__any(alpha < 1.f)) { if (hi == 0) al_l[r32] = alpha; asm volatile("s_waitcnt lgkmcnt(0)" ::: "memory");
#pragma unroll
            for (int r = 0; r < 16; ++r) { const float av = al_l[crow(r, hi)];
#pragma unroll
                for (int d = 0; d < 4; ++d) o[d][r] *= av; } }
        bf16x8 pa0, pa1, pa2, pa3;
        finishSM(p0, p1, alpha, l_reg, pa0, pa1, pa2, pa3);
        pv_tile(o, vbase + (unsigned)(cur * SHM_V), pa0, pa1, pa2, pa3);
        }
        if (t + 1 < NT) WRITE(cur ^ 1);
        __syncthreads();
    }
    if (hi == 0) li_l[r32] = l_reg;
    asm volatile("s_waitcnt lgkmcnt(0)" ::: "memory");
#pragma unroll
    for (int r = 0; r < 16; ++r) { const float rl = __builtin_amdgcn_rcpf(li_l[crow(r, hi)]);
#pragma unroll
        for (int d = 0; d < 4; ++d) o[d][r] *= rl; }
#undef TROW
#undef ISSUE
#undef WRITE
}
template <int MODE>
__device__ __forceinline__ void attn_pass_dma(const PassArgs& a, LAS char* lds, f32x16 (&o)[4], const int tid) {
    constexpr int DK = Cfg<MODE>::DK;
    constexpr float SCALE = Cfg<MODE>::SCALE, INV_SCALE = 1.0f / SCALE;
    const int wid = __builtin_amdgcn_readfirstlane(tid >> 6);
    bf16x8 qr[DK / 16];
    { const int lane = tid & 63, r32 = lane & 31, hi = lane >> 5; const bf16_t* qp = a.Q + (size_t)(wid * 32 + r32) * a.ldq + hi * 8;
#pragma unroll
      for (int d0 = 0; d0 < 8; ++d0) qr[d0] = *(const bf16x8*)(qp + d0 * 16);
      if constexpr (MODE == 1) { const bf16_t* qp2 = a.Q2 + (size_t)(wid * 32 + r32) * a.ldq2 + hi * 8;
#pragma unroll
          for (int d0 = 0; d0 < 4; ++d0) qr[8 + d0] = *(const bf16x8*)(qp2 + d0 * 16); } }
    float st_b = 0.f;
#define TROW(t) ((t) == 0 ? META0 : a.krow0 + ((t) - 1) * 64)
#define DMA16(gp, ldsoff) __builtin_amdgcn_global_load_lds((const unsigned*)(gp), (LAS unsigned*)(lds + (ldsoff)), 16, 0, 0)
#define ISSUE_D(t, bf) do { int tl_ = tid; asm volatile("" : "+v"(tl_)); const int tr_ = TROW(t);                                         \
        const int krow = tl_ >> 4, kcol = ((tl_ & 15) ^ (krow & 15)) * 8;                                                                \
        const int vkk = ((tl_ >> 7) << 3) | ((tl_ & 31) >> 2), vrow = (vkk & ~0xC) | ((vkk & 4) << 1) | ((vkk & 8) >> 1), vcol = ((tl_ >> 5) & 3) * 32 + (tl_ & 3) * 8;   \
        _Pragma("unroll") for (int i_ = 0; i_ < 2; ++i_) DMA16(a.K + (size_t)(tr_ + krow + 32 * i_) * a.ldk + kcol, OFF_K + (bf) * SHM_K + i_ * 8192 + wid * 1024);   \
        _Pragma("unroll") for (int i_ = 0; i_ < 2; ++i_) DMA16(a.V + (size_t)(tr_ + vrow + 32 * i_) * a.ldv + vcol, OFF_V + (bf) * SHM_V + i_ * 8192 + wid * 1024);   \
        if constexpr (MODE == 1) { const int r2_ = tl_ >> 3, c2_ = ((tl_ & 7) ^ ((r2_ >> 1) & 7)) * 8; DMA16(a.K2 + (size_t)(tr_ + r2_) * a.ldk2 + c2_, OFF_K2 + (bf) * SHM_K2 + wid * 1024); } \
        if constexpr (MODE == 0) { if (tl_ < 64) st_b = a.cum[tr_ + tl_]; } } while (0)
#define WRITE_B(bf) do { if constexpr (MODE == 0) { int tl_ = tid; asm volatile("" : "+v"(tl_)); if (tl_ < 64) ((LAS float*)(lds + OFF_BIAS + (bf) * 256))[tl_] = -st_b * INV_SCALE; } } while (0)
    ISSUE_D(0, 0);
    WRITE_B(0);
    asm volatile("s_waitcnt vmcnt(0)" ::: "memory");
    __syncthreads();
    float m_reg = -1e30f, l_reg = 0.f;
#pragma unroll
    for (int d = 0; d < 4; ++d) o[d] = f32x16{};
    const int NT = a.NT;
    for (int t = 0; t < NT; ++t) {
        const int cur = t & 1;
        if (t + 1 < NT) ISSUE_D(t + 1, cur ^ 1);
        int tl = tid; asm volatile("" : "+v"(tl));
        const int lane = tl & 63, r32 = lane & 31, hi = lane >> 5;
        const int qlo = a.qvp0 + wid * 32, qv = qlo + r32;
        LAS float* al_l = (LAS float*)(lds + OFF_WS + wid * 256) + 32;
        const int kb = 64 * t;
        if (t == 0 || kb <= qlo + 31) {
        f32x16 p0, p1;
        qkt<MODE>(p0, p1, lds + OFF_K + cur * SHM_K, lds + OFF_K2 + cur * SHM_K2, (const LAS float*)(lds + OFF_BIAS + cur * 256), r32, hi, qr);
        if (t == 0 || kb + 63 > qlo) { int lim = qv - kb; const int tm = t == 0 ? 15 : 63; lim = (lim < tm ? lim : tm) - 4 * hi; mask_tile(p0, p1, lim); }
        float mn, alpha;
        partialSM<MODE>(p0, p1, m_reg, mn, alpha);
        if (__any(alpha < 1.f)) { if (hi == 0) al_l[r32] = alpha; asm volatile("s_waitcnt lgkmcnt(0)" ::: "memory");
#pragma unroll
            for (int r = 0; r < 16; ++r) { const float av = al_l[crow(r, hi)];
#pragma unroll
                for (int d = 0; d < 4; ++d) o[d][r] *= av; } }
        bf16x8 pa0, pa1, pa2, pa3;
        finishSM(p0, p1, alpha, l_reg, pa0, pa1, pa2, pa3);
        pv_tile(o, (unsigned)(uintptr_t)(lds + OFF_V) + (unsigned)v_rd_base(lane) + (unsigned)(cur * SHM_V), pa0, pa1, pa2, pa3);
        }
        if (t + 1 < NT) WRITE_B(cur ^ 1);
        asm volatile("s_waitcnt vmcnt(0)" ::: "memory");
        __syncthreads();
    }
    { int tl = tid; asm volatile("" : "+v"(tl));
      const int lane = tl & 63, r32 = lane & 31, hi = lane >> 5;
      LAS float* li_l = (LAS float*)(lds + OFF_WS + wid * 256);
      if (hi == 0) li_l[r32] = l_reg;
      asm volatile("s_waitcnt lgkmcnt(0)" ::: "memory");
#pragma unroll
      for (int r = 0; r < 16; ++r) { const float rl = __builtin_amdgcn_rcpf(li_l[crow(r, hi)]);
#pragma unroll
          for (int d = 0; d < 4; ++d) o[d][r] *= rl; } }
#undef TROW
#undef DMA16
#undef ISSUE_D
#undef WRITE_B
}
constexpr int D_OFF_V = 0  , D_OFF_K = 65536  , D_OFF_TBL = 98304, D_OFF_WS = D_OFF_TBL + 512, D_LDS_END = D_OFF_WS + 8 * 256;
__device__ __forceinline__ void attn_pass_diff(const PassArgs& a, LAS char* lds, f32x16 (&o)[8], const int tid) {
    const int wid = __builtin_amdgcn_readfirstlane(tid >> 6);
    bf16x8 qr[8];
    { const int lane = tid & 63, r32 = lane & 31, hi = lane >> 5; const bf16_t* qp = a.Q + (size_t)(wid * 32 + r32) * a.ldq + hi * 8;
#pragma unroll
      for (int d0 = 0; d0 < 8; ++d0) qr[d0] = *(const bf16x8*)(qp + d0 * 16); }
#define TROW(t) ((t) == 0 ? META0 : a.krow0 + ((t) - 1) * 64)
#define DMA16(gp, ldsoff) __builtin_amdgcn_global_load_lds((const unsigned*)(gp), (LAS unsigned*)(lds + (ldsoff)), 16, 0, 0)
#define ISSUE_D(t, bf) do { int tl_ = tid; asm volatile("" : "+v"(tl_)); const int tr_ = TROW(t);                                         \
        const int krow = tl_ >> 4, kcol = ((tl_ & 15) ^ (krow & 15)) * 8;                                                                \
        const int vkk = ((tl_ >> 7) << 3) | ((tl_ & 31) >> 2), vrow = (vkk & ~0xC) | ((vkk & 4) << 1) | ((vkk & 8) >> 1), vcol = ((tl_ >> 5) & 3) * 32 + (tl_ & 3) * 8;   \
        _Pragma("unroll") for (int i_ = 0; i_ < 2; ++i_) DMA16(a.K + (size_t)(tr_ + krow + 32 * i_) * a.ldk + kcol, D_OFF_K + (bf) * 16384 + i_ * 8192 + wid * 1024);   \
        _Pragma("unroll") for (int h_ = 0; h_ < 2; ++h_) _Pragma("unroll") for (int i_ = 0; i_ < 2; ++i_)                                 \
            DMA16(a.V + (size_t)(tr_ + vrow + 32 * i_) * a.ldv + h_ * 128 + vcol, D_OFF_V + (bf) * 32768 + h_ * 16384 + i_ * 8192 + wid * 1024); } while (0)
    ISSUE_D(0, 0);
    asm volatile("s_waitcnt vmcnt(0)" ::: "memory");
    __syncthreads();
    float m_reg = -1e30f, l_reg = 0.f;
#pragma unroll
    for (int d = 0; d < 8; ++d) o[d] = f32x16{};
    const int NT = a.NT;
    for (int t = 0; t < NT; ++t) {
        const int cur = t & 1;
        if (t + 1 < NT) ISSUE_D(t + 1, cur ^ 1);
        int tl = tid; asm volatile("" : "+v"(tl));
        const int lane = tl & 63, r32 = lane & 31, hi = lane >> 5;
        const int qlo = a.qvp0 + wid * 32, qv = qlo + r32;
        LAS float* al_l = (LAS float*)(lds + D_OFF_WS + wid * 256) + 32;
        const int kb = 64 * t;
        if (t == 0 || kb <= qlo + 31) {
        f32x16 p0, p1;
        qkt<2>(p0, p1, lds + D_OFF_K + cur * 16384, lds, (const LAS float*)lds, r32, hi, qr);
        { const int sh = t == 0 ? a.shift0 : 0; if (qlo - sh - (kb + 63) <= 112) t5_bias(p0, p1, (const LAS float*)(lds + D_OFF_TBL), qv - kb - sh - 4 * hi); }
        if (t == 0 || kb + 63 > qlo) { int lim = qv - kb; const int tm = t == 0 ? 15 : 63; lim = (lim < tm ? lim : tm) - 4 * hi; mask_tile(p0, p1, lim); }
        float mn, alpha;
        partialSM<2>(p0, p1, m_reg, mn, alpha);
        if (__any(alpha < 1.f)) { if (hi == 0) al_l[r32] = alpha; asm volatile("s_waitcnt lgkmcnt(0)" ::: "memory");
#pragma unroll
            for (int r = 0; r < 16; ++r) { const float av = al_l[crow(r, hi)];
#pragma unroll
                for (int d = 0; d < 8; ++d) o[d][r] *= av; } }
        bf16x8 pa0, pa1, pa2, pa3;
        finishSM(p0, p1, alpha, l_reg, pa0, pa1, pa2, pa3);
        const unsigned vbase = (unsigned)(uintptr_t)(lds + D_OFF_V) + (unsigned)v_rd_base(lane) + (unsigned)(cur * 32768);
        pv_tile(o, vbase, pa0, pa1, pa2, pa3);
        pv_tile(o + 4, vbase + 16384u, pa0, pa1, pa2, pa3);
        }
        asm volatile("s_waitcnt vmcnt(0)" ::: "memory");
        __syncthreads();
    }
    { int tl = tid; asm volatile("" : "+v"(tl));
      const int lane = tl & 63, r32 = lane & 31, hi = lane >> 5;
      LAS float* li_l = (LAS float*)(lds + D_OFF_WS + wid * 256);
      if (hi == 0) li_l[r32] = l_reg;
      asm volatile("s_waitcnt lgkmcnt(0)" ::: "memory");
#pragma unroll
      for (int r = 0; r < 16; ++r) { const float rl = __builtin_amdgcn_rcpf(li_l[crow(r, hi)]);
#pragma unroll
          for (int d = 0; d < 8; ++d) o[d][r] *= rl; } }
#undef TROW
#undef DMA16
#undef ISSUE_D
}
#ifdef PROBE_ATT
template <int PVAR  >
__device__ __forceinline__ void attn_pass_diff_probe(const PassArgs& a, LAS char* lds, f32x16 (&o)[8], const int tid) {
    const int wid = __builtin_amdgcn_readfirstlane(tid >> 6);
    bf16x8 qr[8];
    { const int lane = tid & 63, r32 = lane & 31, hi = lane >> 5; const bf16_t* qp = a.Q + (size_t)(wid * 32 + r32) * a.ldq + hi * 8;
#pragma unroll
      for (int d0 = 0; d0 < 8; ++d0) qr[d0] = *(const bf16x8*)(qp + d0 * 16); }
#define TROW(t) ((t) == 0 ? META0 : a.krow0 + ((t) - 1) * 64)
#define DMA16(gp, ldsoff) __builtin_amdgcn_global_load_lds((const unsigned*)(gp), (LAS unsigned*)(lds + (ldsoff)), 16, 0, 0)
#define ISSUE_D(t, bf) do { int tl_ = tid; asm volatile("" : "+v"(tl_)); const int tr_ = TROW(t);                                         \
        const int krow = tl_ >> 4, kcol = ((tl_ & 15) ^ (krow & 15)) * 8;                                                                \
        const int vkk = ((tl_ >> 7) << 3) | ((tl_ & 31) >> 2), vrow = (vkk & ~0xC) | ((vkk & 4) << 1) | ((vkk & 8) >> 1), vcol = ((tl_ >> 5) & 3) * 32 + (tl_ & 3) * 8;   \
        _Pragma("unroll") for (int i_ = 0; i_ < 2; ++i_) DMA16(a.K + (size_t)(tr_ + krow + 32 * i_) * a.ldk + kcol, D_OFF_K + (bf) * 16384 + i_ * 8192 + wid * 1024);   \
        _Pragma("unroll") for (int h_ = 0; h_ < 2; ++h_) _Pragma("unroll") for (int i_ = 0; i_ < 2; ++i_)                                 \
            DMA16(a.V + (size_t)(tr_ + vrow + 32 * i_) * a.ldv + h_ * 128 + vcol, D_OFF_V + (bf) * 32768 + h_ * 16384 + i_ * 8192 + wid * 1024); } while (0)
    ISSUE_D(0, 0);
    asm volatile("s_waitcnt vmcnt(0)" ::: "memory");
    __syncthreads();
    float m_reg = -1e30f, l_reg = 0.f;
#pragma unroll
    for (int d = 0; d < 8; ++d) o[d] = f32x16{};
    const int NT = a.NT;
    for (int t = 0; t < NT; ++t) {
        const int cur = t & 1;
        if constexpr (PVAR != 6 && PVAR != 8) { if (t + 1 < NT) ISSUE_D(t + 1, cur ^ 1); }
        int tl = tid; asm volatile("" : "+v"(tl));
        const int lane = tl & 63, r32 = lane & 31, hi = lane >> 5;
        const int qlo = a.qvp0 + wid * 32, qv = qlo + r32;
        LAS float* al_l = (LAS float*)(lds + D_OFF_WS + wid * 256) + 32;
        const int kb = 64 * t;
        if (t == 0 || kb <= qlo + 31) {
        f32x16 p0, p1;
        if constexpr (PVAR == 5 || PVAR == 7 || PVAR == 8) { p0 = f32x16{}; p1 = f32x16{};
#pragma unroll
            for (int d0 = 0; d0 < 8; ++d0) { p0 = __builtin_amdgcn_mfma_f32_32x32x16_bf16(qr[(d0 + 1) & 7], qr[d0], p0, 0, 0, 0); p1 = __builtin_amdgcn_mfma_f32_32x32x16_bf16(qr[(d0 + 3) & 7], qr[d0], p1, 0, 0, 0); } }
        else qkt<2>(p0, p1, lds + D_OFF_K + cur * 16384, lds, (const LAS float*)lds, r32, hi, qr);
        { const int sh = t == 0 ? a.shift0 : 0; if (qlo - sh - (kb + 63) <= 112) t5_bias(p0, p1, (const LAS float*)(lds + D_OFF_TBL), qv - kb - sh - 4 * hi); }
        if (t == 0 || kb + 63 > qlo) { int lim = qv - kb; const int tm = t == 0 ? 15 : 63; lim = (lim < tm ? lim : tm) - 4 * hi; mask_tile(p0, p1, lim); }
        float mn, alpha;
        partialSM<2>(p0, p1, m_reg, mn, alpha);
        if (__any(alpha < 1.f)) { if (hi == 0) al_l[r32] = alpha; asm volatile("s_waitcnt lgkmcnt(0)" ::: "memory");
#pragma unroll
            for (int r = 0; r < 16; ++r) { const float av = al_l[crow(r, hi)];
#pragma unroll
                for (int d = 0; d < 8; ++d) o[d][r] *= av; } }
        bf16x8 pa0, pa1, pa2, pa3;
        finishSM(p0, p1, alpha, l_reg, pa0, pa1, pa2, pa3);
        const unsigned vbase = (unsigned)(uintptr_t)(lds + D_OFF_V) + (unsigned)v_rd_base(lane) + (unsigned)(cur * 32768);
        if constexpr (PVAR == 4 || PVAR == 7 || PVAR == 8) {
#pragma unroll
            for (int d = 0; d < 8; ++d) { o[d] = __builtin_amdgcn_mfma_f32_32x32x16_bf16(pa0, pa1, o[d], 0, 0, 0); o[d] = __builtin_amdgcn_mfma_f32_32x32x16_bf16(pa1, pa2, o[d], 0, 0, 0);
                o[d] = __builtin_amdgcn_mfma_f32_32x32x16_bf16(pa2, pa3, o[d], 0, 0, 0); o[d] = __builtin_amdgcn_mfma_f32_32x32x16_bf16(pa3, pa0, o[d], 0, 0, 0); } }
        else { pv_tile(o, vbase, pa0, pa1, pa2, pa3); pv_tile(o + 4, vbase + 16384u, pa0, pa1, pa2, pa3); }
        }
        asm volatile("s_waitcnt vmcnt(0)" ::: "memory");
        __syncthreads();
    }
    { int tl = tid; asm volatile("" : "+v"(tl));
      const int lane = tl & 63, r32 = lane & 31, hi = lane >> 5;
      LAS float* li_l = (LAS float*)(lds + D_OFF_WS + wid * 256);
      if (hi == 0) li_l[r32] = l_reg;
      asm volatile("s_waitcnt lgkmcnt(0)" ::: "memory");
#pragma unroll
      for (int r = 0; r < 16; ++r) { const float rl = __builtin_amdgcn_rcpf(li_l[crow(r, hi)]);
#pragma unroll
          for (int d = 0; d < 8; ++d) o[d][r] *= rl; } }
#undef TROW
#undef DMA16
#undef ISSUE_D
}
#endif
__device__ __forceinline__ void store_o_bf16(const f32x16* o, bf16_t* Ow, int ldo, int tid) {
    asm volatile("" : "+v"(tid)); const int r32 = tid & 31, hi = (tid >> 5) & 1;
#pragma unroll
    for (int r = 0; r < 16; ++r) { const int orow = crow(r, hi);
#pragma unroll
        for (int d0 = 0; d0 < 4; ++d0) { const float v = o[d0][r]; const float vn = __shfl_xor(v, 1);
            if ((r32 & 1) == 0) *(GAS unsigned*)(Ow + (size_t)orow * ldo + d0 * 32 + r32) = cvt_pk_bf16(v, vn); }
        asm volatile("" ::: "memory"); }
}
}

constexpr size_t MiB = (size_t)1 << 20;
constexpr size_t WS_CTL = 0, CTL_ZERO_BYTES = 1 * MiB;
constexpr size_t WS_PRM = 1 * MiB;
constexpr size_t WS_COS = 2 * MiB, WS_SIN = 3 * MiB;
constexpr size_t WS_RSTD = 4 * MiB;
constexpr size_t WS_STATQ = 14 * MiB, WS_STATKV = 17 * MiB;
constexpr size_t WS_STATM = 5 * MiB;
constexpr size_t WS_FLOG = 10 * MiB, WS_CUM = 12 * MiB;
constexpr size_t WS_W = 20 * MiB;
constexpr size_t SZ_EVIN = 61 * MiB, SZ_UQ = 6 * MiB, SZ_UKV = 4 * MiB, SZ_SQ = 33 * MiB, SZ_ODIN = 98 * MiB, SZ_GU = 175 * MiB, SZ_DN = 87 * MiB;
constexpr size_t W_EVIN = WS_W, W_UQ = W_EVIN + 2 * SZ_EVIN, W_UKV = W_UQ + 2 * SZ_UQ, W_EVOUT = W_UKV + 2 * SZ_UKV, W_ODIN = W_EVOUT + 2 * SZ_SQ, W_ODOUT = W_ODIN + 2 * SZ_ODIN,
                 W_GU = W_ODOUT + 2 * SZ_SQ, W_DN = W_GU + DEPTH * SZ_GU;
constexpr size_t WS_HS = W_DN + DEPTH * SZ_DN;
constexpr size_t WS_HBF = WS_HS + 260 * MiB;
constexpr size_t WS_PROJ = WS_HBF + 133 * MiB;
constexpr size_t WS_QBUF = WS_PROJ + 246 * MiB, WS_KVBUF = WS_PROJ + 346 * MiB;
constexpr size_t WS_OBUF = WS_PROJ + 479 * MiB;
constexpr size_t WS_MBUF = WS_OBUF + 133 * MiB;
constexpr size_t WS_DSCR = WS_MBUF + 133 * MiB;
constexpr size_t WS_PART = WS_DSCR + 64 * MiB;
constexpr size_t WS_END = WS_PART + 12 * MiB;
static_assert((size_t)EV_N * LD_DM * 2 <= SZ_EVIN && (size_t)UQ_N * LD_QR * 2 <= SZ_UQ && (size_t)UKV_N * LD_KV * 2 <= SZ_UKV && (size_t)DM * LD_DM * 2 <= SZ_SQ && (size_t)OD_N * LD_DM * 2 <= SZ_ODIN && (size_t)GU_N * LD_DM * 2 <= SZ_GU && (size_t)DM * LD_FF * 2 <= SZ_DN, "weight sizes");
static_assert((size_t)MPAD * DM * 4 == 260 * MiB && (size_t)MPAD * LD_DM * 2 <= 133 * MiB && (size_t)MPAD * LD_EV * 2 <= 246 * MiB && (size_t)MPAD * LD_UQ * 2 <= 100 * MiB && (size_t)MPAD * LD_UKV * 2 <= 133 * MiB && (size_t)MPAD * LD_OD * 2 <= 479 * MiB && (size_t)MPAD * LD_FF * 2 <= 479 * MiB, "activation sizes");
constexpr int LD8 = 4864;
constexpr size_t WS_A8 = WS_PROJ + 352 * MiB, WS_RS8 = WS_RSTD + 512 * 1024;
constexpr size_t CTL_COLMAX = 65536;
constexpr int I8_IN_ODD = 3;
constexpr size_t CTL_COLMAX_OD = CTL_COLMAX + (size_t)DEPTH * GU_N * 4;
constexpr size_t W_OD8_OFF = 104 * MiB;
constexpr int I8_IN_EV = 2;
constexpr size_t CTL_COLMAX_EV = CTL_COLMAX_OD + 2 * (size_t)OD_N * 4;
static_assert(CTL_COLMAX_EV + 2 * (size_t)EV_N * 4 <= CTL_ZERO_BYTES && (size_t)EV_N * LD8 <= SZ_EVIN, "int8 even in-proj buffers");
static_assert(CTL_COLMAX_OD + 2 * (size_t)OD_N * 4 <= CTL_ZERO_BYTES && (size_t)GU_N * LD8 <= W_OD8_OFF && W_OD8_OFF + (size_t)OD_N * LD8 <= SZ_GU && (size_t)MPAD * LD8 <= 133 * MiB, "int8 in-proj buffers");
static_assert((size_t)MPAD * LD_FF * 2 <= 352 * MiB && 352 * MiB + (size_t)MPAD * LD8 <= 479 * MiB && (size_t)GU_N * LD8 <= SZ_GU && CTL_COLMAX + (size_t)DEPTH * GU_N * 4 <= CTL_ZERO_BYTES, "int8 buffers");
constexpr int I8_DN = 14;
constexpr int LD8F = 11136;
constexpr size_t CTL_COLMAX_DN = CTL_COLMAX_EV + 2 * (size_t)EV_N * 4;
constexpr size_t WS_ACT8 = WS_HS, WS_AMAXP = WS_HS + 180 * MiB, WS_RSD = WS_RSTD + 768 * 1024;
static_assert(CTL_COLMAX_DN + (size_t)DEPTH * DM * 4 <= CTL_ZERO_BYTES && (size_t)MPAD * LD8F <= 180 * MiB && 180 * MiB + (size_t)MPAD * AMAXP_LD * 4 <= 260 * MiB && (size_t)DM * LD8F <= SZ_DN && (GU_N / 256) * 4 <= AMAXP_LD, "int8 down buffers");
constexpr int CW_BAR = 4096;

constexpr int RING_BYTES = 131072;
constexpr int PRO_SCR_BYTES = 8 * 16640;
constexpr int MISC_OFF = 135168 + 320;
constexpr int LDS_BYTES = 147456;
static_assert(att::LDS_END <= RING_BYTES && att::D_LDS_END <= RING_BYTES && PRO_SCR_BYTES <= 135168 && MISC_OFF + 64 <= LDS_BYTES, "LDS map");

#define LDS_WAIT() asm volatile("s_waitcnt lgkmcnt(0)" ::: "memory")
#define VM_WAIT() asm volatile("s_waitcnt vmcnt(0)" ::: "memory")

#define XB_TMO      128
#define XB_XCNT(j)  (256  + 64 * (j))
#define XB_XSUB(j)  (1280 + 64 * (j))
#define XB_XGEN(j)  (2304 + 64 * (j))
#define XB_TOP      3328
#define XB_TOPGEN   3392
#define XCD_BAR_WORDS 3456
#define XB_SPIN_CAP (1u << 18)

__device__ __forceinline__ unsigned xb_ld(unsigned* p)              { return __hip_atomic_load(p, __ATOMIC_RELAXED, __HIP_MEMORY_SCOPE_AGENT); }
__device__ __forceinline__ unsigned xb_add(unsigned* p, unsigned v) { return __hip_atomic_fetch_add(p, v, __ATOMIC_RELAXED, __HIP_MEMORY_SCOPE_AGENT); }
__device__ __forceinline__ unsigned xb_xcc_id() { return (unsigned)__builtin_amdgcn_s_getreg((3 << 11) | 20) & 0xFu; }
#define XB_SPIN(cond, bar) do { unsigned _sp = 0; while (cond) { __builtin_amdgcn_s_sleep(1); \
    if ((++_sp & 255u) == 0u) { if (xb_ld(&(bar)[XB_TMO])) break; if (_sp > XB_SPIN_CAP) { atomicAdd(&(bar)[XB_TMO], 1u); break; } } } } while (0)

struct XcdBarrier {
    unsigned* bar; unsigned x;
    volatile LAS unsigned* st;
};

__device__ __forceinline__ XcdBarrier xcd_barrier_post(unsigned* bar, volatile LAS unsigned* st, int tid) {
    XcdBarrier b; b.bar = bar; b.x = xb_xcc_id(); b.st = st;
    if (tid == 0) (void)xb_add(&bar[XB_XCNT(b.x)], 1u);
    return b;
}
__device__ __forceinline__ void xcd_barrier_complete(unsigned* bar, unsigned x, unsigned& nloc, unsigned& nx) {
    const unsigned G = gridDim.x * gridDim.y * gridDim.z;
    unsigned sum, cnt, mine, sp = 0u;
    for (;;) {
        sum = 0u; cnt = 0u; mine = 0u;
#pragma unroll
        for (unsigned j = 0; j < 16; ++j) { const unsigned c = xb_ld(&bar[XB_XCNT(j)]); sum += c; cnt += (c > 0u) ? 1u : 0u; mine = (j == x) ? c : mine; }
        if (sum == G) break;
        __builtin_amdgcn_s_sleep(1);
        if ((++sp & 255u) == 0u) { if (xb_ld(&bar[XB_TMO])) break; if (sp > XB_SPIN_CAP) { atomicAdd(&bar[XB_TMO], 1u); break; } }
    }
    nloc = mine > 0u ? mine : 1u; nx = cnt > 0u ? cnt : 1u;
}

__device__ __forceinline__ void xcd_barrier(const XcdBarrier& b, int tid) {
    asm volatile("s_waitcnt vmcnt(0)" ::: "memory");
    __syncthreads();
    if (tid == 0) {
        unsigned* bar = b.bar;
        __builtin_amdgcn_s_waitcnt(0);
        unsigned nloc = b.st[0], nx = b.st[1];
        if (nloc == 0u) { xcd_barrier_complete(bar, b.x, nloc, nx); b.st[0] = nloc; b.st[1] = nx; }
        const unsigned old = xb_add(&bar[XB_XSUB(b.x)], 1u);
        const unsigned gen = old / nloc;
        if (old + 1u == (gen + 1u) * nloc) {
            __builtin_amdgcn_fence(__ATOMIC_RELEASE, "agent");
            asm volatile("s_waitcnt vmcnt(0)" ::: "memory");
            const unsigned og = xb_add(&bar[XB_TOP], 1u);
            const unsigned tg = og / nx;
            if (og + 1u == (tg + 1u) * nx) xb_add(&bar[XB_TOPGEN], 1u);
            else XB_SPIN(xb_ld(&bar[XB_TOPGEN]) == tg, bar);
            __builtin_amdgcn_fence(__ATOMIC_ACQUIRE, "agent");
            xb_add(&bar[XB_XGEN(b.x)], 1u);
            asm volatile("s_waitcnt vmcnt(0)" ::: "memory");
        } else {
            XB_SPIN(xb_ld(&bar[XB_XGEN(b.x)]) == gen, bar);
            __builtin_amdgcn_fence(__ATOMIC_ACQUIRE, "agent");
            asm volatile("s_waitcnt vmcnt(0)" ::: "memory");
        }
    }
    __syncthreads();
}

struct Args { const float* in[18]; float* out; unsigned char* ws; int ph_lo, ph_hi; float lam_init[2]; };
enum { IN_X = 0, IN_META, IN_RELB, IN_EVWIN, IN_EVBF, IN_EVQN, IN_EVKVN, IN_EVWUQ, IN_EVWUKV, IN_EVWOUT, IN_ODWIN, IN_ODLAM, IN_ODSUBLN, IN_ODWOUT, IN_NORMG, IN_WGATE, IN_WUP, IN_WDOWN };

struct Frame {
    LAS unsigned char* lds;
    int tid, lane, wave, vcu, G, bx;
    unsigned char* ws;
};

__device__ __forceinline__ int ropeperm(int j) { const int a = j >> 3, e = j & 7; return e < 4 ? 4 * a + e : 32 + 4 * a + (e - 4); }
struct CvtDesc { const float* W; int N, srccol; const float* gain; int Ksrc, k0; bf16_t* WT; int Kdst, dstrow0; const float* cmax; int had; };
__device__ __forceinline__ unsigned pk4_i8(float a, float b, float c, float d) {
    const float M = 12582912.0f;
    const unsigned ab = __builtin_amdgcn_perm(__float_as_uint(b + M), __float_as_uint(a + M), 0x0c0c0400u), cd = __builtin_amdgcn_perm(__float_as_uint(d + M), __float_as_uint(c + M), 0x0c0c0400u);
    return __builtin_amdgcn_perm(cd, ab, 0x05040100u);
}
typedef unsigned short u16x2 __attribute__((ext_vector_type(2)));
__device__ __forceinline__ unsigned pkmax(unsigned a, unsigned b) { return __builtin_bit_cast(unsigned, __builtin_elementwise_max(__builtin_bit_cast(u16x2, a), __builtin_bit_cast(u16x2, b))); }
__device__ __forceinline__ unsigned opq(unsigned v) { asm volatile("" : "+v"(v)); return v; }
__device__ __forceinline__ float wave_max(float v) {
#pragma unroll
    for (int o = 1; o < 64; o <<= 1) v = fmaxf(v, __shfl_xor(v, o));
    return v;
}
__device__ __forceinline__ void fwht8_32(float (&v)[8], int lane) {
    f32x2 a = {v[0], v[1]}, b = {v[2], v[3]}, c = {v[4], v[5]}, d = {v[6], v[7]}, t;
    t = a + c; c = a - c; a = t; t = b + d; d = b - d; b = t;
    t = a + b; b = a - b; a = t; t = c + d; d = c - d; c = t;
    a = (f32x2){a[0] + a[1], a[0] - a[1]}; b = (f32x2){b[0] + b[1], b[0] - b[1]}; c = (f32x2){c[0] + c[1], c[0] - c[1]}; d = (f32x2){d[0] + d[1], d[0] - d[1]};
    const float s1 = (lane & 1) ? -1.f : 1.f, s2 = (lane & 2) ? -1.f : 1.f;
#define FW_X(x, ctrl) __int_as_float(__builtin_amdgcn_update_dpp(0, __float_as_int(x), ctrl, 0xf, 0xf, true))
#define FW_ST(p, sg, ctrl) do { const f32x2 q_ = {FW_X(p[0], ctrl), FW_X(p[1], ctrl)}; p = p * (f32x2){sg, sg} + q_; } while (0)
    FW_ST(a, s1, 0xB1); FW_ST(b, s1, 0xB1); FW_ST(c, s1, 0xB1); FW_ST(d, s1, 0xB1);
    FW_ST(a, s2, 0x4E); FW_ST(b, s2, 0x4E); FW_ST(c, s2, 0x4E); FW_ST(d, s2, 0x4E);
#undef FW_ST
#undef FW_X
    v[0] = a[0]; v[1] = a[1]; v[2] = b[0]; v[3] = b[1]; v[4] = c[0]; v[5] = c[1]; v[6] = d[0]; v[7] = d[1];
}
__device__ __forceinline__ void cvt_load(const CvtDesc& d, f32x4 (&v)[16], int lane) {
    const int kq = lane >> 4;
#pragma unroll
    for (int i = 0; i < 16; ++i) { const int k = d.k0 + 4 * i + kq;
        v[i] = (d.srccol >= 0 && k < d.Ksrc) ? __builtin_nontemporal_load((const f32x4*)(d.W + (size_t)k * d.N + d.srccol)) : (f32x4){0.f, 0.f, 0.f, 0.f}; }
}
__device__ __forceinline__ void cvt_finish(const CvtDesc& d, f32x4 (&v)[16], LAS float* scr, int lane) {
    const int l16 = lane & 15, kq = lane >> 4;
    if (d.gain) {
#pragma unroll
        for (int i = 0; i < 16; ++i) { const int k = d.k0 + 4 * i + kq; if (k < d.Ksrc) v[i] = v[i] * d.gain[k]; } }
#pragma unroll
    for (int i = 0; i < 16; ++i) { LAS float* q = scr + (4 * i + kq) * 65 + 4 * l16; q[0] = v[i][0]; q[1] = v[i][1]; q[2] = v[i][2]; q[3] = v[i][3]; }
    LDS_WAIT(); asm volatile("" ::: "memory");
    const int c = lane & 7, nr = lane >> 3;
    if (d.cmax) {
#pragma unroll
        for (int j = 0; j < 8; ++j) { const int n = nr + 8 * j; const LAS float* t = scr + (8 * c) * 65 + n;
            const float cm = d.cmax[d.dstrow0 + n], inv = cm > 0.f ? 127.0f * __builtin_amdgcn_rcpf(cm) : 0.f;
            float v[8];
#pragma unroll
            for (int i = 0; i < 8; ++i) v[i] = t[i * 65];
            if (d.had) fwht8_32(v, lane);
            u32x2 o; o.x = pk4_i8(v[0] * inv, v[1] * inv, v[2] * inv, v[3] * inv); o.y = pk4_i8(v[4] * inv, v[5] * inv, v[6] * inv, v[7] * inv);
            __builtin_nontemporal_store(o, (u32x2*)((unsigned char*)d.WT + (size_t)(d.dstrow0 + n) * d.Kdst + d.k0 + 8 * c)); }
        LDS_WAIT(); asm volatile("" ::: "memory");
        return;
    }
    if (d.had) {
#pragma unroll
        for (int j = 0; j < 8; ++j) { const int n = nr + 8 * j; const LAS float* t = scr + (8 * c) * 65 + n;
            float v[8];
#pragma unroll
            for (int i = 0; i < 8; ++i) v[i] = t[i * 65];
            fwht8_32(v, lane);
            u32x4 o; o.x = cvt_pk_bf16(v[0] * 0.03125f, v[1] * 0.03125f); o.y = cvt_pk_bf16(v[2] * 0.03125f, v[3] * 0.03125f); o.z = cvt_pk_bf16(v[4] * 0.03125f, v[5] * 0.03125f); o.w = cvt_pk_bf16(v[6] * 0.03125f, v[7] * 0.03125f);
            __builtin_nontemporal_store(o, (u32x4*)(d.WT + (size_t)(d.dstrow0 + n) * d.Kdst + d.k0 + 8 * c)); }
        LDS_WAIT(); asm volatile("" ::: "memory");
        return;
    }
#pragma unroll
    for (int j = 0; j < 8; ++j) { const int n = nr + 8 * j; const LAS float* t = scr + (8 * c) * 65 + n;
        u32x4 o; o.x = cvt_pk_bf16(t[0 * 65], t[1 * 65]); o.y = cvt_pk_bf16(t[2 * 65], t[3 * 65]); o.z = cvt_pk_bf16(t[4 * 65], t[5 * 65]); o.w = cvt_pk_bf16(t[6 * 65], t[7 * 65]);
        __builtin_nontemporal_store(o, (u32x4*)(d.WT + (size_t)(d.dstrow0 + n) * d.Kdst + d.k0 + 8 * c)); }
    LDS_WAIT(); asm volatile("" ::: "memory");
}
constexpr int I_EVIN = 64 * (EV_N / 64), I_UQ = (QRANK / 64) * (UQ_N / 64), I_UKV = (KVK / 64) * (UKV_N / 64), I_SQ = 64 * (DM / 64), I_ODIN = 64 * (OD_N / 64);
constexpr int I_PAIR = I_EVIN + I_UQ + I_UKV + I_SQ + I_ODIN + I_SQ;
constexpr int I_GU = 64 * (GU_N / 64), I_DN = (DFF / 64) * (DM / 64), I_FFN = I_GU + I_DN;
constexpr int N_CVT_ITEMS = 2 * I_PAIR + DEPTH * I_FFN;

__device__ __forceinline__ CvtDesc cvt_describe(const Args& A, unsigned char* ws, int it, int lane) {
    const int l4 = 4 * (lane & 15);
    const float* ng = A.in[IN_NORMG];
    if (it < 2 * I_PAIR) {
        const int e = it / I_PAIR; int r = it - e * I_PAIR;
        if (r < I_EVIN) { const int nblk = EV_N / 64, kb = r / nblk, nb = r - kb * nblk, n = nb * 64 + l4;
            int sc;
            if (n < EV_CQ) sc = n; else if (n < EV_KR) sc = n + 16; else if (n < EV_FL) sc = 7376 + ropeperm(n - EV_KR); else if (n < EV_FL + 16) sc = 6144 + (n - EV_FL); else sc = -1;
            return CvtDesc{A.in[IN_EVWIN] + (size_t)e * DM * EV_SRC_N, EV_SRC_N, sc, ng + (size_t)(2 * e * 4 + 0) * DM, DM, kb * 64, (bf16_t*)(ws + W_EVIN + e * SZ_EVIN), LD_DM, nb * 64}; }
        r -= I_EVIN;
        if (r < I_UQ) { const int nblk = UQ_N / 64, kb = r / nblk, nb = r - kb * nblk, n = nb * 64 + l4;
            int sc; if (n < 2048) sc = (n >> 7) * 192 + (n & 127); else { const int j2 = n - 2048; sc = (j2 >> 6) * 192 + 128 + ropeperm(j2 & 63); }
            return CvtDesc{A.in[IN_EVWUQ] + (size_t)e * QRANK * UQ_N, UQ_N, sc, A.in[IN_EVQN] + e * QRANK, QRANK, kb * 64, (bf16_t*)(ws + W_UQ + e * SZ_UQ), LD_QR, nb * 64}; }
        r -= I_UQ;
        if (r < I_UKV) { const int nblk = UKV_N / 64, kb = r / nblk, nb = r - kb * nblk, n = nb * 64 + l4;
            int sc; if (n < 2048) sc = (n >> 7) * 256 + (n & 127); else { const int n2 = n - 2048; sc = (n2 >> 7) * 256 + 128 + (n2 & 127); }
            return CvtDesc{A.in[IN_EVWUKV] + (size_t)e * KVRANK * UKV_N, UKV_N, sc, A.in[IN_EVKVN] + e * KVRANK, KVRANK, kb * 64, (bf16_t*)(ws + W_UKV + e * SZ_UKV), LD_KV, nb * 64}; }
        r -= I_UKV;
        if (r < I_SQ) { const int nblk = DM / 64, kb = r / nblk, nb = r - kb * nblk;
            return CvtDesc{A.in[IN_EVWOUT] + (size_t)e * DM * DM, DM, nb * 64 + l4, nullptr, DM, kb * 64, (bf16_t*)(ws + W_EVOUT + e * SZ_SQ), LD_DM, nb * 64}; }
        r -= I_SQ;
        if (r < I_ODIN) { const int nblk = OD_N / 64, kb = r / nblk, nb = r - kb * nblk;
            return CvtDesc{A.in[IN_ODWIN] + (size_t)e * DM * OD_N, OD_N, nb * 64 + l4, ng + (size_t)((2 * e + 1) * 4 + 0) * DM, DM, kb * 64, (bf16_t*)(ws + W_ODIN + e * SZ_ODIN), LD_DM, nb * 64}; }
        r -= I_ODIN;
        { const int nblk = DM / 64, kb = r / nblk, nb = r - kb * nblk;
            return CvtDesc{A.in[IN_ODWOUT] + (size_t)e * DM * DM, DM, nb * 64 + l4, nullptr, DM, kb * 64, (bf16_t*)(ws + W_ODOUT + e * SZ_SQ), LD_DM, nb * 64}; }
    }
    it -= 2 * I_PAIR;
    const int L = it / I_FFN; int r = it - L * I_FFN;
    if (r < I_GU) { const int nblk = GU_N / 64, kb = r / nblk, nb = r - kb * nblk, n0 = nb * 64, tile = n0 >> 8, w = n0 & 255;
        const float* src = (w < 128 ? A.in[IN_WGATE] : A.in[IN_WUP]) + (size_t)L * DM * DFF;
        return CvtDesc{src, DFF, tile * 128 + (w & 127) + l4, ng + (size_t)(L * 4 + 2) * DM, DM, kb * 64, (bf16_t*)(ws + W_GU + L * SZ_GU), LD8, n0, (const float*)(ws + WS_CTL + CTL_COLMAX) + (size_t)L * GU_N}; }
    r -= I_GU;
    { const int nblk = DM / 64, kb = r / nblk, nb = r - kb * nblk;
        return CvtDesc{A.in[IN_WDOWN] + (size_t)L * DFF * DM, DM, nb * 64 + l4, nullptr, DFF, kb * 64, (bf16_t*)(ws + W_DN + L * SZ_DN), LD_FF, nb * 64}; }
}

__device__ __forceinline__ int ev_srccol(int n) {
    if (n < EV_CQ) return n; if (n < EV_KR) return n + 16; if (n < EV_FL) return 7376 + ropeperm(n - EV_KR); if (n < EV_FL + 16) return 6144 + (n - EV_FL); return -1;
}
__device__ __forceinline__ void row_to_bf16(const float* xrow, bf16_t* orow, float* rstd, int lane) {
    float ss = 0.f;
#pragma unroll
    for (int j = 0; j < 8; ++j) { const f32x4 a = *(const f32x4*)(xrow + 8 * lane + 512 * j), b = *(const f32x4*)(xrow + 8 * lane + 512 * j + 4);
        ss += sq8(a, b); store8(orow + 8 * lane + 512 * j, a, b); }
    ss = wave_sum(ss);
    if (lane == 0) *rstd = rsqrtf(ss * (1.0f / DM) + EPS);
}
__device__ __forceinline__ void row_to_i8(const float* xrow, unsigned char* orow, float* rs8, int lane) {
    f32x4 a[8], b[8]; float ss = 0.f, mx = 0.f;
#pragma unroll
    for (int j = 0; j < 8; ++j) { a[j] = *(const f32x4*)(xrow + 8 * lane + 512 * j); b[j] = *(const f32x4*)(xrow + 8 * lane + 512 * j + 4);
        ss += sq8(a[j], b[j]);
        mx = fmaxf(mx, fmaxf(fmaxf(fmaxf(fabsf(a[j][0]), fabsf(a[j][1])), fmaxf(fabsf(a[j][2]), fabsf(a[j][3]))), fmaxf(fmaxf(fabsf(b[j][0]), fabsf(b[j][1])), fmaxf(fabsf(b[j][2]), fabsf(b[j][3]))))); }
    ss = wave_sum(ss); mx = wave_max(mx);
    const float inv = mx > 0.f ? 127.0f * __builtin_amdgcn_rcpf(mx) : 0.f;
#pragma unroll
    for (int j = 0; j < 8; ++j) { u32x2 q; q.x = pk4_i8(a[j][0] * inv, a[j][1] * inv, a[j][2] * inv, a[j][3] * inv); q.y = pk4_i8(b[j][0] * inv, b[j][1] * inv, b[j][2] * inv, b[j][3] * inv);
        *(u32x2*)(orow + 8 * lane + 512 * j) = q; }
    if (lane == 0) *rs8 = rsqrtf(ss * (1.0f / DM) + EPS) * mx * (1.0f / 16129.0f);
}
constexpr int N_OD8 = ((I8_IN_ODD & 1) + ((I8_IN_ODD >> 1) & 1));
constexpr int I_PAIR0 = I_PAIR - I_EVIN;
constexpr int N_EV8 = ((I8_IN_EV & 1) + ((I8_IN_EV >> 1) & 1));
constexpr int NP0 = I_PAIR - ((I8_IN_EV & 1) ? I_EVIN : 0) - ((I8_IN_ODD & 1) ? I_ODIN : 0), NP1 = I_PAIR - ((I8_IN_EV & 2) ? I_EVIN : 0) - ((I8_IN_ODD & 2) ? I_ODIN : 0);
__device__ __forceinline__ int pair_item(int r, int e) {
    if (!((I8_IN_EV >> e) & 1)) { if (r < I_EVIN) return r; r -= I_EVIN; }
    if (r < I_UQ + I_UKV + I_SQ) return I_EVIN + r;
    r -= I_UQ + I_UKV + I_SQ;
    if (!((I8_IN_ODD >> e) & 1)) { if (r < I_ODIN) return I_EVIN + I_UQ + I_UKV + I_SQ + r; r -= I_ODIN; }
    return I_EVIN + I_UQ + I_UKV + I_SQ + I_ODIN + r;
}
constexpr int N_DN8 = (I8_DN & 1) + ((I8_DN >> 1) & 1) + ((I8_DN >> 2) & 1) + ((I8_DN >> 3) & 1);
__device__ __forceinline__ int nth_layer(int idx, int mask) {
    int L = 0;
#pragma unroll
    for (int b = 0; b < DEPTH; ++b) { if ((mask >> b) & 1) { if (idx == 0) L = b; --idx; } }
    return L;
}
template <int PH> __device__ __forceinline__ CvtDesc cvt_desc(const Args& A, unsigned char* ws, int j, int lane) {
    if constexpr (PH == 0) {
        if (j < NP0) return cvt_describe(A, ws, pair_item(j, 0), lane);
        if (j < NP0 + NP1) return cvt_describe(A, ws, I_PAIR + pair_item(j - NP0, 1), lane);
        const int q = j - NP0 - NP1, idx = q / I_DN, L = nth_layer(idx, ~I8_DN & ((1 << DEPTH) - 1)); return cvt_describe(A, ws, 2 * I_PAIR + L * I_FFN + I_GU + (q - idx * I_DN), lane); }
    else {
        const int q = j;
        const int idx = q / I_DN, r = q - idx * I_DN, L = nth_layer(idx, I8_DN), nblk = DM / 64, kb = r / nblk, nb = r - kb * nblk;
        return CvtDesc{A.in[IN_WDOWN] + (size_t)L * DFF * DM, DM, nb * 64 + 4 * (lane & 15), nullptr, DFF, kb * 64, (bf16_t*)(ws + W_DN + L * SZ_DN), LD8F, nb * 64, (const float*)(ws + WS_CTL + CTL_COLMAX_DN) + (size_t)L * DM, 1};
    }
}
template <int PH> __device__ __forceinline__ void cvt_items(const Args& A, Frame& F) {
    constexpr int NIT = PH == 0 ? NP0 + NP1 + (DEPTH - N_DN8) * I_DN : N_DN8 * I_DN;
    LAS float* scr = (LAS float*)(F.lds + F.wave * 16640);
    const int gw = F.vcu * 8 + F.wave, NGW = F.G * 8;
    unsigned char* ws = F.ws;
    f32x4 vA[16], vB[16]; CvtDesc dA{}, dB{};
    int it = gw;
    if (it < NIT) { dA = cvt_desc<PH>(A, ws, it, F.lane); cvt_load(dA, vA, F.lane); }
    for (; it < NIT; it += 2 * NGW) {
        const int it1 = it + NGW, it2 = it1 + NGW;
        if (it1 < NIT) { dB = cvt_desc<PH>(A, ws, it1, F.lane); cvt_load(dB, vB, F.lane); }
        cvt_finish(dA, vA, scr, F.lane);
        if (it2 < NIT) { dA = cvt_desc<PH>(A, ws, it2, F.lane); cvt_load(dA, vA, F.lane); }
        if (it1 < NIT) cvt_finish(dB, vB, scr, F.lane);
    }
}
__device__ __forceinline__ int ropeperm_inv(int d) { return d < 32 ? 8 * (d >> 2) + (d & 3) : 8 * ((d - 32) >> 2) + 4 + ((d - 32) & 3); }
__device__ __forceinline__ int ev_dstcol(int sc) { if (sc < 6144) return sc; if (sc < 6160) return EV_FL + (sc - 6144); if (sc < 7376) return sc - 16; return EV_KR + ropeperm_inv(sc - 7376); }
constexpr int NS_GU = DFF / 32, NS_OD = OD_N / 32, NS_EV = (EV_SRC_N + 31) / 32, N_STRIPS = DEPTH * 2 * NS_GU + N_OD8 * NS_OD + N_EV8 * NS_EV, STRIP_SLOTS = 135168;
__device__ __forceinline__ void strip_phase(const Args& A, Frame& F) {
    LAS unsigned char* lds = F.lds; unsigned char* ws = F.ws; const int tid = F.tid;
    int par = 0;
    for (int s = F.vcu; s < N_STRIPS; s += F.G, par ^= 1) {
        LAS unsigned* slots = (LAS unsigned*)(lds + STRIP_SLOTS) + 32 * par;
        const float* src; const float* gain; unsigned char* dst; float* cmx; int N, c0, kind, rbase = 0;
        if (s < DEPTH * 2 * NS_GU) { const int mi = s / NS_GU, cb = s - mi * NS_GU, L = mi >> 1, up = mi & 1; kind = 0; N = DFF; c0 = cb * 32;
            src = (up ? A.in[IN_WUP] : A.in[IN_WGATE]) + (size_t)L * DM * DFF; gain = A.in[IN_NORMG] + (size_t)(L * 4 + 2) * DM;
            dst = ws + W_GU + (size_t)L * SZ_GU; cmx = (float*)(ws + WS_CTL + CTL_COLMAX) + (size_t)L * GU_N; rbase = (c0 >> 7) * 256 + up * 128 + (c0 & 127); }
        else if (s < DEPTH * 2 * NS_GU + N_OD8 * NS_OD) { const int q = s - DEPTH * 2 * NS_GU, idx = q / NS_OD, cb = q - idx * NS_OD, e = (I8_IN_ODD & 1) ? idx : 1; kind = 1; N = OD_N; c0 = cb * 32;
            src = A.in[IN_ODWIN] + (size_t)e * DM * OD_N; gain = A.in[IN_NORMG] + (size_t)((2 * e + 1) * 4 + 0) * DM;
            dst = ws + W_GU + (size_t)(2 * e + 1) * SZ_GU + W_OD8_OFF; cmx = (float*)(ws + WS_CTL + CTL_COLMAX_OD) + (size_t)e * OD_N; rbase = c0; }
        else { const int q = s - DEPTH * 2 * NS_GU - N_OD8 * NS_OD, idx = q / NS_EV, cb = q - idx * NS_EV, e = (I8_IN_EV & 1) ? idx : 1; kind = 2; N = EV_SRC_N; c0 = cb * 32 + 32 <= EV_SRC_N ? cb * 32 : EV_SRC_N - 32;
            src = A.in[IN_EVWIN] + (size_t)e * DM * EV_SRC_N; gain = A.in[IN_NORMG] + (size_t)(2 * e * 4 + 0) * DM;
            dst = ws + W_EVIN + (size_t)e * SZ_EVIN; cmx = (float*)(ws + WS_CTL + CTL_COLMAX_EV) + (size_t)e * EV_N; }
        if (tid < 32) slots[tid] = 0u;
        __syncthreads();
        const int cg = tid & 7;
        unsigned m0 = 0u, m1 = 0u;
        {
            const float* sp = src + (size_t)(tid >> 3) * N + c0 + 4 * cg;
#pragma unroll 1
            for (int h = 0; h < 2; ++h) {
                f32x4 v[16];
#pragma unroll
                for (int i = 0; i < 16; ++i) v[i] = __builtin_nontemporal_load((const f32x4*)(sp + (size_t)(64 * (16 * h + i)) * N));
#pragma unroll
                for (int i = 0; i < 16; ++i) { const int k = (tid >> 3) + 64 * (16 * h + i); const float g = gain[k];
                    u32x2 w; w.x = cvt_pk_bf16(v[i][0] * g, v[i][1] * g); w.y = cvt_pk_bf16(v[i][2] * g, v[i][3] * g);
                    m0 = pkmax(m0, w.x & 0x7fff7fffu); m1 = pkmax(m1, w.y & 0x7fff7fffu);
                    *(LAS u32x2*)(lds + (k >> 2) * 264 + (k & 3) * 64 + cg * 8) = w; }
            }
        }
        u32x2 rg[4][8];
        {   const float* sp = src + (size_t)(2048 + 8 * (tid >> 3)) * N + c0 + 4 * cg;
#pragma unroll
            for (int jj = 0; jj < 2; ++jj) {
                f32x4 v[16];
#pragma unroll
                for (int i = 0; i < 16; ++i) v[i] = __builtin_nontemporal_load((const f32x4*)(sp + (size_t)(512 * (2 * jj + (i >> 3)) + (i & 7)) * N));
#pragma unroll
                for (int i = 0; i < 16; ++i) { const int k = 2048 + 8 * (tid >> 3) + 512 * (2 * jj + (i >> 3)) + (i & 7); const float g = gain[k];
                    u32x2 w; w.x = cvt_pk_bf16(v[i][0] * g, v[i][1] * g); w.y = cvt_pk_bf16(v[i][2] * g, v[i][3] * g);
                    m0 = pkmax(m0, w.x & 0x7fff7fffu); m1 = pkmax(m1, w.y & 0x7fff7fffu);
                    rg[2 * jj + (i >> 3)][i & 7] = w; }
            }
        }
        atomicMax((unsigned*)(slots + 4 * cg + 0), m0 << 16); atomicMax((unsigned*)(slots + 4 * cg + 1), m0 & 0xffff0000u);
        atomicMax((unsigned*)(slots + 4 * cg + 2), m1 << 16); atomicMax((unsigned*)(slots + 4 * cg + 3), m1 & 0xffff0000u);
        __syncthreads();
        {
            const int ch = tid >> 1, hf = tid & 1;
            u32x2 w[8][4];
#pragma unroll
            for (int r = 0; r < 8; ++r) { const LAS u32x2* cp = (const LAS u32x2*)(lds + (2 * ch + (r >> 2)) * 264 + (r & 3) * 64 + hf * 32);
#pragma unroll
                for (int j = 0; j < 4; ++j) w[r][j] = cp[j]; }
#pragma unroll
            for (int n = 0; n < 16; ++n) {
                const float cm = __uint_as_float(slots[16 * hf + n]), inv = cm > 0.f ? 127.0f * __builtin_amdgcn_rcpf(cm) : 0.f;
                float x[8];
#pragma unroll
                for (int r = 0; r < 8; ++r) { const unsigned word = (n & 2) ? w[r][n >> 2].y : w[r][n >> 2].x; x[r] = ((n & 1) ? bf_hi(word) : bf_lo(word)) * inv; }
                u32x2 q; q.x = pk4_i8(x[0], x[1], x[2], x[3]); q.y = pk4_i8(x[4], x[5], x[6], x[7]);
                const int col = 16 * hf + n, drow = kind == 2 ? ev_dstcol(c0 + col) : rbase + col;
                __builtin_nontemporal_store(q, (u32x2*)(dst + (size_t)drow * LD8 + 8 * ch));
            }
        }
        {
#pragma unroll
            for (int c = 0; c < 4; ++c) {
                const float cm = __uint_as_float(slots[4 * cg + c]), inv = cm > 0.f ? 127.0f * __builtin_amdgcn_rcpf(cm) : 0.f;
                const int col = 4 * cg + c, drow = kind == 2 ? ev_dstcol(c0 + col) : rbase + col;
#pragma unroll
                for (int j = 0; j < 4; ++j) {
                    float x[8];
#pragma unroll
                    for (int r = 0; r < 8; ++r) { const unsigned word = (c & 2) ? rg[j][r].y : rg[j][r].x; x[r] = ((c & 1) ? bf_hi(word) : bf_lo(word)) * inv; }
                    u32x2 q; q.x = pk4_i8(x[0], x[1], x[2], x[3]); q.y = pk4_i8(x[4], x[5], x[6], x[7]);
                    __builtin_nontemporal_store(q, (u32x2*)(dst + (size_t)drow * LD8 + 2048 + 8 * ((tid >> 3) + 64 * j)));
                }
            }
        }
        if (tid < 32) { const int drow = kind == 2 ? ev_dstcol(c0 + tid) : rbase + tid; cmx[drow] = __uint_as_float(slots[tid]); }
    }
    __syncthreads();
    { const int gw = F.vcu * 8 + F.wave, NGW = F.G * 8;
      for (int r = gw; r < N_EV8 * (EV_N - EV_SRC_N); r += NGW) { const int idx = r / (EV_N - EV_SRC_N), row = EV_SRC_N + (r - idx * (EV_N - EV_SRC_N)), e = (I8_IN_EV & 1) ? idx : 1;
          unsigned char* d = ws + W_EVIN + (size_t)e * SZ_EVIN + (size_t)row * LD8; const u32x4 z = {0u, 0u, 0u, 0u};
#pragma unroll
          for (int j = 0; j < 4; ++j) *(u32x4*)(d + 16 * F.lane + 1024 * j) = z; } }
}
__device__ __forceinline__ void colmax_dn_pass(const Args& A, Frame& F) {
    const int gw = F.vcu * 8 + F.wave, NGW = F.G * 8, lane = F.lane;
    constexpr int NKC = DFF / 256, NCB = DM / 256;
    for (int item = gw; item < N_DN8 * NKC * NCB; item += NGW) {
        const int cb = item % NCB, q = item / NCB, kc = q % NKC, L = nth_layer(q / NKC, I8_DN);
        const float* src = A.in[IN_WDOWN] + (size_t)L * DFF * DM + (size_t)(kc * 256) * DM + cb * 256 + 4 * lane;
        f32x4 mx = {0.f, 0.f, 0.f, 0.f};
#pragma unroll 1
        for (int g = 0; g < 8; ++g) {
            f32x4 w[32];
#pragma unroll
            for (int i = 0; i < 32; ++i) w[i] = __builtin_nontemporal_load((const f32x4*)(src + (size_t)(g * 32 + i) * DM));
#pragma unroll
            for (int h = 1; h < 32; h <<= 1)
#pragma unroll
                for (int i = 0; i < 32; ++i) if (!(i & h)) { const f32x4 x = w[i], y = w[i | h]; w[i] = x + y; w[i | h] = x - y; }
#pragma unroll
            for (int i = 0; i < 32; ++i) { mx[0] = fmaxf(mx[0], fabsf(w[i][0])); mx[1] = fmaxf(mx[1], fabsf(w[i][1])); mx[2] = fmaxf(mx[2], fabsf(w[i][2])); mx[3] = fmaxf(mx[3], fabsf(w[i][3])); }
        }
        unsigned* dstp = (unsigned*)(F.ws + WS_CTL + CTL_COLMAX_DN) + (size_t)L * DM + cb * 256 + 4 * lane;
#pragma unroll
        for (int e = 0; e < 4; ++e) atomicMax(dstp + e, __float_as_uint(mx[e]));
    }
}
__device__ __forceinline__ void actq_load(u32x4 (&w)[22], const bf16_t* act, int row, int lane) {
    const char* src = (const char*)(act + (size_t)row * LD_FF);
#pragma unroll
    for (int j = 0; j < 22; ++j) { w[j] = (u32x4){0u, 0u, 0u, 0u}; if (8 * lane + 512 * j < DFF) w[j] = __builtin_nontemporal_load((const u32x4*)(src + 16 * lane + 1024 * j)); }
}
__device__ __forceinline__ void actq_row(u32x4 (&w)[22], unsigned char* act8, float* rsd, int row, int lane) {
    unsigned char* dst = act8 + (size_t)row * LD8F;
    unsigned amx2 = 0u;
#pragma unroll
    for (int j = 0; j < 22; ++j) {
        float v[8] = {bf_lo(w[j].x), bf_hi(w[j].x), bf_lo(w[j].y), bf_hi(w[j].y), bf_lo(w[j].z), bf_hi(w[j].z), bf_lo(w[j].w), bf_hi(w[j].w)};
        fwht8_32(v, lane);
        w[j].x = cvt_pk_bf16(v[0], v[1]); w[j].y = cvt_pk_bf16(v[2], v[3]); w[j].z = cvt_pk_bf16(v[4], v[5]); w[j].w = cvt_pk_bf16(v[6], v[7]);
        amx2 = pkmax(pkmax(amx2, w[j].x & 0x7fff7fffu), pkmax(w[j].y & 0x7fff7fffu, pkmax(w[j].z & 0x7fff7fffu, w[j].w & 0x7fff7fffu)));
    }
    const float m = wave_max(fmaxf(bf_lo(amx2), bf_hi(amx2)));
    const float inv = m > 0.f ? 127.0f * __builtin_amdgcn_rcpf(m) : 0.f;
#pragma unroll
    for (int j = 0; j < 22; ++j) { if (8 * lane + 512 * j < DFF) { u32x2 q;
        q.x = pk4_i8(bf_lo(w[j].x) * inv, bf_hi(w[j].x) * inv, bf_lo(w[j].y) * inv, bf_hi(w[j].y) * inv); q.y = pk4_i8(bf_lo(w[j].z) * inv, bf_hi(w[j].z) * inv, bf_lo(w[j].w) * inv, bf_hi(w[j].w) * inv);
        *(u32x2*)(dst + 8 * lane + 512 * j) = q; } }
    if (lane == 0) rsd[row] = m * (1.0f / (16129.0f * 32.0f));
}
__device__ __forceinline__ void actq_phase(Frame& F) {
    unsigned char* ws = F.ws;
    const int gw = F.vcu * 8 + F.wave, NGW = F.G * 8, lane = F.lane;
    const bf16_t* act = (const bf16_t*)(ws + WS_PROJ); unsigned char* act8 = ws + WS_ACT8; float* rsd = (float*)(ws + WS_RSD);
    u32x4 wA[22], wB[22];
    int row = gw;
    if (row < MPAD) actq_load(wA, act, row, lane);
    for (; row < MPAD; row += 2 * NGW) {
        const int r1 = row + NGW, r2 = r1 + NGW;
        if (r1 < MPAD) actq_load(wB, act, r1, lane);
        actq_row(wA, act8, rsd, row, lane);
        if (r2 < MPAD) actq_load(wA, act, r2, lane);
        if (r1 < MPAD) actq_row(wB, act8, rsd, r1, lane);
    }
}
__device__ __forceinline__ void p0_prologue(const Args& A, Frame& F) {
    const int gw = F.vcu * 8 + F.wave, NGW = F.G * 8;
    unsigned char* ws = F.ws;
    strip_phase(A, F);
    colmax_dn_pass(A, F);
    cvt_items<0>(A, F);
    { float* cosT = (float*)(ws + WS_COS); float* sinT = (float*)(ws + WS_SIN);
      for (int idx = gw * 64 + F.lane; idx < NPOS * 32; idx += NGW * 64) { const int pos = idx >> 5, i = idx & 31;
          const float inv = powf(10000.0f, -(float)i * (1.0f / 32.0f)); const float ang = (float)pos * inv;
          cosT[idx] = cosf(ang); sinT[idx] = sinf(ang); } }
    if (gw == 0) { float* prm = (float*)(ws + WS_PRM);
        for (int o = 0; o < 2; ++o) { const float* l = A.in[IN_ODLAM] + o * 4 * 128;
            const float s01 = wave_sum(l[F.lane] * l[128 + F.lane] + l[64 + F.lane] * l[192 + F.lane]);
            const float s23 = wave_sum(l[256 + F.lane] * l[384 + F.lane] + l[320 + F.lane] * l[448 + F.lane]);
            if (F.lane == 0) prm[o] = expf(s01) - expf(s23) + A.lam_init[o]; } }
    bf16_t* hbf = (bf16_t*)(ws + WS_HBF); float* rstd = (float*)(ws + WS_RSTD); unsigned char* a8 = ws + WS_OBUF; float* rs8 = (float*)(ws + WS_RS8);
    for (int row = gw; row < MPAD; row += NGW) {
        if (row < MUSED) { const float* src = row < MREAL ? A.in[IN_X] + (size_t)row * DM : A.in[IN_META] + (size_t)(row - MREAL) * DM;
            if constexpr (I8_IN_EV & 1) row_to_i8(src, a8 + (size_t)row * LD8, rs8 + row, F.lane); else row_to_bf16(src, hbf + (size_t)row * LD_DM, rstd + row, F.lane); }
        else { const u32x4 z = {0u, 0u, 0u, 0u};
#pragma unroll
            for (int j = 0; j < 8; ++j) *(u32x4*)(hbf + (size_t)row * LD_DM + 8 * F.lane + 512 * j) = z;
#pragma unroll
            for (int j = 0; j < 4; ++j) *(u32x4*)(a8 + (size_t)row * LD8 + 16 * F.lane + 1024 * j) = z;
            if (F.lane == 0) { rstd[row] = 0.f; rs8[row] = 0.f; } }
    }
}

__device__ __forceinline__ void ew_phase(const Args& A, Frame& F, int layer, int which) {
    unsigned char* ws = F.ws;
    const int gw = F.vcu * 8 + F.wave, NGW = F.G * 8, lane = F.lane;
    const float* gpost = A.in[IN_NORMG] + (size_t)(layer * 4 + (which ? 3 : 1)) * DM;
    const bool first = (layer == 0 && which == 0), last = (layer == DEPTH - 1 && which == 1);
    const bf16_t* mbuf = (const bf16_t*)(ws + WS_MBUF); bf16_t* hbf = (bf16_t*)(ws + WS_HBF);
    float* rstd = (float*)(ws + WS_RSTD); const float* statm = (const float*)(ws + WS_STATM);
    const bool q8 = (which == 0) || (layer + 1 < DEPTH && (((((layer + 1) & 1) ? I8_IN_ODD : I8_IN_EV) >> ((layer + 1) >> 1)) & 1));
    unsigned char* a8 = ws + (which == 0 ? WS_A8 : WS_OBUF); float* rs8 = (float*)(ws + WS_RS8);
    if (q8) {
        for (int row = MUSED + gw; row < MPAD; row += NGW) { const u32x4 z = {0u, 0u, 0u, 0u};
#pragma unroll
            for (int j = 0; j < 4; ++j) *(u32x4*)(a8 + (size_t)row * LD8 + 16 * lane + 1024 * j) = z;
            if (lane == 0) rs8[row] = 0.f; }
    }
    if (F.vcu < NMETA && !last) {
        const int r = F.vcu, row = MREAL + r, nS = which ? (DFF / 256) : (DM / 256), c0 = F.wave * 512 + 8 * lane;
        const float* part = (const float*)(ws + WS_PART) + (size_t)r * DM + c0;
        LAS float* red = (LAS float*)F.lds;
        f32x4 ma = {0.f, 0.f, 0.f, 0.f}, mb = {0.f, 0.f, 0.f, 0.f};
        if (which && ((I8_DN >> layer) & 1)) {
            i32x4 ia = {0, 0, 0, 0}, ib = {0, 0, 0, 0};
#pragma unroll 16
            for (int ks = 0; ks < DFF / 256; ++ks) { ia += *(const i32x4*)(part + (size_t)ks * 16 * DM); ib += *(const i32x4*)(part + (size_t)ks * 16 * DM + 4); }
            const float* cs = (const float*)(ws + WS_CTL + CTL_COLMAX_DN) + (size_t)layer * DM + c0; const float rsc = ((const float*)(ws + WS_RSD))[row];
            ma = __builtin_convertvector(ia, f32x4) * (*(const f32x4*)cs * rsc); mb = __builtin_convertvector(ib, f32x4) * (*(const f32x4*)(cs + 4) * rsc);
        } else {
#pragma unroll 16
        for (int ks = 0; ks < nS; ++ks) { ma += *(const f32x4*)(part + (size_t)ks * 16 * DM); mb += *(const f32x4*)(part + (size_t)ks * 16 * DM + 4); }
        }
        const float s1 = wave_sum(sq8(ma, mb));
        if (lane == 0) red[F.wave] = s1;
        __syncthreads();
        const float rm = __builtin_amdgcn_rsqf((((red[0] + red[1]) + (red[2] + red[3])) + ((red[4] + red[5]) + (red[6] + red[7]))) * (1.0f / DM) + EPS);
        f32x4 ha, hb;
        if (first) { ha = *(const f32x4*)(A.in[IN_META] + (size_t)r * DM + c0); hb = *(const f32x4*)(A.in[IN_META] + (size_t)r * DM + c0 + 4); }
        else { const u32x4 wh = *(const u32x4*)(hbf + (size_t)row * LD_DM + c0);
            ha = (f32x4){bf_lo(wh.x), bf_hi(wh.x), bf_lo(wh.y), bf_hi(wh.y)}; hb = (f32x4){bf_lo(wh.z), bf_hi(wh.z), bf_lo(wh.w), bf_hi(wh.w)}; }
        const f32x4 ga = *(const f32x4*)(gpost + c0), gb = *(const f32x4*)(gpost + c0 + 4);
        ha = ha + ma * rm * ga; hb = hb + mb * rm * gb;
        const float s2 = wave_sum(sq8(ha, hb));
        const float mxw = wave_max(fmaxf(fmaxf(fmaxf(fabsf(ha[0]), fabsf(ha[1])), fmaxf(fabsf(ha[2]), fabsf(ha[3]))), fmaxf(fmaxf(fabsf(hb[0]), fabsf(hb[1])), fmaxf(fabsf(hb[2]), fabsf(hb[3])))));
        if (lane == 0) { red[8 + F.wave] = s2; red[16 + F.wave] = mxw; }
        __syncthreads();
        store8(hbf + (size_t)row * LD_DM + c0, ha, hb);
        const float amx = fmaxf(fmaxf(fmaxf(red[16], red[17]), fmaxf(red[18], red[19])), fmaxf(fmaxf(red[20], red[21]), fmaxf(red[22], red[23])));
        if (q8) { const float inv = amx > 0.f ? 127.0f * __builtin_amdgcn_rcpf(amx) : 0.f;
            u32x2 q; q.x = pk4_i8(ha[0] * inv, ha[1] * inv, ha[2] * inv, ha[3] * inv); q.y = pk4_i8(hb[0] * inv, hb[1] * inv, hb[2] * inv, hb[3] * inv); *(u32x2*)(a8 + (size_t)row * LD8 + c0) = q; }
        if (F.tid == 0) { const float rr = __builtin_amdgcn_rsqf((((red[8] + red[9]) + (red[10] + red[11])) + ((red[12] + red[13]) + (red[14] + red[15]))) * (1.0f / DM) + EPS);
            rstd[row] = rr; if (q8) rs8[row] = rr * amx * (1.0f / 16129.0f); }
        __syncthreads();
    }
    u32x4 mv[8], ha[8], hb[8]; float sq = 0.f;
    unsigned v16 = (unsigned)lane * 16u, v32 = (unsigned)lane * 32u, v8 = (unsigned)lane * 8u;
    asm volatile("" : "+v"(v16), "+v"(v32), "+v"(v8));
    const char* const mbufc = (const char*)mbuf; const char* const hbfc = (const char*)hbf; const char* const xc = (const char*)A.in[IN_X]; const char* const gpc = (const char*)gpost;
#define EW_FETCH(j_, row_) do { mv[j_] = __builtin_nontemporal_load((const u32x4*)(mbufc + ((size_t)(row_) * (LD_DM * 2) + 1024 * (j_)) + opq(v16)));           \
        if (first) { ha[j_] = *(const u32x4*)(xc + ((size_t)(row_) * (DM * 4) + 2048 * (j_)) + opq(v32)); hb[j_] = *(const u32x4*)(xc + ((size_t)(row_) * (DM * 4) + 2048 * (j_) + 16) + opq(v32)); } \
        else { ha[j_] = *(const u32x4*)(hbfc + ((size_t)(row_) * (LD_DM * 2) + 1024 * (j_)) + opq(v16)); } } while (0)
    LAS u32x4* const wst = (LAS u32x4*)(F.lds + 1024 + F.wave * 8192) + lane;
    int row = gw;
    if (row < MREAL) {
#pragma unroll
        for (int j = 0; j < 8; ++j) EW_FETCH(j, row);
        sq = *(const float*)((const char*)statm + (size_t)row * 256 + opq((unsigned)lane * 4u)); }
    for (; row < MREAL; row += NGW) {
        asm volatile("" : "+v"(v16), "+v"(v32), "+v"(v8));
        unsigned amx2 = 0u;
        const float rm = __builtin_amdgcn_rsqf(wave_sum(sq) * (1.0f / DM) + EPS);
        const int nrow = row + NGW; const bool more = nrow < MREAL;
        if (more) sq = *(const float*)((const char*)statm + (size_t)nrow * 256 + opq((unsigned)lane * 4u));
        float ss2 = 0.f;
        char* const hbw = (char*)hbf + (size_t)row * (LD_DM * 2); char* const outw = (char*)A.out + (size_t)row * (DM * 4);
#pragma unroll
        for (int j = 0; j < 8; ++j) { const f32x4 g0 = *(const f32x4*)(gpc + 2048 * j + opq(v32)), g1 = *(const f32x4*)(gpc + (2048 * j + 16) + opq(v32));
            const f32x4 m0 = {bf_lo(mv[j].x), bf_hi(mv[j].x), bf_lo(mv[j].y), bf_hi(mv[j].y)}, m1 = {bf_lo(mv[j].z), bf_hi(mv[j].z), bf_lo(mv[j].w), bf_hi(mv[j].w)};
            f32x4 h0, h1;
            if (first) { h0 = (f32x4){__uint_as_float(ha[j].x), __uint_as_float(ha[j].y), __uint_as_float(ha[j].z), __uint_as_float(ha[j].w)}; h1 = (f32x4){__uint_as_float(hb[j].x), __uint_as_float(hb[j].y), __uint_as_float(hb[j].z), __uint_as_float(hb[j].w)}; }
            else { h0 = (f32x4){bf_lo(ha[j].x), bf_hi(ha[j].x), bf_lo(ha[j].y), bf_hi(ha[j].y)}; h1 = (f32x4){bf_lo(ha[j].z), bf_hi(ha[j].z), bf_lo(ha[j].w), bf_hi(ha[j].w)}; }
            const f32x4 n0 = h0 + m0 * rm * g0, n1 = h1 + m1 * rm * g1; ss2 += sq8(n0, n1);
            if (last) { *(f32x4*)(outw + 2048 * j + opq(v32)) = n0; *(f32x4*)(outw + (2048 * j + 16) + opq(v32)) = n1; }
            else { u32x4 wh; wh.x = cvt_pk_bf16(n0[0], n0[1]); wh.y = cvt_pk_bf16(n0[2], n0[3]); wh.z = cvt_pk_bf16(n1[0], n1[1]); wh.w = cvt_pk_bf16(n1[2], n1[3]);
                *(u32x4*)(hbw + 1024 * j + opq(v16)) = wh;
                if (q8) { wst[j * 64] = wh;
                    amx2 = pkmax(pkmax(amx2, wh.x & 0x7fff7fffu), pkmax(wh.y & 0x7fff7fffu, pkmax(wh.z & 0x7fff7fffu, wh.w & 0x7fff7fffu))); } }
            if (more) EW_FETCH(j, nrow);
        }
        if (!last) { ss2 = wave_sum(ss2); const float rr = __builtin_amdgcn_rsqf(ss2 * (1.0f / DM) + EPS);
            if (lane == 0) rstd[row] = rr;
            if (q8) { const float amax = wave_max(fmaxf(bf_lo(amx2), bf_hi(amx2))); const float inv = amax > 0.f ? 127.0f * __builtin_amdgcn_rcpf(amax) : 0.f;
                if (lane == 0) rs8[row] = rr * amax * (1.0f / 16129.0f);
                char* const a8w = (char*)a8 + (size_t)row * LD8;
#pragma unroll
                for (int j = 0; j < 8; ++j) { u32x2 q; const u32x4 w = wst[j * 64];
                    q.x = pk4_i8(bf_lo(w.x) * inv, bf_hi(w.x) * inv, bf_lo(w.y) * inv, bf_hi(w.y) * inv); q.y = pk4_i8(bf_lo(w.z) * inv, bf_hi(w.z) * inv, bf_lo(w.w) * inv, bf_hi(w.w) * inv);
                    *(u32x2*)(a8w + 512 * j + opq(v8)) = q; } } }
    }
#undef EW_FETCH
}

__device__ __forceinline__ float logsig(float x) { return fminf(x, 0.f) - 0.6931471805599453f * __builtin_amdgcn_logf(1.0f + __builtin_amdgcn_exp2f(-1.4426950408889634f * fabsf(x))); }
__device__ __forceinline__ void scan_phase(const Args& A, Frame& F, int e) {
    const int gw = (F.G - 1 - F.vcu) * 8 + F.wave, lane = F.lane;
    if (gw >= NB * 16) return;
    const int b = gw >> 4, h = gw & 15;
    const float* flogT = (const float*)(F.ws + WS_FLOG) + (size_t)h * MPAD; float* cumT = (float*)(F.ws + WS_CUM) + (size_t)h * MPAD;
    const float bf = A.in[IN_EVBF][e * 16 + h];
    float cm = 0.f, mine = 0.f;
#pragma unroll 1
    for (int m = 0; m < NMETA; ++m) { cm += logsig(flogT[META0 + m] + bf); if (lane == m) mine = cm; }
    if (b == 0) cumT[META0 + lane] = lane < NMETA ? mine : 0.f;
    const float* src = flogT + b * SEQ + lane * 64; float* dst = cumT + b * SEQ + lane * 64;
    float s = 0.f;
#pragma unroll 1
    for (int i = 0; i < 16; ++i) { const f32x4 v = *(const f32x4*)(src + 4 * i); s += (logsig(v[0] + bf) + logsig(v[1] + bf)) + (logsig(v[2] + bf) + logsig(v[3] + bf)); }
    float inc = s;
#pragma unroll
    for (int off = 1; off < 64; off <<= 1) { const float t = __shfl_up(inc, off); if (lane >= off) inc += t; }
    float run = cm + (inc - s);
#pragma unroll 1
    for (int i = 0; i < 16; ++i) { const f32x4 v = *(const f32x4*)(src + 4 * i); f32x4 o;
        run += logsig(v[0] + bf); o[0] = run; run += logsig(v[1] + bf); o[1] = run; run += logsig(v[2] + bf); o[2] = run; run += logsig(v[3] + bf); o[3] = run;
        *(f32x4*)(dst + 4 * i) = o; }
}

__device__ __forceinline__ void fixup_odd_meta(Frame& F, int e) {
    unsigned char* ws = F.ws;
    const float* part = (const float*)(ws + WS_PART); const float* rstd = (const float*)(ws + WS_RSTD); bf16_t* proj = (bf16_t*)(ws + WS_PROJ);
    const bool i8 = (I8_IN_ODD >> e) & 1;
    const float* cs = (const float*)(ws + WS_CTL + CTL_COLMAX_OD) + (size_t)e * OD_N; const float* rs8 = (const float*)(ws + WS_RS8);
    constexpr int CG = OD_N / 8;
    for (int item = F.vcu * 512 + F.tid; item < 256 * CG; item += F.G * 512) {
        const int r = item / CG, col = (item - r * CG) * 8;
        f32x4 a = {0.f, 0.f, 0.f, 0.f}, b = {0.f, 0.f, 0.f, 0.f};
        if (r < NMETA) {
            if (i8) { i32x4 ia = {0, 0, 0, 0}, ib = {0, 0, 0, 0};
#pragma unroll 16
                for (int ks = 0; ks < DM / 256; ++ks) { ia += *(const i32x4*)(part + (size_t)(ks * 16 + r) * OD_N + col); ib += *(const i32x4*)(part + (size_t)(ks * 16 + r) * OD_N + col + 4); }
                const float sc = rs8[META0 + r]; a = __builtin_convertvector(ia, f32x4) * (*(const f32x4*)(cs + col) * sc); b = __builtin_convertvector(ib, f32x4) * (*(const f32x4*)(cs + col + 4) * sc);
            } else {
#pragma unroll 16
            for (int ks = 0; ks < DM / 256; ++ks) { a += *(const f32x4*)(part + (size_t)(ks * 16 + r) * OD_N + col); b += *(const f32x4*)(part + (size_t)(ks * 16 + r) * OD_N + col + 4); }
            const float sc = rstd[META0 + r]; a = a * sc; b = b * sc;
            }
        }
        pg8::store8(proj + (size_t)(META0 + r) * LD_OD + col, a, b);
    }
}

__device__ __forceinline__ int t5_bucket(int d) {
    if (d < 16) return d;
    return 16 + (d >= 19) + (d >= 21) + (d >= 24) + (d >= 27) + (d >= 31) + (d >= 35) + (d >= 40) + (d >= 46) + (d >= 52) + (d >= 59) + (d >= 67) + (d >= 77) + (d >= 87) + (d >= 99) + (d >= 113);
}
__device__ __forceinline__ void attn_even_phase(Frame& F) {
    unsigned char* ws = F.ws; LAS char* lds = (LAS char*)F.lds;
    const bf16_t* proj = (const bf16_t*)(ws + WS_PROJ); const bf16_t* qbuf = (const bf16_t*)(ws + WS_QBUF); const bf16_t* kvbuf = (const bf16_t*)(ws + WS_KVBUF);
    bf16_t* obuf = (bf16_t*)(ws + WS_OBUF); const float* cumT = (const float*)(ws + WS_CUM);
    for (int i = F.vcu; i < 512 + 16; i += F.G) {
        const bool meta = i >= 512; const int bh = i >> 3, p = i & 7, b = meta ? 0 : bh >> 4, h = meta ? i - 512 : bh & 15, nblk = meta ? 1 : 2;
        for (int k = 0; k < nblk; ++k) {
            const int qb = meta ? 0 : (k == 0 ? 15 - p : p), qrow0 = meta ? META0 : b * SEQ + qb * 256;
            att::PassArgs a;
            a.Q = proj + (size_t)qrow0 * LD_EV + EV_QF + h * 128; a.ldq = LD_EV; a.Q2 = nullptr; a.ldq2 = 0;
            a.K = proj + EV_KF + h * 128; a.ldk = LD_EV; a.K2 = nullptr; a.ldk2 = 0; a.V = proj + EV_VF + h * 128; a.ldv = LD_EV;
            a.cum = cumT + (size_t)h * MPAD; a.krow0 = b * SEQ; a.qvp0 = meta ? 0 : 64 + qb * 256; a.NT = meta ? 1 : 4 * qb + 5; a.shift0 = 0;
            f32x16 o[4];
            att::attn_pass_dma<0>(a, lds, o, F.tid);
            att::store_o_bf16(o, obuf + (size_t)(qrow0 + F.wave * 32) * LD_DM + h * 128, LD_DM, F.tid);
        }
    }
    for (int i = F.vcu; i < 512 + 16; i += F.G) {
        const bool meta = i >= 512; const int bh = i >> 3, p = i & 7, b = meta ? 0 : bh >> 4, h = meta ? i - 512 : bh & 15, nblk = meta ? 1 : 2;
        for (int k = 0; k < nblk; ++k) {
            const int qb = meta ? 0 : (k == 0 ? 15 - p : p), qrow0 = meta ? META0 : b * SEQ + qb * 256;
            att::PassArgs a;
            a.Q = qbuf + (size_t)qrow0 * LD_UQ + h * 128; a.ldq = LD_UQ; a.Q2 = qbuf + (size_t)qrow0 * LD_UQ + 2048 + h * 64; a.ldq2 = LD_UQ;
            a.K = kvbuf + h * 128; a.ldk = LD_UKV; a.K2 = proj + EV_KR; a.ldk2 = LD_EV; a.V = kvbuf + 2048 + h * 128; a.ldv = LD_UKV;
            a.cum = nullptr; a.krow0 = b * SEQ; a.qvp0 = meta ? 0 : 64 + qb * 256; a.NT = meta ? 1 : 4 * qb + 5; a.shift0 = 0;
            f32x16 o[4];
            att::attn_pass_dma<1>(a, lds, o, F.tid);
            att::store_o_bf16(o, obuf + (size_t)(qrow0 + F.wave * 32) * LD_DM + 2048 + h * 128, LD_DM, F.tid);
        }
    }
}
__device__ __forceinline__ void attn_odd_phase(const Args& A, Frame& F, int o_idx) {
    unsigned char* ws = F.ws; LAS char* lds = (LAS char*)F.lds;
    const bf16_t* proj = (const bf16_t*)(ws + WS_PROJ); bf16_t* obuf = (bf16_t*)(ws + WS_OBUF);
    const float post = 1.0f - A.lam_init[o_idx];
    const float* subg = A.in[IN_ODSUBLN] + o_idx * 256; const float* relb = A.in[IN_RELB];
    float* S1base = (float*)(ws + WS_DSCR) + (size_t)(F.vcu & 255) * 65536;
    constexpr float INV_SCALE = 1.0f / att::Cfg<2>::SCALE;
    for (int i = F.vcu; i < 512 + 16; i += F.G) {
        const bool meta = i >= 512; const int bh = i >> 3, p = i & 7, b = meta ? 0 : bh >> 4, h = meta ? i - 512 : bh & 15, nblk = meta ? 1 : 2;
        for (int k = 0; k < nblk; ++k) {
            const int qb = meta ? 0 : (k == 0 ? 15 - p : p), qrow0 = meta ? META0 : b * SEQ + qb * 256;
            { int tt = F.tid; asm volatile("" : "+v"(tt));
              if (tt < 128) ((LAS float*)(lds + att::D_OFF_TBL))[tt] = tt <= 112 ? (relb[t5_bucket(tt) * 16 + h] - relb[31 * 16 + h]) * INV_SCALE : 0.f; }
            f32x16 o[8];
            for (int br = 0; br < 2; ++br) {
                att::PassArgs a;
                a.Q = proj + (size_t)qrow0 * LD_OD + h * 256 + br * 128; a.ldq = LD_OD; a.Q2 = nullptr; a.ldq2 = 0;
                a.K = proj + 4096 + h * 256 + br * 128; a.ldk = LD_OD; a.K2 = nullptr; a.ldk2 = 0; a.V = proj + 8192 + h * 256; a.ldv = LD_OD;
                a.cum = nullptr; a.krow0 = b * SEQ; a.qvp0 = meta ? 0 : 64 + qb * 256; a.NT = meta ? 1 : 4 * qb + 5; a.shift0 = meta ? 0 : 48;
                att::attn_pass_diff(a, lds, o, F.tid);
                if (br == 0) {
                    int tq = F.tid; asm volatile("" : "+v"(tq));
                    float* S1 = S1base + (size_t)tq * 4;
#pragma unroll
                    for (int d = 0; d < 8; ++d) {
#pragma unroll
                        for (int q = 0; q < 4; ++q) *(f32x4*)(S1 + (d * 4 + q) * 2048) = (f32x4){o[d][4 * q], o[d][4 * q + 1], o[d][4 * q + 2], o[d][4 * q + 3]}; }
                }
            }
            {
                int tq = F.tid; asm volatile("" : "+v"(tq));
                const float* S1 = S1base + (size_t)tq * 4;
                const float lam = ((const float*)(ws + WS_PRM))[o_idx];
                VM_WAIT();
#pragma unroll
                for (int d = 0; d < 8; ++d) {
#pragma unroll
                    for (int q = 0; q < 4; ++q) { const f32x4 s1 = *(const f32x4*)(S1 + (d * 4 + q) * 2048);
#pragma unroll
                        for (int j = 0; j < 4; ++j) o[d][4 * q + j] = s1[j] - lam * o[d][4 * q + j]; }
                    asm volatile("" ::: "memory"); }
            }
            int tq2 = F.tid; asm volatile("" : "+v"(tq2));
            const int r32 = tq2 & 31;
            float ssum[16];
#pragma unroll
            for (int r = 0; r < 16; ++r) { float t = 0.f;
#pragma unroll
                for (int d = 0; d < 8; ++d) t += o[d][r] * o[d][r];
#pragma unroll
                for (int off = 1; off < 32; off <<= 1) t += __shfl_xor(t, off);
                ssum[r] = __builtin_amdgcn_rsqf(t * (1.0f / 256.0f) + EPS) * post; }
#pragma unroll
            for (int d = 0; d < 8; ++d) { const float g = subg[d * 32 + r32];
#pragma unroll
                for (int r = 0; r < 16; ++r) o[d][r] *= ssum[r] * g; }
            bf16_t* Ow = obuf + (size_t)(qrow0 + F.wave * 32) * LD_DM + h * 256;
            att::store_o_bf16(o, Ow, LD_DM, F.tid);
            att::store_o_bf16(o + 4, Ow + 128, LD_DM, F.tid);
        }
    }
}
#ifdef PROBE_ATT
template <int PVAR>
__device__ __forceinline__ void attn_odd_phase_probe(const Args& A, Frame& F, int o_idx) {
    unsigned char* ws = F.ws; LAS char* lds = (LAS char*)F.lds;
    const bf16_t* proj = (const bf16_t*)(ws + WS_PROJ); bf16_t* obuf = (bf16_t*)(ws + WS_OBUF);
    const float post = 1.0f - A.lam_init[o_idx];
    const float* subg = A.in[IN_ODSUBLN] + o_idx * 256; const float* relb = A.in[IN_RELB];
    float* S1base = (float*)(ws + WS_DSCR) + (size_t)(F.vcu & 255) * 65536;
    constexpr float INV_SCALE = 1.0f / att::Cfg<2>::SCALE;
    for (int i = F.vcu; i < 512 + 16; i += F.G) {
        const bool meta = i >= 512; const int bh = i >> 3, p = i & 7, b = meta ? 0 : bh >> 4, h = meta ? i - 512 : bh & 15, nblk = meta ? 1 : 2;
        for (int k = 0; k < nblk; ++k) {
            const int qb = meta ? 0 : (k == 0 ? 15 - p : p), qrow0 = meta ? META0 : b * SEQ + qb * 256;
            { int tt = F.tid; asm volatile("" : "+v"(tt));
              if (tt < 128) ((LAS float*)(lds + att::D_OFF_TBL))[tt] = tt <= 112 ? (relb[t5_bucket(tt) * 16 + h] - relb[31 * 16 + h]) * INV_SCALE : 0.f; }
            f32x16 o[8];
            for (int br = 0; br < 2; ++br) {
                att::PassArgs a;
                a.Q = proj + (size_t)qrow0 * LD_OD + h * 256 + br * 128; a.ldq = LD_OD; a.Q2 = nullptr; a.ldq2 = 0;
                a.K = proj + 4096 + h * 256 + br * 128; a.ldk = LD_OD; a.K2 = nullptr; a.ldk2 = 0; a.V = proj + 8192 + h * 256; a.ldv = LD_OD;
                a.cum = nullptr; a.krow0 = b * SEQ; a.qvp0 = meta ? 0 : 64 + qb * 256; a.NT = meta ? 1 : 4 * qb + 5; a.shift0 = meta ? 0 : 48;
                if constexpr (PVAR == 0) att::attn_pass_diff(a, lds, o, F.tid); else att::attn_pass_diff_probe<PVAR>(a, lds, o, F.tid);
                if (br == 0) {
                    int tq = F.tid; asm volatile("" : "+v"(tq));
                    float* S1 = S1base + (size_t)tq * 4;
#pragma unroll
                    for (int d = 0; d < 8; ++d) {
#pragma unroll
                        for (int q = 0; q < 4; ++q) *(f32x4*)(S1 + (d * 4 + q) * 2048) = (f32x4){o[d][4 * q], o[d][4 * q + 1], o[d][4 * q + 2], o[d][4 * q + 3]}; }
                }
            }
            {
                int tq = F.tid; asm volatile("" : "+v"(tq));
                const float* S1 = S1base + (size_t)tq * 4;
                const float lam = ((const float*)(ws + WS_PRM))[o_idx];
                VM_WAIT();
#pragma unroll
                for (int d = 0; d < 8; ++d) {
#pragma unroll
                    for (int q = 0; q < 4; ++q) { const f32x4 s1 = *(const f32x4*)(S1 + (d * 4 + q) * 2048);
#pragma unroll
                        for (int j = 0; j < 4; ++j) o[d][4 * q + j] = s1[j] - lam * o[d][4 * q + j]; }
                    asm volatile("" ::: "memory"); }
            }
            int tq2 = F.tid; asm volatile("" : "+v"(tq2));
            const int r32 = tq2 & 31;
            float ssum[16];
#pragma unroll
            for (int r = 0; r < 16; ++r) { float t = 0.f;
#pragma unroll
                for (int d = 0; d < 8; ++d) t += o[d][r] * o[d][r];
#pragma unroll
                for (int off = 1; off < 32; off <<= 1) t += __shfl_xor(t, off);
                ssum[r] = __builtin_amdgcn_rsqf(t * (1.0f / 256.0f) + EPS) * post; }
#pragma unroll
            for (int d = 0; d < 8; ++d) { const float g = subg[d * 32 + r32];
#pragma unroll
                for (int r = 0; r < 16; ++r) o[d][r] *= ssum[r] * g; }
            bf16_t* Ow = obuf + (size_t)(qrow0 + F.wave * 32) * LD_DM + h * 256;
            att::store_o_bf16(o, Ow, LD_DM, F.tid);
            att::store_o_bf16(o + 4, Ow + 128, LD_DM, F.tid);
        }
    }
}
#endif

#ifndef PHM
#define PHM 1023
#endif
#ifndef P4SUB
#define P4SUB 7
#endif
constexpr int PPL = 9, N_PHASES = 2 + PPL * DEPTH;
__global__ void __launch_bounds__(512, 2) mega_fwd(Args args) {
    extern __shared__ __attribute__((aligned(16))) unsigned char lds_raw[];
    Frame F;
    F.lds = (LAS unsigned char*)lds_raw;
    const int wave_s = __builtin_amdgcn_readfirstlane((int)threadIdx.x >> 6);
    F.tid = opq_tid(wave_s); F.lane = F.tid & 63; F.wave = wave_s;
    F.G = gridDim.x; { const int bx = blockIdx.x; F.bx = bx; F.vcu = (F.G % 8 == 0) ? (bx % 8) * (F.G / 8) + bx / 8 : bx; }
    F.ws = args.ws;
    unsigned char* ws = args.ws;
    volatile LAS unsigned* MISC = (volatile LAS unsigned*)(F.lds + MISC_OFF);
    for (int u = F.tid; u < (LDS_BYTES - 135168) / 4; u += 512) ((LAS unsigned*)(F.lds + 135168))[u] = 0u;
    __syncthreads();
#if MK_ONE_LAUNCH
    XcdBarrier bar = xcd_barrier_post((unsigned*)(ws + WS_CTL) + CW_BAR, MISC + 8, F.tid);
#define IN(k) true
#else
    const int lo = args.ph_lo, hi = args.ph_hi;
    XcdBarrier bar; bar.bar = (unsigned*)(ws + WS_CTL) + CW_BAR; bar.x = 0; bar.st = nullptr;
    if (hi - lo > 1) bar = xcd_barrier_post((unsigned*)(ws + WS_CTL) + CW_BAR, MISC + 8, F.tid);
#define IN(k) (lo <= (k) && (k) < hi)
#endif
#define REFRESH() Frame Fp = F; { const int t_ = opq_tid(wave_s); Fp.tid = t_; Fp.lane = t_ & 63; size_t z_ = 0; asm volatile("" : "+s"(z_)); Fp.ws = args.ws + z_; Fp.vcu = opq_s(F.vcu); Fp.G = opq_s(F.G); Fp.bx = opq_s(F.bx); } unsigned char* ws = Fp.ws; (void)ws
#define SEAM(k, kn) do { if (IN(k) && IN(kn)) { XcdBarrier b_; size_t z_ = 0; asm volatile("" : "+s"(z_)); b_.bar = (unsigned*)(args.ws + z_ + WS_CTL) + CW_BAR; b_.x = xb_xcc_id(); b_.st = MISC + 8; xcd_barrier(b_, opq_tid(wave_s)); } } while (0)
#define PTRS() bf16_t* hbf = (bf16_t*)(ws + WS_HBF); bf16_t* proj = (bf16_t*)(ws + WS_PROJ); bf16_t* qbuf = (bf16_t*)(ws + WS_QBUF); bf16_t* kvbuf = (bf16_t*)(ws + WS_KVBUF); \
    bf16_t* obuf = (bf16_t*)(ws + WS_OBUF); bf16_t* mbuf = (bf16_t*)(ws + WS_MBUF); bf16_t* act = (bf16_t*)(ws + WS_PROJ); \
    pg8::EpiCtx ec; ec.O = nullptr; ec.ldc = 0; ec.rs = (const float*)(ws + WS_RSTD); ec.statq = (float*)(ws + WS_STATQ); ec.statkv = (float*)(ws + WS_STATKV); \
    ec.flogT = (float*)(ws + WS_FLOG); ec.cosT = (const float*)(ws + WS_COS); ec.sinT = (const float*)(ws + WS_SIN); ec.statm = (float*)(ws + WS_STATM); ec.part = (float*)(ws + WS_PART); ec.cs = nullptr; ec.amaxp = (float*)(ws + WS_AMAXP); \
    (void)hbf; (void)proj; (void)qbuf; (void)kvbuf; (void)obuf; (void)mbuf; (void)act

#if PHM & 1
    if (IN(0)) { p0_prologue(args, F); }
#endif
    SEAM(0, 1);
#if PHM & 1
    if (IN(1)) { REFRESH(); cvt_items<1>(args, Fp); }
#endif
    SEAM(1, 2);
#define LAYER() opq_s(layer0)
#define BASE() (2 + PPL * layer0)
#define EVEN() ((LAYER() & 1) == 0)
#define DN8() (((I8_DN >> LAYER()) & 1) != 0)
#define REFRESH_L() REFRESH(); const int layer = LAYER(), e = layer >> 1; (void)e; (void)layer
    for (int layer0 = 0; layer0 < DEPTH; ++layer0) {
#if PHM & 2
        if (IN(BASE())) {
            REFRESH_L(); PTRS();
            if (EVEN() && !((I8_IN_EV >> e) & 1)) {
                pg8::Gemm g{hbf, (const bf16_t*)(ws + W_EVIN + e * SZ_EVIN), LD_DM, LD_DM, DM}; pg8::StaticOrder S; S.init(MPAD, EV_N, Fp.G, Fp.bx);
                pg8::Epi<1> E{ec}; E.c.O = proj; E.c.ldc = LD_EV;
                pg8::gemm_phase<pg8::Epi<1>, pg8::StaticOrder, true, true>(Fp.lds, g, S, E, Fp.tid);
            } else if (EVEN()) {
                pg8::Gemm g{(const bf16_t*)(ws + WS_OBUF), (const bf16_t*)(ws + W_EVIN + e * SZ_EVIN), LD8 / 2, LD8 / 2, DM / 2}; pg8::StaticOrder S; S.init(MPAD, EV_N, Fp.G, Fp.bx);
                pg8::Epi<9> E{ec}; E.c.O = proj; E.c.ldc = LD_EV; E.c.rs = (const float*)(ws + WS_RS8); E.c.cs = (const float*)(ws + WS_CTL + CTL_COLMAX_EV) + (size_t)e * EV_N;
                pg8::gemm_phase<pg8::Epi<9>, pg8::StaticOrder, true, true, 2>(Fp.lds, g, S, E, Fp.tid);
            } else if ((I8_IN_ODD >> e) & 1) {
                pg8::Gemm g{(const bf16_t*)(ws + WS_OBUF), (const bf16_t*)(ws + W_GU + (size_t)layer * SZ_GU + W_OD8_OFF), LD8 / 2, LD8 / 2, DM / 2}; pg8::StaticOrder S; S.init(MREAL, OD_N, Fp.G, Fp.bx);
                pg8::Epi<8> E{ec}; E.c.O = proj; E.c.ldc = LD_OD; E.c.rs = (const float*)(ws + WS_RS8); E.c.cs = (const float*)(ws + WS_CTL + CTL_COLMAX_OD) + (size_t)e * OD_N;
                pg8::gemm_phase<pg8::Epi<8>, pg8::StaticOrder, true, true, 2>(Fp.lds, g, S, E, Fp.tid);
            } else {
                pg8::Gemm g{hbf, (const bf16_t*)(ws + W_ODIN + e * SZ_ODIN), LD_DM, LD_DM, DM}; pg8::StaticOrder S; S.init(MREAL, OD_N, Fp.G, Fp.bx);
                pg8::Epi<0> E{ec}; E.c.O = proj; E.c.ldc = LD_OD;
                pg8::gemm_phase<pg8::Epi<0>, pg8::StaticOrder, true, true>(Fp.lds, g, S, E, Fp.tid);
            }
        }
        if (!EVEN() && IN(BASE())) {
            REFRESH_L(); PTRS();
            if ((I8_IN_ODD >> e) & 1) {
                pg8::Gemm g{(const bf16_t*)(ws + WS_OBUF), (const bf16_t*)(ws + W_GU + (size_t)layer * SZ_GU + W_OD8_OFF), LD8 / 2, LD8 / 2, 128}; pg8::SplitKOrder S; S.init(MREAL / 256, OD_N, DM / 256, 128, Fp.G, Fp.bx);
                pg8::Epi<6> E{ec}; E.c.ldc = OD_N;
                pg8::gemm_phase<pg8::Epi<6>, pg8::SplitKOrder, true, false, 2>(Fp.lds, g, S, E, Fp.tid);
            } else {
                pg8::Gemm g{hbf, (const bf16_t*)(ws + W_ODIN + e * SZ_ODIN), LD_DM, LD_DM, 256}; pg8::SplitKOrder S; S.init(MREAL / 256, OD_N, DM / 256, 256, Fp.G, Fp.bx);
                pg8::Epi<6> E{ec}; E.c.ldc = OD_N;
                pg8::gemm_phase<pg8::Epi<6>, pg8::SplitKOrder, true, false>(Fp.lds, g, S, E, Fp.tid);
            }
        }
#endif
        SEAM(BASE(), BASE() + 1);
#if PHM & 4
        if (EVEN() && IN(BASE() + 1)) {
#if P4SUB & 1
            REFRESH_L();
            scan_phase(args, Fp, e);
#endif
#if P4SUB & 2
            {   REFRESH_L(); PTRS();
                pg8::Gemm g{proj + EV_CQ, (const bf16_t*)(ws + W_UQ + e * SZ_UQ), LD_EV, LD_QR, QRANK}; pg8::StaticOrder S; S.init(MPAD, UQ_N, Fp.G, Fp.bx);
                pg8::Epi<2> E{ec}; E.c.O = qbuf; E.c.ldc = LD_UQ; E.c.rs = (const float*)(ws + WS_STATQ);
                pg8::gemm_phase<pg8::Epi<2>, pg8::StaticOrder, true, true>(Fp.lds, g, S, E, Fp.tid); }
#endif
#if P4SUB & 4
            {   REFRESH_L(); PTRS();
                pg8::Gemm g{proj + EV_CKV, (const bf16_t*)(ws + W_UKV + e * SZ_UKV), LD_EV, LD_KV, KVK}; pg8::StaticOrder S; S.init(MPAD, UKV_N, Fp.G, Fp.bx);
                pg8::Epi<3> E{ec}; E.c.O = kvbuf; E.c.ldc = LD_UKV; E.c.rs = (const float*)(ws + WS_STATKV);
                pg8::gemm_phase<pg8::Epi<3>, pg8::StaticOrder, true, true>(Fp.lds, g, S, E, Fp.tid); }
#endif
        }
#endif
        if (!EVEN() && IN(BASE() + 1)) { REFRESH_L(); fixup_odd_meta(Fp, e); }
        SEAM(BASE() + 1, BASE() + 2);
#if PHM & 8
        if (IN(BASE() + 2) && EVEN()) { REFRESH_L(); attn_even_phase(Fp); }
#endif
#if PHM & 16
        if (IN(BASE() + 2) && !EVEN()) { REFRESH_L(); attn_odd_phase(args, Fp, e); }
#endif
        SEAM(BASE() + 2, BASE() + 3);
#if PHM & 32
        if (IN(BASE() + 3)) {
            REFRESH_L(); PTRS();
            {   pg8::Gemm g{obuf, (const bf16_t*)(ws + (EVEN() ? W_EVOUT : W_ODOUT) + e * SZ_SQ), LD_DM, LD_DM, DM}; pg8::StaticOrder S; S.init(MREAL, DM, Fp.G, Fp.bx);
                pg8::Epi<4> E{ec}; E.c.O = mbuf; E.c.ldc = LD_DM;
                pg8::gemm_phase<pg8::Epi<4>, pg8::StaticOrder, true, true>(Fp.lds, g, S, E, Fp.tid); }
            {   REFRESH_L(); PTRS();
                pg8::Gemm g{obuf, (const bf16_t*)(ws + (EVEN() ? W_EVOUT : W_ODOUT) + e * SZ_SQ), LD_DM, LD_DM, 256}; pg8::SplitKOrder S; S.init(MREAL / 256, DM, DM / 256, 256, Fp.G, Fp.bx);
                pg8::Epi<6> E{ec}; E.c.ldc = DM;
                pg8::gemm_phase<pg8::Epi<6>, pg8::SplitKOrder, true, false>(Fp.lds, g, S, E, Fp.tid); }
        }
#endif
        SEAM(BASE() + 3, BASE() + 4);
#if PHM & 64
        if (IN(BASE() + 4)) { REFRESH_L(); ew_phase(args, Fp, layer, 0); }
#endif
        SEAM(BASE() + 4, BASE() + 5);
#if PHM & 128
        if (IN(BASE() + 5)) {
            REFRESH_L(); PTRS();
            pg8::Gemm g{(const bf16_t*)(ws + WS_A8), (const bf16_t*)(ws + W_GU + layer * SZ_GU), LD8 / 2, LD8 / 2, DM / 2}; pg8::StaticOrder S; S.init(MPAD, GU_N, Fp.G, Fp.bx);
            pg8::Epi<7> E{ec}; E.c.O = act; E.c.ldc = LD_FF; E.c.rs = (const float*)(ws + WS_RS8); E.c.cs = (const float*)(ws + WS_CTL + CTL_COLMAX) + (size_t)layer * GU_N;
            pg8::gemm_phase<pg8::Epi<7>, pg8::StaticOrder, true, true, 2>(Fp.lds, g, S, E, Fp.tid);
        }
#endif
        if (DN8()) SEAM(BASE() + 5, BASE() + 6);
        if (DN8() && IN(BASE() + 6)) { REFRESH_L(); actq_phase(Fp); }
        SEAM(DN8() ? BASE() + 6 : BASE() + 5, BASE() + 7);
#if PHM & 256
        if (IN(BASE() + 7) && DN8()) {
            REFRESH_L(); PTRS();
            {   pg8::Gemm g{(const bf16_t*)(ws + WS_ACT8), (const bf16_t*)(ws + W_DN + layer * SZ_DN), LD8F / 2, LD8F / 2, DFF / 2}; pg8::StaticOrder S; S.init(MREAL, DM, Fp.G, Fp.bx);
                pg8::Epi<10> E{ec}; E.c.O = mbuf; E.c.ldc = LD_DM; E.c.rs = (const float*)(ws + WS_RSD); E.c.cs = (const float*)(ws + WS_CTL + CTL_COLMAX_DN) + (size_t)layer * DM;
                pg8::gemm_phase<pg8::Epi<10>, pg8::StaticOrder, true, true, 2>(Fp.lds, g, S, E, Fp.tid); }
            {   REFRESH_L(); PTRS();
                pg8::Gemm g{(const bf16_t*)(ws + WS_ACT8), (const bf16_t*)(ws + W_DN + layer * SZ_DN), LD8F / 2, LD8F / 2, 128}; pg8::SplitKOrder S; S.init(MREAL / 256, DM, DFF / 256, 128, Fp.G, Fp.bx);
                pg8::Epi<6> E{ec}; E.c.ldc = DM;
                pg8::gemm_phase<pg8::Epi<6>, pg8::SplitKOrder, true, false, 2>(Fp.lds, g, S, E, Fp.tid); }
        }
        if (IN(BASE() + 7) && !DN8()) {
            REFRESH_L(); PTRS();
            {   pg8::Gemm g{act, (const bf16_t*)(ws + W_DN + layer * SZ_DN), LD_FF, LD_FF, DFF}; pg8::StaticOrder S; S.init(MREAL, DM, Fp.G, Fp.bx);
                pg8::Epi<4> E{ec}; E.c.O = mbuf; E.c.ldc = LD_DM;
                pg8::gemm_phase<pg8::Epi<4>, pg8::StaticOrder, true, true>(Fp.lds, g, S, E, Fp.tid); }
            {   REFRESH_L(); PTRS();
                pg8::Gemm g{act, (const bf16_t*)(ws + W_DN + layer * SZ_DN), LD_FF, LD_FF, 256}; pg8::SplitKOrder S; S.init(MREAL / 256, DM, DFF / 256, 256, Fp.G, Fp.bx);
                pg8::Epi<6> E{ec}; E.c.ldc = DM;
                pg8::gemm_phase<pg8::Epi<6>, pg8::SplitKOrder, true, false>(Fp.lds, g, S, E, Fp.tid); }
        }
#endif
        SEAM(BASE() + 7, BASE() + 8);
#if PHM & 512
        if (IN(BASE() + 8)) { REFRESH_L(); ew_phase(args, Fp, layer, 1); }
#endif
        if (layer0 + 1 < DEPTH) SEAM(BASE() + 8, BASE() + 9);
    }
#ifdef PROBE_ATT
    if (IN(N_PHASES)) { REFRESH(); attn_odd_phase_probe<PROBE_ATT>(args, Fp, 1); }
#endif
#ifdef PROBE_EW
    if (IN(N_PHASES)) { REFRESH(); ew_phase(args, Fp, 1, 0); }
#endif
#ifdef PROBE_GEMM
    if (IN(N_PHASES)) {
        REFRESH(); PTRS();
#ifndef PROBE_LD
#define PROBE_LD LD_DM
#endif
        pg8::Gemm g{hbf, (const bf16_t*)(ws + W_GU), PROBE_LD, PROBE_LD, DM}; pg8::StaticOrder S; S.init(PROBE_LD ? MPAD : 256, PROBE_LD ? GU_N : 256 * 86 * 65, Fp.G, Fp.bx, PROBE_WGM);
        pg8::Epi<5> E{ec}; E.c.O = act; E.c.ldc = LD_FF;
        pg8::gemm_phase<pg8::Epi<5>, pg8::StaticOrder, PROBE_ALIGN, PROBE_SP2>(Fp.lds, g, S, E, Fp.tid);
    }
#endif
#undef PTRS
#undef REFRESH
#undef REFRESH_L
#undef LAYER
#undef BASE
#undef EVEN
#undef DN8
#undef IN
#undef SEAM
}

#ifndef MK_ONE_LAUNCH
#define MK_ONE_LAUNCH 1
#endif
extern "C" void kernel_launch(void* const* d_in, const int* in_sizes, int n_in, void* d_out, int out_size, void* d_ws, size_t ws_size, hipStream_t stream) {
    static int grid = 0;
    if (grid == 0) {
        if (n_in != 18 || in_sizes[0] != NB * SEQ * DM || out_size != NB * SEQ * DM || ws_size < WS_END) {
            fprintf(stderr, "kernel_launch: unexpected shapes or workspace (n_in %d, in0 %d, out %d, ws %zu < %zu); nothing launched\n", n_in, n_in > 0 ? in_sizes[0] : -1, out_size, ws_size, (size_t)WS_END); grid = -1; return; }
        int dev = 0, cus = 0;
        if (hipGetDevice(&dev) != hipSuccess || hipDeviceGetAttribute(&cus, hipDeviceAttributeMultiprocessorCount, dev) != hipSuccess || cus <= 0) { fprintf(stderr, "kernel_launch: device query failed\n"); grid = -1; return; }
        if (hipFuncSetAttribute((const void*)mega_fwd, hipFuncAttributeMaxDynamicSharedMemorySize, LDS_BYTES) != hipSuccess) { fprintf(stderr, "kernel_launch: hipFuncSetAttribute failed\n"); grid = -1; return; }
        int per_cu = 0;
        if (hipOccupancyMaxActiveBlocksPerMultiprocessor(&per_cu, (const void*)mega_fwd, 512, LDS_BYTES) != hipSuccess || per_cu < 1) fprintf(stderr, "kernel_launch: note: occupancy query reports %d workgroups per CU\n", per_cu);
        (void)hipGetLastError();
        grid = cus > 256 ? 256 : cus;
    }
    if (grid < 0) return;
    if (hipMemsetAsync((char*)d_ws + WS_CTL, 0, CTL_ZERO_BYTES, stream) != hipSuccess) { fprintf(stderr, "kernel_launch: memset failed\n"); return; }
    Args a{};
    for (int i = 0; i < 18; ++i) a.in[i] = (const float*)d_in[i];
    a.out = (float*)d_out; a.ws = (unsigned char*)d_ws;
    a.lam_init[0] = (float)(0.8 - 0.6 * exp(-0.3 * 1.0)); a.lam_init[1] = (float)(0.8 - 0.6 * exp(-0.3 * 3.0));
#if MK_ONE_LAUNCH
    a.ph_lo = 0; a.ph_hi = N_PHASES;
    hipLaunchKernelGGL(mega_fwd, dim3(grid), dim3(512), LDS_BYTES, stream, a);
#else
    for (int k = 0; k < N_PHASES; ++k) {
        a.ph_lo = k; a.ph_hi = k + 1;
        hipLaunchKernelGGL(mega_fwd, dim3(grid), dim3(512), LDS_BYTES, stream, a);
#ifdef PROBE_MASK
        { const int off = k < 2 ? 9 : ((k - 2) % PPL); if ((PROBE_MASK >> off) & 1) hipLaunchKernelGGL(mega_fwd, dim3(grid), dim3(512), LDS_BYTES, stream, a); }
#endif
    }
#if defined(PROBE_GEMM) || defined(PROBE_EW) || defined(PROBE_ATT)
    for (int r = 0; r < PROBE_REP; ++r) { a.ph_lo = N_PHASES; a.ph_hi = N_PHASES + 1; hipLaunchKernelGGL(mega_fwd, dim3(grid), dim3(512), LDS_BYTES, stream, a); }
#endif
#endif
}
```

```cpp
#define MK_ONE_LAUNCH 1
#include <hip/hip_runtime.h>
#include <cstdio>
#include <cstdint>
#include <cmath>

#define LAS __attribute__((address_space(3)))
#define GAS __attribute__((address_space(1)))
typedef unsigned short bf16_t;
typedef short bf16x8 __attribute__((ext_vector_type(8)));
typedef short s16x4 __attribute__((ext_vector_type(4)));
typedef float f32x2 __attribute__((ext_vector_type(2)));
typedef float f32x4 __attribute__((ext_vector_type(4)));
typedef float f32x16 __attribute__((ext_vector_type(16)));
typedef unsigned u32x2 __attribute__((ext_vector_type(2)));
typedef unsigned u32x4 __attribute__((ext_vector_type(4)));
typedef int i32x4 __attribute__((ext_vector_type(4)));
typedef int i32x8 __attribute__((ext_vector_type(8)));

constexpr int DM = 4096, NB = 4, SEQ = 4096, NMETA = 16, DEPTH = 4;
constexpr int MREAL = NB * SEQ;
constexpr int META0 = MREAL;
constexpr int MUSED = MREAL + NMETA;
constexpr int MPAD = 16640;
constexpr int DFF = 11008;
constexpr int NPOS = NMETA + SEQ;
constexpr float EPS = 1e-6f;
constexpr int EV_N = 7680, EV_QF = 0, EV_KF = 2048, EV_VF = 4096, EV_CQ = 6144, EV_CKV = 7040, EV_KR = 7360, EV_FL = 7424;
constexpr int QRANK = 896, KVRANK = 320, KVK = 384;
constexpr int UQ_N = 3072, UKV_N = 4096, OD_N = 12288, GU_N = 2 * DFF;
constexpr int EV_SRC_N = 7440;
constexpr int AMAXP_LD = 352;
constexpr int LD_DM = 4160, LD_FF = 11072, LD_EV = 7744, LD_OD = 12352, LD_UQ = 3136, LD_UKV = 4160, LD_QR = 960, LD_KV = 448;

__device__ __forceinline__ unsigned cvt_pk_bf16(float lo, float hi) { unsigned r; asm volatile("v_cvt_pk_bf16_f32 %0, %1, %2" : "=v"(r) : "v"(lo), "v"(hi)); return r; }
__device__ __forceinline__ float bf_lo(unsigned w) { return __uint_as_float(w << 16); }
__device__ __forceinline__ float bf_hi(unsigned w) { return __uint_as_float(w & 0xffff0000u); }
__device__ __forceinline__ float wave_sum(float v) {
#pragma unroll
    for (int o = 1; o < 64; o <<= 1) v += __shfl_xor(v, o);
    return v;
}

__device__ __forceinline__ int opq_tid(int wave) {
    int l; asm volatile("v_mbcnt_lo_u32_b32 %0, -1, 0\n\tv_mbcnt_hi_u32_b32 %0, -1, %0" : "=v"(l));
    return (wave << 6) | l;
}

__device__ __forceinline__ int opq_s(int v) { asm volatile("" : "+s"(v)); return v; }

namespace pg8 {
#define PG8_LAS __attribute__((address_space(3)))
constexpr int RS_LDS_OFF = 131072;
constexpr int BM = 256, BK = 64, HALF = 128, HTB = HALF * BK * 2  , STAGE_BYTES = 8 * HTB, NXCD = 8, WGM = 8;

__host__ __device__ __forceinline__ int lds_byte(int r, int c) { const int st = (r >> 4) * 2 + (c >> 5), rr = r & 15, cc = c & 31, ob = rr * 64 + cc * 2; return st * 1024 + (ob ^ (((ob >> 9) & 1) << 5)); }
__host__ __device__ __forceinline__ void stage_rc(int b, int& R, int& C) { const int st = b / 1024, sb = b % 1024, swz = sb ^ (((sb >> 9) & 1) << 5); R = (st >> 1) * 16 + swz / 64; C = (st & 1) * 32 + (swz % 64) / 2; }
__host__ __device__ __forceinline__ int perm32(int rho) { const int n = rho >> 4, i = rho & 15; return 8 * (i >> 2) + 4 * n + (i & 3); }

struct Unit { int pm, pn, ko, ks; };
struct Gemm { const bf16_t* A; const bf16_t* Bt; int lda, ldb, K; };

struct StaticOrder {
    int nM, nN, nwg, G, c, wgm;
    __host__ __device__ void init(int M, int N, int G_, int c_, int wgm_ = WGM) { nM = M / BM; nN = N / BM; nwg = nM * nN; G = G_; c = c_; wgm = wgm_; }
    __host__ __device__ bool next(int i, Unit& u) const {
        const long L = (long)i * G + c; if (L >= nwg) return false;
        int wgid = (int)L; { const int q = nwg / NXCD, r = nwg % NXCD, xcd = wgid % NXCD, off = wgid / NXCD; wgid = (xcd < r ? xcd * (q + 1) : r * (q + 1) + (xcd - r) * q) + off; }
        const int nig = wgm * nN, gid = wgid / nig, fm = gid * wgm, gsz = (nM - fm) < wgm ? (nM - fm) : wgm;
        u.pm = fm + ((wgid % nig) % gsz); u.pn = (wgid % nig) / gsz; u.ko = 0; u.ks = 0; return true;
    }
    __device__ __forceinline__ void a_ready(const Unit&) const {}
    __device__ __forceinline__ void done(const Unit&) const {}
};
struct SplitKOrder {
    int pm, nN, nS, kslice, G, c;
    __host__ __device__ void init(int pm_, int N, int nS_, int kslice_, int G_, int c_) { pm = pm_; nN = N / BM; nS = nS_; kslice = kslice_; G = G_; c = c_; }
    __host__ __device__ bool next(int i, Unit& u) const {
        const int L = i * G + c; if (L >= nN * nS) return false;
        u.pm = pm; u.pn = L % nN; u.ks = L / nN; u.ko = u.ks * kslice; return true;
    }
    __device__ __forceinline__ void a_ready(const Unit&) const {}
    __device__ __forceinline__ void done(const Unit&) const {}
};

struct EpiCtx {
    bf16_t* O; int ldc;
    const float* rs;
    float* statq; float* statkv;
    float* flogT;
    const float* cosT; const float* sinT;
    float* statm;
    float* part;
    const float* cs;
    float* amaxp;
};
__device__ __forceinline__ int row_pos(int row) { return row < MREAL ? NMETA + (row & (SEQ - 1)) : row - META0; }
__device__ __forceinline__ void store8(bf16_t* p, f32x4 v0, f32x4 v1) {
    u32x4 w; w.x = cvt_pk_bf16(v0[0], v0[1]); w.y = cvt_pk_bf16(v0[2], v0[3]); w.z = cvt_pk_bf16(v1[0], v1[1]); w.w = cvt_pk_bf16(v1[2], v1[3]);
    *(u32x4*)p = w;
}
__device__ __forceinline__ float sel4(const float (&a)[4], int i) { return i == 0 ? a[0] : (i == 1 ? a[1] : (i == 2 ? a[2] : a[3])); }
__device__ __forceinline__ float sq8(f32x4 a, f32x4 b) { return (a[0] * a[0] + a[1] * a[1]) + (a[2] * a[2] + a[3] * a[3]) + (b[0] * b[0] + b[1] * b[1]) + (b[2] * b[2] + b[3] * b[3]); }
__device__ __forceinline__ float silu_mul(float g, float u) { return g * __builtin_amdgcn_rcpf(1.0f + __builtin_amdgcn_exp2f(-1.4426950408889634f * g)) * u; }

__device__ __forceinline__ void fwht32_lanes(f32x4& a, f32x4& b, float s16, float s32) {
    f32x4 t;
    t = (f32x4){a[0] + a[1], a[0] - a[1], a[2] + a[3], a[2] - a[3]}; a = (f32x4){t[0] + t[2], t[1] + t[3], t[0] - t[2], t[1] - t[3]};
    t = (f32x4){b[0] + b[1], b[0] - b[1], b[2] + b[3], b[2] - b[3]}; b = (f32x4){t[0] + t[2], t[1] + t[3], t[0] - t[2], t[1] - t[3]};
    t = a + b; b = a - b; a = t;
#pragma unroll
    for (int j = 0; j < 4; ++j) {
        auto r = __builtin_amdgcn_permlane16_swap(__float_as_uint(a[j]), __float_as_uint(a[j]), false, false); a[j] = __builtin_fmaf(s16, __uint_as_float(r[1]), __uint_as_float(r[0]));
        auto q = __builtin_amdgcn_permlane16_swap(__float_as_uint(b[j]), __float_as_uint(b[j]), false, false); b[j] = __builtin_fmaf(s16, __uint_as_float(q[1]), __uint_as_float(q[0])); }
#pragma unroll
    for (int j = 0; j < 4; ++j) {
        auto r = __builtin_amdgcn_permlane32_swap(__float_as_uint(a[j]), __float_as_uint(a[j]), false, false); a[j] = __builtin_fmaf(s32, __uint_as_float(r[1]), __uint_as_float(r[0]));
        auto q = __builtin_amdgcn_permlane32_swap(__float_as_uint(b[j]), __float_as_uint(b[j]), false, false); b[j] = __builtin_fmaf(s32, __uint_as_float(q[1]), __uint_as_float(q[0])); }
}
template <int MODE> struct Epi {
    static constexpr bool PERM = true, AFTER_DRAIN = false;
    EpiCtx c;
    static constexpr bool EVM = (MODE == 1 || MODE == 9), I8M = (MODE == 8 || MODE == 9 || MODE == 10), OUTM = (MODE == 4 || MODE == 10);
    static constexpr bool RS_LDS = (MODE == 0 || MODE == 1 || MODE == 5 || MODE == 7 || MODE == 8 || MODE == 9 || MODE == 10), CS_LDS = (MODE == 7 || MODE == 8 || MODE == 9 || MODE == 10);
    __device__ __forceinline__ void pre(const Unit& u, PG8_LAS unsigned char* slot, int wid) const {
        if constexpr (RS_LDS) { if (wid < 4) { int l; asm volatile("v_mbcnt_lo_u32_b32 %0, -1, 0\n\tv_mbcnt_hi_u32_b32 %0, -1, %0" : "=v"(l));
            const char* b = (const char*)(c.rs + u.pm * BM + wid * 64); asm volatile("" : "+s"(b));
            __builtin_amdgcn_global_load_lds((const unsigned*)(b + (unsigned)(l * 4)), (PG8_LAS unsigned*)(slot + wid * 256), 4, 0, 0); } }
        if constexpr (CS_LDS) { if (wid >= 4) { int l; asm volatile("v_mbcnt_lo_u32_b32 %0, -1, 0\n\tv_mbcnt_hi_u32_b32 %0, -1, %0" : "=v"(l));
            const char* b = (const char*)(c.cs + u.pn * BM + (wid - 4) * 64); asm volatile("" : "+s"(b));
            __builtin_amdgcn_global_load_lds((const unsigned*)(b + (unsigned)(l * 4)), (PG8_LAS unsigned*)(slot + 2048 + (wid - 4) * 256), 4, 0, 0); } }
    }
    __device__ __forceinline__ void operator()(const f32x4 (&acc)[2][2][4][2], const Unit& u, int wr, int wc, int fr, int fq, const PG8_LAS float* rsl) const {
        int pm_ = u.pm, pn_ = u.pn; asm volatile("" : "+s"(pm_), "+s"(pn_));
        if constexpr (MODE == 6) {
            if (wr == 0) { float* P = c.part + (unsigned)((u.ks * 16 + fr) * c.ldc + pn_ * BM + wc * 32 + 8 * fq);
#pragma unroll
                for (int bj = 0; bj < 2; ++bj) { *(f32x4*)(P + bj * HALF) = acc[0][bj][0][0]; *(f32x4*)(P + bj * HALF + 4) = acc[0][bj][0][1]; } }
            return;
        }
        const Unit uu{pm_, pn_};
        const int row0 = uu.pm * BM + wr * 64 + fr;
        float s[2][4];
#pragma unroll
        for (int ai = 0; ai < 2; ++ai)
#pragma unroll
            for (int m = 0; m < 4; ++m) {
                const int row = row0 + ai * HALF + m * 16;
                if constexpr (RS_LDS) s[ai][m] = rsl[ai * HALF + wr * 64 + m * 16 + fr];
                else if constexpr (MODE == 2) { const f32x4* q = (const f32x4*)(c.rs + (unsigned)(row * 32)); f32x4 t = q[0];
#pragma unroll
                    for (int k = 1; k < 7; ++k) t += q[k];
                    s[ai][m] = __builtin_amdgcn_rsqf(((t[0] + t[1]) + (t[2] + t[3])) * (1.0f / QRANK) + EPS); }
                else if constexpr (MODE == 3) { const f32x4* q = (const f32x4*)(c.rs + (unsigned)(row * 16)); const f32x4 t = q[0] + q[1]; const f32x2 t2 = *(const f32x2*)(q + 2);
                    s[ai][m] = __builtin_amdgcn_rsqf((((t[0] + t[1]) + (t[2] + t[3])) + (t2[0] + t2[1])) * (1.0f / KVRANK) + EPS); }
                else s[ai][m] = 1.0f;
            }
        if constexpr (MODE == 7) {
            const int col0 = uu.pn * HALF + wc * 32 + 8 * fq;
            const PG8_LAS float* csl = rsl + 512 + wc * 32 + 8 * fq;
            const f32x4 cg0 = *(const PG8_LAS f32x4*)csl, cg1 = *(const PG8_LAS f32x4*)(csl + 4), cu0 = *(const PG8_LAS f32x4*)(csl + HALF), cu1 = *(const PG8_LAS f32x4*)(csl + HALF + 4);
#pragma unroll
            for (int ai = 0; ai < 2; ++ai)
#pragma unroll
                for (int m = 0; m < 4; ++m) {
                    const int row = row0 + ai * HALF + m * 16; const float sc = s[ai][m];
                    const f32x4 g0 = __builtin_convertvector(__builtin_bit_cast(i32x4, acc[ai][0][m][0]), f32x4) * (cg0 * sc), g1 = __builtin_convertvector(__builtin_bit_cast(i32x4, acc[ai][0][m][1]), f32x4) * (cg1 * sc);
                    const f32x4 u0 = __builtin_convertvector(__builtin_bit_cast(i32x4, acc[ai][1][m][0]), f32x4) * (cu0 * sc), u1 = __builtin_convertvector(__builtin_bit_cast(i32x4, acc[ai][1][m][1]), f32x4) * (cu1 * sc);
                    f32x4 o0, o1;
#pragma unroll
                    for (int j = 0; j < 4; ++j) { o0[j] = silu_mul(g0[j], u0[j]); o1[j] = silu_mul(g1[j], u1[j]); }
                    store8(c.O + (unsigned)(row * c.ldc + col0), o0, o1);
                }
            return;
        } else if constexpr (MODE == 5) {
            const int col0 = uu.pn * HALF + wc * 32 + 8 * fq;
#pragma unroll
            for (int ai = 0; ai < 2; ++ai)
#pragma unroll
                for (int m = 0; m < 4; ++m) {
                    const int row = row0 + ai * HALF + m * 16; const float sc = s[ai][m];
                    const f32x4 g0 = acc[ai][0][m][0] * sc, g1 = acc[ai][0][m][1] * sc, u0 = acc[ai][1][m][0] * sc, u1 = acc[ai][1][m][1] * sc;
                    f32x4 o0, o1;
#pragma unroll
                    for (int j = 0; j < 4; ++j) { o0[j] = silu_mul(g0[j], u0[j]); o1[j] = silu_mul(g1[j], u1[j]); }
                    store8(c.O + (unsigned)(row * c.ldc + col0), o0, o1);
                }
            return;
        } else {
            float ssm[2][4];
            if constexpr (OUTM) {
#pragma unroll
                for (int ai = 0; ai < 2; ++ai)
#pragma unroll
                    for (int m = 0; m < 4; ++m) ssm[ai][m] = 0.f;
            }
#pragma unroll
            for (int bj = 0; bj < 2; ++bj) {
                const int gcol = uu.pn * BM + bj * HALF + wc * 32;
                const int col0 = gcol + 8 * fq;
                bool rope = false; int i0 = 0;
                if constexpr (EVM) { rope = (gcol >= EV_KR && gcol < EV_FL); i0 = (col0 - EV_KR) >> 1; }
                if constexpr (MODE == 2) { rope = (gcol >= 2048); i0 = ((col0 - 2048) & 63) >> 1; }
                f32x4 c0 = {1.f, 1.f, 1.f, 1.f}, c1 = c0;
                if constexpr (I8M) { const PG8_LAS float* csl = rsl + 512 + bj * HALF + wc * 32 + 8 * fq; c0 = *(const PG8_LAS f32x4*)csl; c1 = *(const PG8_LAS f32x4*)(csl + 4); }
                if ((EVM || MODE == 2) && rope) {
#pragma unroll
                    for (int ai = 0; ai < 2; ++ai)
#pragma unroll
                        for (int m = 0; m < 4; ++m) {
                            const int row = row0 + ai * HALF + m * 16; const float sc = s[ai][m]; const int pos = row_pos(row);
                            const f32x4 cs = *(const f32x4*)(c.cosT + (unsigned)(pos * 32 + i0)), sn = *(const f32x4*)(c.sinT + (unsigned)(pos * 32 + i0));
                            f32x4 x1, x2;
                            if constexpr (I8M) { x1 = __builtin_convertvector(__builtin_bit_cast(i32x4, acc[ai][bj][m][0]), f32x4) * (c0 * sc); x2 = __builtin_convertvector(__builtin_bit_cast(i32x4, acc[ai][bj][m][1]), f32x4) * (c1 * sc); }
                            else { x1 = acc[ai][bj][m][0] * sc; x2 = acc[ai][bj][m][1] * sc; }
                            store8(c.O + (unsigned)(row * c.ldc + col0), x1 * cs - x2 * sn, x1 * sn + x2 * cs);
                            asm volatile("" ::: "memory");
                        }
                } else {
                    float ss[2][4];
#pragma unroll
                    for (int ai = 0; ai < 2; ++ai)
#pragma unroll
                        for (int m = 0; m < 4; ++m) {
                            const int row = row0 + ai * HALF + m * 16; const float sc = s[ai][m];
                            f32x4 v0, v1;
                            if constexpr (I8M) { v0 = __builtin_convertvector(__builtin_bit_cast(i32x4, acc[ai][bj][m][0]), f32x4) * (c0 * sc); v1 = __builtin_convertvector(__builtin_bit_cast(i32x4, acc[ai][bj][m][1]), f32x4) * (c1 * sc); }
                            else { v0 = acc[ai][bj][m][0] * sc; v1 = acc[ai][bj][m][1] * sc; }
                            store8(c.O + (unsigned)(row * c.ldc + col0), v0, v1);
                            if constexpr (EVM) {
                                ss[ai][m] = sq8(v0, v1);
                                if (gcol == EV_FL && fq < 2) {
#pragma unroll
                                    for (int j = 0; j < 4; ++j) { c.flogT[(unsigned)((8 * fq + j) * MPAD + row)] = v0[j]; c.flogT[(unsigned)((8 * fq + 4 + j) * MPAD + row)] = v1[j]; }
                                }
                            }
                            if constexpr (OUTM) ssm[ai][m] += sq8(v0, v1);
                            asm volatile("" ::: "memory");
                        }
                    if constexpr (EVM) {
                        if (gcol >= EV_CQ && gcol < EV_KR) {
                            const bool isq = gcol < EV_CKV; float* tgt = isq ? c.statq : c.statkv; const int ld = isq ? 32 : 16, slot = (gcol - (isq ? EV_CQ : EV_CKV)) >> 5;
#pragma unroll
                            for (int ai = 0; ai < 2; ++ai) {
#pragma unroll
                                for (int m = 0; m < 4; ++m) { ss[ai][m] += __shfl_xor(ss[ai][m], 16); ss[ai][m] += __shfl_xor(ss[ai][m], 32); }
                                tgt[(unsigned)((row0 + ai * HALF + fq * 16) * ld + slot)] = sel4(ss[ai], fq);
                            }
                        }
                    }
                }
            }
            if constexpr (OUTM) {
#pragma unroll
                for (int ai = 0; ai < 2; ++ai) {
#pragma unroll
                    for (int m = 0; m < 4; ++m) { ssm[ai][m] += __shfl_xor(ssm[ai][m], 16); ssm[ai][m] += __shfl_xor(ssm[ai][m], 32); }
                    c.statm[(unsigned)((row0 + ai * HALF + fq * 16) * 64 + uu.pn * 4 + wc)] = sel4(ssm[ai], fq);
                }
            }
        }
    }
};
template <int DT> __device__ __forceinline__ f32x4 mma_k2(const bf16x8 (&b)[2], const bf16x8 (&a)[2], f32x4 c) {
    if constexpr (DT == 1) {
        typedef short s16x16 __attribute__((ext_vector_type(16)));
        const s16x16 bb = __builtin_shufflevector(b[0], b[1], 0, 1, 2, 3, 4, 5, 6, 7, 8, 9, 10, 11, 12, 13, 14, 15), aa = __builtin_shufflevector(a[0], a[1], 0, 1, 2, 3, 4, 5, 6, 7, 8, 9, 10, 11, 12, 13, 14, 15);
        return __builtin_amdgcn_mfma_scale_f32_16x16x128_f8f6f4(__builtin_bit_cast(i32x8, bb), __builtin_bit_cast(i32x8, aa), c, 0, 0, 0, 0, 0, 0);
    } else if constexpr (DT == 2) {
        i32x4 ci = __builtin_bit_cast(i32x4, c);
        ci = __builtin_amdgcn_mfma_i32_16x16x64_i8(__builtin_bit_cast(i32x4, b[0]), __builtin_bit_cast(i32x4, a[0]), ci, 0, 0, 0);
        ci = __builtin_amdgcn_mfma_i32_16x16x64_i8(__builtin_bit_cast(i32x4, b[1]), __builtin_bit_cast(i32x4, a[1]), ci, 0, 0, 0);
        return __builtin_bit_cast(f32x4, ci);
    } else {
        c = __builtin_amdgcn_mfma_f32_16x16x32_bf16(b[0], a[0], c, 0, 0, 0);
        return __builtin_amdgcn_mfma_f32_16x16x32_bf16(b[1], a[1], c, 0, 0, 0);
    }
}
template <class Epi, class Sched, bool ALIGN_EPI = false, bool SP2 = false, int DT = 0>
__device__ __forceinline__ void gemm_phase(PG8_LAS unsigned char* lds, const Gemm g, const Sched& S, const Epi& E, const int tid) {
    const int wid = __builtin_amdgcn_readfirstlane(tid >> 6), lane = tid & 63, wr = wid >> 2, wc = wid & 3, fr = lane & 15, fq = lane >> 4;
    const int K = g.K; int nt = K / BK; if (K < 1024) asm volatile("" : "+s"(nt));
    unsigned voffA[2], voffB[2];
#pragma unroll
    for (int i = 0; i < 2; ++i) { int R, C; stage_rc(tid * 16 + i * 8192, R, C); const int Rb = Epi::PERM ? ((R & ~31) + perm32(R & 31)) : R;
        voffA[i] = (unsigned)(R * g.lda + C) * 2u; voffB[i] = (unsigned)(Rb * g.ldb + C) * 2u; }
    const size_t kstep = (size_t)(BK * 2);
    const size_t hstepA = (size_t)HALF * g.lda * 2, hstepB = (size_t)HALF * g.ldb * 2;
    const size_t tstepA = 2 * hstepA, tstepB = 2 * hstepB;
    const unsigned ldsw = (unsigned)wid * 1024u;
    const int aoff = lds_byte(wr * 64 + fr, fq * 8), boff = lds_byte(wc * 32 + fr, fq * 8);
#define PG8_SA(b, h) (((b) * 2 + (h)) * HTB)
#define PG8_SB(b, h) ((4 + (b) * 2 + (h)) * HTB)
#define PG8_STAGE(bufoff, gbase, voff) do { const char* _b = (const char*)(gbase); asm volatile("" : "+s"(_b));     \
        _Pragma("unroll") for (int _i = 0; _i < 2; ++_i) { unsigned _v = (voff)[_i]; asm volatile("" : "+v"(_v)); \
        __builtin_amdgcn_global_load_lds((const unsigned*)(_b + _v), (PG8_LAS unsigned*)(lds + (bufoff) + ldsw + _i * 8192), 16, 0, 0); } } while (0)
#define PG8_LDA(dst, b, h) do { _Pragma("unroll") for (int m = 0; m < 4; ++m) _Pragma("unroll") for (int k = 0; k < 2; ++k) dst[m][k] = *(const PG8_LAS bf16x8*)(lds + PG8_SA(b, h) + aoff + m * 2048 + k * 1024); } while (0)
#define PG8_LDB(dst, b, h) do { _Pragma("unroll") for (int n = 0; n < 2; ++n) _Pragma("unroll") for (int k = 0; k < 2; ++k) dst[n][k] = *(const PG8_LAS bf16x8*)(lds + PG8_SB(b, h) + boff + n * 2048 + k * 1024); } while (0)
#define PG8_MMA(ai, bj, At, Bt) do { __builtin_amdgcn_s_setprio(1); _Pragma("unroll") for (int m = 0; m < 4; ++m) _Pragma("unroll") for (int n = 0; n < 2; ++n) \
        acc[ai][bj][m][n] = mma_k2<DT>(Bt[n], At[m], acc[ai][bj][m][n]); __builtin_amdgcn_s_setprio(0); } while (0)
#define PG8_WAIT_V(n) asm volatile("s_waitcnt vmcnt(" #n ")" ::: "memory")
#define PG8_WAIT_L(n) asm volatile("s_waitcnt lgkmcnt(" #n ")" ::: "memory")
#define PG8_BAR __builtin_amdgcn_s_barrier()
#define PG8_SCHED __builtin_amdgcn_sched_barrier(0)
    Unit cur, nxt; int ui = 0;
    if (!S.next(0, cur)) return;
    f32x4 acc[2][2][4][2];
#pragma unroll
    for (int a = 0; a < 2; ++a)
#pragma unroll
        for (int b = 0; b < 2; ++b)
#pragma unroll
            for (int m = 0; m < 4; ++m)
#pragma unroll
                for (int n = 0; n < 2; ++n) acc[a][b][m][n] = (f32x4){0.f, 0.f, 0.f, 0.f};
    bf16x8 At[4][2], B0[2][2], B1[2][2];
    const char* cA = (const char*)g.A + (size_t)cur.pm * tstepA + (size_t)cur.ko * 2; const char* cB = (const char*)g.Bt + (size_t)cur.pn * tstepB + (size_t)cur.ko * 2;
    S.a_ready(cur);
    E.pre(cur, lds + RS_LDS_OFF, wid);
    if constexpr (SP2) {
        PG8_STAGE(PG8_SB(0, 0), cB, voffB); PG8_STAGE(PG8_SB(0, 1), cB + hstepB, voffB); PG8_STAGE(PG8_SA(0, 0), cA, voffA); PG8_STAGE(PG8_SA(0, 1), cA + hstepA, voffA);
        if (wr == 1) PG8_BAR;
        PG8_WAIT_V(2); PG8_BAR;
        PG8_STAGE(PG8_SB(1, 0), cB + kstep, voffB); PG8_STAGE(PG8_SA(1, 0), cA + kstep, voffA); PG8_STAGE(PG8_SB(1, 1), cB + hstepB + kstep, voffB);
        PG8_WAIT_V(6); PG8_BAR;
    } else {
        PG8_STAGE(PG8_SB(0, 0), cB, voffB); PG8_STAGE(PG8_SA(0, 0), cA, voffA); PG8_STAGE(PG8_SB(0, 1), cB + hstepB, voffB); PG8_STAGE(PG8_SA(0, 1), cA + hstepA, voffA);
        if (wr == 1) PG8_BAR;
        PG8_WAIT_V(4); PG8_BAR;
        PG8_STAGE(PG8_SB(1, 0), cB + kstep, voffB); PG8_STAGE(PG8_SA(1, 0), cA + kstep, voffA); PG8_STAGE(PG8_SB(1, 1), cB + hstepB + kstep, voffB);
        PG8_WAIT_V(6); PG8_BAR;
    }
    for (;;) {
        const bool has_next = S.next(ui + 1, nxt);
        const char* nA = has_next ? (const char*)g.A + (size_t)nxt.pm * tstepA + (size_t)nxt.ko * 2 : cA; const char* nB = has_next ? (const char*)g.Bt + (size_t)nxt.pn * tstepB + (size_t)nxt.ko * 2 : cB;
        for (int t = 0; t < nt; t += 2) {
            const bool last = (t == nt - 2);
            const char* a1 = cA + (size_t)(t + 1) * kstep;
            const char* a2 = last ? nA : cA + (size_t)(t + 2) * kstep; const char* b2 = last ? nB : cB + (size_t)(t + 2) * kstep;
            const char* a3 = a2 + kstep; const char* b3 = b2 + kstep;
            if (last && has_next) { S.a_ready(nxt); E.pre(nxt, lds + RS_LDS_OFF + ((ui + 1) & 1) * 1024, wid); }
            if constexpr (SP2) {
            PG8_LDB(B0, 0, 0); PG8_LDB(B1, 0, 1); PG8_SCHED; PG8_LDA(At, 0, 0); PG8_STAGE(PG8_SA(1, 1), a1 + hstepA, voffA);
            PG8_WAIT_V(8); PG8_WAIT_L(0); PG8_BAR; PG8_MMA(0, 0, At, B0); PG8_MMA(0, 1, At, B1); PG8_BAR; PG8_SCHED;
            PG8_LDA(At, 0, 1); PG8_STAGE(PG8_SB(0, 0), b2, voffB); PG8_STAGE(PG8_SB(0, 1), b2 + hstepB, voffB); PG8_STAGE(PG8_SA(0, 0), a2, voffA);
            PG8_WAIT_V(8); PG8_WAIT_L(0); PG8_BAR; PG8_MMA(1, 0, At, B0); PG8_MMA(1, 1, At, B1); PG8_BAR; PG8_SCHED;
            PG8_LDB(B0, 1, 0); PG8_LDB(B1, 1, 1); PG8_SCHED; PG8_LDA(At, 1, 0); PG8_STAGE(PG8_SA(0, 1), a2 + hstepA, voffA);
            PG8_WAIT_V(8); PG8_WAIT_L(0); PG8_BAR; PG8_MMA(0, 0, At, B0); PG8_MMA(0, 1, At, B1); PG8_BAR; PG8_SCHED;
            PG8_LDA(At, 1, 1); PG8_STAGE(PG8_SB(1, 0), b3, voffB); PG8_STAGE(PG8_SB(1, 1), b3 + hstepB, voffB); PG8_STAGE(PG8_SA(1, 0), a3, voffA);
            PG8_WAIT_V(8); PG8_WAIT_L(0); PG8_BAR; PG8_MMA(1, 0, At, B0); PG8_MMA(1, 1, At, B1); PG8_BAR; PG8_SCHED;
            } else {
            PG8_LDB(B0, 0, 0); PG8_SCHED; PG8_LDA(At, 0, 0); PG8_STAGE(PG8_SA(1, 1), a1 + hstepA, voffA);
            PG8_WAIT_L(8); PG8_BAR; PG8_WAIT_L(0); PG8_MMA(0, 0, At, B0); PG8_BAR; PG8_SCHED;
            PG8_LDB(B1, 0, 1); PG8_STAGE(PG8_SB(0, 0), b2, voffB);
            PG8_BAR; PG8_WAIT_L(0); PG8_MMA(0, 1, At, B1); PG8_BAR;
            PG8_LDA(At, 0, 1); PG8_STAGE(PG8_SA(0, 0), a2, voffA);
            PG8_BAR; PG8_WAIT_L(0); PG8_MMA(1, 0, At, B0); PG8_BAR; PG8_SCHED;
            PG8_STAGE(PG8_SB(0, 1), b2 + hstepB, voffB);
            PG8_WAIT_V(6); PG8_BAR; PG8_MMA(1, 1, At, B1); PG8_BAR;
            PG8_LDB(B0, 1, 0); PG8_SCHED; PG8_LDA(At, 1, 0); PG8_STAGE(PG8_SA(0, 1), a2 + hstepA, voffA);
            PG8_WAIT_L(8); PG8_BAR; PG8_WAIT_L(0); PG8_MMA(0, 0, At, B0); PG8_BAR; PG8_SCHED;
            PG8_LDB(B1, 1, 1); PG8_STAGE(PG8_SB(1, 0), b3, voffB);
            PG8_BAR; PG8_WAIT_L(0); PG8_MMA(0, 1, At, B1); PG8_BAR;
            PG8_LDA(At, 1, 1); PG8_STAGE(PG8_SA(1, 0), a3, voffA);
            PG8_BAR; PG8_WAIT_L(0); PG8_MMA(1, 0, At, B0); PG8_BAR; PG8_SCHED;
            PG8_STAGE(PG8_SB(1, 1), b3 + hstepB, voffB);
            PG8_WAIT_V(6); PG8_BAR; PG8_MMA(1, 1, At, B1); PG8_BAR;
            }
        }
        if constexpr (ALIGN_EPI) { if (wr == 0) PG8_BAR; }
        if constexpr (!Epi::AFTER_DRAIN) { int l2; asm volatile("v_mbcnt_lo_u32_b32 %0, -1, 0\n\tv_mbcnt_hi_u32_b32 %0, -1, %0" : "=v"(l2));
            E(acc, cur, wr, wc, l2 & 15, l2 >> 4, (const PG8_LAS float*)(lds + RS_LDS_OFF + (ui & 1) * 1024)); S.done(cur); }
        if (!has_next) break;
#pragma unroll
        for (int a = 0; a < 2; ++a)
#pragma unroll
            for (int b = 0; b < 2; ++b)
#pragma unroll
                for (int m = 0; m < 4; ++m)
#pragma unroll
                    for (int n = 0; n < 2; ++n) acc[a][b][m][n] = (f32x4){0.f, 0.f, 0.f, 0.f};
        cur = nxt; cA = nA; cB = nB; ++ui;
        if constexpr (ALIGN_EPI) { if (wr == 1) PG8_BAR; }
    }
    PG8_WAIT_V(0);
    if constexpr (!ALIGN_EPI) { if (wr == 0) PG8_BAR; }
    PG8_BAR;
    if constexpr (Epi::AFTER_DRAIN) { E.fused(acc, cur, wr, wc, fr, fq, lds, wid, lane); S.done(cur); }
#undef PG8_SA
#undef PG8_SB
#undef PG8_STAGE
#undef PG8_LDA
#undef PG8_LDB
#undef PG8_MMA
#undef PG8_WAIT_V
#undef PG8_WAIT_L
#undef PG8_BAR
#undef PG8_SCHED
}
}
using pg8::sq8; using pg8::store8;

namespace att {
constexpr int SHM_V = 16384, SHM_K = 16384, SHM_K2 = 8192;
constexpr int OFF_V = 0, OFF_K = 2 * SHM_V, OFF_K2 = OFF_K + 2 * SHM_K, OFF_BIAS = OFF_K2 + 2 * SHM_K2, OFF_TBL = OFF_BIAS + 512, OFF_WS = OFF_TBL + 512, LDS_END = OFF_WS + 8 * 256;
constexpr float THR = 8.f;
#define KSWZ(row, colB) ((row) * 256 + ((colB) ^ (((row) & 15) << 4)))
#define K2SWZ(row, colB) ((row) * 128 + ((colB) ^ ((((row) >> 1) & 7) << 4)))
#define SBAR() __builtin_amdgcn_sched_barrier(0)
__device__ __forceinline__ int v_st(int k, int c) { const int kk = (k & ~0xC) | ((k & 4) << 1) | ((k & 8) >> 1); return ((kk >> 3) * 4 + (c >> 5)) * 512 + ((kk & 7) * 32 + (c & 31)) * 2; }
__device__ __forceinline__ int v_rd_base(int lane) { return ((lane & 3) << 3) | (((lane >> 2) & 3) << 6) | (((lane >> 4) & 1) << 5) | (((lane >> 5) & 1) << 8); }
constexpr int v_rd_off(int d0, int ks, int half) { return d0 * 512 + ks * 4096 + half * 2048; }
__device__ __forceinline__ int crow(int r, int hi) { return (r & 3) + 8 * (r >> 2) + 4 * hi; }

template <int MODE> struct Cfg { static constexpr float SCALE = (MODE == 1) ? 0.07216878364870322f : 0.08838834764831845f; static constexpr int DK = (MODE == 1) ? 192 : 128; };

__device__ __forceinline__ void mask_tile(f32x16& p0, f32x16& p1, int lim) {
    const float NEG = -__builtin_inff();
#pragma unroll
    for (int r = 0; r < 16; ++r) {
        const int c = (r & 3) + 8 * (r >> 2);
        if (c > lim) p0[r] = NEG;
        if (c + 32 > lim) p1[r] = NEG;
    }
}
__device__ __forceinline__ void t5_bias(f32x16& p0, f32x16& p1, const LAS float* tbl, int dd) {
#pragma unroll
    for (int g = 0; g < 4; ++g) {
#pragma unroll
        for (int j = 0; j < 4; ++j) { const int r = 4 * g + j, c = (r & 3) + 8 * (r >> 2);
            int i0 = dd - c; i0 = i0 < 0 ? 0 : (i0 > 127 ? 127 : i0);
            int i1 = dd - c - 32; i1 = i1 < 0 ? 0 : (i1 > 127 ? 127 : i1);
            p0[r] += tbl[i0]; p1[r] += tbl[i1]; }
        asm volatile("" ::: "memory");
    }
}
template <int MODE>
__device__ __forceinline__ void partialSM(f32x16& p0, f32x16& p1, float& m_reg, float& mn, float& alpha) {
    constexpr float SCALE = Cfg<MODE>::SCALE;
    float pmax = p0[0];
#pragma unroll
    for (int r = 1; r < 16; ++r) pmax = fmaxf(pmax, p0[r]);
#pragma unroll
    for (int r = 0; r < 16; ++r) pmax = fmaxf(pmax, p1[r]);
    { auto rr = __builtin_amdgcn_permlane32_swap(__float_as_uint(pmax), __float_as_uint(pmax), false, false);
      pmax = fmaxf(__uint_as_float(rr[0]), __uint_as_float(rr[1])); }
    constexpr float C2 = 1.4426950408889634f * SCALE;
    if (__builtin_expect(__all((pmax - m_reg) * SCALE <= THR), 1)) { mn = m_reg; alpha = 1.f; }
    else { mn = fmaxf(m_reg, pmax); alpha = __builtin_amdgcn_exp2f((m_reg - mn) * C2); m_reg = mn; }
    const float mnL = -mn * C2;
#pragma unroll
    for (int r = 0; r < 16; ++r) p0[r] = fmaf(p0[r], C2, mnL);
#pragma unroll
    for (int r = 0; r < 16; ++r) p1[r] = fmaf(p1[r], C2, mnL);
#pragma unroll
    for (int r = 0; r < 16; ++r) p0[r] = __builtin_amdgcn_exp2f(p0[r]);
}
__device__ __forceinline__ void finishSM(f32x16& p0, f32x16& p1, float alpha, float& l_reg, bf16x8& pa0, bf16x8& pa1, bf16x8& pa2, bf16x8& pa3) {
#pragma unroll
    for (int r = 0; r < 16; ++r) p1[r] = __builtin_amdgcn_exp2f(p1[r]);
    float ps = 0;
#pragma unroll
    for (int r = 0; r < 16; ++r) ps += p0[r];
#pragma unroll
    for (int r = 0; r < 16; ++r) ps += p1[r];
    { auto rr = __builtin_amdgcn_permlane32_swap(__float_as_uint(ps), __float_as_uint(ps), false, false);
      ps = __uint_as_float(rr[0]) + __uint_as_float(rr[1]); }
    l_reg = l_reg * alpha + ps;
#define PK4(P, B_, OUT) do { unsigned a0 = cvt_pk_bf16(P[B_+0], P[B_+1]), a1 = cvt_pk_bf16(P[B_+2], P[B_+3]);                          \
        unsigned b0 = cvt_pk_bf16(P[B_+4], P[B_+5]), b1 = cvt_pk_bf16(P[B_+6], P[B_+7]);                                             \
        auto r0 = __builtin_amdgcn_permlane32_swap(a0, b0, false, false); auto r1 = __builtin_amdgcn_permlane32_swap(a1, b1, false, false); \
        u32x4 w = {r0[0], r1[0], r0[1], r1[1]}; OUT = *reinterpret_cast<bf16x8*>(&w); } while (0)
    PK4(p0, 0, pa0); PK4(p0, 8, pa1); PK4(p1, 0, pa2); PK4(p1, 8, pa3);
#undef PK4
}
template <int MODE>
__device__ __forceinline__ void qkt(f32x16& p0, f32x16& p1, const LAS char* Kt, const LAS char* K2t, const LAS float* biasL, int r32, int hi, const bf16x8* qr) {
    if constexpr (MODE == 0) {
        const LAS f32x4* bl = (const LAS f32x4*)biasL;
#pragma unroll
        for (int g = 0; g < 4; ++g) { const f32x4 a = bl[2 * g + hi], b = bl[8 + 2 * g + hi];
#pragma unroll
            for (int j = 0; j < 4; ++j) { p0[4 * g + j] = a[j]; p1[4 * g + j] = b[j]; } }
    } else { p0 = f32x16{}; p1 = f32x16{}; }
    const int kg_ = ((r32 & 15) << 4) ^ (hi << 4);
    const LAS char* kr_ = Kt + r32 * 256;
    __builtin_amdgcn_s_setprio(1);
#pragma unroll
    for (int d0 = 0; d0 < 8; ++d0) { const LAS char* a = kr_ + (kg_ ^ (d0 << 5));
        const bf16x8 b0 = *reinterpret_cast<const LAS bf16x8*>(a);
        const bf16x8 b1 = *reinterpret_cast<const LAS bf16x8*>(a + 32 * 256);
        p0 = __builtin_amdgcn_mfma_f32_32x32x16_bf16(b0, qr[d0], p0, 0, 0, 0);
        p1 = __builtin_amdgcn_mfma_f32_32x32x16_bf16(b1, qr[d0], p1, 0, 0, 0); }
    if constexpr (MODE == 1) {
#pragma unroll
        for (int d0 = 0; d0 < 4; ++d0) { const LAS char* a = K2t + K2SWZ(r32, (d0 * 16 + hi * 8) * 2);
            const bf16x8 b0 = *reinterpret_cast<const LAS bf16x8*>(a);
            const bf16x8 b1 = *reinterpret_cast<const LAS bf16x8*>(a + 32 * 128);
            p0 = __builtin_amdgcn_mfma_f32_32x32x16_bf16(b0, qr[8 + d0], p0, 0, 0, 0);
            p1 = __builtin_amdgcn_mfma_f32_32x32x16_bf16(b1, qr[8 + d0], p1, 0, 0, 0); }
    }
    __builtin_amdgcn_s_setprio(0);
}
__device__ __forceinline__ void pv_tile(f32x16* o, unsigned vb0, bf16x8 pa0, bf16x8 pa1, bf16x8 pa2, bf16x8 pa3) {
#define TRRD(dst, off) asm volatile("ds_read_b64_tr_b16 %0, %1 offset:%2" : "=&v"(dst) : "v"(vb0), "i"(off) : "memory")
#define PV_RD(S, d0) do { constexpr int b_ = v_rd_off(d0, 0, 0);     \
        TRRD(S##l0, b_); TRRD(S##h0, b_ + 2048); TRRD(S##l1, b_ + 4096); TRRD(S##h1, b_ + 6144); TRRD(S##l2, b_ + 8192); TRRD(S##h2, b_ + 10240); TRRD(S##l3, b_ + 12288); TRRD(S##h3, b_ + 14336); } while (0)
#define PV_MM(S, d0) do { \
        o[d0] = __builtin_amdgcn_mfma_f32_32x32x16_bf16(pa0, (bf16x8){S##l0[0], S##l0[1], S##l0[2], S##l0[3], S##h0[0], S##h0[1], S##h0[2], S##h0[3]}, o[d0], 0, 0, 0);   \
        o[d0] = __builtin_amdgcn_mfma_f32_32x32x16_bf16(pa1, (bf16x8){S##l1[0], S##l1[1], S##l1[2], S##l1[3], S##h1[0], S##h1[1], S##h1[2], S##h1[3]}, o[d0], 0, 0, 0);   \
        o[d0] = __builtin_amdgcn_mfma_f32_32x32x16_bf16(pa2, (bf16x8){S##l2[0], S##l2[1], S##l2[2], S##l2[3], S##h2[0], S##h2[1], S##h2[2], S##h2[3]}, o[d0], 0, 0, 0);   \
        o[d0] = __builtin_amdgcn_mfma_f32_32x32x16_bf16(pa3, (bf16x8){S##l3[0], S##l3[1], S##l3[2], S##l3[3], S##h3[0], S##h3[1], S##h3[2], S##h3[3]}, o[d0], 0, 0, 0); } while (0)
    s16x4 Al0, Al1, Al2, Al3, Ah0, Ah1, Ah2, Ah3, Bl0, Bl1, Bl2, Bl3, Bh0, Bh1, Bh2, Bh3;
    __builtin_amdgcn_s_setprio(1);
    PV_RD(A, 0);
    PV_RD(B, 1); asm volatile("s_waitcnt lgkmcnt(8)" ::: "memory"); SBAR(); PV_MM(A, 0); SBAR();
    PV_RD(A, 2); asm volatile("s_waitcnt lgkmcnt(8)" ::: "memory"); SBAR(); PV_MM(B, 1); SBAR();
    PV_RD(B, 3); asm volatile("s_waitcnt lgkmcnt(8)" ::: "memory"); SBAR(); PV_MM(A, 2); SBAR();
    asm volatile("s_waitcnt lgkmcnt(0)" ::: "memory"); SBAR(); PV_MM(B, 3);
    __builtin_amdgcn_s_setprio(0);
#undef PV_MM
#undef PV_RD
#undef TRRD
}

struct PassArgs {
    const bf16_t* Q; const bf16_t* Q2; const bf16_t* K; const bf16_t* K2; const bf16_t* V; const float* cum;
    int ldq, ldq2, ldk, ldk2, ldv;
    int krow0;
    int qvp0;
    int NT;
    int shift0;
};
template <int MODE>
__device__ __forceinline__ void attn_pass(const PassArgs& a, LAS char* lds, f32x16 (&o)[4], const int tid) {
    constexpr int DK = Cfg<MODE>::DK;
    constexpr float SCALE = Cfg<MODE>::SCALE, INV_SCALE = 1.0f / SCALE;
    const int wid = __builtin_amdgcn_readfirstlane(tid >> 6), lane = tid & 63, r32 = lane & 31, hi = lane >> 5;
    bf16x8 qr[DK / 16];
    { const bf16_t* qp = a.Q + (size_t)(wid * 32 + r32) * a.ldq + hi * 8;
#pragma unroll
      for (int d0 = 0; d0 < 8; ++d0) qr[d0] = *(const bf16x8*)(qp + d0 * 16);
      if constexpr (MODE == 1) { const bf16_t* qp2 = a.Q2 + (size_t)(wid * 32 + r32) * a.ldq2 + hi * 8;
#pragma unroll
          for (int d0 = 0; d0 < 4; ++d0) qr[8 + d0] = *(const bf16x8*)(qp2 + d0 * 16); } }
    const int sr = tid >> 4, sc = (tid & 15) * 8, kws = KSWZ(sr, sc * 2), vst0 = v_st(sr, sc), vst1 = v_st(32 + sr, sc);
    const int sr2 = tid >> 3, sc2 = (tid & 7) * 8, k2ws = K2SWZ(sr2, sc2 * 2);
    bf16x8 st_k0, st_k1, st_v0, st_v1, st_k2; float st_b = 0.f;
#define TROW(t) ((t) == 0 ? META0 : a.krow0 + ((t) - 1) * 64)
#define ISSUE(t) do { const int tr_ = TROW(t); const size_t r0_ = (size_t)(tr_ + sr);                                             \
        st_k0 = *(const bf16x8*)(a.K + r0_ * a.ldk + sc); st_k1 = *(const bf16x8*)(a.K + (r0_ + 32) * a.ldk + sc);                 \
        st_v0 = *(const bf16x8*)(a.V + r0_ * a.ldv + sc); st_v1 = *(const bf16x8*)(a.V + (r0_ + 32) * a.ldv + sc);                 \
        if constexpr (MODE == 1) st_k2 = *(const bf16x8*)(a.K2 + (size_t)(tr_ + sr2) * a.ldk2 + sc2);                              \
        if constexpr (MODE == 0) { if (tid < 64) st_b = a.cum[tr_ + tid]; } } while (0)
#define WRITE(bf) do { *(LAS bf16x8*)(lds + OFF_K + (bf) * SHM_K + kws) = st_k0; *(LAS bf16x8*)(lds + OFF_K + (bf) * SHM_K + kws + 32 * 256) = st_k1;   \
        *(LAS bf16x8*)(lds + OFF_V + (bf) * SHM_V + vst0) = st_v0; *(LAS bf16x8*)(lds + OFF_V + (bf) * SHM_V + vst1) = st_v1;                        \
        if constexpr (MODE == 1) *(LAS bf16x8*)(lds + OFF_K2 + (bf) * SHM_K2 + k2ws) = st_k2;                                                       \
        if constexpr (MODE == 0) { if (tid < 64) ((LAS float*)(lds + OFF_BIAS + (bf) * 256))[tid] = -st_b * INV_SCALE; } } while (0)
    ISSUE(0);
    WRITE(0);
    __syncthreads();
    float m_reg = -1e30f, l_reg = 0.f;
#pragma unroll
    for (int d = 0; d < 4; ++d) o[d] = f32x16{};
    const int qlo = a.qvp0 + wid * 32, qv = qlo + r32;
    LAS float* li_l = (LAS float*)(lds + OFF_WS + wid * 256); LAS float* al_l = li_l + 32;
    const LAS float* tbl = (const LAS float*)(lds + OFF_TBL);
    const unsigned vbase = (unsigned)(uintptr_t)(lds + OFF_V) + (unsigned)v_rd_base(lane);
    const int NT = a.NT;
    for (int t = 0; t < NT; ++t) {
        const int cur = t & 1;
        if (t + 1 < NT) ISSUE(t + 1);
        const int kb = 64 * t;
        if (t == 0 || kb <= qlo + 31) {
        f32x16 p0, p1;
        qkt<MODE>(p0, p1, lds + OFF_K + cur * SHM_K, lds + OFF_K2 + cur * SHM_K2, (const LAS float*)(lds + OFF_BIAS + cur * 256), r32, hi, qr);
        if constexpr (MODE == 2) { const int sh = t == 0 ? a.shift0 : 0; if (qlo - sh - (kb + 63) <= 112) t5_bias(p0, p1, tbl, qv - kb - sh - 4 * hi); }
        if (t == 0 || kb + 63 > qlo) { int lim = qv - kb; const int tm = t == 0 ? 15 : 63; lim = (lim < tm ? lim : tm) - 4 * hi; mask_tile(p0, p1, lim); }
        float mn, alpha;
        partialSM<MODE>(p0, p1, m_reg, mn, alpha);
        if (__any(alpha < 1.f)) { if (hi == 0) al_l[r32] = alpha; asm volatile("s_waitcnt lgkmcnt(0)" ::: "memory");
#pragma unroll
            for (int r = 0; r < 16; ++r) { const float av = al_l[crow(r, hi)];
#pragma unroll
                for (int d = 0; d < 4; ++d) o[d][r] *= av; } }
        bf16x8 pa0, pa1, pa2, pa3;
        finishSM(p0, p1, alpha, l_reg, pa0, pa1, pa2, pa3);
        pv_tile(o, vbase + (unsigned)(cur * SHM_V), pa0, pa1, pa2, pa3);
        }
        if (t + 1 < NT) WRITE(cur ^ 1);
        __syncthreads();
    }
    if (hi == 0) li_l[r32] = l_reg;
    asm volatile("s_waitcnt lgkmcnt(0)" ::: "memory");
#pragma unroll
    for (int r = 0; r < 16; ++r) { const float rl = __builtin_amdgcn_rcpf(li_l[crow(r, hi)]);
#pragma unroll
        for (int d = 0; d < 4; ++d) o[d][r] *= rl; }
#undef TROW
#undef ISSUE
#undef WRITE
}
template <int MODE>
__device__ __forceinline__ void attn_pass_dma(const PassArgs& a, LAS char* lds, f32x16 (&o)[4], const int tid) {
    constexpr int DK = Cfg<MODE>::DK;
    constexpr float SCALE = Cfg<MODE>::SCALE, INV_SCALE = 1.0f / SCALE;
    const int wid = __builtin_amdgcn_readfirstlane(tid >> 6);
    bf16x8 qr[DK / 16];
    { const int lane = tid & 63, r32 = lane & 31, hi = lane >> 5; const bf16_t* qp = a.Q + (size_t)(wid * 32 + r32) * a.ldq + hi * 8;
#pragma unroll
      for (int d0 = 0; d0 < 8; ++d0) qr[d0] = *(const bf16x8*)(qp + d0 * 16);
      if constexpr (MODE == 1) { const bf16_t* qp2 = a.Q2 + (size_t)(wid * 32 + r32) * a.ldq2 + hi * 8;
#pragma unroll
          for (int d0 = 0; d0 < 4; ++d0) qr[8 + d0] = *(const bf16x8*)(qp2 + d0 * 16); } }
    float st_b = 0.f;
#define TROW(t) ((t) == 0 ? META0 : a.krow0 + ((t) - 1) * 64)
#define DMA16(gp, ldsoff) __builtin_amdgcn_global_load_lds((const unsigned*)(gp), (LAS unsigned*)(lds + (ldsoff)), 16, 0, 0)
#define ISSUE_D(t, bf) do { int tl_ = tid; asm volatile("" : "+v"(tl_)); const int tr_ = TROW(t);                                         \
        const int krow = tl_ >> 4, kcol = ((tl_ & 15) ^ (krow & 15)) * 8;                                                                \
        const int vkk = ((tl_ >> 7) << 3) | ((tl_ & 31) >> 2), vrow = (vkk & ~0xC) | ((vkk & 4) << 1) | ((vkk & 8) >> 1), vcol = ((tl_ >> 5) & 3) * 32 + (tl_ & 3) * 8;   \
        _Pragma("unroll") for (int i_ = 0; i_ < 2; ++i_) DMA16(a.K + (size_t)(tr_ + krow + 32 * i_) * a.ldk + kcol, OFF_K + (bf) * SHM_K + i_ * 8192 + wid * 1024);   \
        _Pragma("unroll") for (int i_ = 0; i_ < 2; ++i_) DMA16(a.V + (size_t)(tr_ + vrow + 32 * i_) * a.ldv + vcol, OFF_V + (bf) * SHM_V + i_ * 8192 + wid * 1024);   \
        if constexpr (MODE == 1) { const int r2_ = tl_ >> 3, c2_ = ((tl_ & 7) ^ ((r2_ >> 1) & 7)) * 8; DMA16(a.K2 + (size_t)(tr_ + r2_) * a.ldk2 + c2_, OFF_K2 + (bf) * SHM_K2 + wid * 1024); } \
        if constexpr (MODE == 0) { if (tl_ < 64) st_b = a.cum[tr_ + tl_]; } } while (0)
#define WRITE_B(bf) do { if constexpr (MODE == 0) { int tl_ = tid; asm volatile("" : "+v"(tl_)); if (tl_ < 64) ((LAS float*)(lds + OFF_BIAS + (bf) * 256))[tl_] = -st_b * INV_SCALE; } } while (0)
    ISSUE_D(0, 0);
    WRITE_B(0);
    asm volatile("s_waitcnt vmcnt(0)" ::: "memory");
    __syncthreads();
    float m_reg = -1e30f, l_reg = 0.f;
#pragma unroll
    for (int d = 0; d < 4; ++d) o[d] = f32x16{};
    const int NT = a.NT;
    for (int t = 0; t < NT; ++t) {
        const int cur = t & 1;
        if (t + 1 < NT) ISSUE_D(t + 1, cur ^ 1);
        int tl = tid; asm volatile("" : "+v"(tl));
        const int lane = tl & 63, r32 = lane & 31, hi = lane >> 5;
        const int qlo = a.qvp0 + wid * 32, qv = qlo + r32;
        LAS float* al_l = (LAS float*)(lds + OFF_WS + wid * 256) + 32;
        const int kb = 64 * t;
        if (t == 0 || kb <= qlo + 31) {
        f32x16 p0, p1;
        qkt<MODE>(p0, p1, lds + OFF_K + cur * SHM_K, lds + OFF_K2 + cur * SHM_K2, (const LAS float*)(lds + OFF_BIAS + cur * 256), r32, hi, qr);
        if (t == 0 || kb + 63 > qlo) { int lim = qv - kb; const int tm = t == 0 ? 15 : 63; lim = (lim < tm ? lim : tm) - 4 * hi; mask_tile(p0, p1, lim); }
        float mn, alpha;
        partialSM<MODE>(p0, p1, m_reg, mn, alpha);
        if (__any(alpha < 1.f)) { if (hi == 0) al_l[r32] = alpha; asm volatile("s_waitcnt lgkmcnt(0)" ::: "memory");
#pragma unroll
            for (int r = 0; r < 16; ++r) { const float av = al_l[crow(r, hi)];
#pragma unroll
                for (int d = 0; d < 4; ++d) o[d][r] *= av; } }
        bf16x8 pa0, pa1, pa2, pa3;
        finishSM(p0, p1, alpha, l_reg, pa0, pa1, pa2, pa3);
        pv_tile(o, (unsigned)(uintptr_t)(lds + OFF_V) + (unsigned)v_rd_base(lane) + (unsigned)(cur * SHM_V), pa0, pa1, pa2, pa3);
        }
        if (t + 1 < NT) WRITE_B(cur ^ 1);
        asm volatile("s_waitcnt vmcnt(0)" ::: "memory");
        __syncthreads();
    }
    { int tl = tid; asm volatile("" : "+v"(tl));
      const int lane = tl & 63, r32 = lane & 31, hi = lane >> 5;
      LAS float* li_l = (LAS float*)(lds + OFF_WS + wid * 256);
      if (hi == 0) li_l[r32] = l_reg;
      asm volatile("s_waitcnt lgkmcnt(0)" ::: "memory");
#pragma unroll
      for (int r = 0; r < 16; ++r) { const float rl = __builtin_amdgcn_rcpf(li_l[crow(r, hi)]);
#pragma unroll
          for (int d = 0; d < 4; ++d) o[d][r] *= rl; } }
#undef TROW
#undef DMA16
#undef ISSUE_D
#undef WRITE_B
}
constexpr int D_OFF_V = 0  , D_OFF_K = 65536  , D_OFF_TBL = 98304, D_OFF_WS = D_OFF_TBL + 512, D_LDS_END = D_OFF_WS + 8 * 256;
__device__ __forceinline__ void attn_pass_diff(const PassArgs& a, LAS char* lds, f32x16 (&o)[8], const int tid) {
    const int wid = __builtin_amdgcn_readfirstlane(tid >> 6);
    bf16x8 qr[8];
    { const int lane = tid & 63, r32 = lane & 31, hi = lane >> 5; const bf16_t* qp = a.Q + (size_t)(wid * 32 + r32) * a.ldq + hi * 8;
#pragma unroll
      for (int d0 = 0; d0 < 8; ++d0) qr[d0] = *(const bf16x8*)(qp + d0 * 16); }
#define TROW(t) ((t) == 0 ? META0 : a.krow0 + ((t) - 1) * 64)
#define DMA16(gp, ldsoff) __builtin_amdgcn_global_load_lds((const unsigned*)(gp), (LAS unsigned*)(lds + (ldsoff)), 16, 0, 0)
#define ISSUE_D(t, bf) do { int tl_ = tid; asm volatile("" : "+v"(tl_)); const int tr_ = TROW(t);                                         \
        const int krow = tl_ >> 4, kcol = ((tl_ & 15) ^ (krow & 15)) * 8;                                                                \
        const int vkk = ((tl_ >> 7) << 3) | ((tl_ & 31) >> 2), vrow = (vkk & ~0xC) | ((vkk & 4) << 1) | ((vkk & 8) >> 1), vcol = ((tl_ >> 5) & 3) * 32 + (tl_ & 3) * 8;   \
        _Pragma("unroll") for (int i_ = 0; i_ < 2; ++i_) DMA16(a.K + (size_t)(tr_ + krow + 32 * i_) * a.ldk + kcol, D_OFF_K + (bf) * 16384 + i_ * 8192 + wid * 1024);   \
        _Pragma("unroll") for (int h_ = 0; h_ < 2; ++h_) _Pragma("unroll") for (int i_ = 0; i_ < 2; ++i_)                                 \
            DMA16(a.V + (size_t)(tr_ + vrow + 32 * i_) * a.ldv + h_ * 128 + vcol, D_OFF_V + (bf) * 32768 + h_ * 16384 + i_ * 8192 + wid * 1024); } while (0)
    ISSUE_D(0, 0);
    asm volatile("s_waitcnt vmcnt(0)" ::: "memory");
    __syncthreads();
    float m_reg = -1e30f, l_reg = 0.f;
#pragma unroll
    for (int d = 0; d < 8; ++d) o[d] = f32x16{};
    const int NT = a.NT;
    for (int t = 0; t < NT; ++t) {
        const int cur = t & 1;
        if (t + 1 < NT) ISSUE_D(t + 1, cur ^ 1);
        int tl = tid; asm volatile("" : "+v"(tl));
        const int lane = tl & 63, r32 = lane & 31, hi = lane >> 5;
        const int qlo = a.qvp0 + wid * 32, qv = qlo + r32;
        LAS float* al_l = (LAS float*)(lds + D_OFF_WS + wid * 256) + 32;
        const int kb = 64 * t;
        if (t == 0 || kb <= qlo + 31) {
        f32x16 p0, p1;
        qkt<2>(p0, p1, lds + D_OFF_K + cur * 16384, lds, (const LAS float*)lds, r32, hi, qr);
        { const int sh = t == 0 ? a.shift0 : 0; if (qlo - sh - (kb + 63) <= 112) t5_bias(p0, p1, (const LAS float*)(lds + D_OFF_TBL), qv - kb - sh - 4 * hi); }
        if (t == 0 || kb + 63 > qlo) { int lim = qv - kb; const int tm = t == 0 ? 15 : 63; lim = (lim < tm ? lim : tm) - 4 * hi; mask_tile(p0, p1, lim); }
        float mn, alpha;
        partialSM<2>(p0, p1, m_reg, mn, alpha);
        if (__any(alpha < 1.f)) { if (hi == 0) al_l[r32] = alpha; asm volatile("s_waitcnt lgkmcnt(0)" ::: "memory");
#pragma unroll
            for (int r = 0; r < 16; ++r) { const float av = al_l[crow(r, hi)];
#pragma unroll
                for (int d = 0; d < 8; ++d) o[d][r] *= av; } }
        bf16x8 pa0, pa1, pa2, pa3;
        finishSM(p0, p1, alpha, l_reg, pa0, pa1, pa2, pa3);
        const unsigned vbase = (unsigned)(uintptr_t)(lds + D_OFF_V) + (unsigned)v_rd_base(lane) + (unsigned)(cur * 32768);
        pv_tile(o, vbase, pa0, pa1, pa2, pa3);
        pv_tile(o + 4, vbase + 16384u, pa0, pa1, pa2, pa3);
        }
        asm volatile("s_waitcnt vmcnt(0)" ::: "memory");
        __syncthreads();
    }
    { int tl = tid; asm volatile("" : "+v"(tl));
      const int lane = tl & 63, r32 = lane & 31, hi = lane >> 5;
      LAS float* li_l = (LAS float*)(lds + D_OFF_WS + wid * 256);
      if (hi == 0) li_l[r32] = l_reg;
      asm volatile("s_waitcnt lgkmcnt(0)" ::: "memory");
#pragma unroll
      for (int r = 0; r < 16; ++r) { const float rl = __builtin_amdgcn_rcpf(li_l[crow(r, hi)]);
#pragma unroll
          for (int d = 0; d < 8; ++d) o[d][r] *= rl; } }
#undef TROW
#undef DMA16
#undef ISSUE_D
}
#ifdef PROBE_ATT
template <int PVAR  >
__device__ __forceinline__ void attn_pass_diff_probe(const PassArgs& a, LAS char* lds, f32x16 (&o)[8], const int tid) {
    const int wid = __builtin_amdgcn_readfirstlane(tid >> 6);
    bf16x8 qr[8];
    { const int lane = tid & 63, r32 = lane & 31, hi = lane >> 5; const bf16_t* qp = a.Q + (size_t)(wid * 32 + r32) * a.ldq + hi * 8;
#pragma unroll
      for (int d0 = 0; d0 < 8; ++d0) qr[d0] = *(const bf16x8*)(qp + d0 * 16); }
#define TROW(t) ((t) == 0 ? META0 : a.krow0 + ((t) - 1) * 64)
#define DMA16(gp, ldsoff) __builtin_amdgcn_global_load_lds((const unsigned*)(gp), (LAS unsigned*)(lds + (ldsoff)), 16, 0, 0)
#define ISSUE_D(t, bf) do { int tl_ = tid; asm volatile("" : "+v"(tl_)); const int tr_ = TROW(t);                                         \
        const int krow = tl_ >> 4, kcol = ((tl_ & 15) ^ (krow & 15)) * 8;                                                                \
        const int vkk = ((tl_ >> 7) << 3) | ((tl_ & 31) >> 2), vrow = (vkk & ~0xC) | ((vkk & 4) << 1) | ((vkk & 8) >> 1), vcol = ((tl_ >> 5) & 3) * 32 + (tl_ & 3) * 8;   \
        _Pragma("unroll") for (int i_ = 0; i_ < 2; ++i_) DMA16(a.K + (size_t)(tr_ + krow + 32 * i_) * a.ldk + kcol, D_OFF_K + (bf) * 16384 + i_ * 8192 + wid * 1024);   \
        _Pragma("unroll") for (int h_ = 0; h_ < 2; ++h_) _Pragma("unroll") for (int i_ = 0; i_ < 2; ++i_)                                 \
            DMA16(a.V + (size_t)(tr_ + vrow + 32 * i_) * a.ldv + h_ * 128 + vcol, D_OFF_V + (bf) * 32768 + h_ * 16384 + i_ * 8192 + wid * 1024); } while (0)
    ISSUE_D(0, 0);
    asm volatile("s_waitcnt vmcnt(0)" ::: "memory");
    __syncthreads();
    float m_reg = -1e30f, l_reg = 0.f;
#pragma unroll
    for (int d = 0; d < 8; ++d) o[d] = f32x16{};
    const int NT = a.NT;
    for (int t = 0; t < NT; ++t) {
        const int cur = t & 1;
        if constexpr (PVAR != 6 && PVAR != 8) { if (t + 1 < NT) ISSUE_D(t + 1, cur ^ 1); }
        int tl = tid; asm volatile("" : "+v"(tl));
        const int lane = tl & 63, r32 = lane & 31, hi = lane >> 5;
        const int qlo = a.qvp0 + wid * 32, qv = qlo + r32;
        LAS float* al_l = (LAS float*)(lds + D_OFF_WS + wid * 256) + 32;
        const int kb = 64 * t;
        if (t == 0 || kb <= qlo + 31) {
        f32x16 p0, p1;
        if constexpr (PVAR == 5 || PVAR == 7 || PVAR == 8) { p0 = f32x16{}; p1 = f32x16{};
#pragma unroll
            for (int d0 = 0; d0 < 8; ++d0) { p0 = __builtin_amdgcn_mfma_f32_32x32x16_bf16(qr[(d0 + 1) & 7], qr[d0], p0, 0, 0, 0); p1 = __builtin_amdgcn_mfma_f32_32x32x16_bf16(qr[(d0 + 3) & 7], qr[d0], p1, 0, 0, 0); } }
        else qkt<2>(p0, p1, lds + D_OFF_K + cur * 16384, lds, (const LAS float*)lds, r32, hi, qr);
        { const int sh = t == 0 ? a.shift0 : 0; if (qlo - sh - (kb + 63) <= 112) t5_bias(p0, p1, (const LAS float*)(lds + D_OFF_TBL), qv - kb - sh - 4 * hi); }
        if (t == 0 || kb + 63 > qlo) { int lim = qv - kb; const int tm = t == 0 ? 15 : 63; lim = (lim < tm ? lim : tm) - 4 * hi; mask_tile(p0, p1, lim); }
        float mn, alpha;
        partialSM<2>(p0, p1, m_reg, mn, alpha);
        if (__any(alpha < 1.f)) { if (hi == 0) al_l[r32] = alpha; asm volatile("s_waitcnt lgkmcnt(0)" ::: "memory");
#pragma unroll
            for (int r = 0; r < 16; ++r) { const float av = al_l[crow(r, hi)];
#pragma unroll
                for (int d = 0; d < 8; ++d) o[d][r] *= av; } }
        bf16x8 pa0, pa1, pa2, pa3;
        finishSM(p0, p1, alpha, l_reg, pa0, pa1, pa2, pa3);
        const unsigned vbase = (unsigned)(uintptr_t)(lds + D_OFF_V) + (unsigned)v_rd_base(lane) + (unsigned)(cur * 32768);
        if constexpr (PVAR == 4 || PVAR == 7 || PVAR == 8) {
#pragma unroll
            for (int d = 0; d < 8; ++d) { o[d] = __builtin_amdgcn_mfma_f32_32x32x16_bf16(pa0, pa1, o[d], 0, 0, 0); o[d] = __builtin_amdgcn_mfma_f32_32x32x16_bf16(pa1, pa2, o[d], 0, 0, 0);
                o[d] = __builtin_amdgcn_mfma_f32_32x32x16_bf16(pa2, pa3, o[d], 0, 0, 0); o[d] = __builtin_amdgcn_mfma_f32_32x32x16_bf16(pa3, pa0, o[d], 0, 0, 0); } }
        else { pv_tile(o, vbase, pa0, pa1, pa2, pa3); pv_tile(o + 4, vbase + 16384u, pa0, pa1, pa2, pa3); }
        }
        asm volatile("s_waitcnt vmcnt(0)" ::: "memory");
        __syncthreads();
    }
    { int tl = tid; asm volatile("" : "+v"(tl));
      const int lane = tl & 63, r32 = lane & 31, hi = lane >> 5;
      LAS float* li_l = (LAS float*)(lds + D_OFF_WS + wid * 256);
      if (hi == 0) li_l[r32] = l_reg;
      asm volatile("s_waitcnt lgkmcnt(0)" ::: "memory");
#pragma unroll
      for (int r = 0; r < 16; ++r) { const float rl = __builtin_amdgcn_rcpf(li_l[crow(r, hi)]);
#pragma unroll
          for (int d = 0; d < 8; ++d) o[d][r] *= rl; } }
#undef TROW
#undef DMA16
#undef ISSUE_D
}
#endif
__device__ __forceinline__ void store_o_bf16(const f32x16* o, bf16_t* Ow, int ldo, int tid) {
    asm volatile("" : "+v"(tid)); const int r32 = tid & 31, hi = (tid >> 5) & 1;
#pragma unroll
    for (int r = 0; r < 16; ++r) { const int orow = crow(r, hi);
#pragma unroll
        for (int d0 = 0; d0 < 4; ++d0) { const float v = o[d0][r]; const float vn = __shfl_xor(v, 1);
            if ((r32 & 1) == 0) *(GAS unsigned*)(Ow + (size_t)orow * ldo + d0 * 32 + r32) = cvt_pk_bf16(v, vn); }
        asm volatile("" ::: "memory"); }
}
}

constexpr size_t MiB = (size_t)1 << 20;
constexpr size_t WS_CTL = 0, CTL_ZERO_BYTES = 1 * MiB;
constexpr size_t WS_PRM = 1 * MiB;
constexpr size_t WS_COS = 2 * MiB, WS_SIN = 3 * MiB;
constexpr size_t WS_RSTD = 4 * MiB;
constexpr size_t WS_STATQ = 14 * MiB, WS_STATKV = 17 * MiB;
constexpr size_t WS_STATM = 5 * MiB;
constexpr size_t WS_FLOG = 10 * MiB, WS_CUM = 12 * MiB;
constexpr size_t WS_W = 20 * MiB;
constexpr size_t SZ_EVIN = 61 * MiB, SZ_UQ = 6 * MiB, SZ_UKV = 4 * MiB, SZ_SQ = 33 * MiB, SZ_ODIN = 98 * MiB, SZ_GU = 175 * MiB, SZ_DN = 87 * MiB;
constexpr size_t W_EVIN = WS_W, W_UQ = W_EVIN + 2 * SZ_EVIN, W_UKV = W_UQ + 2 * SZ_UQ, W_EVOUT = W_UKV + 2 * SZ_UKV, W_ODIN = W_EVOUT + 2 * SZ_SQ, W_ODOUT = W_ODIN + 2 * SZ_ODIN,
                 W_GU = W_ODOUT + 2 * SZ_SQ, W_DN = W_GU + DEPTH * SZ_GU;
constexpr size_t WS_HS = W_DN + DEPTH * SZ_DN;
constexpr size_t WS_HBF = WS_HS + 260 * MiB;
constexpr size_t WS_PROJ = WS_HBF + 133 * MiB;
constexpr size_t WS_QBUF = WS_PROJ + 246 * MiB, WS_KVBUF = WS_PROJ + 346 * MiB;
constexpr size_t WS_OBUF = WS_PROJ + 479 * MiB;
constexpr size_t WS_MBUF = WS_OBUF + 133 * MiB;
constexpr size_t WS_DSCR = WS_MBUF + 133 * MiB;
constexpr size_t WS_PART = WS_DSCR + 64 * MiB;
constexpr size_t WS_END = WS_PART + 12 * MiB;
static_assert((size_t)EV_N * LD_DM * 2 <= SZ_EVIN && (size_t)UQ_N * LD_QR * 2 <= SZ_UQ && (size_t)UKV_N * LD_KV * 2 <= SZ_UKV && (size_t)DM * LD_DM * 2 <= SZ_SQ && (size_t)OD_N * LD_DM * 2 <= SZ_ODIN && (size_t)GU_N * LD_DM * 2 <= SZ_GU && (size_t)DM * LD_FF * 2 <= SZ_DN, "weight sizes");
static_assert((size_t)MPAD * DM * 4 == 260 * MiB && (size_t)MPAD * LD_DM * 2 <= 133 * MiB && (size_t)MPAD * LD_EV * 2 <= 246 * MiB && (size_t)MPAD * LD_UQ * 2 <= 100 * MiB && (size_t)MPAD * LD_UKV * 2 <= 133 * MiB && (size_t)MPAD * LD_OD * 2 <= 479 * MiB && (size_t)MPAD * LD_FF * 2 <= 479 * MiB, "activation sizes");
constexpr int LD8 = 4224;
constexpr size_t WS_A8 = WS_PROJ + 352 * MiB, WS_RS8 = WS_RSTD + 512 * 1024;
constexpr size_t CTL_COLMAX = 65536;
constexpr int I8_IN_ODD = 3;
constexpr size_t CTL_COLMAX_OD = CTL_COLMAX + (size_t)DEPTH * GU_N * 4;
constexpr size_t W_OD8_OFF = 90 * MiB;
constexpr int I8_IN_EV = 2;
constexpr size_t CTL_COLMAX_EV = CTL_COLMAX_OD + 2 * (size_t)OD_N * 4;
static_assert(CTL_COLMAX_EV + 2 * (size_t)EV_N * 4 <= CTL_ZERO_BYTES && (size_t)EV_N * LD8 <= SZ_EVIN, "int8 even in-proj buffers");
static_assert(CTL_COLMAX_OD + 2 * (size_t)OD_N * 4 <= CTL_ZERO_BYTES && (size_t)GU_N * LD8 <= W_OD8_OFF && W_OD8_OFF + (size_t)OD_N * LD8 <= SZ_GU && (size_t)MPAD * LD8 <= 133 * MiB, "int8 in-proj buffers");
static_assert((size_t)MPAD * LD_FF * 2 <= 352 * MiB && 352 * MiB + (size_t)MPAD * LD8 <= 479 * MiB && (size_t)GU_N * LD8 <= SZ_GU && CTL_COLMAX + (size_t)DEPTH * GU_N * 4 <= CTL_ZERO_BYTES, "int8 buffers");
constexpr int I8_DN = 14;
constexpr int LD8F = 11136;
constexpr size_t CTL_COLMAX_DN = CTL_COLMAX_EV + 2 * (size_t)EV_N * 4;
constexpr size_t WS_ACT8 = WS_HS, WS_AMAXP = WS_HS + 180 * MiB, WS_RSD = WS_RSTD + 768 * 1024;
static_assert(CTL_COLMAX_DN + (size_t)DEPTH * DM * 4 <= CTL_ZERO_BYTES && (size_t)MPAD * LD8F <= 180 * MiB && 180 * MiB + (size_t)MPAD * AMAXP_LD * 4 <= 260 * MiB && (size_t)DM * LD8F <= SZ_DN && (GU_N / 256) * 4 <= AMAXP_LD, "int8 down buffers");
constexpr int CW_BAR = 4096;

constexpr int RING_BYTES = 131072;
constexpr int PRO_SCR_BYTES = 8 * 16640;
constexpr int MISC_OFF = 135168 + 320;
constexpr int LDS_BYTES = 147456;
static_assert(att::LDS_END <= RING_BYTES && att::D_LDS_END <= RING_BYTES && PRO_SCR_BYTES <= 135168 && MISC_OFF + 64 <= LDS_BYTES, "LDS map");

#define LDS_WAIT() asm volatile("s_waitcnt lgkmcnt(0)" ::: "memory")
#define VM_WAIT() asm volatile("s_waitcnt vmcnt(0)" ::: "memory")

#define XB_TMO      128
#define XB_XCNT(j)  (256  + 64 * (j))
#define XB_XSUB(j)  (1280 + 64 * (j))
#define XB_XGEN(j)  (2304 + 64 * (j))
#define XB_TOP      3328
#define XB_TOPGEN   3392
#define XCD_BAR_WORDS 3456
#define XB_SPIN_CAP (1u << 18)

__device__ __forceinline__ unsigned xb_ld(unsigned* p)              { return __hip_atomic_load(p, __ATOMIC_RELAXED, __HIP_MEMORY_SCOPE_AGENT); }
__device__ __forceinline__ unsigned xb_add(unsigned* p, unsigned v) { return __hip_atomic_fetch_add(p, v, __ATOMIC_RELAXED, __HIP_MEMORY_SCOPE_AGENT); }
__device__ __forceinline__ unsigned xb_xcc_id() { return (unsigned)__builtin_amdgcn_s_getreg((3 << 11) | 20) & 0xFu; }
#define XB_SPIN(cond, bar) do { unsigned _sp = 0; while (cond) { __builtin_amdgcn_s_sleep(1); \
    if ((++_sp & 255u) == 0u) { if (xb_ld(&(bar)[XB_TMO])) break; if (_sp > XB_SPIN_CAP) { atomicAdd(&(bar)[XB_TMO], 1u); break; } } } } while (0)

struct XcdBarrier {
    unsigned* bar; unsigned x;
    volatile LAS unsigned* st;
};

__device__ __forceinline__ XcdBarrier xcd_barrier_post(unsigned* bar, volatile LAS unsigned* st, int tid) {
    XcdBarrier b; b.bar = bar; b.x = xb_xcc_id(); b.st = st;
    if (tid == 0) (void)xb_add(&bar[XB_XCNT(b.x)], 1u);
    return b;
}
__device__ __forceinline__ void xcd_barrier_complete(unsigned* bar, unsigned x, unsigned& nloc, unsigned& nx) {
    const unsigned G = gridDim.x * gridDim.y * gridDim.z;
    unsigned sum, cnt, mine, sp = 0u;
    for (;;) {
        sum = 0u; cnt = 0u; mine = 0u;
#pragma unroll
        for (unsigned j = 0; j < 16; ++j) { const unsigned c = xb_ld(&bar[XB_XCNT(j)]); sum += c; cnt += (c > 0u) ? 1u : 0u; mine = (j == x) ? c : mine; }
        if (sum == G) break;
        __builtin_amdgcn_s_sleep(1);
        if ((++sp & 255u) == 0u) { if (xb_ld(&bar[XB_TMO])) break; if (sp > XB_SPIN_CAP) { atomicAdd(&bar[XB_TMO], 1u); break; } }
    }
    nloc = mine > 0u ? mine : 1u; nx = cnt > 0u ? cnt : 1u;
}

__device__ __forceinline__ void xcd_barrier(const XcdBarrier& b, int tid) {
    asm volatile("s_waitcnt vmcnt(0)" ::: "memory");
    __syncthreads();
    if (tid == 0) {
        unsigned* bar = b.bar;
        __builtin_amdgcn_s_waitcnt(0);
        unsigned nloc = b.st[0], nx = b.st[1];
        if (nloc == 0u) { xcd_barrier_complete(bar, b.x, nloc, nx); b.st[0] = nloc; b.st[1] = nx; }
        const unsigned old = xb_add(&bar[XB_XSUB(b.x)], 1u);
        const unsigned gen = old / nloc;
        if (old + 1u == (gen + 1u) * nloc) {
            __builtin_amdgcn_fence(__ATOMIC_RELEASE, "agent");
            asm volatile("s_waitcnt vmcnt(0)" ::: "memory");
            const unsigned og = xb_add(&bar[XB_TOP], 1u);
            const unsigned tg = og / nx;
            if (og + 1u == (tg + 1u) * nx) xb_add(&bar[XB_TOPGEN], 1u);
            else XB_SPIN(xb_ld(&bar[XB_TOPGEN]) == tg, bar);
            __builtin_amdgcn_fence(__ATOMIC_ACQUIRE, "agent");
            xb_add(&bar[XB_XGEN(b.x)], 1u);
            asm volatile("s_waitcnt vmcnt(0)" ::: "memory");
        } else {
            XB_SPIN(xb_ld(&bar[XB_XGEN(b.x)]) == gen, bar);
            __builtin_amdgcn_fence(__ATOMIC_ACQUIRE, "agent");
            asm volatile("s_waitcnt vmcnt(0)" ::: "memory");
        }
    }
    __syncthreads();
}

struct Args { const float* in[18]; float* out; unsigned char* ws; int ph_lo, ph_hi; float lam_init[2]; };
enum { IN_X = 0, IN_META, IN_RELB, IN_EVWIN, IN_EVBF, IN_EVQN, IN_EVKVN, IN_EVWUQ, IN_EVWUKV, IN_EVWOUT, IN_ODWIN, IN_ODLAM, IN_ODSUBLN, IN_ODWOUT, IN_NORMG, IN_WGATE, IN_WUP, IN_WDOWN };

struct Frame {
    LAS unsigned char* lds;
    int tid, lane, wave, vcu, G, bx;
    unsigned char* ws;
};

__device__ __forceinline__ int ropeperm(int j) { const int a = j >> 3, e = j & 7; return e < 4 ? 4 * a + e : 32 + 4 * a + (e - 4); }
struct CvtDesc { const float* W; int N, srccol; const float* gain; int Ksrc, k0; bf16_t* WT; int Kdst, dstrow0; const float* cmax; int had; };
__device__ __forceinline__ unsigned pk4_i8(float a, float b, float c, float d) {
    const float M = 12582912.0f;
    const unsigned ab = __builtin_amdgcn_perm(__float_as_uint(b + M), __float_as_uint(a + M), 0x0c0c0400u), cd = __builtin_amdgcn_perm(__float_as_uint(d + M), __float_as_uint(c + M), 0x0c0c0400u);
    return __builtin_amdgcn_perm(cd, ab, 0x05040100u);
}
typedef unsigned short u16x2 __attribute__((ext_vector_type(2)));
__device__ __forceinline__ unsigned pkmax(unsigned a, unsigned b) { return __builtin_bit_cast(unsigned, __builtin_elementwise_max(__builtin_bit_cast(u16x2, a), __builtin_bit_cast(u16x2, b))); }
__device__ __forceinline__ unsigned opq(unsigned v) { asm volatile("" : "+v"(v)); return v; }
__device__ __forceinline__ float wave_max(float v) {
#pragma unroll
    for (int o = 1; o < 64; o <<= 1) v = fmaxf(v, __shfl_xor(v, o));
    return v;
}
__device__ __forceinline__ void fwht8_32(float (&v)[8], int lane) {
    f32x2 a = {v[0], v[1]}, b = {v[2], v[3]}, c = {v[4], v[5]}, d = {v[6], v[7]}, t;
    t = a + c; c = a - c; a = t; t = b + d; d = b - d; b = t;
    t = a + b; b = a - b; a = t; t = c + d; d = c - d; c = t;
    a = (f32x2){a[0] + a[1], a[0] - a[1]}; b = (f32x2){b[0] + b[1], b[0] - b[1]}; c = (f32x2){c[0] + c[1], c[0] - c[1]}; d = (f32x2){d[0] + d[1], d[0] - d[1]};
    const float s1 = (lane & 1) ? -1.f : 1.f, s2 = (lane & 2) ? -1.f : 1.f;
#define FW_X(x, ctrl) __int_as_float(__builtin_amdgcn_update_dpp(0, __float_as_int(x), ctrl, 0xf, 0xf, true))
#define FW_ST(p, sg, ctrl) do { const f32x2 q_ = {FW_X(p[0], ctrl), FW_X(p[1], ctrl)}; p = p * (f32x2){sg, sg} + q_; } while (0)
    FW_ST(a, s1, 0xB1); FW_ST(b, s1, 0xB1); FW_ST(c, s1, 0xB1); FW_ST(d, s1, 0xB1);
    FW_ST(a, s2, 0x4E); FW_ST(b, s2, 0x4E); FW_ST(c, s2, 0x4E); FW_ST(d, s2, 0x4E);
#undef FW_ST
#undef FW_X
    v[0] = a[0]; v[1] = a[1]; v[2] = b[0]; v[3] = b[1]; v[4] = c[0]; v[5] = c[1]; v[6] = d[0]; v[7] = d[1];
}
__device__ __forceinline__ void cvt_load(const CvtDesc& d, f32x4 (&v)[16], int lane) {
    const int kq = lane >> 4;
#pragma unroll
    for (int i = 0; i < 16; ++i) { const int k = d.k0 + 4 * i + kq;
        v[i] = (d.srccol >= 0 && k < d.Ksrc) ? __builtin_nontemporal_load((const f32x4*)(d.W + (size_t)k * d.N + d.srccol)) : (f32x4){0.f, 0.f, 0.f, 0.f}; }
}
__device__ __forceinline__ void cvt_finish(const CvtDesc& d, f32x4 (&v)[16], LAS float* scr, int lane) {
    const int l16 = lane & 15, kq = lane >> 4;
    if (d.gain) {
#pragma unroll
        for (int i = 0; i < 16; ++i) { const int k = d.k0 + 4 * i + kq; if (k < d.Ksrc) v[i] = v[i] * d.gain[k]; } }
#pragma unroll
    for (int i = 0; i < 16; ++i) { LAS float* q = scr + (4 * i + kq) * 65 + 4 * l16; q[0] = v[i][0]; q[1] = v[i][1]; q[2] = v[i][2]; q[3] = v[i][3]; }
    LDS_WAIT(); asm volatile("" ::: "memory");
    const int c = lane & 7, nr = lane >> 3;
    if (d.cmax) {
#pragma unroll
        for (int j = 0; j < 8; ++j) { const int n = nr + 8 * j; const LAS float* t = scr + (8 * c) * 65 + n;
            const float cm = d.cmax[d.dstrow0 + n], inv = cm > 0.f ? 127.0f * __builtin_amdgcn_rcpf(cm) : 0.f;
            float v[8];
#pragma unroll
            for (int i = 0; i < 8; ++i) v[i] = t[i * 65];
            if (d.had) fwht8_32(v, lane);
            u32x2 o; o.x = pk4_i8(v[0] * inv, v[1] * inv, v[2] * inv, v[3] * inv); o.y = pk4_i8(v[4] * inv, v[5] * inv, v[6] * inv, v[7] * inv);
            __builtin_nontemporal_store(o, (u32x2*)((unsigned char*)d.WT + (size_t)(d.dstrow0 + n) * d.Kdst + d.k0 + 8 * c)); }
        LDS_WAIT(); asm volatile("" ::: "memory");
        return;
    }
    if (d.had) {
#pragma unroll
        for (int j = 0; j < 8; ++j) { const int n = nr + 8 * j; const LAS float* t = scr + (8 * c) * 65 + n;
            float v[8];
#pragma unroll
            for (int i = 0; i < 8; ++i) v[i] = t[i * 65];
            fwht8_32(v, lane);
            u32x4 o; o.x = cvt_pk_bf16(v[0] * 0.03125f, v[1] * 0.03125f); o.y = cvt_pk_bf16(v[2] * 0.03125f, v[3] * 0.03125f); o.z = cvt_pk_bf16(v[4] * 0.03125f, v[5] * 0.03125f); o.w = cvt_pk_bf16(v[6] * 0.03125f, v[7] * 0.03125f);
            __builtin_nontemporal_store(o, (u32x4*)(d.WT + (size_t)(d.dstrow0 + n) * d.Kdst + d.k0 + 8 * c)); }
        LDS_WAIT(); asm volatile("" ::: "memory");
        return;
    }
#pragma unroll
    for (int j = 0; j < 8; ++j) { const int n = nr + 8 * j; const LAS float* t = scr + (8 * c) * 65 + n;
        u32x4 o; o.x = cvt_pk_bf16(t[0 * 65], t[1 * 65]); o.y = cvt_pk_bf16(t[2 * 65], t[3 * 65]); o.z = cvt_pk_bf16(t[4 * 65], t[5 * 65]); o.w = cvt_pk_bf16(t[6 * 65], t[7 * 65]);
        __builtin_nontemporal_store(o, (u32x4*)(d.WT + (size_t)(d.dstrow0 + n) * d.Kdst + d.k0 + 8 * c)); }
    LDS_WAIT(); asm volatile("" ::: "memory");
}
constexpr int I_EVIN = 64 * (EV_N / 64), I_UQ = (QRANK / 64) * (UQ_N / 64), I_UKV = (KVK / 64) * (UKV_N / 64), I_SQ = 64 * (DM / 64), I_ODIN = 64 * (OD_N / 64);
constexpr int I_PAIR = I_EVIN + I_UQ + I_UKV + I_SQ + I_ODIN + I_SQ;
constexpr int I_GU = 64 * (GU_N / 64), I_DN = (DFF / 64) * (DM / 64), I_FFN = I_GU + I_DN;
constexpr int N_CVT_ITEMS = 2 * I_PAIR + DEPTH * I_FFN;

__device__ __forceinline__ CvtDesc cvt_describe(const Args& A, unsigned char* ws, int it, int lane) {
    const int l4 = 4 * (lane & 15);
    const float* ng = A.in[IN_NORMG];
    if (it < 2 * I_PAIR) {
        const int e = it / I_PAIR; int r = it - e * I_PAIR;
        if (r < I_EVIN) { const int nblk = EV_N / 64, kb = r / nblk, nb = r - kb * nblk, n = nb * 64 + l4;
            int sc;
            if (n < EV_CQ) sc = n; else if (n < EV_KR) sc = n + 16; else if (n < EV_FL) sc = 7376 + ropeperm(n - EV_KR); else if (n < EV_FL + 16) sc = 6144 + (n - EV_FL); else sc = -1;
            return CvtDesc{A.in[IN_EVWIN] + (size_t)e * DM * EV_SRC_N, EV_SRC_N, sc, ng + (size_t)(2 * e * 4 + 0) * DM, DM, kb * 64, (bf16_t*)(ws + W_EVIN + e * SZ_EVIN), LD_DM, nb * 64}; }
        r -= I_EVIN;
        if (r < I_UQ) { const int nblk = UQ_N / 64, kb = r / nblk, nb = r - kb * nblk, n = nb * 64 + l4;
            int sc; if (n < 2048) sc = (n >> 7) * 192 + (n & 127); else { const int j2 = n - 2048; sc = (j2 >> 6) * 192 + 128 + ropeperm(j2 & 63); }
            return CvtDesc{A.in[IN_EVWUQ] + (size_t)e * QRANK * UQ_N, UQ_N, sc, A.in[IN_EVQN] + e * QRANK, QRANK, kb * 64, (bf16_t*)(ws + W_UQ + e * SZ_UQ), LD_QR, nb * 64}; }
        r -= I_UQ;
        if (r < I_UKV) { const int nblk = UKV_N / 64, kb = r / nblk, nb = r - kb * nblk, n = nb * 64 + l4;
            int sc; if (n < 2048) sc = (n >> 7) * 256 + (n & 127); else { const int n2 = n - 2048; sc = (n2 >> 7) * 256 + 128 + (n2 & 127); }
            return CvtDesc{A.in[IN_EVWUKV] + (size_t)e * KVRANK * UKV_N, UKV_N, sc, A.in[IN_EVKVN] + e * KVRANK, KVRANK, kb * 64, (bf16_t*)(ws + W_UKV + e * SZ_UKV), LD_KV, nb * 64}; }
        r -= I_UKV;
        if (r < I_SQ) { const int nblk = DM / 64, kb = r / nblk, nb = r - kb * nblk;
            return CvtDesc{A.in[IN_EVWOUT] + (size_t)e * DM * DM, DM, nb * 64 + l4, nullptr, DM, kb * 64, (bf16_t*)(ws + W_EVOUT + e * SZ_SQ), LD_DM, nb * 64}; }
        r -= I_SQ;
        if (r < I_ODIN) { const int nblk = OD_N / 64, kb = r / nblk, nb = r - kb * nblk;
            return CvtDesc{A.in[IN_ODWIN] + (size_t)e * DM * OD_N, OD_N, nb * 64 + l4, ng + (size_t)((2 * e + 1) * 4 + 0) * DM, DM, kb * 64, (bf16_t*)(ws + W_ODIN + e * SZ_ODIN), LD_DM, nb * 64}; }
        r -= I_ODIN;
        { const int nblk = DM / 64, kb = r / nblk, nb = r - kb * nblk;
            return CvtDesc{A.in[IN_ODWOUT] + (size_t)e * DM * DM, DM, nb * 64 + l4, nullptr, DM, kb * 64, (bf16_t*)(ws + W_ODOUT + e * SZ_SQ), LD_DM, nb * 64}; }
    }
    it -= 2 * I_PAIR;
    const int L = it / I_FFN; int r = it - L * I_FFN;
    if (r < I_GU) { const int nblk = GU_N / 64, kb = r / nblk, nb = r - kb * nblk, n0 = nb * 64, tile = n0 >> 8, w = n0 & 255;
        const float* src = (w < 128 ? A.in[IN_WGATE] : A.in[IN_WUP]) + (size_t)L * DM * DFF;
        return CvtDesc{src, DFF, tile * 128 + (w & 127) + l4, ng + (size_t)(L * 4 + 2) * DM, DM, kb * 64, (bf16_t*)(ws + W_GU + L * SZ_GU), LD8, n0, (const float*)(ws + WS_CTL + CTL_COLMAX) + (size_t)L * GU_N}; }
    r -= I_GU;
    { const int nblk = DM / 64, kb = r / nblk, nb = r - kb * nblk;
        return CvtDesc{A.in[IN_WDOWN] + (size_t)L * DFF * DM, DM, nb * 64 + l4, nullptr, DFF, kb * 64, (bf16_t*)(ws + W_DN + L * SZ_DN), LD_FF, nb * 64}; }
}

__device__ __forceinline__ int ev_srccol(int n) {
    if (n < EV_CQ) return n; if (n < EV_KR) return n + 16; if (n < EV_FL) return 7376 + ropeperm(n - EV_KR); if (n < EV_FL + 16) return 6144 + (n - EV_FL); return -1;
}
__device__ __forceinline__ void row_to_bf16(const float* xrow, bf16_t* orow, float* rstd, int lane) {
    float ss = 0.f;
#pragma unroll
    for (int j = 0; j < 8; ++j) { const f32x4 a = *(const f32x4*)(xrow + 8 * lane + 512 * j), b = *(const f32x4*)(xrow + 8 * lane + 512 * j + 4);
        ss += sq8(a, b); store8(orow + 8 * lane + 512 * j, a, b); }
    ss = wave_sum(ss);
    if (lane == 0) *rstd = rsqrtf(ss * (1.0f / DM) + EPS);
}
__device__ __forceinline__ void row_to_i8(const float* xrow, unsigned char* orow, float* rs8, int lane) {
    f32x4 a[8], b[8]; float ss = 0.f, mx = 0.f;
#pragma unroll
    for (int j = 0; j < 8; ++j) { a[j] = *(const f32x4*)(xrow + 8 * lane + 512 * j); b[j] = *(const f32x4*)(xrow + 8 * lane + 512 * j + 4);
        ss += sq8(a[j], b[j]);
        mx = fmaxf(mx, fmaxf(fmaxf(fmaxf(fabsf(a[j][0]), fabsf(a[j][1])), fmaxf(fabsf(a[j][2]), fabsf(a[j][3]))), fmaxf(fmaxf(fabsf(b[j][0]), fabsf(b[j][1])), fmaxf(fabsf(b[j][2]), fabsf(b[j][3]))))); }
    ss = wave_sum(ss); mx = wave_max(mx);
    const float inv = mx > 0.f ? 127.0f * __builtin_amdgcn_rcpf(mx) : 0.f;
#pragma unroll
    for (int j = 0; j < 8; ++j) { u32x2 q; q.x = pk4_i8(a[j][0] * inv, a[j][1] * inv, a[j][2] * inv, a[j][3] * inv); q.y = pk4_i8(b[j][0] * inv, b[j][1] * inv, b[j][2] * inv, b[j][3] * inv);
        *(u32x2*)(orow + 8 * lane + 512 * j) = q; }
    if (lane == 0) *rs8 = rsqrtf(ss * (1.0f / DM) + EPS) * mx * (1.0f / 16129.0f);
}
constexpr int N_OD8 = ((I8_IN_ODD & 1) + ((I8_IN_ODD >> 1) & 1));
constexpr int I_PAIR0 = I_PAIR - I_EVIN;
constexpr int N_EV8 = ((I8_IN_EV & 1) + ((I8_IN_EV >> 1) & 1));
constexpr int NP0 = I_PAIR - ((I8_IN_EV & 1) ? I_EVIN : 0) - ((I8_IN_ODD & 1) ? I_ODIN : 0), NP1 = I_PAIR - ((I8_IN_EV & 2) ? I_EVIN : 0) - ((I8_IN_ODD & 2) ? I_ODIN : 0);
__device__ __forceinline__ int pair_item(int r, int e) {
    if (!((I8_IN_EV >> e) & 1)) { if (r < I_EVIN) return r; r -= I_EVIN; }
    if (r < I_UQ + I_UKV + I_SQ) return I_EVIN + r;
    r -= I_UQ + I_UKV + I_SQ;
    if (!((I8_IN_ODD >> e) & 1)) { if (r < I_ODIN) return I_EVIN + I_UQ + I_UKV + I_SQ + r; r -= I_ODIN; }
    return I_EVIN + I_UQ + I_UKV + I_SQ + I_ODIN + r;
}
constexpr int N_DN8 = (I8_DN & 1) + ((I8_DN >> 1) & 1) + ((I8_DN >> 2) & 1) + ((I8_DN >> 3) & 1);
__device__ __forceinline__ int nth_layer(int idx, int mask) {
    int L = 0;
#pragma unroll
    for (int b = 0; b < DEPTH; ++b) { if ((mask >> b) & 1) { if (idx == 0) L = b; --idx; } }
    return L;
}
template <int PH> __device__ __forceinline__ CvtDesc cvt_desc(const Args& A, unsigned char* ws, int j, int lane) {
    if constexpr (PH == 0) {
        if (j < NP0) return cvt_describe(A, ws, pair_item(j, 0), lane);
        if (j < NP0 + NP1) return cvt_describe(A, ws, I_PAIR + pair_item(j - NP0, 1), lane);
        const int q = j - NP0 - NP1, idx = q / I_DN, L = nth_layer(idx, ~I8_DN & ((1 << DEPTH) - 1)); return cvt_describe(A, ws, 2 * I_PAIR + L * I_FFN + I_GU + (q - idx * I_DN), lane); }
    else {
        const int q = j;
        const int idx = q / I_DN, r = q - idx * I_DN, L = nth_layer(idx, I8_DN), nblk = DM / 64, kb = r / nblk, nb = r - kb * nblk;
        return CvtDesc{A.in[IN_WDOWN] + (size_t)L * DFF * DM, DM, nb * 64 + 4 * (lane & 15), nullptr, DFF, kb * 64, (bf16_t*)(ws + W_DN + L * SZ_DN), LD8F, nb * 64, (const float*)(ws + WS_CTL + CTL_COLMAX_DN) + (size_t)L * DM, 1};
    }
}
template <int PH> __device__ __forceinline__ void cvt_items(const Args& A, Frame& F) {
    constexpr int NIT = PH == 0 ? NP0 + NP1 + (DEPTH - N_DN8) * I_DN : N_DN8 * I_DN;
    LAS float* scr = (LAS float*)(F.lds + F.wave * 16640);
    const int gw = F.vcu * 8 + F.wave, NGW = F.G * 8;
    unsigned char* ws = F.ws;
    f32x4 vA[16], vB[16]; CvtDesc dA{}, dB{};
    int it = gw;
    if (it < NIT) { dA = cvt_desc<PH>(A, ws, it, F.lane); cvt_load(dA, vA, F.lane); }
    for (; it < NIT; it += 2 * NGW) {
        const int it1 = it + NGW, it2 = it1 + NGW;
        if (it1 < NIT) { dB = cvt_desc<PH>(A, ws, it1, F.lane); cvt_load(dB, vB, F.lane); }
        cvt_finish(dA, vA, scr, F.lane);
        if (it2 < NIT) { dA = cvt_desc<PH>(A, ws, it2, F.lane); cvt_load(dA, vA, F.lane); }
        if (it1 < NIT) cvt_finish(dB, vB, scr, F.lane);
    }
}
__device__ __forceinline__ int ropeperm_inv(int d) { return d < 32 ? 8 * (d >> 2) + (d & 3) : 8 * ((d - 32) >> 2) + 4 + ((d - 32) & 3); }
__device__ __forceinline__ int ev_dstcol(int sc) { if (sc < 6144) return sc; if (sc < 6160) return EV_FL + (sc - 6144); if (sc < 7376) return sc - 16; return EV_KR + ropeperm_inv(sc - 7376); }
constexpr int NS_GU = DFF / 32, NS_OD = OD_N / 32, NS_EV = (EV_SRC_N + 31) / 32, N_STRIPS = DEPTH * 2 * NS_GU + N_OD8 * NS_OD + N_EV8 * NS_EV, STRIP_SLOTS = 135168;
__device__ __forceinline__ void strip_phase(const Args& A, Frame& F) {
    LAS unsigned char* lds = F.lds; unsigned char* ws = F.ws; const int tid = F.tid;
    int par = 0;
    for (int s = F.vcu; s < N_STRIPS; s += F.G, par ^= 1) {
        LAS unsigned* slots = (LAS unsigned*)(lds + STRIP_SLOTS) + 32 * par;
        const float* src; const float* gain; unsigned char* dst; float* cmx; int N, c0, kind, rbase = 0;
        if (s < DEPTH * 2 * NS_GU) { const int mi = s / NS_GU, cb = s - mi * NS_GU, L = mi >> 1, up = mi & 1; kind = 0; N = DFF; c0 = cb * 32;
            src = (up ? A.in[IN_WUP] : A.in[IN_WGATE]) + (size_t)L * DM * DFF; gain = A.in[IN_NORMG] + (size_t)(L * 4 + 2) * DM;
            dst = ws + W_GU + (size_t)L * SZ_GU; cmx = (float*)(ws + WS_CTL + CTL_COLMAX) + (size_t)L * GU_N; rbase = (c0 >> 7) * 256 + up * 128 + (c0 & 127); }
        else if (s < DEPTH * 2 * NS_GU + N_OD8 * NS_OD) { const int q = s - DEPTH * 2 * NS_GU, idx = q / NS_OD, cb = q - idx * NS_OD, e = (I8_IN_ODD & 1) ? idx : 1; kind = 1; N = OD_N; c0 = cb * 32;
            src = A.in[IN_ODWIN] + (size_t)e * DM * OD_N; gain = A.in[IN_NORMG] + (size_t)((2 * e + 1) * 4 + 0) * DM;
            dst = ws + W_GU + (size_t)(2 * e + 1) * SZ_GU + W_OD8_OFF; cmx = (float*)(ws + WS_CTL + CTL_COLMAX_OD) + (size_t)e * OD_N; rbase = c0; }
        else { const int q = s - DEPTH * 2 * NS_GU - N_OD8 * NS_OD, idx = q / NS_EV, cb = q - idx * NS_EV, e = (I8_IN_EV & 1) ? idx : 1; kind = 2; N = EV_SRC_N; c0 = cb * 32 + 32 <= EV_SRC_N ? cb * 32 : EV_SRC_N - 32;
            src = A.in[IN_EVWIN] + (size_t)e * DM * EV_SRC_N; gain = A.in[IN_NORMG] + (size_t)(2 * e * 4 + 0) * DM;
            dst = ws + W_EVIN + (size_t)e * SZ_EVIN; cmx = (float*)(ws + WS_CTL + CTL_COLMAX_EV) + (size_t)e * EV_N; }
        if (tid < 32) slots[tid] = 0u;
        __syncthreads();
        const int cg = tid & 7;
        unsigned m0 = 0u, m1 = 0u;
        {
            const float* sp = src + (size_t)(tid >> 3) * N + c0 + 4 * cg;
#pragma unroll 1
            for (int h = 0; h < 2; ++h) {
                f32x4 v[16];
#pragma unroll
                for (int i = 0; i < 16; ++i) v[i] = __builtin_nontemporal_load((const f32x4*)(sp + (size_t)(64 * (16 * h + i)) * N));
#pragma unroll
                for (int i = 0; i < 16; ++i) { const int k = (tid >> 3) + 64 * (16 * h + i); const float g = gain[k];
                    u32x2 w; w.x = cvt_pk_bf16(v[i][0] * g, v[i][1] * g); w.y = cvt_pk_bf16(v[i][2] * g, v[i][3] * g);
                    m0 = pkmax(m0, w.x & 0x7fff7fffu); m1 = pkmax(m1, w.y & 0x7fff7fffu);
                    *(LAS u32x2*)(lds + (k >> 2) * 264 + (k & 3) * 64 + cg * 8) = w; }
            }
        }
        u32x2 rg[4][8];
        {   const float* sp = src + (size_t)(2048 + 8 * (tid >> 3)) * N + c0 + 4 * cg;
#pragma unroll
            for (int jj = 0; jj < 2; ++jj) {
                f32x4 v[16];
#pragma unroll
                for (int i = 0; i < 16; ++i) v[i] = __builtin_nontemporal_load((const f32x4*)(sp + (size_t)(512 * (2 * jj + (i >> 3)) + (i & 7)) * N));
#pragma unroll
                for (int i = 0; i < 16; ++i) { const int k = 2048 + 8 * (tid >> 3) + 512 * (2 * jj + (i >> 3)) + (i & 7); const float g = gain[k];
                    u32x2 w; w.x = cvt_pk_bf16(v[i][0] * g, v[i][1] * g); w.y = cvt_pk_bf16(v[i][2] * g, v[i][3] * g);
                    m0 = pkmax(m0, w.x & 0x7fff7fffu); m1 = pkmax(m1, w.y & 0x7fff7fffu);
                    rg[2 * jj + (i >> 3)][i & 7] = w; }
            }
        }
        atomicMax((unsigned*)(slots + 4 * cg + 0), m0 << 16); atomicMax((unsigned*)(slots + 4 * cg + 1), m0 & 0xffff0000u);
        atomicMax((unsigned*)(slots + 4 * cg + 2), m1 << 16); atomicMax((unsigned*)(slots + 4 * cg + 3), m1 & 0xffff0000u);
        __syncthreads();
        {
            const int ch = tid >> 1, hf = tid & 1;
            u32x2 w[8][4];
#pragma unroll
            for (int r = 0; r < 8; ++r) { const LAS u32x2* cp = (const LAS u32x2*)(lds + (2 * ch + (r >> 2)) * 264 + (r & 3) * 64 + hf * 32);
#pragma unroll
                for (int j = 0; j < 4; ++j) w[r][j] = cp[j]; }
#pragma unroll
            for (int n = 0; n < 16; ++n) {
                const float cm = __uint_as_float(slots[16 * hf + n]), inv = cm > 0.f ? 127.0f * __builtin_amdgcn_rcpf(cm) : 0.f;
                float x[8];
#pragma unroll
                for (int r = 0; r < 8; ++r) { const unsigned word = (n & 2) ? w[r][n >> 2].y : w[r][n >> 2].x; x[r] = ((n & 1) ? bf_hi(word) : bf_lo(word)) * inv; }
                u32x2 q; q.x = pk4_i8(x[0], x[1], x[2], x[3]); q.y = pk4_i8(x[4], x[5], x[6], x[7]);
                const int col = 16 * hf + n, drow = kind == 2 ? ev_dstcol(c0 + col) : rbase + col;
                __builtin_nontemporal_store(q, (u32x2*)(dst + (size_t)drow * LD8 + 8 * ch));
            }
        }
        {
#pragma unroll
            for (int c = 0; c < 4; ++c) {
                const float cm = __uint_as_float(slots[4 * cg + c]), inv = cm > 0.f ? 127.0f * __builtin_amdgcn_rcpf(cm) : 0.f;
                const int col = 4 * cg + c, drow = kind == 2 ? ev_dstcol(c0 + col) : rbase + col;
#pragma unroll
                for (int j = 0; j < 4; ++j) {
                    float x[8];
#pragma unroll
                    for (int r = 0; r < 8; ++r) { const unsigned word = (c & 2) ? rg[j][r].y : rg[j][r].x; x[r] = ((c & 1) ? bf_hi(word) : bf_lo(word)) * inv; }
                    u32x2 q; q.x = pk4_i8(x[0], x[1], x[2], x[3]); q.y = pk4_i8(x[4], x[5], x[6], x[7]);
                    __builtin_nontemporal_store(q, (u32x2*)(dst + (size_t)drow * LD8 + 2048 + 8 * ((tid >> 3) + 64 * j)));
                }
            }
        }
        if (tid < 32) { const int drow = kind == 2 ? ev_dstcol(c0 + tid) : rbase + tid; cmx[drow] = __uint_as_float(slots[tid]); }
    }
    __syncthreads();
    { const int gw = F.vcu * 8 + F.wave, NGW = F.G * 8;
      for (int r = gw; r < N_EV8 * (EV_N - EV_SRC_N); r += NGW) { const int idx = r / (EV_N - EV_SRC_N), row = EV_SRC_N + (r - idx * (EV_N - EV_SRC_N)), e = (I8_IN_EV & 1) ? idx : 1;
          unsigned char* d = ws + W_EVIN + (size_t)e * SZ_EVIN + (size_t)row * LD8; const u32x4 z = {0u, 0u, 0u, 0u};
#pragma unroll
          for (int j = 0; j < 4; ++j) *(u32x4*)(d + 16 * F.lane + 1024 * j) = z; } }
}
__device__ __forceinline__ void colmax_dn_pass(const Args& A, Frame& F) {
    const int gw = F.vcu * 8 + F.wave, NGW = F.G * 8, lane = F.lane;
    constexpr int NKC = DFF / 256, NCB = DM / 256;
    for (int item = gw; item < N_DN8 * NKC * NCB; item += NGW) {
        const int cb = item % NCB, q = item / NCB, kc = q % NKC, L = nth_layer(q / NKC, I8_DN);
        const float* src = A.in[IN_WDOWN] + (size_t)L * DFF * DM + (size_t)(kc * 256) * DM + cb * 256 + 4 * lane;
        f32x4 mx = {0.f, 0.f, 0.f, 0.f};
#pragma unroll 1
        for (int g = 0; g < 8; ++g) {
            f32x4 w[32];
#pragma unroll
            for (int i = 0; i < 32; ++i) w[i] = __builtin_nontemporal_load((const f32x4*)(src + (size_t)(g * 32 + i) * DM));
#pragma unroll
            for (int h = 1; h < 32; h <<= 1)
#pragma unroll
                for (int i = 0; i < 32; ++i) if (!(i & h)) { const f32x4 x = w[i], y = w[i | h]; w[i] = x + y; w[i | h] = x - y; }
#pragma unroll
            for (int i = 0; i < 32; ++i) { mx[0] = fmaxf(mx[0], fabsf(w[i][0])); mx[1] = fmaxf(mx[1], fabsf(w[i][1])); mx[2] = fmaxf(mx[2], fabsf(w[i][2])); mx[3] = fmaxf(mx[3], fabsf(w[i][3])); }
        }
        unsigned* dstp = (unsigned*)(F.ws + WS_CTL + CTL_COLMAX_DN) + (size_t)L * DM + cb * 256 + 4 * lane;
#pragma unroll
        for (int e = 0; e < 4; ++e) atomicMax(dstp + e, __float_as_uint(mx[e]));
    }
}
__device__ __forceinline__ void actq_load(u32x4 (&w)[22], const bf16_t* act, int row, int lane) {
    const char* src = (const char*)(act + (size_t)row * LD_FF);
#pragma unroll
    for (int j = 0; j < 22; ++j) { w[j] = (u32x4){0u, 0u, 0u, 0u}; if (8 * lane + 512 * j < DFF) w[j] = __builtin_nontemporal_load((const u32x4*)(src + 16 * lane + 1024 * j)); }
}
__device__ __forceinline__ void actq_row(u32x4 (&w)[22], unsigned char* act8, float* rsd, int row, int lane) {
    unsigned char* dst = act8 + (size_t)row * LD8F;
    unsigned amx2 = 0u;
#pragma unroll
    for (int j = 0; j < 22; ++j) {
        float v[8] = {bf_lo(w[j].x), bf_hi(w[j].x), bf_lo(w[j].y), bf_hi(w[j].y), bf_lo(w[j].z), bf_hi(w[j].z), bf_lo(w[j].w), bf_hi(w[j].w)};
        fwht8_32(v, lane);
        w[j].x = cvt_pk_bf16(v[0], v[1]); w[j].y = cvt_pk_bf16(v[2], v[3]); w[j].z = cvt_pk_bf16(v[4], v[5]); w[j].w = cvt_pk_bf16(v[6], v[7]);
        amx2 = pkmax(pkmax(amx2, w[j].x & 0x7fff7fffu), pkmax(w[j].y & 0x7fff7fffu, pkmax(w[j].z & 0x7fff7fffu, w[j].w & 0x7fff7fffu)));
    }
    const float m = wave_max(fmaxf(bf_lo(amx2), bf_hi(amx2)));
    const float inv = m > 0.f ? 127.0f * __builtin_amdgcn_rcpf(m) : 0.f;
#pragma unroll
    for (int j = 0; j < 22; ++j) { if (8 * lane + 512 * j < DFF) { u32x2 q;
        q.x = pk4_i8(bf_lo(w[j].x) * inv, bf_hi(w[j].x) * inv, bf_lo(w[j].y) * inv, bf_hi(w[j].y) * inv); q.y = pk4_i8(bf_lo(w[j].z) * inv, bf_hi(w[j].z) * inv, bf_lo(w[j].w) * inv, bf_hi(w[j].w) * inv);
        *(u32x2*)(dst + 8 * lane + 512 * j) = q; } }
    if (lane == 0) rsd[row] = m * (1.0f / (16129.0f * 32.0f));
}
__device__ __forceinline__ void actq_phase(Frame& F) {
    unsigned char* ws = F.ws;
    const int gw = F.vcu * 8 + F.wave, NGW = F.G * 8, lane = F.lane;
    const bf16_t* act = (const bf16_t*)(ws + WS_PROJ); unsigned char* act8 = ws + WS_ACT8; float* rsd = (float*)(ws + WS_RSD);
    u32x4 wA[22], wB[22];
    int row = gw;
    if (row < MPAD) actq_load(wA, act, row, lane);
    for (; row < MPAD; row += 2 * NGW) {
        const int r1 = row + NGW, r2 = r1 + NGW;
        if (r1 < MPAD) actq_load(wB, act, r1, lane);
        actq_row(wA, act8, rsd, row, lane);
        if (r2 < MPAD) actq_load(wA, act, r2, lane);
        if (r1 < MPAD) actq_row(wB, act8, rsd, r1, lane);
    }
}
__device__ __forceinline__ void p0_prologue(const Args& A, Frame& F) {
    const int gw = F.vcu * 8 + F.wave, NGW = F.G * 8;
    unsigned char* ws = F.ws;
    strip_phase(A, F);
    colmax_dn_pass(A, F);
    cvt_items<0>(A, F);
    { float* cosT = (float*)(ws + WS_COS); float* sinT = (float*)(ws + WS_SIN);
      for (int idx = gw * 64 + F.lane; idx < NPOS * 32; idx += NGW * 64) { const int pos = idx >> 5, i = idx & 31;
          const float inv = powf(10000.0f, -(float)i * (1.0f / 32.0f)); const float ang = (float)pos * inv;
          cosT[idx] = cosf(ang); sinT[idx] = sinf(ang); } }
    if (gw == 0) { float* prm = (float*)(ws + WS_PRM);
        for (int o = 0; o < 2; ++o) { const float* l = A.in[IN_ODLAM] + o * 4 * 128;
            const float s01 = wave_sum(l[F.lane] * l[128 + F.lane] + l[64 + F.lane] * l[192 + F.lane]);
            const float s23 = wave_sum(l[256 + F.lane] * l[384 + F.lane] + l[320 + F.lane] * l[448 + F.lane]);
            if (F.lane == 0) prm[o] = expf(s01) - expf(s23) + A.lam_init[o]; } }
    bf16_t* hbf = (bf16_t*)(ws + WS_HBF); float* rstd = (float*)(ws + WS_RSTD); unsigned char* a8 = ws + WS_OBUF; float* rs8 = (float*)(ws + WS_RS8);
    for (int row = gw; row < MPAD; row += NGW) {
        if (row < MUSED) { const float* src = row < MREAL ? A.in[IN_X] + (size_t)row * DM : A.in[IN_META] + (size_t)(row - MREAL) * DM;
            if constexpr (I8_IN_EV & 1) row_to_i8(src, a8 + (size_t)row * LD8, rs8 + row, F.lane); else row_to_bf16(src, hbf + (size_t)row * LD_DM, rstd + row, F.lane); }
        else { const u32x4 z = {0u, 0u, 0u, 0u};
#pragma unroll
            for (int j = 0; j < 8; ++j) *(u32x4*)(hbf + (size_t)row * LD_DM + 8 * F.lane + 512 * j) = z;
#pragma unroll
            for (int j = 0; j < 4; ++j) *(u32x4*)(a8 + (size_t)row * LD8 + 16 * F.lane + 1024 * j) = z;
            if (F.lane == 0) { rstd[row] = 0.f; rs8[row] = 0.f; } }
    }
}

__device__ __forceinline__ void ew_phase(const Args& A, Frame& F, int layer, int which) {
    unsigned char* ws = F.ws;
    const int gw = F.vcu * 8 + F.wave, NGW = F.G * 8, lane = F.lane;
    const float* gpost = A.in[IN_NORMG] + (size_t)(layer * 4 + (which ? 3 : 1)) * DM;
    const bool first = (layer == 0 && which == 0), last = (layer == DEPTH - 1 && which == 1);
    const bf16_t* mbuf = (const bf16_t*)(ws + WS_MBUF); bf16_t* hbf = (bf16_t*)(ws + WS_HBF);
    float* rstd = (float*)(ws + WS_RSTD); const float* statm = (const float*)(ws + WS_STATM);
    const bool q8 = (which == 0) || (layer + 1 < DEPTH && (((((layer + 1) & 1) ? I8_IN_ODD : I8_IN_EV) >> ((layer + 1) >> 1)) & 1));
    unsigned char* a8 = ws + (which == 0 ? WS_A8 : WS_OBUF); float* rs8 = (float*)(ws + WS_RS8);
    if (q8) {
        for (int row = MUSED + gw; row < MPAD; row += NGW) { const u32x4 z = {0u, 0u, 0u, 0u};
#pragma unroll
            for (int j = 0; j < 4; ++j) *(u32x4*)(a8 + (size_t)row * LD8 + 16 * lane + 1024 * j) = z;
            if (lane == 0) rs8[row] = 0.f; }
    }
    if (F.vcu < NMETA && !last) {
        const int r = F.vcu, row = MREAL + r, nS = which ? (DFF / 256) : (DM / 256), c0 = F.wave * 512 + 8 * lane;
        const float* part = (const float*)(ws + WS_PART) + (size_t)r * DM + c0;
        LAS float* red = (LAS float*)F.lds;
        f32x4 ma = {0.f, 0.f, 0.f, 0.f}, mb = {0.f, 0.f, 0.f, 0.f};
        if (which && ((I8_DN >> layer) & 1)) {
            i32x4 ia = {0, 0, 0, 0}, ib = {0, 0, 0, 0};
#pragma unroll 16
            for (int ks = 0; ks < DFF / 256; ++ks) { ia += *(const i32x4*)(part + (size_t)ks * 16 * DM); ib += *(const i32x4*)(part + (size_t)ks * 16 * DM + 4); }
            const float* cs = (const float*)(ws + WS_CTL + CTL_COLMAX_DN) + (size_t)layer * DM + c0; const float rsc = ((const float*)(ws + WS_RSD))[row];
            ma = __builtin_convertvector(ia, f32x4) * (*(const f32x4*)cs * rsc); mb = __builtin_convertvector(ib, f32x4) * (*(const f32x4*)(cs + 4) * rsc);
        } else {
#pragma unroll 16
        for (int ks = 0; ks < nS; ++ks) { ma += *(const f32x4*)(part + (size_t)ks * 16 * DM); mb += *(const f32x4*)(part + (size_t)ks * 16 * DM + 4); }
        }
        const float s1 = wave_sum(sq8(ma, mb));
        if (lane == 0) red[F.wave] = s1;
        __syncthreads();
        const float rm = __builtin_amdgcn_rsqf((((red[0] + red[1]) + (red[2] + red[3])) + ((red[4] + red[5]) + (red[6] + red[7]))) * (1.0f / DM) + EPS);
        f32x4 ha, hb;
        if (first) { ha = *(const f32x4*)(A.in[IN_META] + (size_t)r * DM + c0); hb = *(const f32x4*)(A.in[IN_META] + (size_t)r * DM + c0 + 4); }
        else { const u32x4 wh = *(const u32x4*)(hbf + (size_t)row * LD_DM + c0);
            ha = (f32x4){bf_lo(wh.x), bf_hi(wh.x), bf_lo(wh.y), bf_hi(wh.y)}; hb = (f32x4){bf_lo(wh.z), bf_hi(wh.z), bf_lo(wh.w), bf_hi(wh.w)}; }
        const f32x4 ga = *(const f32x4*)(gpost + c0), gb = *(const f32x4*)(gpost + c0 + 4);
        ha = ha + ma * rm * ga; hb = hb + mb * rm * gb;
        const float s2 = wave_sum(sq8(ha, hb));
        const float mxw = wave_max(fmaxf(fmaxf(fmaxf(fabsf(ha[0]), fabsf(ha[1])), fmaxf(fabsf(ha[2]), fabsf(ha[3]))), fmaxf(fmaxf(fabsf(hb[0]), fabsf(hb[1])), fmaxf(fabsf(hb[2]), fabsf(hb[3])))));
        if (lane == 0) { red[8 + F.wave] = s2; red[16 + F.wave] = mxw; }
        __syncthreads();
        store8(hbf + (size_t)row * LD_DM + c0, ha, hb);
        const float amx = fmaxf(fmaxf(fmaxf(red[16], red[17]), fmaxf(red[18], red[19])), fmaxf(fmaxf(red[20], red[21]), fmaxf(red[22], red[23])));
        if (q8) { const float inv = amx > 0.f ? 127.0f * __builtin_amdgcn_rcpf(amx) : 0.f;
            u32x2 q; q.x = pk4_i8(ha[0] * inv, ha[1] * inv, ha[2] * inv, ha[3] * inv); q.y = pk4_i8(hb[0] * inv, hb[1] * inv, hb[2] * inv, hb[3] * inv); *(u32x2*)(a8 + (size_t)row * LD8 + c0) = q; }
        if (F.tid == 0) { const float rr = __builtin_amdgcn_rsqf((((red[8] + red[9]) + (red[10] + red[11])) + ((red[12] + red[13]) + (red[14] + red[15]))) * (1.0f / DM) + EPS);
            rstd[row] = rr; if (q8) rs8[row] = rr * amx * (1.0f / 16129.0f); }
        __syncthreads();
    }
    u32x4 mv[8], ha[8], hb[8]; float sq = 0.f;
    unsigned v16 = (unsigned)lane * 16u, v32 = (unsigned)lane * 32u, v8 = (unsigned)lane * 8u;
    asm volatile("" : "+v"(v16), "+v"(v32), "+v"(v8));
    const char* const mbufc = (const char*)mbuf; const char* const hbfc = (const char*)hbf; const char* const xc = (const char*)A.in[IN_X]; const char* const gpc = (const char*)gpost;
#define EW_FETCH(j_, row_) do { mv[j_] = __builtin_nontemporal_load((const u32x4*)(mbufc + ((size_t)(row_) * (LD_DM * 2) + 1024 * (j_)) + opq(v16)));           \
        if (first) { ha[j_] = *(const u32x4*)(xc + ((size_t)(row_) * (DM * 4) + 2048 * (j_)) + opq(v32)); hb[j_] = *(const u32x4*)(xc + ((size_t)(row_) * (DM * 4) + 2048 * (j_) + 16) + opq(v32)); } \
        else { ha[j_] = *(const u32x4*)(hbfc + ((size_t)(row_) * (LD_DM * 2) + 1024 * (j_)) + opq(v16)); } } while (0)
    LAS u32x4* const wst = (LAS u32x4*)(F.lds + 1024 + F.wave * 8192) + lane;
    int row = gw;
    if (row < MREAL) {
#pragma unroll
        for (int j = 0; j < 8; ++j) EW_FETCH(j, row);
        sq = *(const float*)((const char*)statm + (size_t)row * 256 + opq((unsigned)lane * 4u)); }
    for (; row < MREAL; row += NGW) {
        asm volatile("" : "+v"(v16), "+v"(v32), "+v"(v8));
        unsigned amx2 = 0u;
        const float rm = __builtin_amdgcn_rsqf(wave_sum(sq) * (1.0f / DM) + EPS);
        const int nrow = row + NGW; const bool more = nrow < MREAL;
        if (more) sq = *(const float*)((const char*)statm + (size_t)nrow * 256 + opq((unsigned)lane * 4u));
        float ss2 = 0.f;
        char* const hbw = (char*)hbf + (size_t)row * (LD_DM * 2); char* const outw = (char*)A.out + (size_t)row * (DM * 4);
#pragma unroll
        for (int j = 0; j < 8; ++j) { const f32x4 g0 = *(const f32x4*)(gpc + 2048 * j + opq(v32)), g1 = *(const f32x4*)(gpc + (2048 * j + 16) + opq(v32));
            const f32x4 m0 = {bf_lo(mv[j].x), bf_hi(mv[j].x), bf_lo(mv[j].y), bf_hi(mv[j].y)}, m1 = {bf_lo(mv[j].z), bf_hi(mv[j].z), bf_lo(mv[j].w), bf_hi(mv[j].w)};
            f32x4 h0, h1;
            if (first) { h0 = (f32x4){__uint_as_float(ha[j].x), __uint_as_float(ha[j].y), __uint_as_float(ha[j].z), __uint_as_float(ha[j].w)}; h1 = (f32x4){__uint_as_float(hb[j].x), __uint_as_float(hb[j].y), __uint_as_float(hb[j].z), __uint_as_float(hb[j].w)}; }
            else { h0 = (f32x4){bf_lo(ha[j].x), bf_hi(ha[j].x), bf_lo(ha[j].y), bf_hi(ha[j].y)}; h1 = (f32x4){bf_lo(ha[j].z), bf_hi(ha[j].z), bf_lo(ha[j].w), bf_hi(ha[j].w)}; }
            const f32x4 n0 = h0 + m0 * rm * g0, n1 = h1 + m1 * rm * g1; ss2 += sq8(n0, n1);
            if (last) { *(f32x4*)(outw + 2048 * j + opq(v32)) = n0; *(f32x4*)(outw + (2048 * j + 16) + opq(v32)) = n1; }
            else { u32x4 wh; wh.x = cvt_pk_bf16(n0[0], n0[1]); wh.y = cvt_pk_bf16(n0[2], n0[3]); wh.z = cvt_pk_bf16(n1[0], n1[1]); wh.w = cvt_pk_bf16(n1[2], n1[3]);
                *(u32x4*)(hbw + 1024 * j + opq(v16)) = wh;
                if (q8) { wst[j * 64] = wh;
                    amx2 = pkmax(pkmax(amx2, wh.x & 0x7fff7fffu), pkmax(wh.y & 0x7fff7fffu, pkmax(wh.z & 0x7fff7fffu, wh.w & 0x7fff7fffu))); } }
            if (more) EW_FETCH(j, nrow);
        }
        if (!last) { ss2 = wave_sum(ss2); const float rr = __builtin_amdgcn_rsqf(ss2 * (1.0f / DM) + EPS);
            if (lane == 0) rstd[row] = rr;
            if (q8) { const float amax = wave_max(fmaxf(bf_lo(amx2), bf_hi(amx2))); const float inv = amax > 0.f ? 127.0f * __builtin_amdgcn_rcpf(amax) : 0.f;
                if (lane == 0) rs8[row] = rr * amax * (1.0f / 16129.0f);
                char* const a8w = (char*)a8 + (size_t)row * LD8;
#pragma unroll
                for (int j = 0; j < 8; ++j) { u32x2 q; const u32x4 w = wst[j * 64];
                    q.x = pk4_i8(bf_lo(w.x) * inv, bf_hi(w.x) * inv, bf_lo(w.y) * inv, bf_hi(w.y) * inv); q.y = pk4_i8(bf_lo(w.z) * inv, bf_hi(w.z) * inv, bf_lo(w.w) * inv, bf_hi(w.w) * inv);
                    *(u32x2*)(a8w + 512 * j + opq(v8)) = q; } } }
    }
#undef EW_FETCH
}

__device__ __forceinline__ float logsig(float x) { return fminf(x, 0.f) - 0.6931471805599453f * __builtin_amdgcn_logf(1.0f + __builtin_amdgcn_exp2f(-1.4426950408889634f * fabsf(x))); }
__device__ __forceinline__ void scan_phase(const Args& A, Frame& F, int e) {
    const int gw = (F.G - 1 - F.vcu) * 8 + F.wave, lane = F.lane;
    if (gw >= NB * 16) return;
    const int b = gw >> 4, h = gw & 15;
    const float* flogT = (const float*)(F.ws + WS_FLOG) + (size_t)h * MPAD; float* cumT = (float*)(F.ws + WS_CUM) + (size_t)h * MPAD;
    const float bf = A.in[IN_EVBF][e * 16 + h];
    float cm = 0.f, mine = 0.f;
#pragma unroll 1
    for (int m = 0; m < NMETA; ++m) { cm += logsig(flogT[META0 + m] + bf); if (lane == m) mine = cm; }
    if (b == 0) cumT[META0 + lane] = lane < NMETA ? mine : 0.f;
    const float* src = flogT + b * SEQ + lane * 64; float* dst = cumT + b * SEQ + lane * 64;
    float s = 0.f;
#pragma unroll 1
    for (int i = 0; i < 16; ++i) { const f32x4 v = *(const f32x4*)(src + 4 * i); s += (logsig(v[0] + bf) + logsig(v[1] + bf)) + (logsig(v[2] + bf) + logsig(v[3] + bf)); }
    float inc = s;
#pragma unroll
    for (int off = 1; off < 64; off <<= 1) { const float t = __shfl_up(inc, off); if (lane >= off) inc += t; }
    float run = cm + (inc - s);
#pragma unroll 1
    for (int i = 0; i < 16; ++i) { const f32x4 v = *(const f32x4*)(src + 4 * i); f32x4 o;
        run += logsig(v[0] + bf); o[0] = run; run += logsig(v[1] + bf); o[1] = run; run += logsig(v[2] + bf); o[2] = run; run += logsig(v[3] + bf); o[3] = run;
        *(f32x4*)(dst + 4 * i) = o; }
}

__device__ __forceinline__ void fixup_odd_meta(Frame& F, int e) {
    unsigned char* ws = F.ws;
    const float* part = (const float*)(ws + WS_PART); const float* rstd = (const float*)(ws + WS_RSTD); bf16_t* proj = (bf16_t*)(ws + WS_PROJ);
    const bool i8 = (I8_IN_ODD >> e) & 1;
    const float* cs = (const float*)(ws + WS_CTL + CTL_COLMAX_OD) + (size_t)e * OD_N; const float* rs8 = (const float*)(ws + WS_RS8);
    constexpr int CG = OD_N / 8;
    for (int item = F.vcu * 512 + F.tid; item < 256 * CG; item += F.G * 512) {
        const int r = item / CG, col = (item - r * CG) * 8;
        f32x4 a = {0.f, 0.f, 0.f, 0.f}, b = {0.f, 0.f, 0.f, 0.f};
        if (r < NMETA) {
            if (i8) { i32x4 ia = {0, 0, 0, 0}, ib = {0, 0, 0, 0};
#pragma unroll 16
                for (int ks = 0; ks < DM / 256; ++ks) { ia += *(const i32x4*)(part + (size_t)(ks * 16 + r) * OD_N + col); ib += *(const i32x4*)(part + (size_t)(ks * 16 + r) * OD_N + col + 4); }
                const float sc = rs8[META0 + r]; a = __builtin_convertvector(ia, f32x4) * (*(const f32x4*)(cs + col) * sc); b = __builtin_convertvector(ib, f32x4) * (*(const f32x4*)(cs + col + 4) * sc);
            } else {
#pragma unroll 16
            for (int ks = 0; ks < DM / 256; ++ks) { a += *(const f32x4*)(part + (size_t)(ks * 16 + r) * OD_N + col); b += *(const f32x4*)(part + (size_t)(ks * 16 + r) * OD_N + col + 4); }
            const float sc = rstd[META0 + r]; a = a * sc; b = b * sc;
            }
        }
        pg8::store8(proj + (size_t)(META0 + r) * LD_OD + col, a, b);
    }
}

__device__ __forceinline__ int t5_bucket(int d) {
    if (d < 16) return d;
    return 16 + (d >= 19) + (d >= 21) + (d >= 24) + (d >= 27) + (d >= 31) + (d >= 35) + (d >= 40) + (d >= 46) + (d >= 52) + (d >= 59) + (d >= 67) + (d >= 77) + (d >= 87) + (d >= 99) + (d >= 113);
}
__device__ __forceinline__ void attn_even_phase(Frame& F) {
    unsigned char* ws = F.ws; LAS char* lds = (LAS char*)F.lds;
    const bf16_t* proj = (const bf16_t*)(ws + WS_PROJ); const bf16_t* qbuf = (const bf16_t*)(ws + WS_QBUF); const bf16_t* kvbuf = (const bf16_t*)(ws + WS_KVBUF);
    bf16_t* obuf = (bf16_t*)(ws + WS_OBUF); const float* cumT = (const float*)(ws + WS_CUM);
    for (int i = F.vcu; i < 512 + 16; i += F.G) {
        const bool meta = i >= 512; const int bh = i >> 3, p = i & 7, b = meta ? 0 : bh >> 4, h = meta ? i - 512 : bh & 15, nblk = meta ? 1 : 2;
        for (int k = 0; k < nblk; ++k) {
            const int qb = meta ? 0 : (k == 0 ? 15 - p : p), qrow0 = meta ? META0 : b * SEQ + qb * 256;
            att::PassArgs a;
            a.Q = proj + (size_t)qrow0 * LD_EV + EV_QF + h * 128; a.ldq = LD_EV; a.Q2 = nullptr; a.ldq2 = 0;
            a.K = proj + EV_KF + h * 128; a.ldk = LD_EV; a.K2 = nullptr; a.ldk2 = 0; a.V = proj + EV_VF + h * 128; a.ldv = LD_EV;
            a.cum = cumT + (size_t)h * MPAD; a.krow0 = b * SEQ; a.qvp0 = meta ? 0 : 64 + qb * 256; a.NT = meta ? 1 : 4 * qb + 5; a.shift0 = 0;
            f32x16 o[4];
            att::attn_pass_dma<0>(a, lds, o, F.tid);
            att::store_o_bf16(o, obuf + (size_t)(qrow0 + F.wave * 32) * LD_DM + h * 128, LD_DM, F.tid);
        }
    }
    for (int i = F.vcu; i < 512 + 16; i += F.G) {
        const bool meta = i >= 512; const int bh = i >> 3, p = i & 7, b = meta ? 0 : bh >> 4, h = meta ? i - 512 : bh & 15, nblk = meta ? 1 : 2;
        for (int k = 0; k < nblk; ++k) {
            const int qb = meta ? 0 : (k == 0 ? 15 - p : p), qrow0 = meta ? META0 : b * SEQ + qb * 256;
            att::PassArgs a;
            a.Q = qbuf + (size_t)qrow0 * LD_UQ + h * 128; a.ldq = LD_UQ; a.Q2 = qbuf + (size_t)qrow0 * LD_UQ + 2048 + h * 64; a.ldq2 = LD_UQ;
            a.K = kvbuf + h * 128; a.ldk = LD_UKV; a.K2 = proj + EV_KR; a.ldk2 = LD_EV; a.V = kvbuf + 2048 + h * 128; a.ldv = LD_UKV;
            a.cum = nullptr; a.krow0 = b * SEQ; a.qvp0 = meta ? 0 : 64 + qb * 256; a.NT = meta ? 1 : 4 * qb + 5; a.shift0 = 0;
            f32x16 o[4];
            att::attn_pass_dma<1>(a, lds, o, F.tid);
            att::store_o_bf16(o, obuf + (size_t)(qrow0 + F.wave * 32) * LD_DM + 2048 + h * 128, LD_DM, F.tid);
        }
    }
}
__device__ __forceinline__ void attn_odd_phase(const Args& A, Frame& F, int o_idx) {
    unsigned char* ws = F.ws; LAS char* lds = (LAS char*)F.lds;
    const bf16_t* proj = (const bf16_t*)(ws + WS_PROJ); bf16_t* obuf = (bf16_t*)(ws + WS_OBUF);
    const float post = 1.0f - A.lam_init[o_idx];
    const float* subg = A.in[IN_ODSUBLN] + o_idx * 256; const float* relb = A.in[IN_RELB];
    float* S1base = (float*)(ws + WS_DSCR) + (size_t)(F.vcu & 255) * 65536;
    constexpr float INV_SCALE = 1.0f / att::Cfg<2>::SCALE;
    for (int i = F.vcu; i < 512 + 16; i += F.G) {
        const bool meta = i >= 512; const int bh = i >> 3, p = i & 7, b = meta ? 0 : bh >> 4, h = meta ? i - 512 : bh & 15, nblk = meta ? 1 : 2;
        for (int k = 0; k < nblk; ++k) {
            const int qb = meta ? 0 : (k == 0 ? 15 - p : p), qrow0 = meta ? META0 : b * SEQ + qb * 256;
            { int tt = F.tid; asm volatile("" : "+v"(tt));
              if (tt < 128) ((LAS float*)(lds + att::D_OFF_TBL))[tt] = tt <= 112 ? (relb[t5_bucket(tt) * 16 + h] - relb[31 * 16 + h]) * INV_SCALE : 0.f; }
            f32x16 o[8];
            for (int br = 0; br < 2; ++br) {
                att::PassArgs a;
                a.Q = proj + (size_t)qrow0 * LD_OD + h * 256 + br * 128; a.ldq = LD_OD; a.Q2 = nullptr; a.ldq2 = 0;
                a.K = proj + 4096 + h * 256 + br * 128; a.ldk = LD_OD; a.K2 = nullptr; a.ldk2 = 0; a.V = proj + 8192 + h * 256; a.ldv = LD_OD;
                a.cum = nullptr; a.krow0 = b * SEQ; a.qvp0 = meta ? 0 : 64 + qb * 256; a.NT = meta ? 1 : 4 * qb + 5; a.shift0 = meta ? 0 : 48;
                att::attn_pass_diff(a, lds, o, F.tid);
                if (br == 0) {
                    int tq = F.tid; asm volatile("" : "+v"(tq));
                    float* S1 = S1base + (size_t)tq * 4;
#pragma unroll
                    for (int d = 0; d < 8; ++d) {
#pragma unroll
                        for (int q = 0; q < 4; ++q) *(f32x4*)(S1 + (d * 4 + q) * 2048) = (f32x4){o[d][4 * q], o[d][4 * q + 1], o[d][4 * q + 2], o[d][4 * q + 3]}; }
                }
            }
            {
                int tq = F.tid; asm volatile("" : "+v"(tq));
                const float* S1 = S1base + (size_t)tq * 4;
                const float lam = ((const float*)(ws + WS_PRM))[o_idx];
                VM_WAIT();
#pragma unroll
                for (int d = 0; d < 8; ++d) {
#pragma unroll
                    for (int q = 0; q < 4; ++q) { const f32x4 s1 = *(const f32x4*)(S1 + (d * 4 + q) * 2048);
#pragma unroll
                        for (int j = 0; j < 4; ++j) o[d][4 * q + j] = s1[j] - lam * o[d][4 * q + j]; }
                    asm volatile("" ::: "memory"); }
            }
            int tq2 = F.tid; asm volatile("" : "+v"(tq2));
            const int r32 = tq2 & 31;
            float ssum[16];
#pragma unroll
            for (int r = 0; r < 16; ++r) { float t = 0.f;
#pragma unroll
                for (int d = 0; d < 8; ++d) t += o[d][r] * o[d][r];
#pragma unroll
                for (int off = 1; off < 32; off <<= 1) t += __shfl_xor(t, off);
                ssum[r] = __builtin_amdgcn_rsqf(t * (1.0f / 256.0f) + EPS) * post; }
#pragma unroll
            for (int d = 0; d < 8; ++d) { const float g = subg[d * 32 + r32];
#pragma unroll
                for (int r = 0; r < 16; ++r) o[d][r] *= ssum[r] * g; }
            bf16_t* Ow = obuf + (size_t)(qrow0 + F.wave * 32) * LD_DM + h * 256;
            att::store_o_bf16(o, Ow, LD_DM, F.tid);
            att::store_o_bf16(o + 4, Ow + 128, LD_DM, F.tid);
        }
    }
}
#ifdef PROBE_ATT
template <int PVAR>
__device__ __forceinline__ void attn_odd_phase_probe(const Args& A, Frame& F, int o_idx) {
    unsigned char* ws = F.ws; LAS char* lds = (LAS char*)F.lds;
    const bf16_t* proj = (const bf16_t*)(ws + WS_PROJ); bf16_t* obuf = (bf16_t*)(ws + WS_OBUF);
    const float post = 1.0f - A.lam_init[o_idx];
    const float* subg = A.in[IN_ODSUBLN] + o_idx * 256; const float* relb = A.in[IN_RELB];
    float* S1base = (float*)(ws + WS_DSCR) + (size_t)(F.vcu & 255) * 65536;
    constexpr float INV_SCALE = 1.0f / att::Cfg<2>::SCALE;
    for (int i = F.vcu; i < 512 + 16; i += F.G) {
        const bool meta = i >= 512; const int bh = i >> 3, p = i & 7, b = meta ? 0 : bh >> 4, h = meta ? i - 512 : bh & 15, nblk = meta ? 1 : 2;
        for (int k = 0; k < nblk; ++k) {
            const int qb = meta ? 0 : (k == 0 ? 15 - p : p), qrow0 = meta ? META0 : b * SEQ + qb * 256;
            { int tt = F.tid; asm volatile("" : "+v"(tt));
              if (tt < 128) ((LAS float*)(lds + att::D_OFF_TBL))[tt] = tt <= 112 ? (relb[t5_bucket(tt) * 16 + h] - relb[31 * 16 + h]) * INV_SCALE : 0.f; }
            f32x16 o[8];
            for (int br = 0; br < 2; ++br) {
                att::PassArgs a;
                a.Q = proj + (size_t)qrow0 * LD_OD + h * 256 + br * 128; a.ldq = LD_OD; a.Q2 = nullptr; a.ldq2 = 0;
                a.K = proj + 4096 + h * 256 + br * 128; a.ldk = LD_OD; a.K2 = nullptr; a.ldk2 = 0; a.V = proj + 8192 + h * 256; a.ldv = LD_OD;
                a.cum = nullptr; a.krow0 = b * SEQ; a.qvp0 = meta ? 0 : 64 + qb * 256; a.NT = meta ? 1 : 4 * qb + 5; a.shift0 = meta ? 0 : 48;
                if constexpr (PVAR == 0) att::attn_pass_diff(a, lds, o, F.tid); else att::attn_pass_diff_probe<PVAR>(a, lds, o, F.tid);
                if (br == 0) {
                    int tq = F.tid; asm volatile("" : "+v"(tq));
                    float* S1 = S1base + (size_t)tq * 4;
#pragma unroll
                    for (int d = 0; d < 8; ++d) {
#pragma unroll
                        for (int q = 0; q < 4; ++q) *(f32x4*)(S1 + (d * 4 + q) * 2048) = (f32x4){o[d][4 * q], o[d][4 * q + 1], o[d][4 * q + 2], o[d][4 * q + 3]}; }
                }
            }
            {
                int tq = F.tid; asm volatile("" : "+v"(tq));
                const float* S1 = S1base + (size_t)tq * 4;
                const float lam = ((const float*)(ws + WS_PRM))[o_idx];
                VM_WAIT();
#pragma unroll
                for (int d = 0; d < 8; ++d) {
#pragma unroll
                    for (int q = 0; q < 4; ++q) { const f32x4 s1 = *(const f32x4*)(S1 + (d * 4 + q) * 2048);
#pragma unroll
                        for (int j = 0; j < 4; ++j) o[d][4 * q + j] = s1[j] - lam * o[d][4 * q + j]; }
                    asm volatile("" ::: "memory"); }
            }
            int tq2 = F.tid; asm volatile("" : "+v"(tq2));
            const int r32 = tq2 & 31;
            float ssum[16];
#pragma unroll
            for (int r = 0; r < 16; ++r) { float t = 0.f;
#pragma unroll
                for (int d = 0; d < 8; ++d) t += o[d][r] * o[d][r];
#pragma unroll
                for (int off = 1; off < 32; off <<= 1) t += __shfl_xor(t, off);
                ssum[r] = __builtin_amdgcn_rsqf(t * (1.0f / 256.0f) + EPS) * post; }
#pragma unroll
            for (int d = 0; d < 8; ++d) { const float g = subg[d * 32 + r32];
#pragma unroll
                for (int r = 0; r < 16; ++r) o[d][r] *= ssum[r] * g; }
            bf16_t* Ow = obuf + (size_t)(qrow0 + F.wave * 32) * LD_DM + h * 256;
            att::store_o_bf16(o, Ow, LD_DM, F.tid);
            att::store_o_bf16(o + 4, Ow + 128, LD_DM, F.tid);
        }
    }
}
#endif

#ifndef PHM
#define PHM 1023
#endif
#ifndef P4SUB
#define P4SUB 7
#endif
constexpr int PPL = 9, N_PHASES = 2 + PPL * DEPTH;
__global__ void __launch_bounds__(512, 2) mega_fwd(Args args) {
    extern __shared__ __attribute__((aligned(16))) unsigned char lds_raw[];
    Frame F;
    F.lds = (LAS unsigned char*)lds_raw;
    const int wave_s = __builtin_amdgcn_readfirstlane((int)threadIdx.x >> 6);
    F.tid = opq_tid(wave_s); F.lane = F.tid & 63; F.wave = wave_s;
    F.G = gridDim.x; { const int bx = blockIdx.x; F.bx = bx; F.vcu = (F.G % 8 == 0) ? (bx % 8) * (F.G / 8) + bx / 8 : bx; }
    F.ws = args.ws;
    unsigned char* ws = args.ws;
    volatile LAS unsigned* MISC = (volatile LAS unsigned*)(F.lds + MISC_OFF);
    for (int u = F.tid; u < (LDS_BYTES - 135168) / 4; u += 512) ((LAS unsigned*)(F.lds + 135168))[u] = 0u;
    __syncthreads();
#if MK_ONE_LAUNCH
    XcdBarrier bar = xcd_barrier_post((unsigned*)(ws + WS_CTL) + CW_BAR, MISC + 8, F.tid);
#define IN(k) true
#else
    const int lo = args.ph_lo, hi = args.ph_hi;
    XcdBarrier bar; bar.bar = (unsigned*)(ws + WS_CTL) + CW_BAR; bar.x = 0; bar.st = nullptr;
    if (hi - lo > 1) bar = xcd_barrier_post((unsigned*)(ws + WS_CTL) + CW_BAR, MISC + 8, F.tid);
#define IN(k) (lo <= (k) && (k) < hi)
#endif
#define REFRESH() Frame Fp = F; { const int t_ = opq_tid(wave_s); Fp.tid = t_; Fp.lane = t_ & 63; size_t z_ = 0; asm volatile("" : "+s"(z_)); Fp.ws = args.ws + z_; Fp.vcu = opq_s(F.vcu); Fp.G = opq_s(F.G); Fp.bx = opq_s(F.bx); } unsigned char* ws = Fp.ws; (void)ws
#define SEAM(k, kn) do { if (IN(k) && IN(kn)) { XcdBarrier b_; size_t z_ = 0; asm volatile("" : "+s"(z_)); b_.bar = (unsigned*)(args.ws + z_ + WS_CTL) + CW_BAR; b_.x = xb_xcc_id(); b_.st = MISC + 8; xcd_barrier(b_, opq_tid(wave_s)); } } while (0)
#define PTRS() bf16_t* hbf = (bf16_t*)(ws + WS_HBF); bf16_t* proj = (bf16_t*)(ws + WS_PROJ); bf16_t* qbuf = (bf16_t*)(ws + WS_QBUF); bf16_t* kvbuf = (bf16_t*)(ws + WS_KVBUF); \
    bf16_t* obuf = (bf16_t*)(ws + WS_OBUF); bf16_t* mbuf = (bf16_t*)(ws + WS_MBUF); bf16_t* act = (bf16_t*)(ws + WS_PROJ); \
    pg8::EpiCtx ec; ec.O = nullptr; ec.ldc = 0; ec.rs = (const float*)(ws + WS_RSTD); ec.statq = (float*)(ws + WS_STATQ); ec.statkv = (float*)(ws + WS_STATKV); \
    ec.flogT = (float*)(ws + WS_FLOG); ec.cosT = (const float*)(ws + WS_COS); ec.sinT = (const float*)(ws + WS_SIN); ec.statm = (float*)(ws + WS_STATM); ec.part = (float*)(ws + WS_PART); ec.cs = nullptr; ec.amaxp = (float*)(ws + WS_AMAXP); \
    (void)hbf; (void)proj; (void)qbuf; (void)kvbuf; (void)obuf; (void)mbuf; (void)act

#if PHM & 1
    if (IN(0)) { p0_prologue(args, F); }
#endif
    SEAM(0, 1);
#if PHM & 1
    if (IN(1)) { REFRESH(); cvt_items<1>(args, Fp); }
#endif
    SEAM(1, 2);
#define LAYER() opq_s(layer0)
#define BASE() (2 + PPL * layer0)
#define EVEN() ((LAYER() & 1) == 0)
#define DN8() (((I8_DN >> LAYER()) & 1) != 0)
#define REFRESH_L() REFRESH(); const int layer = LAYER(), e = layer >> 1; (void)e; (void)layer
    for (int layer0 = 0; layer0 < DEPTH; ++layer0) {
#if PHM & 2
        if (IN(BASE())) {
            REFRESH_L(); PTRS();
            if (EVEN() && !((I8_IN_EV >> e) & 1)) {
                pg8::Gemm g{hbf, (const bf16_t*)(ws + W_EVIN + e * SZ_EVIN), LD_DM, LD_DM, DM}; pg8::StaticOrder S; S.init(MPAD, EV_N, Fp.G, Fp.bx);
                pg8::Epi<1> E{ec}; E.c.O = proj; E.c.ldc = LD_EV;
                pg8::gemm_phase<pg8::Epi<1>, pg8::StaticOrder, true, true>(Fp.lds, g, S, E, Fp.tid);
            } else if (EVEN()) {
                pg8::Gemm g{(const bf16_t*)(ws + WS_OBUF), (const bf16_t*)(ws + W_EVIN + e * SZ_EVIN), LD8 / 2, LD8 / 2, DM / 2}; pg8::StaticOrder S; S.init(MPAD, EV_N, Fp.G, Fp.bx);
                pg8::Epi<9> E{ec}; E.c.O = proj; E.c.ldc = LD_EV; E.c.rs = (const float*)(ws + WS_RS8); E.c.cs = (const float*)(ws + WS_CTL + CTL_COLMAX_EV) + (size_t)e * EV_N;
                pg8::gemm_phase<pg8::Epi<9>, pg8::StaticOrder, true, true, 2>(Fp.lds, g, S, E, Fp.tid);
            } else if ((I8_IN_ODD >> e) & 1) {
                pg8::Gemm g{(const bf16_t*)(ws + WS_OBUF), (const bf16_t*)(ws + W_GU + (size_t)layer * SZ_GU + W_OD8_OFF), LD8 / 2, LD8 / 2, DM / 2}; pg8::StaticOrder S; S.init(MREAL, OD_N, Fp.G, Fp.bx);
                pg8::Epi<8> E{ec}; E.c.O = proj; E.c.ldc = LD_OD; E.c.rs = (const float*)(ws + WS_RS8); E.c.cs = (const float*)(ws + WS_CTL + CTL_COLMAX_OD) + (size_t)e * OD_N;
                pg8::gemm_phase<pg8::Epi<8>, pg8::StaticOrder, true, true, 2>(Fp.lds, g, S, E, Fp.tid);
            } else {
                pg8::Gemm g{hbf, (const bf16_t*)(ws + W_ODIN + e * SZ_ODIN), LD_DM, LD_DM, DM}; pg8::StaticOrder S; S.init(MREAL, OD_N, Fp.G, Fp.bx);
                pg8::Epi<0> E{ec}; E.c.O = proj; E.c.ldc = LD_OD;
                pg8::gemm_phase<pg8::Epi<0>, pg8::StaticOrder, true, true>(Fp.lds, g, S, E, Fp.tid);
            }
        }
        if (!EVEN() && IN(BASE())) {
            REFRESH_L(); PTRS();
            if ((I8_IN_ODD >> e) & 1) {
                pg8::Gemm g{(const bf16_t*)(ws + WS_OBUF), (const bf16_t*)(ws + W_GU + (size_t)layer * SZ_GU + W_OD8_OFF), LD8 / 2, LD8 / 2, 128}; pg8::SplitKOrder S; S.init(MREAL / 256, OD_N, DM / 256, 128, Fp.G, Fp.bx);
                pg8::Epi<6> E{ec}; E.c.ldc = OD_N;
                pg8::gemm_phase<pg8::Epi<6>, pg8::SplitKOrder, true, false, 2>(Fp.lds, g, S, E, Fp.tid);
            } else {
                pg8::Gemm g{hbf, (const bf16_t*)(ws + W_ODIN + e * SZ_ODIN), LD_DM, LD_DM, 256}; pg8::SplitKOrder S; S.init(MREAL / 256, OD_N, DM / 256, 256, Fp.G, Fp.bx);
                pg8::Epi<6> E{ec}; E.c.ldc = OD_N;
                pg8::gemm_phase<pg8::Epi<6>, pg8::SplitKOrder, true, false>(Fp.lds, g, S, E, Fp.tid);
            }
        }
#endif
        SEAM(BASE(), BASE() + 1);
#if PHM & 4
        if (EVEN() && IN(BASE() + 1)) {
#if P4SUB & 1
            REFRESH_L();
            scan_phase(args, Fp, e);
#endif
#if P4SUB & 2
            {   REFRESH_L(); PTRS();
                pg8::Gemm g{proj + EV_CQ, (const bf16_t*)(ws + W_UQ + e * SZ_UQ), LD_EV, LD_QR, QRANK}; pg8::StaticOrder S; S.init(MPAD, UQ_N, Fp.G, Fp.bx);
                pg8::Epi<2> E{ec}; E.c.O = qbuf; E.c.ldc = LD_UQ; E.c.rs = (const float*)(ws + WS_STATQ);
                pg8::gemm_phase<pg8::Epi<2>, pg8::StaticOrder, true, true>(Fp.lds, g, S, E, Fp.tid); }
#endif
#if P4SUB & 4
            {   REFRESH_L(); PTRS();
                pg8::Gemm g{proj + EV_CKV, (const bf16_t*)(ws + W_UKV + e * SZ_UKV), LD_EV, LD_KV, KVK}; pg8::StaticOrder S; S.init(MPAD, UKV_N, Fp.G, Fp.bx);
                pg8::Epi<3> E{ec}; E.c.O = kvbuf; E.c.ldc = LD_UKV; E.c.rs = (const float*)(ws + WS_STATKV);
                pg8::gemm_phase<pg8::Epi<3>, pg8::StaticOrder, true, true>(Fp.lds, g, S, E, Fp.tid); }
#endif
        }
#endif
        if (!EVEN() && IN(BASE() + 1)) { REFRESH_L(); fixup_odd_meta(Fp, e); }
        SEAM(BASE() + 1, BASE() + 2);
#if PHM & 8
        if (IN(BASE() + 2) && EVEN()) { REFRESH_L(); attn_even_phase(Fp); }
#endif
#if PHM & 16
        if (IN(BASE() + 2) && !EVEN()) { REFRESH_L(); attn_odd_phase(args, Fp, e); }
#endif
        SEAM(BASE() + 2, BASE() + 3);
#if PHM & 32
        if (IN(BASE() + 3)) {
            REFRESH_L(); PTRS();
            {   pg8::Gemm g{obuf, (const bf16_t*)(ws + (EVEN() ? W_EVOUT : W_ODOUT) + e * SZ_SQ), LD_DM, LD_DM, DM}; pg8::StaticOrder S; S.init(MREAL, DM, Fp.G, Fp.bx);
                pg8::Epi<4> E{ec}; E.c.O = mbuf; E.c.ldc = LD_DM;
                pg8::gemm_phase<pg8::Epi<4>, pg8::StaticOrder, true, true>(Fp.lds, g, S, E, Fp.tid); }
            {   REFRESH_L(); PTRS();
                pg8::Gemm g{obuf, (const bf16_t*)(ws + (EVEN() ? W_EVOUT : W_ODOUT) + e * SZ_SQ), LD_DM, LD_DM, 256}; pg8::SplitKOrder S; S.init(MREAL / 256, DM, DM / 256, 256, Fp.G, Fp.bx);
                pg8::Epi<6> E{ec}; E.c.ldc = DM;
                pg8::gemm_phase<pg8::Epi<6>, pg8::SplitKOrder, true, false>(Fp.lds, g, S, E, Fp.tid); }
        }
#endif
        SEAM(BASE() + 3, BASE() + 4);
#if PHM & 64
        if (IN(BASE() + 4)) { REFRESH_L(); ew_phase(args, Fp, layer, 0); }
#endif
        SEAM(BASE() + 4, BASE() + 5);
#if PHM & 128
        if (IN(BASE() + 5)) {
            REFRESH_L(); PTRS();
            pg8::Gemm g{(const bf16_t*)(ws + WS_A8), (const bf16_t*)(ws + W_GU + layer * SZ_GU), LD8 / 2, LD8 / 2, DM / 2}; pg8::StaticOrder S; S.init(MPAD, GU_N, Fp.G, Fp.bx);
            pg8::Epi<7> E{ec}; E.c.O = act; E.c.ldc = LD_FF; E.c.rs = (const float*)(ws + WS_RS8); E.c.cs = (const float*)(ws + WS_CTL + CTL_COLMAX) + (size_t)layer * GU_N;
            pg8::gemm_phase<pg8::Epi<7>, pg8::StaticOrder, true, true, 2>(Fp.lds, g, S, E, Fp.tid);
        }
#endif
        if (DN8()) SEAM(BASE() + 5, BASE() + 6);
        if (DN8() && IN(BASE() + 6)) { REFRESH_L(); actq_phase(Fp); }
        SEAM(DN8() ? BASE() + 6 : BASE() + 5, BASE() + 7);
#if PHM & 256
        if (IN(BASE() + 7) && DN8()) {
            REFRESH_L(); PTRS();
            {   pg8::Gemm g{(const bf16_t*)(ws + WS_ACT8), (const bf16_t*)(ws + W_DN + layer * SZ_DN), LD8F / 2, LD8F / 2, DFF / 2}; pg8::StaticOrder S; S.init(MREAL, DM, Fp.G, Fp.bx);
                pg8::Epi<10> E{ec}; E.c.O = mbuf; E.c.ldc = LD_DM; E.c.rs = (const float*)(ws + WS_RSD); E.c.cs = (const float*)(ws + WS_CTL + CTL_COLMAX_DN) + (size_t)layer * DM;
                pg8::gemm_phase<pg8::Epi<10>, pg8::StaticOrder, true, true, 2>(Fp.lds, g, S, E, Fp.tid); }
            {   REFRESH_L(); PTRS();
                pg8::Gemm g{(const bf16_t*)(ws + WS_ACT8), (const bf16_t*)(ws + W_DN + layer * SZ_DN), LD8F / 2, LD8F / 2, 128}; pg8::SplitKOrder S; S.init(MREAL / 256, DM, DFF / 256, 128, Fp.G, Fp.bx);
                pg8::Epi<6> E{ec}; E.c.ldc = DM;
                pg8::gemm_phase<pg8::Epi<6>, pg8::SplitKOrder, true, false, 2>(Fp.lds, g, S, E, Fp.tid); }
        }
        if (IN(BASE() + 7) && !DN8()) {
            REFRESH_L(); PTRS();
            {   pg8::Gemm g{act, (const bf16_t*)(ws + W_DN + layer * SZ_DN), LD_FF, LD_FF, DFF}; pg8::StaticOrder S; S.init(MREAL, DM, Fp.G, Fp.bx);
                pg8::Epi<4> E{ec}; E.c.O = mbuf; E.c.ldc = LD_DM;
                pg8::gemm_phase<pg8::Epi<4>, pg8::StaticOrder, true, true>(Fp.lds, g, S, E, Fp.tid); }
            {   REFRESH_L(); PTRS();
                pg8::Gemm g{act, (const bf16_t*)(ws + W_DN + layer * SZ_DN), LD_FF, LD_FF, 256}; pg8::SplitKOrder S; S.init(MREAL / 256, DM, DFF / 256, 256, Fp.G, Fp.bx);
                pg8::Epi<6> E{ec}; E.c.ldc = DM;
                pg8::gemm_phase<pg8::Epi<6>, pg8::SplitKOrder, true, false>(Fp.lds, g, S, E, Fp.tid); }
        }
#endif
        SEAM(BASE() + 7, BASE() + 8);
#if PHM & 512
        if (IN(BASE() + 8)) { REFRESH_L(); ew_phase(args, Fp, layer, 1); }
#endif
        if (layer0 + 1 < DEPTH) SEAM(BASE() + 8, BASE() + 9);
    }
#ifdef PROBE_ATT
    if (IN(N_PHASES)) { REFRESH(); attn_odd_phase_probe<PROBE_ATT>(args, Fp, 1); }
#endif
#ifdef PROBE_EW
    if (IN(N_PHASES)) { REFRESH(); ew_phase(args, Fp, 1, 0); }
#endif
#ifdef PROBE_GEMM
    if (IN(N_PHASES)) {
        REFRESH(); PTRS();
#ifndef PROBE_LD
#define PROBE_LD LD_DM
#endif
        pg8::Gemm g{hbf, (const bf16_t*)(ws + W_GU), PROBE_LD, PROBE_LD, DM}; pg8::StaticOrder S; S.init(PROBE_LD ? MPAD : 256, PROBE_LD ? GU_N : 256 * 86 * 65, Fp.G, Fp.bx, PROBE_WGM);
        pg8::Epi<5> E{ec}; E.c.O = act; E.c.ldc = LD_FF;
        pg8::gemm_phase<pg8::Epi<5>, pg8::StaticOrder, PROBE_ALIGN, PROBE_SP2>(Fp.lds, g, S, E, Fp.tid);
    }
#endif
#undef PTRS
#undef REFRESH
#undef REFRESH_L
#undef LAYER
#undef BASE
#undef EVEN
#undef DN8
#undef IN
#undef SEAM
}

#ifndef MK_ONE_LAUNCH
#define MK_ONE_LAUNCH 1
#endif
extern "C" void kernel_launch(void* const* d_in, const int* in_sizes, int n_in, void* d_out, int out_size, void* d_ws, size_t ws_size, hipStream_t stream) {
    static int grid = 0;
    if (grid == 0) {
        if (n_in != 18 || in_sizes[0] != NB * SEQ * DM || out_size != NB * SEQ * DM || ws_size < WS_END) {
            fprintf(stderr, "kernel_launch: unexpected shapes or workspace (n_in %d, in0 %d, out %d, ws %zu < %zu); nothing launched\n", n_in, n_in > 0 ? in_sizes[0] : -1, out_size, ws_size, (size_t)WS_END); grid = -1; return; }
        int dev = 0, cus = 0;
        if (hipGetDevice(&dev) != hipSuccess || hipDeviceGetAttribute(&cus, hipDeviceAttributeMultiprocessorCount, dev) != hipSuccess || cus <= 0) { fprintf(stderr, "kernel_launch: device query failed\n"); grid = -1; return; }
        if (hipFuncSetAttribute((const void*)mega_fwd, hipFuncAttributeMaxDynamicSharedMemorySize, LDS_BYTES) != hipSuccess) { fprintf(stderr, "kernel_launch: hipFuncSetAttribute failed\n"); grid = -1; return; }
        int per_cu = 0;
        if (hipOccupancyMaxActiveBlocksPerMultiprocessor(&per_cu, (const void*)mega_fwd, 512, LDS_BYTES) != hipSuccess || per_cu < 1) fprintf(stderr, "kernel_launch: note: occupancy query reports %d workgroups per CU\n", per_cu);
        (void)hipGetLastError();
        grid = cus > 256 ? 256 : cus;
    }
    if (grid < 0) return;
    if (hipMemsetAsync((char*)d_ws + WS_CTL, 0, CTL_ZERO_BYTES, stream) != hipSuccess) { fprintf(stderr, "kernel_launch: memset failed\n"); return; }
    Args a{};
    for (int i = 0; i < 18; ++i) a.in[i] = (const float*)d_in[i];
    a.out = (float*)d_out; a.ws = (unsigned char*)d_ws;
    a.lam_init[0] = (float)(0.8 - 0.6 * exp(-0.3 * 1.0)); a.lam_init[1] = (float)(0.8 - 0.6 * exp(-0.3 * 3.0));
#if MK_ONE_LAUNCH
    a.ph_lo = 0; a.ph_hi = N_PHASES;
    hipLaunchKernelGGL(mega_fwd, dim3(grid), dim3(512), LDS_BYTES, stream, a);
#else
    for (int k = 0; k < N_PHASES; ++k) {
        a.ph_lo = k; a.ph_hi = k + 1;
        hipLaunchKernelGGL(mega_fwd, dim3(grid), dim3(512), LDS_BYTES, stream, a);
#ifdef PROBE_MASK
        { const int off = k < 2 ? 9 : ((k - 2) % PPL); if ((PROBE_MASK >> off) & 1) hipLaunchKernelGGL(mega_fwd, dim3(grid), dim3(512), LDS_BYTES, stream, a); }
#endif
    }
#if defined(PROBE_GEMM) || defined(PROBE_EW) || defined(PROBE_ATT)
    for (int r = 0; r < PROBE_REP; ++r) { a.ph_lo = N_PHASES; a.ph_hi = N_PHASES + 1; hipLaunchKernelGGL(mega_fwd, dim3(grid), dim3(512), LDS_BYTES, stream, a); }
#endif
#endif
}
```

```cpp
#define MK_ONE_LAUNCH 1
#include <hip/hip_runtime.h>
#include <cstdio>
#include <cstdint>
#include <cmath>

#define LAS __attribute__((address_space(3)))
#define GAS __attribute__((address_space(1)))
typedef unsigned short bf16_t;
typedef short bf16x8 __attribute__((ext_vector_type(8)));
typedef short s16x4 __attribute__((ext_vector_type(4)));
typedef float f32x2 __attribute__((ext_vector_type(2)));
typedef float f32x4 __attribute__((ext_vector_type(4)));
typedef float f32x16 __attribute__((ext_vector_type(16)));
typedef unsigned u32x2 __attribute__((ext_vector_type(2)));
typedef unsigned u32x4 __attribute__((ext_vector_type(4)));
typedef int i32x4 __attribute__((ext_vector_type(4)));
typedef int i32x8 __attribute__((ext_vector_type(8)));

constexpr int DM = 4096, NB = 4, SEQ = 4096, NMETA = 16, DEPTH = 4;
constexpr int MREAL = NB * SEQ;
constexpr int META0 = MREAL;
constexpr int MUSED = MREAL + NMETA;
constexpr int MPAD = 16640;
constexpr int DFF = 11008;
constexpr int NPOS = NMETA + SEQ;
constexpr float EPS = 1e-6f;
constexpr int EV_N = 7680, EV_QF = 0, EV_KF = 2048, EV_VF = 4096, EV_CQ = 6144, EV_CKV = 7040, EV_KR = 7360, EV_FL = 7424;
constexpr int QRANK = 896, KVRANK = 320, KVK = 384;
constexpr int UQ_N = 3072, UKV_N = 4096, OD_N = 12288, GU_N = 2 * DFF;
constexpr int EV_SRC_N = 7440;
constexpr int AMAXP_LD = 352;
constexpr int LD_DM = 4160, LD_FF = 11072, LD_EV = 7744, LD_OD = 12352, LD_UQ = 3136, LD_UKV = 4160, LD_QR = 960, LD_KV = 448;

__device__ __forceinline__ unsigned cvt_pk_bf16(float lo, float hi) { unsigned r; asm volatile("v_cvt_pk_bf16_f32 %0, %1, %2" : "=v"(r) : "v"(lo), "v"(hi)); return r; }
__device__ __forceinline__ float bf_lo(unsigned w) { return __uint_as_float(w << 16); }
__device__ __forceinline__ float bf_hi(unsigned w) { return __uint_as_float(w & 0xffff0000u); }
__device__ __forceinline__ float wave_sum(float v) {
#pragma unroll
    for (int o = 1; o < 64; o <<= 1) v += __shfl_xor(v, o);
    return v;
}

__device__ __forceinline__ int opq_tid(int wave) {
    int l; asm volatile("v_mbcnt_lo_u32_b32 %0, -1, 0\n\tv_mbcnt_hi_u32_b32 %0, -1, %0" : "=v"(l));
    return (wave << 6) | l;
}

__device__ __forceinline__ int opq_s(int v) { asm volatile("" : "+s"(v)); return v; }

namespace pg8 {
#define PG8_LAS __attribute__((address_space(3)))
constexpr int RS_LDS_OFF = 131072;
constexpr int BM = 256, BK = 64, HALF = 128, HTB = HALF * BK * 2  , STAGE_BYTES = 8 * HTB, NXCD = 8, WGM = 8;

__host__ __device__ __forceinline__ int lds_byte(int r, int c) { const int st = (r >> 4) * 2 + (c >> 5), rr = r & 15, cc = c & 31, ob = rr * 64 + cc * 2; return st * 1024 + (ob ^ (((ob >> 9) & 1) << 5)); }
__host__ __device__ __forceinline__ void stage_rc(int b, int& R, int& C) { const int st = b / 1024, sb = b % 1024, swz = sb ^ (((sb >> 9) & 1) << 5); R = (st >> 1) * 16 + swz / 64; C = (st & 1) * 32 + (swz % 64) / 2; }
__host__ __device__ __forceinline__ int perm32(int rho) { const int n = rho >> 4, i = rho & 15; return 8 * (i >> 2) + 4 * n + (i & 3); }

struct Unit { int pm, pn, ko, ks; };
struct Gemm { const bf16_t* A; const bf16_t* Bt; int lda, ldb, K; };

struct StaticOrder {
    int nM, nN, nwg, G, c, wgm;
    __host__ __device__ void init(int M, int N, int G_, int c_, int wgm_ = WGM) { nM = M / BM; nN = N / BM; nwg = nM * nN; G = G_; c = c_; wgm = wgm_; }
    __host__ __device__ bool next(int i, Unit& u) const {
        const long L = (long)i * G + c; if (L >= nwg) return false;
        int wgid = (int)L; { const int q = nwg / NXCD, r = nwg % NXCD, xcd = wgid % NXCD, off = wgid / NXCD; wgid = (xcd < r ? xcd * (q + 1) : r * (q + 1) + (xcd - r) * q) + off; }
        const int nig = wgm * nN, gid = wgid / nig, fm = gid * wgm, gsz = (nM - fm) < wgm ? (nM - fm) : wgm;
        u.pm = fm + ((wgid % nig) % gsz); u.pn = (wgid % nig) / gsz; u.ko = 0; u.ks = 0; return true;
    }
    __device__ __forceinline__ void a_ready(const Unit&) const {}
    __device__ __forceinline__ void done(const Unit&) const {}
};
struct SplitKOrder {
    int pm, nN, nS, kslice, G, c;
    __host__ __device__ void init(int pm_, int N, int nS_, int kslice_, int G_, int c_) { pm = pm_; nN = N / BM; nS = nS_; kslice = kslice_; G = G_; c = c_; }
    __host__ __device__ bool next(int i, Unit& u) const {
        const int L = i * G + c; if (L >= nN * nS) return false;
        u.pm = pm; u.pn = L % nN; u.ks = L / nN; u.ko = u.ks * kslice; return true;
    }
    __device__ __forceinline__ void a_ready(const Unit&) const {}
    __device__ __forceinline__ void done(const Unit&) const {}
};

struct EpiCtx {
    bf16_t* O; int ldc;
    const float* rs;
    float* statq; float* statkv;
    float* flogT;
    const float* cosT; const float* sinT;
    float* statm;
    float* part;
    const float* cs;
    float* amaxp;
};
__device__ __forceinline__ int row_pos(int row) { return row < MREAL ? NMETA + (row & (SEQ - 1)) : row - META0; }
__device__ __forceinline__ void store8(bf16_t* p, f32x4 v0, f32x4 v1) {
    u32x4 w; w.x = cvt_pk_bf16(v0[0], v0[1]); w.y = cvt_pk_bf16(v0[2], v0[3]); w.z = cvt_pk_bf16(v1[0], v1[1]); w.w = cvt_pk_bf16(v1[2], v1[3]);
    *(u32x4*)p = w;
}
__device__ __forceinline__ float sel4(const float (&a)[4], int i) { return i == 0 ? a[0] : (i == 1 ? a[1] : (i == 2 ? a[2] : a[3])); }
__device__ __forceinline__ float sq8(f32x4 a, f32x4 b) { return (a[0] * a[0] + a[1] * a[1]) + (a[2] * a[2] + a[3] * a[3]) + (b[0] * b[0] + b[1] * b[1]) + (b[2] * b[2] + b[3] * b[3]); }
__device__ __forceinline__ float silu_mul(float g, float u) { return g * __builtin_amdgcn_rcpf(1.0f + __builtin_amdgcn_exp2f(-1.4426950408889634f * g)) * u; }

__device__ __forceinline__ void fwht32_lanes(f32x4& a, f32x4& b, float s16, float s32) {
    f32x4 t;
    t = (f32x4){a[0] + a[1], a[0] - a[1], a[2] + a[3], a[2] - a[3]}; a = (f32x4){t[0] + t[2], t[1] + t[3], t[0] - t[2], t[1] - t[3]};
    t = (f32x4){b[0] + b[1], b[0] - b[1], b[2] + b[3], b[2] - b[3]}; b = (f32x4){t[0] + t[2], t[1] + t[3], t[0] - t[2], t[1] - t[3]};
    t = a + b; b = a - b; a = t;
#pragma unroll
    for (int j = 0; j < 4; ++j) {
        auto r = __builtin_amdgcn_permlane16_swap(__float_as_uint(a[j]), __float_as_uint(a[j]), false, false); a[j] = __builtin_fmaf(s16, __uint_as_float(r[1]), __uint_as_float(r[0]));
        auto q = __builtin_amdgcn_permlane16_swap(__float_as_uint(b[j]), __float_as_uint(b[j]), false, false); b[j] = __builtin_fmaf(s16, __uint_as_float(q[1]), __uint_as_float(q[0])); }
#pragma unroll
    for (int j = 0; j < 4; ++j) {
        auto r = __builtin_amdgcn_permlane32_swap(__float_as_uint(a[j]), __float_as_uint(a[j]), false, false); a[j] = __builtin_fmaf(s32, __uint_as_float(r[1]), __uint_as_float(r[0]));
        auto q = __builtin_amdgcn_permlane32_swap(__float_as_uint(b[j]), __float_as_uint(b[j]), false, false); b[j] = __builtin_fmaf(s32, __uint_as_float(q[1]), __uint_as_float(q[0])); }
}
template <int MODE> struct Epi {
    static constexpr bool PERM = true, AFTER_DRAIN = false;
    EpiCtx c;
    static constexpr bool EVM = (MODE == 1 || MODE == 9), I8M = (MODE == 8 || MODE == 9 || MODE == 10), OUTM = (MODE == 4 || MODE == 10);
    static constexpr bool RS_LDS = (MODE == 0 || MODE == 1 || MODE == 5 || MODE == 7 || MODE == 8 || MODE == 9 || MODE == 10), CS_LDS = (MODE == 7 || MODE == 8 || MODE == 9 || MODE == 10);
    __device__ __forceinline__ void pre(const Unit& u, PG8_LAS unsigned char* slot, int wid) const {
        if constexpr (RS_LDS) { if (wid < 4) { int l; asm volatile("v_mbcnt_lo_u32_b32 %0, -1, 0\n\tv_mbcnt_hi_u32_b32 %0, -1, %0" : "=v"(l));
            const char* b = (const char*)(c.rs + u.pm * BM + wid * 64); asm volatile("" : "+s"(b));
            __builtin_amdgcn_global_load_lds((const unsigned*)(b + (unsigned)(l * 4)), (PG8_LAS unsigned*)(slot + wid * 256), 4, 0, 0); } }
        if constexpr (CS_LDS) { if (wid >= 4) { int l; asm volatile("v_mbcnt_lo_u32_b32 %0, -1, 0\n\tv_mbcnt_hi_u32_b32 %0, -1, %0" : "=v"(l));
            const char* b = (const char*)(c.cs + u.pn * BM + (wid - 4) * 64); asm volatile("" : "+s"(b));
            __builtin_amdgcn_global_load_lds((const unsigned*)(b + (unsigned)(l * 4)), (PG8_LAS unsigned*)(slot + 2048 + (wid - 4) * 256), 4, 0, 0); } }
    }
    __device__ __forceinline__ void operator()(const f32x4 (&acc)[2][2][4][2], const Unit& u, int wr, int wc, int fr, int fq, const PG8_LAS float* rsl) const {
        int pm_ = u.pm, pn_ = u.pn; asm volatile("" : "+s"(pm_), "+s"(pn_));
        if constexpr (MODE == 6) {
            if (wr == 0) { float* P = c.part + (unsigned)((u.ks * 16 + fr) * c.ldc + pn_ * BM + wc * 32 + 8 * fq);
#pragma unroll
                for (int bj = 0; bj < 2; ++bj) { *(f32x4*)(P + bj * HALF) = acc[0][bj][0][0]; *(f32x4*)(P + bj * HALF + 4) = acc[0][bj][0][1]; } }
            return;
        }
        const Unit uu{pm_, pn_};
        const int row0 = uu.pm * BM + wr * 64 + fr;
        float s[2][4];
#pragma unroll
        for (int ai = 0; ai < 2; ++ai)
#pragma unroll
            for (int m = 0; m < 4; ++m) {
                const int row = row0 + ai * HALF + m * 16;
                if constexpr (RS_LDS) s[ai][m] = rsl[ai * HALF + wr * 64 + m * 16 + fr];
                else if constexpr (MODE == 2) { const f32x4* q = (const f32x4*)(c.rs + (unsigned)(row * 32)); f32x4 t = q[0];
#pragma unroll
                    for (int k = 1; k < 7; ++k) t += q[k];
                    s[ai][m] = __builtin_amdgcn_rsqf(((t[0] + t[1]) + (t[2] + t[3])) * (1.0f / QRANK) + EPS); }
                else if constexpr (MODE == 3) { const f32x4* q = (const f32x4*)(c.rs + (unsigned)(row * 16)); const f32x4 t = q[0] + q[1]; const f32x2 t2 = *(const f32x2*)(q + 2);
                    s[ai][m] = __builtin_amdgcn_rsqf((((t[0] + t[1]) + (t[2] + t[3])) + (t2[0] + t2[1])) * (1.0f / KVRANK) + EPS); }
                else s[ai][m] = 1.0f;
            }
        if constexpr (MODE == 7) {
            const int col0 = uu.pn * HALF + wc * 32 + 8 * fq;
            const PG8_LAS float* csl = rsl + 512 + wc * 32 + 8 * fq;
            const f32x4 cg0 = *(const PG8_LAS f32x4*)csl, cg1 = *(const PG8_LAS f32x4*)(csl + 4), cu0 = *(const PG8_LAS f32x4*)(csl + HALF), cu1 = *(const PG8_LAS f32x4*)(csl + HALF + 4);
#pragma unroll
            for (int ai = 0; ai < 2; ++ai)
#pragma unroll
                for (int m = 0; m < 4; ++m) {
                    const int row = row0 + ai * HALF + m * 16; const float sc = s[ai][m];
                    const f32x4 g0 = __builtin_convertvector(__builtin_bit_cast(i32x4, acc[ai][0][m][0]), f32x4) * (cg0 * sc), g1 = __builtin_convertvector(__builtin_bit_cast(i32x4, acc[ai][0][m][1]), f32x4) * (cg1 * sc);
                    const f32x4 u0 = __builtin_convertvector(__builtin_bit_cast(i32x4, acc[ai][1][m][0]), f32x4) * (cu0 * sc), u1 = __builtin_convertvector(__builtin_bit_cast(i32x4, acc[ai][1][m][1]), f32x4) * (cu1 * sc);
                    f32x4 o0, o1;
#pragma unroll
                    for (int j = 0; j < 4; ++j) { o0[j] = silu_mul(g0[j], u0[j]); o1[j] = silu_mul(g1[j], u1[j]); }
                    store8(c.O + (unsigned)(row * c.ldc + col0), o0, o1);
                }
            return;
        } else if constexpr (MODE == 5) {
            const int col0 = uu.pn * HALF + wc * 32 + 8 * fq;
#pragma unroll
            for (int ai = 0; ai < 2; ++ai)
#pragma unroll
                for (int m = 0; m < 4; ++m) {
                    const int row = row0 + ai * HALF + m * 16; const float sc = s[ai][m];
                    const f32x4 g0 = acc[ai][0][m][0] * sc, g1 = acc[ai][0][m][1] * sc, u0 = acc[ai][1][m][0] * sc, u1 = acc[ai][1][m][1] * sc;
                    f32x4 o0, o1;
#pragma unroll
                    for (int j = 0; j < 4; ++j) { o0[j] = silu_mul(g0[j], u0[j]); o1[j] = silu_mul(g1[j], u1[j]); }
                    store8(c.O + (unsigned)(row * c.ldc + col0), o0, o1);
                }
            return;
        } else {
            float ssm[2][4];
            if constexpr (OUTM) {
#pragma unroll
                for (int ai = 0; ai < 2; ++ai)
#pragma unroll
                    for (int m = 0; m < 4; ++m) ssm[ai][m] = 0.f;
            }
#pragma unroll
            for (int bj = 0; bj < 2; ++bj) {
                const int gcol = uu.pn * BM + bj * HALF + wc * 32;
                const int col0 = gcol + 8 * fq;
                bool rope = false; int i0 = 0;
                if constexpr (EVM) { rope = (gcol >= EV_KR && gcol < EV_FL); i0 = (col0 - EV_KR) >> 1; }
                if constexpr (MODE == 2) { rope = (gcol >= 2048); i0 = ((col0 - 2048) & 63) >> 1; }
                f32x4 c0 = {1.f, 1.f, 1.f, 1.f}, c1 = c0;
                if constexpr (I8M) { const PG8_LAS float* csl = rsl + 512 + bj * HALF + wc * 32 + 8 * fq; c0 = *(const PG8_LAS f32x4*)csl; c1 = *(const PG8_LAS f32x4*)(csl + 4); }
                if ((EVM || MODE == 2) && rope) {
#pragma unroll
                    for (int ai = 0; ai < 2; ++ai)
#pragma unroll
                        for (int m = 0; m < 4; ++m) {
                            const int row = row0 + ai * HALF + m * 16; const float sc = s[ai][m]; const int pos = row_pos(row);
                            const f32x4 cs = *(const f32x4*)(c.cosT + (unsigned)(pos * 32 + i0)), sn = *(const f32x4*)(c.sinT + (unsigned)(pos * 32 + i0));
                            f32x4 x1, x2;
                            if constexpr (I8M) { x1 = __builtin_convertvector(__builtin_bit_cast(i32x4, acc[ai][bj][m][0]), f32x4) * (c0 * sc); x2 = __builtin_convertvector(__builtin_bit_cast(i32x4, acc[ai][bj][m][1]), f32x4) * (c1 * sc); }
                            else { x1 = acc[ai][bj][m][0] * sc; x2 = acc[ai][bj][m][1] * sc; }
                            store8(c.O + (unsigned)(row * c.ldc + col0), x1 * cs - x2 * sn, x1 * sn + x2 * cs);
                            asm volatile("" ::: "memory");
                        }
                } else {
                    float ss[2][4];
#pragma unroll
                    for (int ai = 0; ai < 2; ++ai)
#pragma unroll
                        for (int m = 0; m < 4; ++m) {
                            const int row = row0 + ai * HALF + m * 16; const float sc = s[ai][m];
                            f32x4 v0, v1;
                            if constexpr (I8M) { v0 = __builtin_convertvector(__builtin_bit_cast(i32x4, acc[ai][bj][m][0]), f32x4) * (c0 * sc); v1 = __builtin_convertvector(__builtin_bit_cast(i32x4, acc[ai][bj][m][1]), f32x4) * (c1 * sc); }
                            else { v0 = acc[ai][bj][m][0] * sc; v1 = acc[ai][bj][m][1] * sc; }
                            store8(c.O + (unsigned)(row * c.ldc + col0), v0, v1);
                            if constexpr (EVM) {
                                ss[ai][m] = sq8(v0, v1);
                                if (gcol == EV_FL && fq < 2) {
#pragma unroll
                                    for (int j = 0; j < 4; ++j) { c.flogT[(unsigned)((8 * fq + j) * MPAD + row)] = v0[j]; c.flogT[(unsigned)((8 * fq + 4 + j) * MPAD + row)] = v1[j]; }
                                }
                            }
                            if constexpr (OUTM) ssm[ai][m] += sq8(v0, v1);
                            asm volatile("" ::: "memory");
                        }
                    if constexpr (EVM) {
                        if (gcol >= EV_CQ && gcol < EV_KR) {
                            const bool isq = gcol < EV_CKV; float* tgt = isq ? c.statq : c.statkv; const int ld = isq ? 32 : 16, slot = (gcol - (isq ? EV_CQ : EV_CKV)) >> 5;
#pragma unroll
                            for (int ai = 0; ai < 2; ++ai) {
#pragma unroll
                                for (int m = 0; m < 4; ++m) { ss[ai][m] += __shfl_xor(ss[ai][m], 16); ss[ai][m] += __shfl_xor(ss[ai][m], 32); }
                                tgt[(unsigned)((row0 + ai * HALF + fq * 16) * ld + slot)] = sel4(ss[ai], fq);
                            }
                        }
                    }
                }
            }
            if constexpr (OUTM) {
#pragma unroll
                for (int ai = 0; ai < 2; ++ai) {
#pragma unroll
                    for (int m = 0; m < 4; ++m) { ssm[ai][m] += __shfl_xor(ssm[ai][m], 16); ssm[ai][m] += __shfl_xor(ssm[ai][m], 32); }
                    c.statm[(unsigned)((row0 + ai * HALF + fq * 16) * 64 + uu.pn * 4 + wc)] = sel4(ssm[ai], fq);
                }
            }
        }
    }
};
template <int DT> __device__ __forceinline__ f32x4 mma_k2(const bf16x8 (&b)[2], const bf16x8 (&a)[2], f32x4 c) {
    if constexpr (DT == 1) {
        typedef short s16x16 __attribute__((ext_vector_type(16)));
        const s16x16 bb = __builtin_shufflevector(b[0], b[1], 0, 1, 2, 3, 4, 5, 6, 7, 8, 9, 10, 11, 12, 13, 14, 15), aa = __builtin_shufflevector(a[0], a[1], 0, 1, 2, 3, 4, 5, 6, 7, 8, 9, 10, 11, 12, 13, 14, 15);
        return __builtin_amdgcn_mfma_scale_f32_16x16x128_f8f6f4(__builtin_bit_cast(i32x8, bb), __builtin_bit_cast(i32x8, aa), c, 0, 0, 0, 0, 0, 0);
    } else if constexpr (DT == 2) {
        i32x4 ci = __builtin_bit_cast(i32x4, c);
        ci = __builtin_amdgcn_mfma_i32_16x16x64_i8(__builtin_bit_cast(i32x4, b[0]), __builtin_bit_cast(i32x4, a[0]), ci, 0, 0, 0);
        ci = __builtin_amdgcn_mfma_i32_16x16x64_i8(__builtin_bit_cast(i32x4, b[1]), __builtin_bit_cast(i32x4, a[1]), ci, 0, 0, 0);
        return __builtin_bit_cast(f32x4, ci);
    } else {
        c = __builtin_amdgcn_mfma_f32_16x16x32_bf16(b[0], a[0], c, 0, 0, 0);
        return __builtin_amdgcn_mfma_f32_16x16x32_bf16(b[1], a[1], c, 0, 0, 0);
    }
}
template <class Epi, class Sched, bool ALIGN_EPI = false, bool SP2 = false, int DT = 0>
__device__ __forceinline__ void gemm_phase(PG8_LAS unsigned char* lds, const Gemm g, const Sched& S, const Epi& E, const int tid) {
    const int wid = __builtin_amdgcn_readfirstlane(tid >> 6), lane = tid & 63, wr = wid >> 2, wc = wid & 3, fr = lane & 15, fq = lane >> 4;
    const int K = g.K; int nt = K / BK; if (K < 1024) asm volatile("" : "+s"(nt));
    unsigned voffA[2], voffB[2];
#pragma unroll
    for (int i = 0; i < 2; ++i) { int R, C; stage_rc(tid * 16 + i * 8192, R, C); const int Rb = Epi::PERM ? ((R & ~31) + perm32(R & 31)) : R;
        voffA[i] = (unsigned)(R * g.lda + C) * 2u; voffB[i] = (unsigned)(Rb * g.ldb + C) * 2u; }
    const size_t kstep = (size_t)(BK * 2);
    const size_t hstepA = (size_t)HALF * g.lda * 2, hstepB = (size_t)HALF * g.ldb * 2;
    const size_t tstepA = 2 * hstepA, tstepB = 2 * hstepB;
    const unsigned ldsw = (unsigned)wid * 1024u;
    const int aoff = lds_byte(wr * 64 + fr, fq * 8), boff = lds_byte(wc * 32 + fr, fq * 8);
#define PG8_SA(b, h) (((b) * 2 + (h)) * HTB)
#define PG8_SB(b, h) ((4 + (b) * 2 + (h)) * HTB)
#define PG8_STAGE(bufoff, gbase, voff) do { const char* _b = (const char*)(gbase); asm volatile("" : "+s"(_b));     \
        _Pragma("unroll") for (int _i = 0; _i < 2; ++_i) { unsigned _v = (voff)[_i]; asm volatile("" : "+v"(_v)); \
        __builtin_amdgcn_global_load_lds((const unsigned*)(_b + _v), (PG8_LAS unsigned*)(lds + (bufoff) + ldsw + _i * 8192), 16, 0, 0); } } while (0)
#define PG8_LDA(dst, b, h) do { _Pragma("unroll") for (int m = 0; m < 4; ++m) _Pragma("unroll") for (int k = 0; k < 2; ++k) dst[m][k] = *(const PG8_LAS bf16x8*)(lds + PG8_SA(b, h) + aoff + m * 2048 + k * 1024); } while (0)
#define PG8_LDB(dst, b, h) do { _Pragma("unroll") for (int n = 0; n < 2; ++n) _Pragma("unroll") for (int k = 0; k < 2; ++k) dst[n][k] = *(const PG8_LAS bf16x8*)(lds + PG8_SB(b, h) + boff + n * 2048 + k * 1024); } while (0)
#define PG8_MMA(ai, bj, At, Bt) do { __builtin_amdgcn_s_setprio(1); _Pragma("unroll") for (int m = 0; m < 4; ++m) _Pragma("unroll") for (int n = 0; n < 2; ++n) \
        acc[ai][bj][m][n] = mma_k2<DT>(Bt[n], At[m], acc[ai][bj][m][n]); __builtin_amdgcn_s_setprio(0); } while (0)
#define PG8_WAIT_V(n) asm volatile("s_waitcnt vmcnt(" #n ")" ::: "memory")
#define PG8_WAIT_L(n) asm volatile("s_waitcnt lgkmcnt(" #n ")" ::: "memory")
#define PG8_BAR __builtin_amdgcn_s_barrier()
#define PG8_SCHED __builtin_amdgcn_sched_barrier(0)
    Unit cur, nxt; int ui = 0;
    if (!S.next(0, cur)) return;
    f32x4 acc[2][2][4][2];
#pragma unroll
    for (int a = 0; a < 2; ++a)
#pragma unroll
        for (int b = 0; b < 2; ++b)
#pragma unroll
            for (int m = 0; m < 4; ++m)
#pragma unroll
                for (int n = 0; n < 2; ++n) acc[a][b][m][n] = (f32x4){0.f, 0.f, 0.f, 0.f};
    bf16x8 At[4][2], B0[2][2], B1[2][2];
    const char* cA = (const char*)g.A + (size_t)cur.pm * tstepA + (size_t)cur.ko * 2; const char* cB = (const char*)g.Bt + (size_t)cur.pn * tstepB + (size_t)cur.ko * 2;
    S.a_ready(cur);
    E.pre(cur, lds + RS_LDS_OFF, wid);
    if constexpr (SP2) {
        PG8_STAGE(PG8_SB(0, 0), cB, voffB); PG8_STAGE(PG8_SB(0, 1), cB + hstepB, voffB); PG8_STAGE(PG8_SA(0, 0), cA, voffA); PG8_STAGE(PG8_SA(0, 1), cA + hstepA, voffA);
        if (wr == 1) PG8_BAR;
        PG8_WAIT_V(2); PG8_BAR;
        PG8_STAGE(PG8_SB(1, 0), cB + kstep, voffB); PG8_STAGE(PG8_SA(1, 0), cA + kstep, voffA); PG8_STAGE(PG8_SB(1, 1), cB + hstepB + kstep, voffB);
        PG8_WAIT_V(6); PG8_BAR;
    } else {
        PG8_STAGE(PG8_SB(0, 0), cB, voffB); PG8_STAGE(PG8_SA(0, 0), cA, voffA); PG8_STAGE(PG8_SB(0, 1), cB + hstepB, voffB); PG8_STAGE(PG8_SA(0, 1), cA + hstepA, voffA);
        if (wr == 1) PG8_BAR;
        PG8_WAIT_V(4); PG8_BAR;
        PG8_STAGE(PG8_SB(1, 0), cB + kstep, voffB); PG8_STAGE(PG8_SA(1, 0), cA + kstep, voffA); PG8_STAGE(PG8_SB(1, 1), cB + hstepB + kstep, voffB);
        PG8_WAIT_V(6); PG8_BAR;
    }
    for (;;) {
        const bool has_next = S.next(ui + 1, nxt);
        const char* nA = has_next ? (const char*)g.A + (size_t)nxt.pm * tstepA + (size_t)nxt.ko * 2 : cA; const char* nB = has_next ? (const char*)g.Bt + (size_t)nxt.pn * tstepB + (size_t)nxt.ko * 2 : cB;
        for (int t = 0; t < nt; t += 2) {
            const bool last = (t == nt - 2);
            const char* a1 = cA + (size_t)(t + 1) * kstep;
            const char* a2 = last ? nA : cA + (size_t)(t + 2) * kstep; const char* b2 = last ? nB : cB + (size_t)(t + 2) * kstep;
            const char* a3 = a2 + kstep; const char* b3 = b2 + kstep;
            if (last && has_next) { S.a_ready(nxt); E.pre(nxt, lds + RS_LDS_OFF + ((ui + 1) & 1) * 1024, wid); }
            if constexpr (SP2) {
            PG8_LDB(B0, 0, 0); PG8_LDB(B1, 0, 1); PG8_SCHED; PG8_LDA(At, 0, 0); PG8_STAGE(PG8_SA(1, 1), a1 + hstepA, voffA);
            PG8_WAIT_V(8); PG8_WAIT_L(0); PG8_BAR; PG8_MMA(0, 0, At, B0); PG8_MMA(0, 1, At, B1); PG8_BAR; PG8_SCHED;
            PG8_LDA(At, 0, 1); PG8_STAGE(PG8_SB(0, 0), b2, voffB); PG8_STAGE(PG8_SB(0, 1), b2 + hstepB, voffB); PG8_STAGE(PG8_SA(0, 0), a2, voffA);
            PG8_WAIT_V(8); PG8_WAIT_L(0); PG8_BAR; PG8_MMA(1, 0, At, B0); PG8_MMA(1, 1, At, B1); PG8_BAR; PG8_SCHED;
            PG8_LDB(B0, 1, 0); PG8_LDB(B1, 1, 1); PG8_SCHED; PG8_LDA(At, 1, 0); PG8_STAGE(PG8_SA(0, 1), a2 + hstepA, voffA);
            PG8_WAIT_V(8); PG8_WAIT_L(0); PG8_BAR; PG8_MMA(0, 0, At, B0); PG8_MMA(0, 1, At, B1); PG8_BAR; PG8_SCHED;
            PG8_LDA(At, 1, 1); PG8_STAGE(PG8_SB(1, 0), b3, voffB); PG8_STAGE(PG8_SB(1, 1), b3 + hstepB, voffB); PG8_STAGE(PG8_SA(1, 0), a3, voffA);
            PG8_WAIT_V(8); PG8_WAIT_L(0); PG8_BAR; PG8_MMA(1, 0, At, B0); PG8_MMA(1, 1, At, B1); PG8_BAR; PG8_SCHED;
            } else {
            PG8_LDB(B0, 0, 0); PG8_SCHED; PG8_LDA(At, 0, 0); PG8_STAGE(PG8_SA(1, 1), a1 + hstepA, voffA);
            PG8_WAIT_L(8); PG8_BAR; PG8_WAIT_L(0); PG8_MMA(0, 0, At, B0); PG8_BAR; PG8_SCHED;
            PG8_LDB(B1, 0, 1); PG8_STAGE(PG8_SB(0, 0), b2, voffB);
            PG8_BAR; PG8_WAIT_L(0); PG8_MMA(0, 1, At, B1); PG8_BAR;
            PG8_LDA(At, 0, 1); PG8_STAGE(PG8_SA(0, 0), a2, voffA);
            PG8_BAR; PG8_WAIT_L(0); PG8_MMA(1, 0, At, B0); PG8_BAR; PG8_SCHED;
            PG8_STAGE(PG8_SB(0, 1), b2 + hstepB, voffB);
            PG8_WAIT_V(6); PG8_BAR; PG8_MMA(1, 1, At, B1); PG8_BAR;
            PG8_LDB(B0, 1, 0); PG8_SCHED; PG8_LDA(At, 1, 0); PG8_STAGE(PG8_SA(0, 1), a2 + hstepA, voffA);
            PG8_WAIT_L(8); PG8_BAR; PG8_WAIT_L(0); PG8_MMA(0, 0, At, B0); PG8_BAR; PG8_SCHED;
            PG8_LDB(B1, 1, 1); PG8_STAGE(PG8_SB(1, 0), b3, voffB);
            PG8_BAR; PG8_WAIT_L(0); PG8_MMA(0, 1, At, B1); PG8_BAR;
            PG8_LDA(At, 1, 1); PG8_STAGE(PG8_SA(1, 0), a3, voffA);
            PG8_BAR; PG8_WAIT_L(0); PG8_MMA(1, 0, At, B0); PG8_BAR; PG8_SCHED;
            PG8_STAGE(PG8_SB(1, 1), b3 + hstepB, voffB);
            PG8_WAIT_V(6); PG8_BAR; PG8_MMA(1, 1, At, B1); PG8_BAR;
            }
        }
        if constexpr (ALIGN_EPI) { if (wr == 0) PG8_BAR; }
        if constexpr (!Epi::AFTER_DRAIN) { int l2; asm volatile("v_mbcnt_lo_u32_b32 %0, -1, 0\n\tv_mbcnt_hi_u32_b32 %0, -1, %0" : "=v"(l2));
            E(acc, cur, wr, wc, l2 & 15, l2 >> 4, (const PG8_LAS float*)(lds + RS_LDS_OFF + (ui & 1) * 1024)); S.done(cur); }
        if (!has_next) break;
#pragma unroll
        for (int a = 0; a < 2; ++a)
#pragma unroll
            for (int b = 0; b < 2; ++b)
#pragma unroll
                for (int m = 0; m < 4; ++m)
#pragma unroll
                    for (int n = 0; n < 2; ++n) acc[a][b][m][n] = (f32x4){0.f, 0.f, 0.f, 0.f};
        cur = nxt; cA = nA; cB = nB; ++ui;
        if constexpr (ALIGN_EPI) { if (wr == 1) PG8_BAR; }
    }
    PG8_WAIT_V(0);
    if constexpr (!ALIGN_EPI) { if (wr == 0) PG8_BAR; }
    PG8_BAR;
    if constexpr (Epi::AFTER_DRAIN) { E.fused(acc, cur, wr, wc, fr, fq, lds, wid, lane); S.done(cur); }
#undef PG8_SA
#undef PG8_SB
#undef PG8_STAGE
#undef PG8_LDA
#undef PG8_LDB
#undef PG8_MMA
#undef PG8_WAIT_V
#undef PG8_WAIT_L
#undef PG8_BAR
#undef PG8_SCHED
}
}
using pg8::sq8; using pg8::store8;

namespace att {
constexpr int SHM_V = 16384, SHM_K = 16384, SHM_K2 = 8192;
constexpr int OFF_V = 0, OFF_K = 2 * SHM_V, OFF_K2 = OFF_K + 2 * SHM_K, OFF_BIAS = OFF_K2 + 2 * SHM_K2, OFF_TBL = OFF_BIAS + 512, OFF_WS = OFF_TBL + 512, LDS_END = OFF_WS + 8 * 256;
constexpr float THR = 8.f;
#define KSWZ(row, colB) ((row) * 256 + ((colB) ^ (((row) & 15) << 4)))
#define K2SWZ(row, colB) ((row) * 128 + ((colB) ^ ((((row) >> 1) & 7) << 4)))
#define SBAR() __builtin_amdgcn_sched_barrier(0)
__device__ __forceinline__ int v_st(int k, int c) { const int kk = (k & ~0xC) | ((k & 4) << 1) | ((k & 8) >> 1); return ((kk >> 3) * 4 + (c >> 5)) * 512 + ((kk & 7) * 32 + (c & 31)) * 2; }
__device__ __forceinline__ int v_rd_base(int lane) { return ((lane & 3) << 3) | (((lane >> 2) & 3) << 6) | (((lane >> 4) & 1) << 5) | (((lane >> 5) & 1) << 8); }
constexpr int v_rd_off(int d0, int ks, int half) { return d0 * 512 + ks * 4096 + half * 2048; }
__device__ __forceinline__ int crow(int r, int hi) { return (r & 3) + 8 * (r >> 2) + 4 * hi; }

template <int MODE> struct Cfg { static constexpr float SCALE = (MODE == 1) ? 0.07216878364870322f : 0.08838834764831845f; static constexpr int DK = (MODE == 1) ? 192 : 128; };

__device__ __forceinline__ void mask_tile(f32x16& p0, f32x16& p1, int lim) {
    const float NEG = -__builtin_inff();
#pragma unroll
    for (int r = 0; r < 16; ++r) {
        const int c = (r & 3) + 8 * (r >> 2);
        if (c > lim) p0[r] = NEG;
        if (c + 32 > lim) p1[r] = NEG;
    }
}
__device__ __forceinline__ void t5_bias(f32x16& p0, f32x16& p1, const LAS float* tbl, int dd) {
#pragma unroll
    for (int g = 0; g < 4; ++g) {
#pragma unroll
        for (int j = 0; j < 4; ++j) { const int r = 4 * g + j, c = (r & 3) + 8 * (r >> 2);
            int i0 = dd - c; i0 = i0 < 0 ? 0 : (i0 > 127 ? 127 : i0);
            int i1 = dd - c - 32; i1 = i1 < 0 ? 0 : (i1 > 127 ? 127 : i1);
            p0[r] += tbl[i0]; p1[r] += tbl[i1]; }
        asm volatile("" ::: "memory");
    }
}
template <int MODE>
__device__ __forceinline__ void partialSM(f32x16& p0, f32x16& p1, float& m_reg, float& mn, float& alpha) {
    constexpr float SCALE = Cfg<MODE>::SCALE;
    float pmax = p0[0];
#pragma unroll
    for (int r = 1; r < 16; ++r) pmax = fmaxf(pmax, p0[r]);
#pragma unroll
    for (int r = 0; r < 16; ++r) pmax = fmaxf(pmax, p1[r]);
    { auto rr = __builtin_amdgcn_permlane32_swap(__float_as_uint(pmax), __float_as_uint(pmax), false, false);
      pmax = fmaxf(__uint_as_float(rr[0]), __uint_as_float(rr[1])); }
    constexpr float C2 = 1.4426950408889634f * SCALE;
    if (__builtin_expect(__all((pmax - m_reg) * SCALE <= THR), 1)) { mn = m_reg; alpha = 1.f; }
    else { mn = fmaxf(m_reg, pmax); alpha = __builtin_amdgcn_exp2f((m_reg - mn) * C2); m_reg = mn; }
    const float mnL = -mn * C2;
#pragma unroll
    for (int r = 0; r < 16; ++r) p0[r] = fmaf(p0[r], C2, mnL);
#pragma unroll
    for (int r = 0; r < 16; ++r) p1[r] = fmaf(p1[r], C2, mnL);
#pragma unroll
    for (int r = 0; r < 16; ++r) p0[r] = __builtin_amdgcn_exp2f(p0[r]);
}
__device__ __forceinline__ void finishSM(f32x16& p0, f32x16& p1, float alpha, float& l_reg, bf16x8& pa0, bf16x8& pa1, bf16x8& pa2, bf16x8& pa3) {
#pragma unroll
    for (int r = 0; r < 16; ++r) p1[r] = __builtin_amdgcn_exp2f(p1[r]);
    float ps = 0;
#pragma unroll
    for (int r = 0; r < 16; ++r) ps += p0[r];
#pragma unroll
    for (int r = 0; r < 16; ++r) ps += p1[r];
    { auto rr = __builtin_amdgcn_permlane32_swap(__float_as_uint(ps), __float_as_uint(ps), false, false);
      ps = __uint_as_float(rr[0]) + __uint_as_float(rr[1]); }
    l_reg = l_reg * alpha + ps;
#define PK4(P, B_, OUT) do { unsigned a0 = cvt_pk_bf16(P[B_+0], P[B_+1]), a1 = cvt_pk_bf16(P[B_+2], P[B_+3]);                          \
        unsigned b0 = cvt_pk_bf16(P[B_+4], P[B_+5]), b1 = cvt_pk_bf16(P[B_+6], P[B_+7]);                                             \
        auto r0 = __builtin_amdgcn_permlane32_swap(a0, b0, false, false); auto r1 = __builtin_amdgcn_permlane32_swap(a1, b1, false, false); \
        u32x4 w = {r0[0], r1[0], r0[1], r1[1]}; OUT = *reinterpret_cast<bf16x8*>(&w); } while (0)
    PK4(p0, 0, pa0); PK4(p0, 8, pa1); PK4(p1, 0, pa2); PK4(p1, 8, pa3);
#undef PK4
}
template <int MODE>
__device__ __forceinline__ void qkt(f32x16& p0, f32x16& p1, const LAS char* Kt, const LAS char* K2t, const LAS float* biasL, int r32, int hi, const bf16x8* qr) {
    if constexpr (MODE == 0) {
        const LAS f32x4* bl = (const LAS f32x4*)biasL;
#pragma unroll
        for (int g = 0; g < 4; ++g) { const f32x4 a = bl[2 * g + hi], b = bl[8 + 2 * g + hi];
#pragma unroll
            for (int j = 0; j < 4; ++j) { p0[4 * g + j] = a[j]; p1[4 * g + j] = b[j]; } }
    } else { p0 = f32x16{}; p1 = f32x16{}; }
    const int kg_ = ((r32 & 15) << 4) ^ (hi << 4);
    const LAS char* kr_ = Kt + r32 * 256;
    __builtin_amdgcn_s_setprio(1);
#pragma unroll
    for (int d0 = 0; d0 < 8; ++d0) { const LAS char* a = kr_ + (kg_ ^ (d0 << 5));
        const bf16x8 b0 = *reinterpret_cast<const LAS bf16x8*>(a);
        const bf16x8 b1 = *reinterpret_cast<const LAS bf16x8*>(a + 32 * 256);
        p0 = __builtin_amdgcn_mfma_f32_32x32x16_bf16(b0, qr[d0], p0, 0, 0, 0);
        p1 = __builtin_amdgcn_mfma_f32_32x32x16_bf16(b1, qr[d0], p1, 0, 0, 0); }
    if constexpr (MODE == 1) {
#pragma unroll
        for (int d0 = 0; d0 < 4; ++d0) { const LAS char* a = K2t + K2SWZ(r32, (d0 * 16 + hi * 8) * 2);
            const bf16x8 b0 = *reinterpret_cast<const LAS bf16x8*>(a);
            const bf16x8 b1 = *reinterpret_cast<const LAS bf16x8*>(a + 32 * 128);
            p0 = __builtin_amdgcn_mfma_f32_32x32x16_bf16(b0, qr[8 + d0], p0, 0, 0, 0);
            p1 = __builtin_amdgcn_mfma_f32_32x32x16_bf16(b1, qr[8 + d0], p1, 0, 0, 0); }
    }
    __builtin_amdgcn_s_setprio(0);
}
__device__ __forceinline__ void pv_tile(f32x16* o, unsigned vb0, bf16x8 pa0, bf16x8 pa1, bf16x8 pa2, bf16x8 pa3) {
#define TRRD(dst, off) asm volatile("ds_read_b64_tr_b16 %0, %1 offset:%2" : "=&v"(dst) : "v"(vb0), "i"(off) : "memory")
#define PV_RD(S, d0) do { constexpr int b_ = v_rd_off(d0, 0, 0);     \
        TRRD(S##l0, b_); TRRD(S##h0, b_ + 2048); TRRD(S##l1, b_ + 4096); TRRD(S##h1, b_ + 6144); TRRD(S##l2, b_ + 8192); TRRD(S##h2, b_ + 10240); TRRD(S##l3, b_ + 12288); TRRD(S##h3, b_ + 14336); } while (0)
#define PV_MM(S, d0) do { \
        o[d0] = __builtin_amdgcn_mfma_f32_32x32x16_bf16(pa0, (bf16x8){S##l0[0], S##l0[1], S##l0[2], S##l0[3], S##h0[0], S##h0[1], S##h0[2], S##h0[3]}, o[d0], 0, 0, 0);   \
        o[d0] = __builtin_amdgcn_mfma_f32_32x32x16_bf16(pa1, (bf16x8){S##l1[0], S##l1[1], S##l1[2], S##l1[3], S##h1[0], S##h1[1], S##h1[2], S##h1[3]}, o[d0], 0, 0, 0);   \
        o[d0] = __builtin_amdgcn_mfma_f32_32x32x16_bf16(pa2, (bf16x8){S##l2[0], S##l2[1], S##l2[2], S##l2[3], S##h2[0], S##h2[1], S##h2[2], S##h2[3]}, o[d0], 0, 0, 0);   \
        o[d0] = __builtin_amdgcn_mfma_f32_32x32x16_bf16(pa3, (bf16x8){S##l3[0], S##l3[1], S##l3[2], S##l3[3], S##h3[0], S##h3[1], S##h3[2], S##h3[3]}, o[d0], 0, 0, 0); } while (0)
    s16x4 Al0, Al1, Al2, Al3, Ah0, Ah1, Ah2, Ah3, Bl0, Bl1, Bl2, Bl3, Bh0, Bh1, Bh2, Bh3;
    __builtin_amdgcn_s_setprio(1);
    PV_RD(A, 0);
    PV_RD(B, 1); asm volatile("s_waitcnt lgkmcnt(8)" ::: "memory"); SBAR(); PV_MM(A, 0); SBAR();
    PV_RD(A, 2); asm volatile("s_waitcnt lgkmcnt(8)" ::: "memory"); SBAR(); PV_MM(B, 1); SBAR();
    PV_RD(B, 3); asm volatile("s_waitcnt lgkmcnt(8)" ::: "memory"); SBAR(); PV_MM(A, 2); SBAR();
    asm volatile("s_waitcnt lgkmcnt(0)" ::: "memory"); SBAR(); PV_MM(B, 3);
    __builtin_amdgcn_s_setprio(0);
#undef PV_MM
#undef PV_RD
#undef TRRD
}

struct PassArgs {
    const bf16_t* Q; const bf16_t* Q2; const bf16_t* K; const bf16_t* K2; const bf16_t* V; const float* cum;
    int ldq, ldq2, ldk, ldk2, ldv;
    int krow0;
    int qvp0;
    int NT;
    int shift0;
};
template <int MODE>
__device__ __forceinline__ void attn_pass(const PassArgs& a, LAS char* lds, f32x16 (&o)[4], const int tid) {
    constexpr int DK = Cfg<MODE>::DK;
    constexpr float SCALE = Cfg<MODE>::SCALE, INV_SCALE = 1.0f / SCALE;
    const int wid = __builtin_amdgcn_readfirstlane(tid >> 6), lane = tid & 63, r32 = lane & 31, hi = lane >> 5;
    bf16x8 qr[DK / 16];
    { const bf16_t* qp = a.Q + (size_t)(wid * 32 + r32) * a.ldq + hi * 8;
#pragma unroll
      for (int d0 = 0; d0 < 8; ++d0) qr[d0] = *(const bf16x8*)(qp + d0 * 16);
      if constexpr (MODE == 1) { const bf16_t* qp2 = a.Q2 + (size_t)(wid * 32 + r32) * a.ldq2 + hi * 8;
#pragma unroll
          for (int d0 = 0; d0 < 4; ++d0) qr[8 + d0] = *(const bf16x8*)(qp2 + d0 * 16); } }
    const int sr = tid >> 4, sc = (tid & 15) * 8, kws = KSWZ(sr, sc * 2), vst0 = v_st(sr, sc), vst1 = v_st(32 + sr, sc);
    const int sr2 = tid >> 3, sc2 = (tid & 7) * 8, k2ws = K2SWZ(sr2, sc2 * 2);
    bf16x8 st_k0, st_k1, st_v0, st_v1, st_k2; float st_b = 0.f;
#define TROW(t) ((t) == 0 ? META0 : a.krow0 + ((t) - 1) * 64)
#define ISSUE(t) do { const int tr_ = TROW(t); const size_t r0_ = (size_t)(tr_ + sr);                                             \
        st_k0 = *(const bf16x8*)(a.K + r0_ * a.ldk + sc); st_k1 = *(const bf16x8*)(a.K + (r0_ + 32) * a.ldk + sc);                 \
        st_v0 = *(const bf16x8*)(a.V + r0_ * a.ldv + sc); st_v1 = *(const bf16x8*)(a.V + (r0_ + 32) * a.ldv + sc);                 \
        if constexpr (MODE == 1) st_k2 = *(const bf16x8*)(a.K2 + (size_t)(tr_ + sr2) * a.ldk2 + sc2);                              \
        if constexpr (MODE == 0) { if (tid < 64) st_b = a.cum[tr_ + tid]; } } while (0)
#define WRITE(bf) do { *(LAS bf16x8*)(lds + OFF_K + (bf) * SHM_K + kws) = st_k0; *(LAS bf16x8*)(lds + OFF_K + (bf) * SHM_K + kws + 32 * 256) = st_k1;   \
        *(LAS bf16x8*)(lds + OFF_V + (bf) * SHM_V + vst0) = st_v0; *(LAS bf16x8*)(lds + OFF_V + (bf) * SHM_V + vst1) = st_v1;                        \
        if constexpr (MODE == 1) *(LAS bf16x8*)(lds + OFF_K2 + (bf) * SHM_K2 + k2ws) = st_k2;                                                       \
        if constexpr (MODE == 0) { if (tid < 64) ((LAS float*)(lds + OFF_BIAS + (bf) * 256))[tid] = -st_b * INV_SCALE; } } while (0)
    ISSUE(0);
    WRITE(0);
    __syncthreads();
    float m_reg = -1e30f, l_reg = 0.f;
#pragma unroll
    for (int d = 0; d < 4; ++d) o[d] = f32x16{};
    const int qlo = a.qvp0 + wid * 32, qv = qlo + r32;
    LAS float* li_l = (LAS float*)(lds + OFF_WS + wid * 256); LAS float* al_l = li_l + 32;
    const LAS float* tbl = (const LAS float*)(lds + OFF_TBL);
    const unsigned vbase = (unsigned)(uintptr_t)(lds + OFF_V) + (unsigned)v_rd_base(lane);
    const int NT = a.NT;
    for (int t = 0; t < NT; ++t) {
        const int cur = t & 1;
        if (t + 1 < NT) ISSUE(t + 1);
        const int kb = 64 * t;
        if (t == 0 || kb <= qlo + 31) {
        f32x16 p0, p1;
        qkt<MODE>(p0, p1, lds + OFF_K + cur * SHM_K, lds + OFF_K2 + cur * SHM_K2, (const LAS float*)(lds + OFF_BIAS + cur * 256), r32, hi, qr);
        if constexpr (MODE == 2) { const int sh = t == 0 ? a.shift0 : 0; if (qlo - sh - (kb + 63) <= 112) t5_bias(p0, p1, tbl, qv - kb - sh - 4 * hi); }
        if (t == 0 || kb + 63 > qlo) { int lim = qv - kb; const int tm = t == 0 ? 15 : 63; lim = (lim < tm ? lim : tm) - 4 * hi; mask_tile(p0, p1, lim); }
        float mn, alpha;
        partialSM<MODE>(p0, p1, m_reg, mn, alpha);
        if (__any(alpha < 1.f)) { if (hi == 0) al_l[r32] = alpha; asm volatile("s_waitcnt lgkmcnt(0)" ::: "memory");
#pragma unroll
            for (int r = 0; r < 16; ++r) { const float av = al_l[crow(r, hi)];
#pragma unroll
                for (int d = 0; d < 4; ++d) o[d][r] *= av; } }
        bf16x8 pa0, pa1, pa2, pa3;
        finishSM(p0, p1, alpha, l_reg, pa0, pa1, pa2, pa3);
        pv_tile(o, vbase + (unsigned)(cur * SHM_V), pa0, pa1, pa2, pa3);
        }
        if (t + 1 < NT) WRITE(cur ^ 1);
        __syncthreads();
    }
    if (hi == 0) li_l[r32] = l_reg;
    asm volatile("s_waitcnt lgkmcnt(0)" ::: "memory");
#pragma unroll
    for (int r = 0; r < 16; ++r) { const float rl = __builtin_amdgcn_rcpf(li_l[crow(r, hi)]);
#pragma unroll
        for (int d = 0; d < 4; ++d) o[d][r] *= rl; }
#undef TROW
#undef ISSUE
#undef WRITE
}
template <int MODE>
__device__ __forceinline__ void attn_pass_dma(const PassArgs& a, LAS char* lds, f32x16 (&o)[4], const int tid) {
    constexpr int DK = Cfg<MODE>::DK;
    constexpr float SCALE = Cfg<MODE>::SCALE, INV_SCALE = 1.0f / SCALE;
    const int wid = __builtin_amdgcn_readfirstlane(tid >> 6);
    bf16x8 qr[DK / 16];
    { const int lane = tid & 63, r32 = lane & 31, hi = lane >> 5; const bf16_t* qp = a.Q + (size_t)(wid * 32 + r32) * a.ldq + hi * 8;
#pragma unroll
      for (int d0 = 0; d0 < 8; ++d0) qr[d0] = *(const bf16x8*)(qp + d0 * 16);
      if constexpr (MODE == 1) { const bf16_t* qp2 = a.Q2 + (size_t)(wid * 32 + r32) * a.ldq2 + hi * 8;
#pragma unroll
          for (int d0 = 0; d0 < 4; ++d0) qr[8 + d0] = *(const bf16x8*)(qp2 + d0 * 16); } }
    float st_b = 0.f;
#define TROW(t) ((t) == 0 ? META0 : a.krow0 + ((t) - 1) * 64)
#define DMA16(gp, ldsoff) __builtin_amdgcn_global_load_lds((const unsigned*)(gp), (LAS unsigned*)(lds + (ldsoff)), 16, 0, 0)
#define ISSUE_D(t, bf) do { int tl_ = tid; asm volatile("" : "+v"(tl_)); const int tr_ = TROW(t);                                         \
        const int krow = tl_ >> 4, kcol = ((tl_ & 15) ^ (krow & 15)) * 8;                                                                \
        const int vkk = ((tl_ >> 7) << 3) | ((tl_ & 31) >> 2), vrow = (vkk & ~0xC) | ((vkk & 4) << 1) | ((vkk & 8) >> 1), vcol = ((tl_ >> 5) & 3) * 32 + (tl_ & 3) * 8;   \
        _Pragma("unroll") for (int i_ = 0; i_ < 2; ++i_) DMA16(a.K + (size_t)(tr_ + krow + 32 * i_) * a.ldk + kcol, OFF_K + (bf) * SHM_K + i_ * 8192 + wid * 1024);   \
        _Pragma("unroll") for (int i_ = 0; i_ < 2; ++i_) DMA16(a.V + (size_t)(tr_ + vrow + 32 * i_) * a.ldv + vcol, OFF_V + (bf) * SHM_V + i_ * 8192 + wid * 1024);   \
        if constexpr (MODE == 1) { const int r2_ = tl_ >> 3, c2_ = ((tl_ & 7) ^ ((r2_ >> 1) & 7)) * 8; DMA16(a.K2 + (size_t)(tr_ + r2_) * a.ldk2 + c2_, OFF_K2 + (bf) * SHM_K2 + wid * 1024); } \
        if constexpr (MODE == 0) { if (tl_ < 64) st_b = a.cum[tr_ + tl_]; } } while (0)
#define WRITE_B(bf) do { if constexpr (MODE == 0) { int tl_ = tid; asm volatile("" : "+v"(tl_)); if (tl_ < 64) ((LAS float*)(lds + OFF_BIAS + (bf) * 256))[tl_] = -st_b * INV_SCALE; } } while (0)
    ISSUE_D(0, 0);
    WRITE_B(0);
    asm volatile("s_waitcnt vmcnt(0)" ::: "memory");
    __syncthreads();
    float m_reg = -1e30f, l_reg = 0.f;
#pragma unroll
    for (int d = 0; d < 4; ++d) o[d] = f32x16{};
    const int NT = a.NT;
    for (int t = 0; t < NT; ++t) {
        const int cur = t & 1;
        if (t + 1 < NT) ISSUE_D(t + 1, cur ^ 1);
        int tl = tid; asm volatile("" : "+v"(tl));
        const int lane = tl & 63, r32 = lane & 31, hi = lane >> 5;
        const int qlo = a.qvp0 + wid * 32, qv = qlo + r32;
        LAS float* al_l = (LAS float*)(lds + OFF_WS + wid * 256) + 32;
        const int kb = 64 * t;
        if (t == 0 || kb <= qlo + 31) {
        f32x16 p0, p1;
        qkt<MODE>(p0, p1, lds + OFF_K + cur * SHM_K, lds + OFF_K2 + cur * SHM_K2, (const LAS float*)(lds + OFF_BIAS + cur * 256), r32, hi, qr);
        if (t == 0 || kb + 63 > qlo) { int lim = qv - kb; const int tm = t == 0 ? 15 : 63; lim = (lim < tm ? lim : tm) - 4 * hi; mask_tile(p0, p1, lim); }
        float mn, alpha;
        partialSM<MODE>(p0, p1, m_reg, mn, alpha);
        if (__any(alpha < 1.f)) { if (hi == 0) al_l[r32] = alpha; asm volatile("s_waitcnt lgkmcnt(0)" ::: "memory");
#pragma unroll
            for (int r = 0; r < 16; ++r) { const float av = al_l[crow(r, hi)];
#pragma unroll
                for (int d = 0; d < 4; ++d) o[d][r] *= av; } }
        bf16x8 pa0, pa1, pa2, pa3;
        finishSM(p0, p1, alpha, l_reg, pa0, pa1, pa2, pa3);
        pv_tile(o, (unsigned)(uintptr_t)(lds + OFF_V) + (unsigned)v_rd_base(lane) + (unsigned)(cur * SHM_V), pa0, pa1, pa2, pa3);
        }
        if (t + 1 < NT) WRITE_B(cur ^ 1);
        asm volatile("s_waitcnt vmcnt(0)" ::: "memory");
        __syncthreads();
    }
    { int tl = tid; asm volatile("" : "+v"(tl));
      const int lane = tl & 63, r32 = lane & 31, hi = lane >> 5;
      LAS float* li_l = (LAS float*)(lds + OFF_WS + wid * 256);
      if (hi == 0) li_l[r32] = l_reg;
      asm volatile("s_waitcnt lgkmcnt(0)" ::: "memory");
#pragma unroll
      for (int r = 0; r < 16; ++r) { const float rl = __builtin_amdgcn_rcpf(li_l[crow(r, hi)]);
#pragma unroll
          for (int d = 0; d < 4; ++d) o[d][r] *= rl; } }
#undef TROW
#undef DMA16
#undef ISSUE_D
#undef WRITE_B
}
constexpr int D_OFF_V = 0  , D_OFF_K = 65536  , D_OFF_TBL = 98304, D_OFF_WS = D_OFF_TBL + 512, D_LDS_END = D_OFF_WS + 8 * 256;
__device__ __forceinline__ void attn_pass_diff(const PassArgs& a, LAS char* lds, f32x16 (&o)[8], const int tid) {
    const int wid = __builtin_amdgcn_readfirstlane(tid >> 6);
    bf16x8 qr[8];
    { const int lane = tid & 63, r32 = lane & 31, hi = lane >> 5; const bf16_t* qp = a.Q + (size_t)(wid * 32 + r32) * a.ldq + hi * 8;
#pragma unroll
      for (int d0 = 0; d0 < 8; ++d0) qr[d0] = *(const bf16x8*)(qp + d0 * 16); }
#define TROW(t) ((t) == 0 ? META0 : a.krow0 + ((t) - 1) * 64)
#define DMA16(gp, ldsoff) __builtin_amdgcn_global_load_lds((const unsigned*)(gp), (LAS unsigned*)(lds + (ldsoff)), 16, 0, 0)
#define ISSUE_D(t, bf) do { int tl_ = tid; asm volatile("" : "+v"(tl_)); const int tr_ = TROW(t);                                         \
        const int krow = tl_ >> 4, kcol = ((tl_ & 15) ^ (krow & 15)) * 8;                                                                \
        const int vkk = ((tl_ >> 7) << 3) | ((tl_ & 31) >> 2), vrow = (vkk & ~0xC) | ((vkk & 4) << 1) | ((vkk & 8) >> 1), vcol = ((tl_ >> 5) & 3) * 32 + (tl_ & 3) * 8;   \
        _Pragma("unroll") for (int i_ = 0; i_ < 2; ++i_) DMA16(a.K + (size_t)(tr_ + krow + 32 * i_) * a.ldk + kcol, D_OFF_K + (bf) * 16384 + i_ * 8192 + wid * 1024);   \
        _Pragma("unroll") for (int h_ = 0; h_ < 2; ++h_) _Pragma("unroll") for (int i_ = 0; i_ < 2; ++i_)                                 \
            DMA16(a.V + (size_t)(tr_ + vrow + 32 * i_) * a.ldv + h_ * 128 + vcol, D_OFF_V + (bf) * 32768 + h_ * 16384 + i_ * 8192 + wid * 1024); } while (0)
    ISSUE_D(0, 0);
    asm volatile("s_waitcnt vmcnt(0)" ::: "memory");
    __syncthreads();
    float m_reg = -1e30f, l_reg = 0.f;
#pragma unroll
    for (int d = 0; d < 8; ++d) o[d] = f32x16{};
    const int NT = a.NT;
    for (int t = 0; t < NT; ++t) {
        const int cur = t & 1;
        if (t + 1 < NT) ISSUE_D(t + 1, cur ^ 1);
        int tl = tid; asm volatile("" : "+v"(tl));
        const int lane = tl & 63, r32 = lane & 31, hi = lane >> 5;
        const int qlo = a.qvp0 + wid * 32, qv = qlo + r32;
        LAS float* al_l = (LAS float*)(lds + D_OFF_WS + wid * 256) + 32;
        const int kb = 64 * t;
        if (t == 0 || kb <= qlo + 31) {
        f32x16 p0, p1;
        qkt<2>(p0, p1, lds + D_OFF_K + cur * 16384, lds, (const LAS float*)lds, r32, hi, qr);
        { const int sh = t == 0 ? a.shift0 : 0; if (qlo - sh - (kb + 63) <= 112) t5_bias(p0, p1, (const LAS float*)(lds + D_OFF_TBL), qv - kb - sh - 4 * hi); }
        if (t == 0 || kb + 63 > qlo) { int lim = qv - kb; const int tm = t == 0 ? 15 : 63; lim = (lim < tm ? lim : tm) - 4 * hi; mask_tile(p0, p1, lim); }
        float mn, alpha;
        partialSM<2>(p0, p1, m_reg, mn, alpha);
        if (__any(alpha < 1.f)) { if (hi == 0) al_l[r32] = alpha; asm volatile("s_waitcnt lgkmcnt(0)" ::: "memory");
#pragma unroll
            for (int r = 0; r < 16; ++r) { const float av = al_l[crow(r, hi)];
#pragma unroll
                for (int d = 0; d < 8; ++d) o[d][r] *= av; } }
        bf16x8 pa0, pa1, pa2, pa3;
        finishSM(p0, p1, alpha, l_reg, pa0, pa1, pa2, pa3);
        const unsigned vbase = (unsigned)(uintptr_t)(lds + D_OFF_V) + (unsigned)v_rd_base(lane) + (unsigned)(cur * 32768);
        pv_tile(o, vbase, pa0, pa1, pa2, pa3);
        pv_tile(o + 4, vbase + 16384u, pa0, pa1, pa2, pa3);
        }
        asm volatile("s_waitcnt vmcnt(0)" ::: "memory");
        __syncthreads();
    }
    { int tl = tid; asm volatile("" : "+v"(tl));
      const int lane = tl & 63, r32 = lane & 31, hi = lane >> 5;
      LAS float* li_l = (LAS float*)(lds + D_OFF_WS + wid * 256);
      if (hi == 0) li_l[r32] = l_reg;
      asm volatile("s_waitcnt lgkmcnt(0)" ::: "memory");
#pragma unroll
      for (int r = 0; r < 16; ++r) { const float rl = __builtin_amdgcn_rcpf(li_l[crow(r, hi)]);
#pragma unroll
          for (int d = 0; d < 8; ++d) o[d][r] *= rl; } }
#undef TROW
#undef DMA16
#undef ISSUE_D
}
#ifdef PROBE_ATT
template <int PVAR  >
__device__ __forceinline__ void attn_pass_diff_probe(const PassArgs& a, LAS char* lds, f32x16 (&o)[8], const int tid) {
    const int wid = __builtin_amdgcn_readfirstlane(tid >> 6);
    bf16x8 qr[8];
    { const int lane = tid & 63, r32 = lane & 31, hi = lane >> 5; const bf16_t* qp = a.Q + (size_t)(wid * 32 + r32) * a.ldq + hi * 8;
#pragma unroll
      for (int d0 = 0; d0 < 8; ++d0) qr[d0] = *(const bf16x8*)(qp + d0 * 16); }
#define TROW(t) ((t) == 0 ? META0 : a.krow0 + ((t) - 1) * 64)
#define DMA16(gp, ldsoff) __builtin_amdgcn_global_load_lds((const unsigned*)(gp), (LAS unsigned*)(lds + (ldsoff)), 16, 0, 0)
#define ISSUE_D(t, bf) do { int tl_ = tid; asm volatile("" : "+v"(tl_)); const int tr_ = TROW(t);                                         \
        const int krow = tl_ >> 4, kcol = ((tl_ & 15) ^ (krow & 15)) * 8;                                                                \
        const int vkk = ((tl_ >> 7) << 3) | ((tl_ & 31) >> 2), vrow = (vkk & ~0xC) | ((vkk & 4) << 1) | ((vkk & 8) >> 1), vcol = ((tl_ >> 5) & 3) * 32 + (tl_ & 3) * 8;   \
        _Pragma("unroll") for (int i_ = 0; i_ < 2; ++i_) DMA16(a.K + (size_t)(tr_ + krow + 32 * i_) * a.ldk + kcol, D_OFF_K + (bf) * 16384 + i_ * 8192 + wid * 1024);   \
        _Pragma("unroll") for (int h_ = 0; h_ < 2; ++h_) _Pragma("unroll") for (int i_ = 0; i_ < 2; ++i_)                                 \
            DMA16(a.V + (size_t)(tr_ + vrow + 32 * i_) * a.ldv + h_ * 128 + vcol, D_OFF_V + (bf) * 32768 + h_ * 16384 + i_ * 8192 + wid * 1024); } while (0)
    ISSUE_D(0, 0);
    asm volatile("s_waitcnt vmcnt(0)" ::: "memory");
    __syncthreads();
    float m_reg = -1e30f, l_reg = 0.f;
#pragma unroll
    for (int d = 0; d < 8; ++d) o[d] = f32x16{};
    const int NT = a.NT;
    for (int t = 0; t < NT; ++t) {
        const int cur = t & 1;
        if constexpr (PVAR != 6 && PVAR != 8) { if (t + 1 < NT) ISSUE_D(t + 1, cur ^ 1); }
        int tl = tid; asm volatile("" : "+v"(tl));
        const int lane = tl & 63, r32 = lane & 31, hi = lane >> 5;
        const int qlo = a.qvp0 + wid * 32, qv = qlo + r32;
        LAS float* al_l = (LAS float*)(lds + D_OFF_WS + wid * 256) + 32;
        const int kb = 64 * t;
        if (t == 0 || kb <= qlo + 31) {
        f32x16 p0, p1;
        if constexpr (PVAR == 5 || PVAR == 7 || PVAR == 8) { p0 = f32x16{}; p1 = f32x16{};
#pragma unroll
            for (int d0 = 0; d0 < 8; ++d0) { p0 = __builtin_amdgcn_mfma_f32_32x32x16_bf16(qr[(d0 + 1) & 7], qr[d0], p0, 0, 0, 0); p1 = __builtin_amdgcn_mfma_f32_32x32x16_bf16(qr[(d0 + 3) & 7], qr[d0], p1, 0, 0, 0); } }
        else qkt<2>(p0, p1, lds + D_OFF_K + cur * 16384, lds, (const LAS float*)lds, r32, hi, qr);
        { const int sh = t == 0 ? a.shift0 : 0; if (qlo - sh - (kb + 63) <= 112) t5_bias(p0, p1, (const LAS float*)(lds + D_OFF_TBL), qv - kb - sh - 4 * hi); }
        if (t == 0 || kb + 63 > qlo) { int lim = qv - kb; const int tm = t == 0 ? 15 : 63; lim = (lim < tm ? lim : tm) - 4 * hi; mask_tile(p0, p1, lim); }
        float mn, alpha;
        partialSM<2>(p0, p1, m_reg, mn, alpha);
        if (__any(alpha < 1.f)) { if (hi == 0) al_l[r32] = alpha; asm volatile("s_waitcnt lgkmcnt(0)" ::: "memory");
#pragma unroll
            for (int r = 0; r < 16; ++r) { const float av = al_l[crow(r, hi)];
#pragma unroll
                for (int d = 0; d < 8; ++d) o[d][r] *= av; } }
        bf16x8 pa0, pa1, pa2, pa3;
        finishSM(p0, p1, alpha, l_reg, pa0, pa1, pa2, pa3);
        const unsigned vbase = (unsigned)(uintptr_t)(lds + D_OFF_V) + (unsigned)v_rd_base(lane) + (unsigned)(cur * 32768);
        if constexpr (PVAR == 4 || PVAR == 7 || PVAR == 8) {
#pragma unroll
            for (int d = 0; d < 8; ++d) { o[d] = __builtin_amdgcn_mfma_f32_32x32x16_bf16(pa0, pa1, o[d], 0, 0, 0); o[d] = __builtin_amdgcn_mfma_f32_32x32x16_bf16(pa1, pa2, o[d], 0, 0, 0);
                o[d] = __builtin_amdgcn_mfma_f32_32x32x16_bf16(pa2, pa3, o[d], 0, 0, 0); o[d] = __builtin_amdgcn_mfma_f32_32x32x16_bf16(pa3, pa0, o[d], 0, 0, 0); } }
        else { pv_tile(o, vbase, pa0, pa1, pa2, pa3); pv_tile(o + 4, vbase + 16384u, pa0, pa1, pa2, pa3); }
        }
        asm volatile("s_waitcnt vmcnt(0)" ::: "memory");
        __syncthreads();
    }
    { int tl = tid; asm volatile("" : "+v"(tl));
      const int lane = tl & 63, r32 = lane & 31, hi = lane >> 5;
      LAS float* li_l = (LAS float*)(lds + D_OFF_WS + wid * 256);
      if (hi == 0) li_l[r32] = l_reg;
      asm volatile("s_waitcnt lgkmcnt(0)" ::: "memory");
#pragma unroll
      for (int r = 0; r < 16; ++r) { const float rl = __builtin_amdgcn_rcpf(li_l[crow(r, hi)]);
#pragma unroll
          for (int d = 0; d < 8; ++d) o[d][r] *= rl; } }
#undef TROW
#undef DMA16
#undef ISSUE_D
}
#endif
__device__ __forceinline__ void store_o_bf16(const f32x16* o, bf16_t* Ow, int ldo, int tid) {
    asm volatile("" : "+v"(tid)); const int r32 = tid & 31, hi = (tid >> 5) & 1;
#pragma unroll
    for (int r = 0; r < 16; ++r) { const int orow = crow(r, hi);
#pragma unroll
        for (int d0 = 0; d0 < 4; ++d0) { const float v = o[d0][r]; const float vn = __shfl_xor(v, 1);
            if ((r32 & 1) == 0) *(GAS unsigned*)(Ow + (size_t)orow * ldo + d0 * 32 + r32) = cvt_pk_bf16(v, vn); }
        asm volatile("" ::: "memory"); }
}
}

constexpr size_t MiB = (size_t)1 << 20;
constexpr size_t WS_CTL = 0, CTL_ZERO_BYTES = 1 * MiB;
constexpr size_t WS_PRM = 1 * MiB;
constexpr size_t WS_COS = 2 * MiB, WS_SIN = 3 * MiB;
constexpr size_t WS_RSTD = 4 * MiB;
constexpr size_t WS_STATQ = 14 * MiB, WS_STATKV = 17 * MiB;
constexpr size_t WS_STATM = 5 * MiB;
constexpr size_t WS_FLOG = 10 * MiB, WS_CUM = 12 * MiB;
constexpr size_t WS_W = 20 * MiB;
constexpr size_t SZ_EVIN = 61 * MiB, SZ_UQ = 6 * MiB, SZ_UKV = 4 * MiB, SZ_SQ = 33 * MiB, SZ_ODIN = 98 * MiB, SZ_GU = 175 * MiB, SZ_DN = 87 * MiB;
constexpr size_t W_EVIN = WS_W, W_UQ = W_EVIN + 2 * SZ_EVIN, W_UKV = W_UQ + 2 * SZ_UQ, W_EVOUT = W_UKV + 2 * SZ_UKV, W_ODIN = W_EVOUT + 2 * SZ_SQ, W_ODOUT = W_ODIN + 2 * SZ_ODIN,
                 W_GU = W_ODOUT + 2 * SZ_SQ, W_DN = W_GU + DEPTH * SZ_GU;
constexpr size_t WS_HS = W_DN + DEPTH * SZ_DN;
constexpr size_t WS_HBF = WS_HS + 260 * MiB;
constexpr size_t WS_PROJ = WS_HBF + 133 * MiB;
constexpr size_t WS_QBUF = WS_PROJ + 246 * MiB, WS_KVBUF = WS_PROJ + 346 * MiB;
constexpr size_t WS_OBUF = WS_PROJ + 479 * MiB;
constexpr size_t WS_MBUF = WS_OBUF + 133 * MiB;
constexpr size_t WS_DSCR = WS_MBUF + 133 * MiB;
constexpr size_t WS_PART = WS_DSCR + 64 * MiB;
constexpr size_t WS_END = WS_PART + 12 * MiB;
static_assert((size_t)EV_N * LD_DM * 2 <= SZ_EVIN && (size_t)UQ_N * LD_QR * 2 <= SZ_UQ && (size_t)UKV_N * LD_KV * 2 <= SZ_UKV && (size_t)DM * LD_DM * 2 <= SZ_SQ && (size_t)OD_N * LD_DM * 2 <= SZ_ODIN && (size_t)GU_N * LD_DM * 2 <= SZ_GU && (size_t)DM * LD_FF * 2 <= SZ_DN, "weight sizes");
static_assert((size_t)MPAD * DM * 4 == 260 * MiB && (size_t)MPAD * LD_DM * 2 <= 133 * MiB && (size_t)MPAD * LD_EV * 2 <= 246 * MiB && (size_t)MPAD * LD_UQ * 2 <= 100 * MiB && (size_t)MPAD * LD_UKV * 2 <= 133 * MiB && (size_t)MPAD * LD_OD * 2 <= 479 * MiB && (size_t)MPAD * LD_FF * 2 <= 479 * MiB, "activation sizes");
constexpr int LD8 = 4224;
constexpr size_t WS_A8 = WS_PROJ + 352 * MiB, WS_RS8 = WS_RSTD + 512 * 1024;
constexpr size_t CTL_COLMAX = 65536;
constexpr int I8_IN_ODD = 3;
constexpr size_t CTL_COLMAX_OD = CTL_COLMAX + (size_t)DEPTH * GU_N * 4;
constexpr size_t W_OD8_OFF = 90 * MiB;
constexpr int I8_IN_EV = 2;
constexpr size_t CTL_COLMAX_EV = CTL_COLMAX_OD + 2 * (size_t)OD_N * 4;
static_assert(CTL_COLMAX_EV + 2 * (size_t)EV_N * 4 <= CTL_ZERO_BYTES && (size_t)EV_N * LD8 <= SZ_EVIN, "int8 even in-proj buffers");
static_assert(CTL_COLMAX_OD + 2 * (size_t)OD_N * 4 <= CTL_ZERO_BYTES && (size_t)GU_N * LD8 <= W_OD8_OFF && W_OD8_OFF + (size_t)OD_N * LD8 <= SZ_GU && (size_t)MPAD * LD8 <= 133 * MiB, "int8 in-proj buffers");
static_assert((size_t)MPAD * LD_FF * 2 <= 352 * MiB && 352 * MiB + (size_t)MPAD * LD8 <= 479 * MiB && (size_t)GU_N * LD8 <= SZ_GU && CTL_COLMAX + (size_t)DEPTH * GU_N * 4 <= CTL_ZERO_BYTES, "int8 buffers");
constexpr int I8_DN = 14;
constexpr int LD8F = 11136;
constexpr size_t CTL_COLMAX_DN = CTL_COLMAX_EV + 2 * (size_t)EV_N * 4;
constexpr size_t WS_ACT8 = WS_HS, WS_AMAXP = WS_HS + 180 * MiB, WS_RSD = WS_RSTD + 768 * 1024;
static_assert(CTL_COLMAX_DN + (size_t)DEPTH * DM * 4 <= CTL_ZERO_BYTES && (size_t)MPAD * LD8F <= 180 * MiB && 180 * MiB + (size_t)MPAD * AMAXP_LD * 4 <= 260 * MiB && (size_t)DM * LD8F <= SZ_DN && (GU_N / 256) * 4 <= AMAXP_LD, "int8 down buffers");
constexpr int CW_BAR = 4096;

constexpr int RING_BYTES = 131072;
constexpr int PRO_SCR_BYTES = 8 * 16640;
constexpr int MISC_OFF = 135168 + 320;
constexpr int LDS_BYTES = 147456;
static_assert(att::LDS_END <= RING_BYTES && att::D_LDS_END <= RING_BYTES && PRO_SCR_BYTES <= 135168 && MISC_OFF + 64 <= LDS_BYTES, "LDS map");

#define LDS_WAIT() asm volatile("s_waitcnt lgkmcnt(0)" ::: "memory")
#define VM_WAIT() asm volatile("s_waitcnt vmcnt(0)" ::: "memory")

#define XB_TMO      128
#define XB_XCNT(j)  (256  + 64 * (j))
#define XB_XSUB(j)  (1280 + 64 * (j))
#define XB_XGEN(j)  (2304 + 64 * (j))
#define XB_TOP      3328
#define XB_TOPGEN   3392
#define XCD_BAR_WORDS 3456
#define XB_SPIN_CAP (1u << 18)

__device__ __forceinline__ unsigned xb_ld(unsigned* p)              { return __hip_atomic_load(p, __ATOMIC_RELAXED, __HIP_MEMORY_SCOPE_AGENT); }
__device__ __forceinline__ unsigned xb_add(unsigned* p, unsigned v) { return __hip_atomic_fetch_add(p, v, __ATOMIC_RELAXED, __HIP_MEMORY_SCOPE_AGENT); }
__device__ __forceinline__ unsigned xb_xcc_id() { return (unsigned)__builtin_amdgcn_s_getreg((3 << 11) | 20) & 0xFu; }
#define XB_SPIN(cond, bar) do { unsigned _sp = 0; while (cond) { __builtin_amdgcn_s_sleep(1); \
    if ((++_sp & 255u) == 0u) { if (xb_ld(&(bar)[XB_TMO])) break; if (_sp > XB_SPIN_CAP) { atomicAdd(&(bar)[XB_TMO], 1u); break; } } } } while (0)

struct XcdBarrier {
    unsigned* bar; unsigned x;
    volatile LAS unsigned* st;
};

__device__ __forceinline__ XcdBarrier xcd_barrier_post(unsigned* bar, volatile LAS unsigned* st, int tid) {
    XcdBarrier b; b.bar = bar; b.x = xb_xcc_id(); b.st = st;
    if (tid == 0) (void)xb_add(&bar[XB_XCNT(b.x)], 1u);
    return b;
}
__device__ __forceinline__ void xcd_barrier_complete(unsigned* bar, unsigned x, unsigned& nloc, unsigned& nx) {
    const unsigned G = gridDim.x * gridDim.y * gridDim.z;
    unsigned sum, cnt, mine, sp = 0u;
    for (;;) {
        sum = 0u; cnt = 0u; mine = 0u;
#pragma unroll
        for (unsigned j = 0; j < 16; ++j) { const unsigned c = xb_ld(&bar[XB_XCNT(j)]); sum += c; cnt += (c > 0u) ? 1u : 0u; mine = (j == x) ? c : mine; }
        if (sum == G) break;
        __builtin_amdgcn_s_sleep(1);
        if ((++sp & 255u) == 0u) { if (xb_ld(&bar[XB_TMO])) break; if (sp > XB_SPIN_CAP) { atomicAdd(&bar[XB_TMO], 1u); break; } }
    }
    nloc = mine > 0u ? mine : 1u; nx = cnt > 0u ? cnt : 1u;
}

__device__ __forceinline__ void xcd_barrier(const XcdBarrier& b, int tid) {
    asm volatile("s_waitcnt vmcnt(0)" ::: "memory");
    __syncthreads();
    if (tid == 0) {
        unsigned* bar = b.bar;
        __builtin_amdgcn_s_waitcnt(0);
        unsigned nloc = b.st[0], nx = b.st[1];
        if (nloc == 0u) { xcd_barrier_complete(bar, b.x, nloc, nx); b.st[0] = nloc; b.st[1] = nx; }
        const unsigned old = xb_add(&bar[XB_XSUB(b.x)], 1u);
        const unsigned gen = old / nloc;
        if (old + 1u == (gen + 1u) * nloc) {
            __builtin_amdgcn_fence(__ATOMIC_RELEASE, "agent");
            asm volatile("s_waitcnt vmcnt(0)" ::: "memory");
            const unsigned og = xb_add(&bar[XB_TOP], 1u);
            const unsigned tg = og / nx;
            if (og + 1u == (tg + 1u) * nx) xb_add(&bar[XB_TOPGEN], 1u);
            else XB_SPIN(xb_ld(&bar[XB_TOPGEN]) == tg, bar);
            __builtin_amdgcn_fence(__ATOMIC_ACQUIRE, "agent");
            xb_add(&bar[XB_XGEN(b.x)], 1u);
            asm volatile("s_waitcnt vmcnt(0)" ::: "memory");
        } else {
            XB_SPIN(xb_ld(&bar[XB_XGEN(b.x)]) == gen, bar);
            __builtin_amdgcn_fence(__ATOMIC_ACQUIRE, "agent");
            asm volatile("s_waitcnt vmcnt(0)" ::: "memory");
        }
    }
    __syncthreads();
}

struct Args { const float* in[18]; float* out; unsigned char* ws; int ph_lo, ph_hi; float lam_init[2]; };
enum { IN_X = 0, IN_META, IN_RELB, IN_EVWIN, IN_EVBF, IN_EVQN, IN_EVKVN, IN_EVWUQ, IN_EVWUKV, IN_EVWOUT, IN_ODWIN, IN_ODLAM, IN_ODSUBLN, IN_ODWOUT, IN_NORMG, IN_WGATE, IN_WUP, IN_WDOWN };

struct Frame {
    LAS unsigned char* lds;
    int tid, lane, wave, vcu, G, bx;
    unsigned char* ws;
};

__device__ __forceinline__ int ropeperm(int j) { const int a = j >> 3, e = j & 7; return e < 4 ? 4 * a + e : 32 + 4 * a + (e - 4); }
struct CvtDesc { const float* W; int N, srccol; const float* gain; int Ksrc, k0; bf16_t* WT; int Kdst, dstrow0; const float* cmax; int had; };
__device__ __forceinline__ unsigned pk4_i8(float a, float b, float c, float d) {
    const float M = 12582912.0f;
    const unsigned ab = __builtin_amdgcn_perm(__float_as_uint(b + M), __float_as_uint(a + M), 0x0c0c0400u), cd = __builtin_amdgcn_perm(__float_as_uint(d + M), __float_as_uint(c + M), 0x0c0c0400u);
    return __builtin_amdgcn_perm(cd, ab, 0x05040100u);
}
typedef unsigned short u16x2 __attribute__((ext_vector_type(2)));
__device__ __forceinline__ unsigned pkmax(unsigned a, unsigned b) { return __builtin_bit_cast(unsigned, __builtin_elementwise_max(__builtin_bit_cast(u16x2, a), __builtin_bit_cast(u16x2, b))); }
__device__ __forceinline__ unsigned opq(unsigned v) { asm volatile("" : "+v"(v)); return v; }
__device__ __forceinline__ float wave_max(float v) {
#pragma unroll
    for (int o = 1; o < 64; o <<= 1) v = fmaxf(v, __shfl_xor(v, o));
    return v;
}
__device__ __forceinline__ void fwht8_32(float (&v)[8], int lane) {
    f32x2 a = {v[0], v[1]}, b = {v[2], v[3]}, c = {v[4], v[5]}, d = {v[6], v[7]}, t;
    t = a + c; c = a - c; a = t; t = b + d; d = b - d; b = t;
    t = a + b; b = a - b; a = t; t = c + d; d = c - d; c = t;
    a = (f32x2){a[0] + a[1], a[0] - a[1]}; b = (f32x2){b[0] + b[1], b[0] - b[1]}; c = (f32x2){c[0] + c[1], c[0] - c[1]}; d = (f32x2){d[0] + d[1], d[0] - d[1]};
    const float s1 = (lane & 1) ? -1.f : 1.f, s2 = (lane & 2) ? -1.f : 1.f;
#define FW_X(x, ctrl) __int_as_float(__builtin_amdgcn_update_dpp(0, __float_as_int(x), ctrl, 0xf, 0xf, true))
#define FW_ST(p, sg, ctrl) do { const f32x2 q_ = {FW_X(p[0], ctrl), FW_X(p[1], ctrl)}; p = p * (f32x2){sg, sg} + q_; } while (0)
    FW_ST(a, s1, 0xB1); FW_ST(b, s1, 0xB1); FW_ST(c, s1, 0xB1); FW_ST(d, s1, 0xB1);
    FW_ST(a, s2, 0x4E); FW_ST(b, s2, 0x4E); FW_ST(c, s2, 0x4E); FW_ST(d, s2, 0x4E);
#undef FW_ST
#undef FW_X
    v[0] = a[0]; v[1] = a[1]; v[2] = b[0]; v[3] = b[1]; v[4] = c[0]; v[5] = c[1]; v[6] = d[0]; v[7] = d[1];
}
__device__ __forceinline__ void cvt_load(const CvtDesc& d, f32x4 (&v)[16], int lane) {
    const int kq = lane >> 4;
#pragma unroll
    for (int i = 0; i < 16; ++i) { const int k = d.k0 + 4 * i + kq;
        v[i] = (d.srccol >= 0 && k < d.Ksrc) ? __builtin_nontemporal_load((const f32x4*)(d.W + (size_t)k * d.N + d.srccol)) : (f32x4){0.f, 0.f, 0.f, 0.f}; }
}
__device__ __forceinline__ void cvt_finish(const CvtDesc& d, f32x4 (&v)[16], LAS float* scr, int lane) {
    const int l16 = lane & 15, kq = lane >> 4;
    if (d.gain) {
#pragma unroll
        for (int i = 0; i < 16; ++i) { const int k = d.k0 + 4 * i + kq; if (k < d.Ksrc) v[i] = v[i] * d.gain[k]; } }
#pragma unroll
    for (int i = 0; i < 16; ++i) { LAS float* q = scr + (4 * i + kq) * 65 + 4 * l16; q[0] = v[i][0]; q[1] = v[i][1]; q[2] = v[i][2]; q[3] = v[i][3]; }
    LDS_WAIT(); asm volatile("" ::: "memory");
    const int c = lane & 7, nr = lane >> 3;
    if (d.cmax) {
#pragma unroll
        for (int j = 0; j < 8; ++j) { const int n = nr + 8 * j; const LAS float* t = scr + (8 * c) * 65 + n;
            const float cm = d.cmax[d.dstrow0 + n], inv = cm > 0.f ? 127.0f * __builtin_amdgcn_rcpf(cm) : 0.f;
            float v[8];
#pragma unroll
            for (int i = 0; i < 8; ++i) v[i] = t[i * 65];
            if (d.had) fwht8_32(v, lane);
            u32x2 o; o.x = pk4_i8(v[0] * inv, v[1] * inv, v[2] * inv, v[3] * inv); o.y = pk4_i8(v[4] * inv, v[5] * inv, v[6] * inv, v[7] * inv);
            __builtin_nontemporal_store(o, (u32x2*)((unsigned char*)d.WT + (size_t)(d.dstrow0 + n) * d.Kdst + d.k0 + 8 * c)); }
        LDS_WAIT(); asm volatile("" ::: "memory");
        return;
    }
    if (d.had) {
#pragma unroll
        for (int j = 0; j < 8; ++j) { const int n = nr + 8 * j; const LAS float* t = scr + (8 * c) * 65 + n;
            float v[8];
#pragma unroll
            for (int i = 0; i < 8; ++i) v[i] = t[i * 65];
            fwht8_32(v, lane);
            u32x4 o; o.x = cvt_pk_bf16(v[0] * 0.03125f, v[1] * 0.03125f); o.y = cvt_pk_bf16(v[2] * 0.03125f, v[3] * 0.03125f); o.z = cvt_pk_bf16(v[4] * 0.03125f, v[5] * 0.03125f); o.w = cvt_pk_bf16(v[6] * 0.03125f, v[7] * 0.03125f);
            __builtin_nontemporal_store(o, (u32x4*)(d.WT + (size_t)(d.dstrow0 + n) * d.Kdst + d.k0 + 8 * c)); }
        LDS_WAIT(); asm volatile("" ::: "memory");
        return;
    }
#pragma unroll
    for (int j = 0; j < 8; ++j) { const int n = nr + 8 * j; const LAS float* t = scr + (8 * c) * 65 + n;
        u32x4 o; o.x = cvt_pk_bf16(t[0 * 65], t[1 * 65]); o.y = cvt_pk_bf16(t[2 * 65], t[3 * 65]); o.z = cvt_pk_bf16(t[4 * 65], t[5 * 65]); o.w = cvt_pk_bf16(t[6 * 65], t[7 * 65]);
        __builtin_nontemporal_store(o, (u32x4*)(d.WT + (size_t)(d.dstrow0 + n) * d.Kdst + d.k0 + 8 * c)); }
    LDS_WAIT(); asm volatile("" ::: "memory");
}
constexpr int I_EVIN = 64 * (EV_N / 64), I_UQ = (QRANK / 64) * (UQ_N / 64), I_UKV = (KVK / 64) * (UKV_N / 64), I_SQ = 64 * (DM / 64), I_ODIN = 64 * (OD_N / 64);
constexpr int I_PAIR = I_EVIN + I_UQ + I_UKV + I_SQ + I_ODIN + I_SQ;
constexpr int I_GU = 64 * (GU_N / 64), I_DN = (DFF / 64) * (DM / 64), I_FFN = I_GU + I_DN;
constexpr int N_CVT_ITEMS = 2 * I_PAIR + DEPTH * I_FFN;

__device__ __forceinline__ CvtDesc cvt_describe(const Args& A, unsigned char* ws, int it, int lane) {
    const int l4 = 4 * (lane & 15);
    const float* ng = A.in[IN_NORMG];
    if (it < 2 * I_PAIR) {
        const int e = it / I_PAIR; int r = it - e * I_PAIR;
        if (r < I_EVIN) { const int nblk = EV_N / 64, kb = r / nblk, nb = r - kb * nblk, n = nb * 64 + l4;
            int sc;
            if (n < EV_CQ) sc = n; else if (n < EV_KR) sc = n + 16; else if (n < EV_FL) sc = 7376 + ropeperm(n - EV_KR); else if (n < EV_FL + 16) sc = 6144 + (n - EV_FL); else sc = -1;
            return CvtDesc{A.in[IN_EVWIN] + (size_t)e * DM * EV_SRC_N, EV_SRC_N, sc, ng + (size_t)(2 * e * 4 + 0) * DM, DM, kb * 64, (bf16_t*)(ws + W_EVIN + e * SZ_EVIN), LD_DM, nb * 64}; }
        r -= I_EVIN;
        if (r < I_UQ) { const int nblk = UQ_N / 64, kb = r / nblk, nb = r - kb * nblk, n = nb * 64 + l4;
            int sc; if (n < 2048) sc = (n >> 7) * 192 + (n & 127); else { const int j2 = n - 2048; sc = (j2 >> 6) * 192 + 128 + ropeperm(j2 & 63); }
            return CvtDesc{A.in[IN_EVWUQ] + (size_t)e * QRANK * UQ_N, UQ_N, sc, A.in[IN_EVQN] + e * QRANK, QRANK, kb * 64, (bf16_t*)(ws + W_UQ + e * SZ_UQ), LD_QR, nb * 64}; }
        r -= I_UQ;
        if (r < I_UKV) { const int nblk = UKV_N / 64, kb = r / nblk, nb = r - kb * nblk, n = nb * 64 + l4;
            int sc; if (n < 2048) sc = (n >> 7) * 256 + (n & 127); else { const int n2 = n - 2048; sc = (n2 >> 7) * 256 + 128 + (n2 & 127); }
            return CvtDesc{A.in[IN_EVWUKV] + (size_t)e * KVRANK * UKV_N, UKV_N, sc, A.in[IN_EVKVN] + e * KVRANK, KVRANK, kb * 64, (bf16_t*)(ws + W_UKV + e * SZ_UKV), LD_KV, nb * 64}; }
        r -= I_UKV;
        if (r < I_SQ) { const int nblk = DM / 64, kb = r / nblk, nb = r - kb * nblk;
            return CvtDesc{A.in[IN_EVWOUT] + (size_t)e * DM * DM, DM, nb * 64 + l4, nullptr, DM, kb * 64, (bf16_t*)(ws + W_EVOUT + e * SZ_SQ), LD_DM, nb * 64}; }
        r -= I_SQ;
        if (r < I_ODIN) { const int nblk = OD_N / 64, kb = r / nblk, nb = r - kb * nblk;
            return CvtDesc{A.in[IN_ODWIN] + (size_t)e * DM * OD_N, OD_N, nb * 64 + l4, ng + (size_t)((2 * e + 1) * 4 + 0) * DM, DM, kb * 64, (bf16_t*)(ws + W_ODIN + e * SZ_ODIN), LD_DM, nb * 64}; }
        r -= I_ODIN;
        { const int nblk = DM / 64, kb = r / nblk, nb = r - kb * nblk;
            return CvtDesc{A.in[IN_ODWOUT] + (size_t)e * DM * DM, DM, nb * 64 + l4, nullptr, DM, kb * 64, (bf16_t*)(ws + W_ODOUT + e * SZ_SQ), LD_DM, nb * 64}; }
    }
    it -= 2 * I_PAIR;
    const int L = it / I_FFN; int r = it - L * I_FFN;
    if (r < I_GU) { const int nblk = GU_N / 64, kb = r / nblk, nb = r - kb * nblk, n0 = nb * 64, tile = n0 >> 8, w = n0 & 255;
        const float* src = (w < 128 ? A.in[IN_WGATE] : A.in[IN_WUP]) + (size_t)L * DM * DFF;
        return CvtDesc{src, DFF, tile * 128 + (w & 127) + l4, ng + (size_t)(L * 4 + 2) * DM, DM, kb * 64, (bf16_t*)(ws + W_GU + L * SZ_GU), LD8, n0, (const float*)(ws + WS_CTL + CTL_COLMAX) + (size_t)L * GU_N}; }
    r -= I_GU;
    { const int nblk = DM / 64, kb = r / nblk, nb = r - kb * nblk;
        return CvtDesc{A.in[IN_WDOWN] + (size_t)L * DFF * DM, DM, nb * 64 + l4, nullptr, DFF, kb * 64, (bf16_t*)(ws + W_DN + L * SZ_DN), LD_FF, nb * 64}; }
}

__device__ __forceinline__ int ev_srccol(int n) {
    if (n < EV_CQ) return n; if (n < EV_KR) return n + 16; if (n < EV_FL) return 7376 + ropeperm(n - EV_KR); if (n < EV_FL + 16) return 6144 + (n - EV_FL); return -1;
}
__device__ __forceinline__ void row_to_bf16(const float* xrow, bf16_t* orow, float* rstd, int lane) {
    float ss = 0.f;
#pragma unroll
    for (int j = 0; j < 8; ++j) { const f32x4 a = *(const f32x4*)(xrow + 8 * lane + 512 * j), b = *(const f32x4*)(xrow + 8 * lane + 512 * j + 4);
        ss += sq8(a, b); store8(orow + 8 * lane + 512 * j, a, b); }
    ss = wave_sum(ss);
    if (lane == 0) *rstd = rsqrtf(ss * (1.0f / DM) + EPS);
}
__device__ __forceinline__ void row_to_i8(const float* xrow, unsigned char* orow, float* rs8, int lane) {
    f32x4 a[8], b[8]; float ss = 0.f, mx = 0.f;
#pragma unroll
    for (int j = 0; j < 8; ++j) { a[j] = *(const f32x4*)(xrow + 8 * lane + 512 * j); b[j] = *(const f32x4*)(xrow + 8 * lane + 512 * j + 4);
        ss += sq8(a[j], b[j]);
        mx = fmaxf(mx, fmaxf(fmaxf(fmaxf(fabsf(a[j][0]), fabsf(a[j][1])), fmaxf(fabsf(a[j][2]), fabsf(a[j][3]))), fmaxf(fmaxf(fabsf(b[j][0]), fabsf(b[j][1])), fmaxf(fabsf(b[j][2]), fabsf(b[j][3]))))); }
    ss = wave_sum(ss); mx = wave_max(mx);
    const float inv = mx > 0.f ? 127.0f * __builtin_amdgcn_rcpf(mx) : 0.f;
#pragma unroll
    for (int j = 0; j < 8; ++j) { u32x2 q; q.x = pk4_i8(a[j][0] * inv, a[j][1] * inv, a[j][2] * inv, a[j][3] * inv); q.y = pk4_i8(b[j][0] * inv, b[j][1] * inv, b[j][2] * inv, b[j][3] * inv);
        *(u32x2*)(orow + 8 * lane + 512 * j) = q; }
    if (lane == 0) *rs8 = rsqrtf(ss * (1.0f / DM) + EPS) * mx * (1.0f / 16129.0f);
}
constexpr int N_OD8 = ((I8_IN_ODD & 1) + ((I8_IN_ODD >> 1) & 1));
constexpr int I_PAIR0 = I_PAIR - I_EVIN;
constexpr int N_EV8 = ((I8_IN_EV & 1) + ((I8_IN_EV >> 1) & 1));
constexpr int NP0 = I_PAIR - ((I8_IN_EV & 1) ? I_EVIN : 0) - ((I8_IN_ODD & 1) ? I_ODIN : 0), NP1 = I_PAIR - ((I8_IN_EV & 2) ? I_EVIN : 0) - ((I8_IN_ODD & 2) ? I_ODIN : 0);
__device__ __forceinline__ int pair_item(int r, int e) {
    if (!((I8_IN_EV >> e) & 1)) { if (r < I_EVIN) return r; r -= I_EVIN; }
    if (r < I_UQ + I_UKV + I_SQ) return I_EVIN + r;
    r -= I_UQ + I_UKV + I_SQ;
    if (!((I8_IN_ODD >> e) & 1)) { if (r < I_ODIN) return I_EVIN + I_UQ + I_UKV + I_SQ + r; r -= I_ODIN; }
    return I_EVIN + I_UQ + I_UKV + I_SQ + I_ODIN + r;
}
constexpr int N_DN8 = (I8_DN & 1) + ((I8_DN >> 1) & 1) + ((I8_DN >> 2) & 1) + ((I8_DN >> 3) & 1);
__device__ __forceinline__ int nth_layer(int idx, int mask) {
    int L = 0;
#pragma unroll
    for (int b = 0; b < DEPTH; ++b) { if ((mask >> b) & 1) { if (idx == 0) L = b; --idx; } }
    return L;
}
template <int PH> __device__ __forceinline__ CvtDesc cvt_desc(const Args& A, unsigned char* ws, int j, int lane) {
    if constexpr (PH == 0) {
        if (j < NP0) return cvt_describe(A, ws, pair_item(j, 0), lane);
        if (j < NP0 + NP1) return cvt_describe(A, ws, I_PAIR + pair_item(j - NP0, 1), lane);
        const int q = j - NP0 - NP1, idx = q / I_DN, L = nth_layer(idx, ~I8_DN & ((1 << DEPTH) - 1)); return cvt_describe(A, ws, 2 * I_PAIR + L * I_FFN + I_GU + (q - idx * I_DN), lane); }
    else {
        const int q = j;
        const int idx = q / I_DN, r = q - idx * I_DN, L = nth_layer(idx, I8_DN), nblk = DM / 64, kb = r / nblk, nb = r - kb * nblk;
        return CvtDesc{A.in[IN_WDOWN] + (size_t)L * DFF * DM, DM, nb * 64 + 4 * (lane & 15), nullptr, DFF, kb * 64, (bf16_t*)(ws + W_DN + L * SZ_DN), LD8F, nb * 64, (const float*)(ws + WS_CTL + CTL_COLMAX_DN) + (size_t)L * DM, 1};
    }
}
template <int PH> __device__ __forceinline__ void cvt_items(const Args& A, Frame& F) {
    constexpr int NIT = PH == 0 ? NP0 + NP1 + (DEPTH - N_DN8) * I_DN : N_DN8 * I_DN;
    LAS float* scr = (LAS float*)(F.lds + F.wave * 16640);
    const int gw = F.vcu * 8 + F.wave, NGW = F.G * 8;
    unsigned char* ws = F.ws;
    f32x4 vA[16], vB[16]; CvtDesc dA{}, dB{};
    int it = gw;
    if (it < NIT) { dA = cvt_desc<PH>(A, ws, it, F.lane); cvt_load(dA, vA, F.lane); }
    for (; it < NIT; it += 2 * NGW) {
        const int it1 = it + NGW, it2 = it1 + NGW;
        if (it1 < NIT) { dB = cvt_desc<PH>(A, ws, it1, F.lane); cvt_load(dB, vB, F.lane); }
        cvt_finish(dA, vA, scr, F.lane);
        if (it2 < NIT) { dA = cvt_desc<PH>(A, ws, it2, F.lane); cvt_load(dA, vA, F.lane); }
        if (it1 < NIT) cvt_finish(dB, vB, scr, F.lane);
    }
}
__device__ __forceinline__ int ropeperm_inv(int d) { return d < 32 ? 8 * (d >> 2) + (d & 3) : 8 * ((d - 32) >> 2) + 4 + ((d - 32) & 3); }
__device__ __forceinline__ int ev_dstcol(int sc) { if (sc < 6144) return sc; if (sc < 6160) return EV_FL + (sc - 6144); if (sc < 7376) return sc - 16; return EV_KR + ropeperm_inv(sc - 7376); }
constexpr int NS_GU = DFF / 32, NS_OD = OD_N / 32, NS_EV = (EV_SRC_N + 31) / 32, N_STRIPS = DEPTH * 2 * NS_GU + N_OD8 * NS_OD + N_EV8 * NS_EV, STRIP_SLOTS = 135168;
__device__ __forceinline__ void strip_phase(const Args& A, Frame& F) {
    LAS unsigned char* lds = F.lds; unsigned char* ws = F.ws; const int tid = F.tid;
    int par = 0;
    for (int s = F.vcu; s < N_STRIPS; s += F.G, par ^= 1) {
        LAS unsigned* slots = (LAS unsigned*)(lds + STRIP_SLOTS) + 32 * par;
        const float* src; const float* gain; unsigned char* dst; float* cmx; int N, c0, kind, rbase = 0;
        if (s < DEPTH * 2 * NS_GU) { const int mi = s / NS_GU, cb = s - mi * NS_GU, L = mi >> 1, up = mi & 1; kind = 0; N = DFF; c0 = cb * 32;
            src = (up ? A.in[IN_WUP] : A.in[IN_WGATE]) + (size_t)L * DM * DFF; gain = A.in[IN_NORMG] + (size_t)(L * 4 + 2) * DM;
            dst = ws + W_GU + (size_t)L * SZ_GU; cmx = (float*)(ws + WS_CTL + CTL_COLMAX) + (size_t)L * GU_N; rbase = (c0 >> 7) * 256 + up * 128 + (c0 & 127); }
        else if (s < DEPTH * 2 * NS_GU + N_OD8 * NS_OD) { const int q = s - DEPTH * 2 * NS_GU, idx = q / NS_OD, cb = q - idx * NS_OD, e = (I8_IN_ODD & 1) ? idx : 1; kind = 1; N = OD_N; c0 = cb * 32;
            src = A.in[IN_ODWIN] + (size_t)e * DM * OD_N; gain = A.in[IN_NORMG] + (size_t)((2 * e + 1) * 4 + 0) * DM;
            dst = ws + W_GU + (size_t)(2 * e + 1) * SZ_GU + W_OD8_OFF; cmx = (float*)(ws + WS_CTL + CTL_COLMAX_OD) + (size_t)e * OD_N; rbase = c0; }
        else { const int q = s - DEPTH * 2 * NS_GU - N_OD8 * NS_OD, idx = q / NS_EV, cb = q - idx * NS_EV, e = (I8_IN_EV & 1) ? idx : 1; kind = 2; N = EV_SRC_N; c0 = cb * 32 + 32 <= EV_SRC_N ? cb * 32 : EV_SRC_N - 32;
            src = A.in[IN_EVWIN] + (size_t)e * DM * EV_SRC_N; gain = A.in[IN_NORMG] + (size_t)(2 * e * 4 + 0) * DM;
            dst = ws + W_EVIN + (size_t)e * SZ_EVIN; cmx = (float*)(ws + WS_CTL + CTL_COLMAX_EV) + (size_t)e * EV_N; }
        if (tid < 32) slots[tid] = 0u;
        __syncthreads();
        const int cg = tid & 7;
        unsigned m0 = 0u, m1 = 0u;
        {
            const float* sp = src + (size_t)(tid >> 3) * N + c0 + 4 * cg;
#pragma unroll 1
            for (int h = 0; h < 2; ++h) {
                f32x4 v[16];
#pragma unroll
                for (int i = 0; i < 16; ++i) v[i] = __builtin_nontemporal_load((const f32x4*)(sp + (size_t)(64 * (16 * h + i)) * N));
#pragma unroll
                for (int i = 0; i < 16; ++i) { const int k = (tid >> 3) + 64 * (16 * h + i); const float g = gain[k];
                    u32x2 w; w.x = cvt_pk_bf16(v[i][0] * g, v[i][1] * g); w.y = cvt_pk_bf16(v[i][2] * g, v[i][3] * g);
                    m0 = pkmax(m0, w.x & 0x7fff7fffu); m1 = pkmax(m1, w.y & 0x7fff7fffu);
                    *(LAS u32x2*)(lds + (k >> 2) * 264 + (k & 3) * 64 + cg * 8) = w; }
            }
        }
        u32x2 rg[4][8];
        {   const float* sp = src + (size_t)(2048 + 8 * (tid >> 3)) * N + c0 + 4 * cg;
#pragma unroll
            for (int jj = 0; jj < 2; ++jj) {
                f32x4 v[16];
#pragma unroll
                for (int i = 0; i < 16; ++i) v[i] = __builtin_nontemporal_load((const f32x4*)(sp + (size_t)(512 * (2 * jj + (i >> 3)) + (i & 7)) * N));
#pragma unroll
                for (int i = 0; i < 16; ++i) { const int k = 2048 + 8 * (tid >> 3) + 512 * (2 * jj + (i >> 3)) + (i & 7); const float g = gain[k];
                    u32x2 w; w.x = cvt_pk_bf16(v[i][0] * g, v[i][1] * g); w.y = cvt_pk_bf16(v[i][2] * g, v[i][3] * g);
                    m0 = pkmax(m0, w.x & 0x7fff7fffu); m1 = pkmax(m1, w.y & 0x7fff7fffu);
                    rg[2 * jj + (i >> 3)][i & 7] = w; }
            }
        }
        atomicMax((unsigned*)(slots + 4 * cg + 0), m0 << 16); atomicMax((unsigned*)(slots + 4 * cg + 1), m0 & 0xffff0000u);
        atomicMax((unsigned*)(slots + 4 * cg + 2), m1 << 16); atomicMax((unsigned*)(slots + 4 * cg + 3), m1 & 0xffff0000u);
        __syncthreads();
        {
            const int ch = tid >> 1, hf = tid & 1;
            u32x2 w[8][4];
#pragma unroll
            for (int r = 0; r < 8; ++r) { const LAS u32x2* cp = (const LAS u32x2*)(lds + (2 * ch + (r >> 2)) * 264 + (r & 3) * 64 + hf * 32);
#pragma unroll
                for (int j = 0; j < 4; ++j) w[r][j] = cp[j]; }
#pragma unroll
            for (int n = 0; n < 16; ++n) {
                const float cm = __uint_as_float(slots[16 * hf + n]), inv = cm > 0.f ? 127.0f * __builtin_amdgcn_rcpf(cm) : 0.f;
                float x[8];
#pragma unroll
                for (int r = 0; r < 8; ++r) { const unsigned word = (n & 2) ? w[r][n >> 2].y : w[r][n >> 2].x; x[r] = ((n & 1) ? bf_hi(word) : bf_lo(word)) * inv; }
                u32x2 q; q.x = pk4_i8(x[0], x[1], x[2], x[3]); q.y = pk4_i8(x[4], x[5], x[6], x[7]);
                const int col = 16 * hf + n, drow = kind == 2 ? ev_dstcol(c0 + col) : rbase + col;
                __builtin_nontemporal_store(q, (u32x2*)(dst + (size_t)drow * LD8 + 8 * ch));
            }
        }
        {
#pragma unroll
            for (int c = 0; c < 4; ++c) {
                const float cm = __uint_as_float(slots[4 * cg + c]), inv = cm > 0.f ? 127.0f * __builtin_amdgcn_rcpf(cm) : 0.f;
                const int col = 4 * cg + c, drow = kind == 2 ? ev_dstcol(c0 + col) : rbase + col;
#pragma unroll
                for (int j = 0; j < 4; ++j) {
                    float x[8];
#pragma unroll
                    for (int r = 0; r < 8; ++r) { const unsigned word = (c & 2) ? rg[j][r].y : rg[j][r].x; x[r] = ((c & 1) ? bf_hi(word) : bf_lo(word)) * inv; }
                    u32x2 q; q.x = pk4_i8(x[0], x[1], x[2], x[3]); q.y = pk4_i8(x[4], x[5], x[6], x[7]);
                    __builtin_nontemporal_store(q, (u32x2*)(dst + (size_t)drow * LD8 + 2048 + 8 * ((tid >> 3) + 64 * j)));
                }
            }
        }
        if (tid < 32) { const int drow = kind == 2 ? ev_dstcol(c0 + tid) : rbase + tid; cmx[drow] = __uint_as_float(slots[tid]); }
    }
    __syncthreads();
    { const int gw = F.vcu * 8 + F.wave, NGW = F.G * 8;
      for (int r = gw; r < N_EV8 * (EV_N - EV_SRC_N); r += NGW) { const int idx = r / (EV_N - EV_SRC_N), row = EV_SRC_N + (r - idx * (EV_N - EV_SRC_N)), e = (I8_IN_EV & 1) ? idx : 1;
          unsigned char* d = ws + W_EVIN + (size_t)e * SZ_EVIN + (size_t)row * LD8; const u32x4 z = {0u, 0u, 0u, 0u};
#pragma unroll
          for (int j = 0; j < 4; ++j) *(u32x4*)(d + 16 * F.lane + 1024 * j) = z; } }
}
__device__ __forceinline__ void colmax_dn_pass(const Args& A, Frame& F) {
    const int gw = F.vcu * 8 + F.wave, NGW = F.G * 8, lane = F.lane;
    constexpr int NKC = DFF / 256, NCB = DM / 256;
    for (int item = gw; item < N_DN8 * NKC * NCB; item += NGW) {
        const int cb = item % NCB, q = item / NCB, kc = q % NKC, L = nth_layer(q / NKC, I8_DN);
        const float* src = A.in[IN_WDOWN] + (size_t)L * DFF * DM + (size_t)(kc * 256) * DM + cb * 256 + 4 * lane;
        f32x4 mx = {0.f, 0.f, 0.f, 0.f};
#pragma unroll 1
        for (int g = 0; g < 8; ++g) {
            f32x4 w[32];
#pragma unroll
            for (int i = 0; i < 32; ++i) w[i] = __builtin_nontemporal_load((const f32x4*)(src + (size_t)(g * 32 + i) * DM));
#pragma unroll
            for (int h = 1; h < 32; h <<= 1)
#pragma unroll
                for (int i = 0; i < 32; ++i) if (!(i & h)) { const f32x4 x = w[i], y = w[i | h]; w[i] = x + y; w[i | h] = x - y; }
#pragma unroll
            for (int i = 0; i < 32; ++i) { mx[0] = fmaxf(mx[0], fabsf(w[i][0])); mx[1] = fmaxf(mx[1], fabsf(w[i][1])); mx[2] = fmaxf(mx[2], fabsf(w[i][2])); mx[3] = fmaxf(mx[3], fabsf(w[i][3])); }
        }
        unsigned* dstp = (unsigned*)(F.ws + WS_CTL + CTL_COLMAX_DN) + (size_t)L * DM + cb * 256 + 4 * lane;
#pragma unroll
        for (int e = 0; e < 4; ++e) atomicMax(dstp + e, __float_as_uint(mx[e]));
    }
}
__device__ __forceinline__ void actq_load(u32x4 (&w)[22], const bf16_t* act, int row, int lane) {
    const char* src = (const char*)(act + (size_t)row * LD_FF);
#pragma unroll
    for (int j = 0; j < 22; ++j) { w[j] = (u32x4){0u, 0u, 0u, 0u}; if (8 * lane + 512 * j < DFF) w[j] = __builtin_nontemporal_load((const u32x4*)(src + 16 * lane + 1024 * j)); }
}
__device__ __forceinline__ void actq_row(u32x4 (&w)[22], unsigned char* act8, float* rsd, int row, int lane) {
    unsigned char* dst = act8 + (size_t)row * LD8F;
    unsigned amx2 = 0u;
#pragma unroll
    for (int j = 0; j < 22; ++j) {
        float v[8] = {bf_lo(w[j].x), bf_hi(w[j].x), bf_lo(w[j].y), bf_hi(w[j].y), bf_lo(w[j].z), bf_hi(w[j].z), bf_lo(w[j].w), bf_hi(w[j].w)};
        fwht8_32(v, lane);
        w[j].x = cvt_pk_bf16(v[0], v[1]); w[j].y = cvt_pk_bf16(v[2], v[3]); w[j].z = cvt_pk_bf16(v[4], v[5]); w[j].w = cvt_pk_bf16(v[6], v[7]);
        amx2 = pkmax(pkmax(amx2, w[j].x & 0x7fff7fffu), pkmax(w[j].y & 0x7fff7fffu, pkmax(w[j].z & 0x7fff7fffu, w[j].w & 0x7fff7fffu)));
    }
    const float m = wave_max(fmaxf(bf_lo(amx2), bf_hi(amx2)));
    const float inv = m > 0.f ? 127.0f * __builtin_amdgcn_rcpf(m) : 0.f;
#pragma unroll
    for (int j = 0; j < 22; ++j) { if (8 * lane + 512 * j < DFF) { u32x2 q;
        q.x = pk4_i8(bf_lo(w[j].x) * inv, bf_hi(w[j].x) * inv, bf_lo(w[j].y) * inv, bf_hi(w[j].y) * inv); q.y = pk4_i8(bf_lo(w[j].z) * inv, bf_hi(w[j].z) * inv, bf_lo(w[j].w) * inv, bf_hi(w[j].w) * inv);
        *(u32x2*)(dst + 8 * lane + 512 * j) = q; } }
    if (lane == 0) rsd[row] = m * (1.0f / (16129.0f * 32.0f));
}
__device__ __forceinline__ void actq_phase(Frame& F) {
    unsigned char* ws = F.ws;
    const int gw = F.vcu * 8 + F.wave, NGW = F.G * 8, lane = F.lane;
    const bf16_t* act = (const bf16_t*)(ws + WS_PROJ); unsigned char* act8 = ws + WS_ACT8; float* rsd = (float*)(ws + WS_RSD);
    u32x4 wA[22], wB[22];
    int row = gw;
    if (row < MPAD) actq_load(wA, act, row, lane);
    for (; row < MPAD; row += 2 * NGW) {
        const int r1 = row + NGW, r2 = r1 + NGW;
        if (r1 < MPAD) actq_load(wB, act, r1, lane);
        actq_row(wA, act8, rsd, row, lane);
        if (r2 < MPAD) actq_load(wA, act, r2, lane);
        if (r1 < MPAD) actq_row(wB, act8, rsd, r1, lane);
    }
}
__device__ __forceinline__ void p0_prologue(const Args& A, Frame& F) {
    const int gw = F.vcu * 8 + F.wave, NGW = F.G * 8;
    unsigned char* ws = F.ws;
    strip_phase(A, F);
    colmax_dn_pass(A, F);
    cvt_items<0>(A, F);
    { float* cosT = (float*)(ws + WS_COS); float* sinT = (float*)(ws + WS_SIN);
      for (int idx = gw * 64 + F.lane; idx < NPOS * 32; idx += NGW * 64) { const int pos = idx >> 5, i = idx & 31;
          const float inv = powf(10000.0f, -(float)i * (1.0f / 32.0f)); const float ang = (float)pos * inv;
          cosT[idx] = cosf(ang); sinT[idx] = sinf(ang); } }
    if (gw == 0) { float* prm = (float*)(ws + WS_PRM);
        for (int o = 0; o < 2; ++o) { const float* l = A.in[IN_ODLAM] + o * 4 * 128;
            const float s01 = wave_sum(l[F.lane] * l[128 + F.lane] + l[64 + F.lane] * l[192 + F.lane]);
            const float s23 = wave_sum(l[256 + F.lane] * l[384 + F.lane] + l[320 + F.lane] * l[448 + F.lane]);
            if (F.lane == 0) prm[o] = expf(s01) - expf(s23) + A.lam_init[o]; } }
    bf16_t* hbf = (bf16_t*)(ws + WS_HBF); float* rstd = (float*)(ws + WS_RSTD); unsigned char* a8 = ws + WS_OBUF; float* rs8 = (float*)(ws + WS_RS8);
    for (int row = gw; row < MPAD; row += NGW) {
        if (row < MUSED) { const float* src = row < MREAL ? A.in[IN_X] + (size_t)row * DM : A.in[IN_META] + (size_t)(row - MREAL) * DM;
            if constexpr (I8_IN_EV & 1) row_to_i8(src, a8 + (size_t)row * LD8, rs8 + row, F.lane); else row_to_bf16(src, hbf + (size_t)row * LD_DM, rstd + row, F.lane); }
        else { const u32x4 z = {0u, 0u, 0u, 0u};
#pragma unroll
            for (int j = 0; j < 8; ++j) *(u32x4*)(hbf + (size_t)row * LD_DM + 8 * F.lane + 512 * j) = z;
#pragma unroll
            for (int j = 0; j < 4; ++j) *(u32x4*)(a8 + (size_t)row * LD8 + 16 * F.lane + 1024 * j) = z;
            if (F.lane == 0) { rstd[row] = 0.f; rs8[row] = 0.f; } }
    }
}

__device__ __forceinline__ void ew_phase(const Args& A, Frame& F, int layer, int which) {
    unsigned char* ws = F.ws;
    const int gw = F.vcu * 8 + F.wave, NGW = F.G * 8, lane = F.lane;
    const float* gpost = A.in[IN_NORMG] + (size_t)(layer * 4 + (which ? 3 : 1)) * DM;
    const bool first = (layer == 0 && which == 0), last = (layer == DEPTH - 1 && which == 1);
    const bf16_t* mbuf = (const bf16_t*)(ws + WS_MBUF); bf16_t* hbf = (bf16_t*)(ws + WS_HBF);
    float* rstd = (float*)(ws + WS_RSTD); const float* statm = (const float*)(ws + WS_STATM);
    const bool q8 = (which == 0) || (layer + 1 < DEPTH && (((((layer + 1) & 1) ? I8_IN_ODD : I8_IN_EV) >> ((layer + 1) >> 1)) & 1));
    unsigned char* a8 = ws + (which == 0 ? WS_A8 : WS_OBUF); float* rs8 = (float*)(ws + WS_RS8);
    if (q8) {
        for (int row = MUSED + gw; row < MPAD; row += NGW) { const u32x4 z = {0u, 0u, 0u, 0u};
#pragma unroll
            for (int j = 0; j < 4; ++j) *(u32x4*)(a8 + (size_t)row * LD8 + 16 * lane + 1024 * j) = z;
            if (lane == 0) rs8[row] = 0.f; }
    }
    if (F.vcu < NMETA && !last) {
        const int r = F.vcu, row = MREAL + r, nS = which ? (DFF / 256) : (DM / 256), c0 = F.wave * 512 + 8 * lane;
        const float* part = (const float*)(ws + WS_PART) + (size_t)r * DM + c0;
        LAS float* red = (LAS float*)F.lds;
        f32x4 ma = {0.f, 0.f, 0.f, 0.f}, mb = {0.f, 0.f, 0.f, 0.f};
        if (which && ((I8_DN >> layer) & 1)) {
            i32x4 ia = {0, 0, 0, 0}, ib = {0, 0, 0, 0};
#pragma unroll 16
            for (int ks = 0; ks < DFF / 256; ++ks) { ia += *(const i32x4*)(part + (size_t)ks * 16 * DM); ib += *(const i32x4*)(part + (size_t)ks * 16 * DM + 4); }
            const float* cs = (const float*)(ws + WS_CTL + CTL_COLMAX_DN) + (size_t)layer * DM + c0; const float rsc = ((const float*)(ws + WS_RSD))[row];
            ma = __builtin_convertvector(ia, f32x4) * (*(const f32x4*)cs * rsc); mb = __builtin_convertvector(ib, f32x4) * (*(const f32x4*)(cs + 4) * rsc);
        } else {
#pragma unroll 16
        for (int ks = 0; ks < nS; ++ks) { ma += *(const f32x4*)(part + (size_t)ks * 16 * DM); mb += *(const f32x4*)(part + (size_t)ks * 16 * DM + 4); }
        }
        const float s1 = wave_sum(sq8(ma, mb));
        if (lane == 0) red[F.wave] = s1;
        __syncthreads();
        const float rm = __builtin_amdgcn_rsqf((((red[0] + red[1]) + (red[2] + red[3])) + ((red[4] + red[5]) + (red[6] + red[7]))) * (1.0f / DM) + EPS);
        f32x4 ha, hb;
        if (first) { ha = *(const f32x4*)(A.in[IN_META] + (size_t)r * DM + c0); hb = *(const f32x4*)(A.in[IN_META] + (size_t)r * DM + c0 + 4); }
        else { const u32x4 wh = *(const u32x4*)(hbf + (size_t)row * LD_DM + c0);
            ha = (f32x4){bf_lo(wh.x), bf_hi(wh.x), bf_lo(wh.y), bf_hi(wh.y)}; hb = (f32x4){bf_lo(wh.z), bf_hi(wh.z), bf_lo(wh.w), bf_hi(wh.w)}; }
        const f32x4 ga = *(const f32x4*)(gpost + c0), gb = *(const f32x4*)(gpost + c0 + 4);
        ha = ha + ma * rm * ga; hb = hb + mb * rm * gb;
        const float s2 = wave_sum(sq8(ha, hb));
        const float mxw = wave_max(fmaxf(fmaxf(fmaxf(fabsf(ha[0]), fabsf(ha[1])), fmaxf(fabsf(ha[2]), fabsf(ha[3]))), fmaxf(fmaxf(fabsf(hb[0]), fabsf(hb[1])), fmaxf(fabsf(hb[2]), fabsf(hb[3])))));
        if (lane == 0) { red[8 + F.wave] = s2; red[16 + F.wave] = mxw; }
        __syncthreads();
        store8(hbf + (size_t)row * LD_DM + c0, ha, hb);
        const float amx = fmaxf(fmaxf(fmaxf(red[16], red[17]), fmaxf(red[18], red[19])), fmaxf(fmaxf(red[20], red[21]), fmaxf(red[22], red[23])));
        if (q8) { const float inv = amx > 0.f ? 127.0f * __builtin_amdgcn_rcpf(amx) : 0.f;
            u32x2 q; q.x = pk4_i8(ha[0] * inv, ha[1] * inv, ha[2] * inv, ha[3] * inv); q.y = pk4_i8(hb[0] * inv, hb[1] * inv, hb[2] * inv, hb[3] * inv); *(u32x2*)(a8 + (size_t)row * LD8 + c0) = q; }
        if (F.tid == 0) { const float rr = __builtin_amdgcn_rsqf((((red[8] + red[9]) + (red[10] + red[11])) + ((red[12] + red[13]) + (red[14] + red[15]))) * (1.0f / DM) + EPS);
            rstd[row] = rr; if (q8) rs8[row] = rr * amx * (1.0f / 16129.0f); }
        __syncthreads();
    }
    u32x4 mv[8], ha[8], hb[8]; float sq = 0.f;
    unsigned v16 = (unsigned)lane * 16u, v32 = (unsigned)lane * 32u, v8 = (unsigned)lane * 8u;
    asm volatile("" : "+v"(v16), "+v"(v32), "+v"(v8));
    const char* const mbufc = (const char*)mbuf; const char* const hbfc = (const char*)hbf; const char* const xc = (const char*)A.in[IN_X]; const char* const gpc = (const char*)gpost;
#define EW_FETCH(j_, row_) do { mv[j_] = __builtin_nontemporal_load((const u32x4*)(mbufc + ((size_t)(row_) * (LD_DM * 2) + 1024 * (j_)) + opq(v16)));           \
        if (first) { ha[j_] = *(const u32x4*)(xc + ((size_t)(row_) * (DM * 4) + 2048 * (j_)) + opq(v32)); hb[j_] = *(const u32x4*)(xc + ((size_t)(row_) * (DM * 4) + 2048 * (j_) + 16) + opq(v32)); } \
        else { ha[j_] = *(const u32x4*)(hbfc + ((size_t)(row_) * (LD_DM * 2) + 1024 * (j_)) + opq(v16)); } } while (0)
    LAS u32x4* const wst = (LAS u32x4*)(F.lds + 1024 + F.wave * 8192) + lane;
    int row = gw;
    if (row < MREAL) {
#pragma unroll
        for (int j = 0; j < 8; ++j) EW_FETCH(j, row);
        sq = *(const float*)((const char*)statm + (size_t)row * 256 + opq((unsigned)lane * 4u)); }
    for (; row < MREAL; row += NGW) {
        asm volatile("" : "+v"(v16), "+v"(v32), "+v"(v8));
        unsigned amx2 = 0u;
        const float rm = __builtin_amdgcn_rsqf(wave_sum(sq) * (1.0f / DM) + EPS);
        const int nrow = row + NGW; const bool more = nrow < MREAL;
        if (more) sq = *(const float*)((const char*)statm + (size_t)nrow * 256 + opq((unsigned)lane * 4u));
        float ss2 = 0.f;
        char* const hbw = (char*)hbf + (size_t)row * (LD_DM * 2); char* const outw = (char*)A.out + (size_t)row * (DM * 4);
#pragma unroll
        for (int j = 0; j < 8; ++j) { const f32x4 g0 = *(const f32x4*)(gpc + 2048 * j + opq(v32)), g1 = *(const f32x4*)(gpc + (2048 * j + 16) + opq(v32));
            const f32x4 m0 = {bf_lo(mv[j].x), bf_hi(mv[j].x), bf_lo(mv[j].y), bf_hi(mv[j].y)}, m1 = {bf_lo(mv[j].z), bf_hi(mv[j].z), bf_lo(mv[j].w), bf_hi(mv[j].w)};
            f32x4 h0, h1;
            if (first) { h0 = (f32x4){__uint_as_float(ha[j].x), __uint_as_float(ha[j].y), __uint_as_float(ha[j].z), __uint_as_float(ha[j].w)}; h1 = (f32x4){__uint_as_float(hb[j].x), __uint_as_float(hb[j].y), __uint_as_float(hb[j].z), __uint_as_float(hb[j].w)}; }
            else { h0 = (f32x4){bf_lo(ha[j].x), bf_hi(ha[j].x), bf_lo(ha[j].y), bf_hi(ha[j].y)}; h1 = (f32x4){bf_lo(ha[j].z), bf_hi(ha[j].z), bf_lo(ha[j].w), bf_hi(ha[j].w)}; }
            const f32x4 n0 = h0 + m0 * rm * g0, n1 = h1 + m1 * rm * g1; ss2 += sq8(n0, n1);
            if (last) { *(f32x4*)(outw + 2048 * j + opq(v32)) = n0; *(f32x4*)(outw + (2048 * j + 16) + opq(v32)) = n1; }
            else { u32x4 wh; wh.x = cvt_pk_bf16(n0[0], n0[1]); wh.y = cvt_pk_bf16(n0[2], n0[3]); wh.z = cvt_pk_bf16(n1[0], n1[1]); wh.w = cvt_pk_bf16(n1[2], n1[3]);
                *(u32x4*)(hbw + 1024 * j + opq(v16)) = wh;
                if (q8) { wst[j * 64] = wh;
                    amx2 = pkmax(pkmax(amx2, wh.x & 0x7fff7fffu), pkmax(wh.y & 0x7fff7fffu, pkmax(wh.z & 0x7fff7fffu, wh.w & 0x7fff7fffu))); } }
            if (more) EW_FETCH(j, nrow);
        }
        if (!last) { ss2 = wave_sum(ss2); const float rr = __builtin_amdgcn_rsqf(ss2 * (1.0f / DM) + EPS);
            if (lane == 0) rstd[row] = rr;
            if (q8) { const float amax = wave_max(fmaxf(bf_lo(amx2), bf_hi(amx2))); const float inv = amax > 0.f ? 127.0f * __builtin_amdgcn_rcpf(amax) : 0.f;
                if (lane == 0) rs8[row] = rr * amax * (1.0f / 16129.0f);
                char* const a8w = (char*)a8 + (size_t)row * LD8;
#pragma unroll
                for (int j = 0; j < 8; ++j) { u32x2 q; const u32x4 w = wst[j * 64];
                    q.x = pk4_i8(bf_lo(w.x) * inv, bf_hi(w.x) * inv, bf_lo(w.y) * inv, bf_hi(w.y) * inv); q.y = pk4_i8(bf_lo(w.z) * inv, bf_hi(w.z) * inv, bf_lo(w.w) * inv, bf_hi(w.w) * inv);
                    *(u32x2*)(a8w + 512 * j + opq(v8)) = q; } } }
    }
#undef EW_FETCH
}

__device__ __forceinline__ float logsig(float x) { return fminf(x, 0.f) - 0.6931471805599453f * __builtin_amdgcn_logf(1.0f + __builtin_amdgcn_exp2f(-1.4426950408889634f * fabsf(x))); }
__device__ __forceinline__ void scan_phase(const Args& A, Frame& F, int e) {
    const int gw = (F.G - 1 - F.vcu) * 8 + F.wave, lane = F.lane;
    if (gw >= NB * 16) return;
    const int b = gw >> 4, h = gw & 15;
    const float* flogT = (const float*)(F.ws + WS_FLOG) + (size_t)h * MPAD; float* cumT = (float*)(F.ws + WS_CUM) + (size_t)h * MPAD;
    const float bf = A.in[IN_EVBF][e * 16 + h];
    float cm = 0.f, mine = 0.f;
#pragma unroll 1
    for (int m = 0; m < NMETA; ++m) { cm += logsig(flogT[META0 + m] + bf); if (lane == m) mine = cm; }
    if (b == 0) cumT[META0 + lane] = lane < NMETA ? mine : 0.f;
    const float* src = flogT + b * SEQ + lane * 64; float* dst = cumT + b * SEQ + lane * 64;
    float s = 0.f;
#pragma unroll 1
    for (int i = 0; i < 16; ++i) { const f32x4 v = *(const f32x4*)(src + 4 * i); s += (logsig(v[0] + bf) + logsig(v[1] + bf)) + (logsig(v[2] + bf) + logsig(v[3] + bf)); }
    float inc = s;
#pragma unroll
    for (int off = 1; off < 64; off <<= 1) { const float t = __shfl_up(inc, off); if (lane >= off) inc += t; }
    float run = cm + (inc - s);
#pragma unroll 1
    for (int i = 0; i < 16; ++i) { const f32x4 v = *(const f32x4*)(src + 4 * i); f32x4 o;
        run += logsig(v[0] + bf); o[0] = run; run += logsig(v[1] + bf); o[1] = run; run += logsig(v[2] + bf); o[2] = run; run += logsig(v[3] + bf); o[3] = run;
        *(f32x4*)(dst + 4 * i) = o; }
}

__device__ __forceinline__ void fixup_odd_meta(Frame& F, int e) {
    unsigned char* ws = F.ws;
    const float* part = (const float*)(ws + WS_PART); const float* rstd = (const float*)(ws + WS_RSTD); bf16_t* proj = (bf16_t*)(ws + WS_PROJ);
    const bool i8 = (I8_IN_ODD >> e) & 1;
    const float* cs = (const float*)(ws + WS_CTL + CTL_COLMAX_OD) + (size_t)e * OD_N; const float* rs8 = (const float*)(ws + WS_RS8);
    constexpr int CG = OD_N / 8;
    for (int item = F.vcu * 512 + F.tid; item < 256 * CG; item += F.G * 512) {
        const int r = item / CG, col = (item - r * CG) * 8;
        f32x4 a = {0.f, 0.f, 0.f, 0.f}, b = {0.f, 0.f, 0.f, 0.f};
        if (r < NMETA) {
            if (i8) { i32x4 ia = {0, 0, 0, 0}, ib = {0, 0, 0, 0};
#pragma unroll 16
                for (int ks = 0; ks < DM / 256; ++ks) { ia += *(const i32x4*)(part + (size_t)(ks * 16 + r) * OD_N + col); ib += *(const i32x4*)(part + (size_t)(ks * 16 + r) * OD_N + col + 4); }
                const float sc = rs8[META0 + r]; a = __builtin_convertvector(ia, f32x4) * (*(const f32x4*)(cs + col) * sc); b = __builtin_convertvector(ib, f32x4) * (*(const f32x4*)(cs + col + 4) * sc);
            } else {
#pragma unroll 16
            for (int ks = 0; ks < DM / 256; ++ks) { a += *(const f32x4*)(part + (size_t)(ks * 16 + r) * OD_N + col); b += *(const f32x4*)(part + (size_t)(ks * 16 + r) * OD_N + col + 4); }
            const float sc = rstd[META0 + r]; a = a * sc; b = b * sc;
            }
        }
        pg8::store8(proj + (size_t)(META0 + r) * LD_OD + col, a, b);
    }
}

__device__ __forceinline__ int t5_bucket(int d) {
    if (d < 16) return d;
    return 16 + (d >= 19) + (d >= 21) + (d >= 24) + (d >= 27) + (d >= 31) + (d >= 35) + (d >= 40) + (d >= 46) + (d >= 52) + (d >= 59) + (d >= 67) + (d >= 77) + (d >= 87) + (d >= 99) + (d >= 113);
}
__device__ __forceinline__ void attn_even_phase(Frame& F) {
    unsigned char* ws = F.ws; LAS char* lds = (LAS char*)F.lds;
    const bf16_t* proj = (const bf16_t*)(ws + WS_PROJ); const bf16_t* qbuf = (const bf16_t*)(ws + WS_QBUF); const bf16_t* kvbuf = (const bf16_t*)(ws + WS_KVBUF);
    bf16_t* obuf = (bf16_t*)(ws + WS_OBUF); const float* cumT = (const float*)(ws + WS_CUM);
    for (int i = F.vcu; i < 512 + 16; i += F.G) {
        const bool meta = i >= 512; const int bh = i >> 3, p = i & 7, b = meta ? 0 : bh >> 4, h = meta ? i - 512 : bh & 15, nblk = meta ? 1 : 2;
        for (int k = 0; k < nblk; ++k) {
            const int qb = meta ? 0 : (k == 0 ? 15 - p : p), qrow0 = meta ? META0 : b * SEQ + qb * 256;
            att::PassArgs a;
            a.Q = proj + (size_t)qrow0 * LD_EV + EV_QF + h * 128; a.ldq = LD_EV; a.Q2 = nullptr; a.ldq2 = 0;
            a.K = proj + EV_KF + h * 128; a.ldk = LD_EV; a.K2 = nullptr; a.ldk2 = 0; a.V = proj + EV_VF + h * 128; a.ldv = LD_EV;
            a.cum = cumT + (size_t)h * MPAD; a.krow0 = b * SEQ; a.qvp0 = meta ? 0 : 64 + qb * 256; a.NT = meta ? 1 : 4 * qb + 5; a.shift0 = 0;
            f32x16 o[4];
            att::attn_pass_dma<0>(a, lds, o, F.tid);
            att::store_o_bf16(o, obuf + (size_t)(qrow0 + F.wave * 32) * LD_DM + h * 128, LD_DM, F.tid);
        }
    }
    for (int i = F.vcu; i < 512 + 16; i += F.G) {
        const bool meta = i >= 512; const int bh = i >> 3, p = i & 7, b = meta ? 0 : bh >> 4, h = meta ? i - 512 : bh & 15, nblk = meta ? 1 : 2;
        for (int k = 0; k < nblk; ++k) {
            const int qb = meta ? 0 : (k == 0 ? 15 - p : p), qrow0 = meta ? META0 : b * SEQ + qb * 256;
            att::PassArgs a;
            a.Q = qbuf + (size_t)qrow0 * LD_UQ + h * 128; a.ldq = LD_UQ; a.Q2 = qbuf + (size_t)qrow0 * LD_UQ + 2048 + h * 64; a.ldq2 = LD_UQ;
            a.K = kvbuf + h * 128; a.ldk = LD_UKV; a.K2 = proj + EV_KR; a.ldk2 = LD_EV; a.V = kvbuf + 2048 + h * 128; a.ldv = LD_UKV;
            a.cum = nullptr; a.krow0 = b * SEQ; a.qvp0 = meta ? 0 : 64 + qb * 256; a.NT = meta ? 1 : 4 * qb + 5; a.shift0 = 0;
            f32x16 o[4];
            att::attn_pass_dma<1>(a, lds, o, F.tid);
            att::store_o_bf16(o, obuf + (size_t)(qrow0 + F.wave * 32) * LD_DM + 2048 + h * 128, LD_DM, F.tid);
        }
    }
}
__device__ __forceinline__ void attn_odd_phase(const Args& A, Frame& F, int o_idx) {
    unsigned char* ws = F.ws; LAS char* lds = (LAS char*)F.lds;
    const bf16_t* proj = (const bf16_t*)(ws + WS_PROJ); bf16_t* obuf = (bf16_t*)(ws + WS_OBUF);
    const float post = 1.0f - A.lam_init[o_idx];
    const float* subg = A.in[IN_ODSUBLN] + o_idx * 256; const float* relb = A.in[IN_RELB];
    float* S1base = (float*)(ws + WS_DSCR) + (size_t)(F.vcu & 255) * 65536;
    constexpr float INV_SCALE = 1.0f / att::Cfg<2>::SCALE;
    for (int i = F.vcu; i < 512 + 16; i += F.G) {
        const bool meta = i >= 512; const int bh = i >> 3, p = i & 7, b = meta ? 0 : bh >> 4, h = meta ? i - 512 : bh & 15, nblk = meta ? 1 : 2;
        for (int k = 0; k < nblk; ++k) {
            const int qb = meta ? 0 : (k == 0 ? 15 - p : p), qrow0 = meta ? META0 : b * SEQ + qb * 256;
            { int tt = F.tid; asm volatile("" : "+v"(tt));
              if (tt < 128) ((LAS float*)(lds + att::D_OFF_TBL))[tt] = tt <= 112 ? (relb[t5_bucket(tt) * 16 + h] - relb[31 * 16 + h]) * INV_SCALE : 0.f; }
            f32x16 o[8];
            for (int br = 0; br < 2; ++br) {
                att::PassArgs a;
                a.Q = proj + (size_t)qrow0 * LD_OD + h * 256 + br * 128; a.ldq = LD_OD; a.Q2 = nullptr; a.ldq2 = 0;
                a.K = proj + 4096 + h * 256 + br * 128; a.ldk = LD_OD; a.K2 = nullptr; a.ldk2 = 0; a.V = proj + 8192 + h * 256; a.ldv = LD_OD;
                a.cum = nullptr; a.krow0 = b * SEQ; a.qvp0 = meta ? 0 : 64 + qb * 256; a.NT = meta ? 1 : 4 * qb + 5; a.shift0 = meta ? 0 : 48;
                att::attn_pass_diff(a, lds, o, F.tid);
                if (br == 0) {
                    int tq = F.tid; asm volatile("" : "+v"(tq));
                    float* S1 = S1base + (size_t)tq * 4;
#pragma unroll
                    for (int d = 0; d < 8; ++d) {
#pragma unroll
                        for (int q = 0; q < 4; ++q) *(f32x4*)(S1 + (d * 4 + q) * 2048) = (f32x4){o[d][4 * q], o[d][4 * q + 1], o[d][4 * q + 2], o[d][4 * q + 3]}; }
                }
            }
            {
                int tq = F.tid; asm volatile("" : "+v"(tq));
                const float* S1 = S1base + (size_t)tq * 4;
                const float lam = ((const float*)(ws + WS_PRM))[o_idx];
                VM_WAIT();
#pragma unroll
                for (int d = 0; d < 8; ++d) {
#pragma unroll
                    for (int q = 0; q < 4; ++q) { const f32x4 s1 = *(const f32x4*)(S1 + (d * 4 + q) * 2048);
#pragma unroll
                        for (int j = 0; j < 4; ++j) o[d][4 * q + j] = s1[j] - lam * o[d][4 * q + j]; }
                    asm volatile("" ::: "memory"); }
            }
            int tq2 = F.tid; asm volatile("" : "+v"(tq2));
            const int r32 = tq2 & 31;
            float ssum[16];
#pragma unroll
            for (int r = 0; r < 16; ++r) { float t = 0.f;
#pragma unroll
                for (int d = 0; d < 8; ++d) t += o[d][r] * o[d][r];
#pragma unroll
                for (int off = 1; off < 32; off <<= 1) t += __shfl_xor(t, off);
                ssum[r] = __builtin_amdgcn_rsqf(t * (1.0f / 256.0f) + EPS) * post; }
#pragma unroll
            for (int d = 0; d < 8; ++d) { const float g = subg[d * 32 + r32];
#pragma unroll
                for (int r = 0; r < 16; ++r) o[d][r] *= ssum[r] * g; }
            bf16_t* Ow = obuf + (size_t)(qrow0 + F.wave * 32) * LD_DM + h * 256;
            att::store_o_bf16(o, Ow, LD_DM, F.tid);
            att::store_o_bf16(o + 4, Ow + 128, LD_DM, F.tid);
        }
    }
}
#ifdef PROBE_ATT
template <int PVAR>
__device__ __forceinline__ void attn_odd_phase_probe(const Args& A, Frame& F, int o_idx) {
    unsigned char* ws = F.ws; LAS char* lds = (LAS char*)F.lds;
    const bf16_t* proj = (const bf16_t*)(ws + WS_PROJ); bf16_t* obuf = (bf16_t*)(ws + WS_OBUF);
    const float post = 1.0f - A.lam_init[o_idx];
    const float* subg = A.in[IN_ODSUBLN] + o_idx * 256; const float* relb = A.in[IN_RELB];
    float* S1base = (float*)(ws + WS_DSCR) + (size_t)(F.vcu & 255) * 65536;
    constexpr float INV_SCALE = 1.0f / att::Cfg<2>::SCALE;
    for (int i = F.vcu; i < 512 + 16; i += F.G) {
        const bool meta = i >= 512; const int bh = i >> 3, p = i & 7, b = meta ? 0 : bh >> 4, h = meta ? i - 512 : bh & 15, nblk = meta ? 1 : 2;
        for (int k = 0; k < nblk; ++k) {
            const int qb = meta ? 0 : (k == 0 ? 15 - p : p), qrow0 = meta ? META0 : b * SEQ + qb * 256;
            { int tt = F.tid; asm volatile("" : "+v"(tt));
              if (tt < 128) ((LAS float*)(lds + att::D_OFF_TBL))[tt] = tt <= 112 ? (relb[t5_bucket(tt) * 16 + h] - relb[31 * 16 + h]) * INV_SCALE : 0.f; }
            f32x16 o[8];
            for (int br = 0; br < 2; ++br) {
                att::PassArgs a;
                a.Q = proj + (size_t)qrow0 * LD_OD + h * 256 + br * 128; a.ldq = LD_OD; a.Q2 = nullptr; a.ldq2 = 0;
                a.K = proj + 4096 + h * 256 + br * 128; a.ldk = LD_OD; a.K2 = nullptr; a.ldk2 = 0; a.V = proj + 8192 + h * 256; a.ldv = LD_OD;
                a.cum = nullptr; a.krow0 = b * SEQ; a.qvp0 = meta ? 0 : 64 + qb * 256; a.NT = meta ? 1 : 4 * qb + 5; a.shift0 = meta ? 0 : 48;
                if constexpr (PVAR == 0) att::attn_pass_diff(a, lds, o, F.tid); else att::attn_pass_diff_probe<PVAR>(a, lds, o, F.tid);
                if (br == 0) {
                    int tq = F.tid; asm volatile("" : "+v"(tq));
                    float* S1 = S1base + (size_t)tq * 4;
#pragma unroll
                    for (int d = 0; d < 8; ++d) {
#pragma unroll
                        for (int q = 0; q < 4; ++q) *(f32x4*)(S1 + (d * 4 + q) * 2048) = (f32x4){o[d][4 * q], o[d][4 * q + 1], o[d][4 * q + 2], o[d][4 * q + 3]}; }
                }
            }
            {
                int tq = F.tid; asm volatile("" : "+v"(tq));
                const float* S1 = S1base + (size_t)tq * 4;
                const float lam = ((const float*)(ws + WS_PRM))[o_idx];
                VM_WAIT();
#pragma unroll
                for (int d = 0; d < 8; ++d) {
#pragma unroll
                    for (int q = 0; q < 4; ++q) { const f32x4 s1 = *(const f32x4*)(S1 + (d * 4 + q) * 2048);
#pragma unroll
                        for (int j = 0; j < 4; ++j) o[d][4 * q + j] = s1[j] - lam * o[d][4 * q + j]; }
                    asm volatile("" ::: "memory"); }
            }
            int tq2 = F.tid; asm volatile("" : "+v"(tq2));
            const int r32 = tq2 & 31;
            float ssum[16];
#pragma unroll
            for (int r = 0; r < 16; ++r) { float t = 0.f;
#pragma unroll
                for (int d = 0; d < 8; ++d) t += o[d][r] * o[d][r];
#pragma unroll
                for (int off = 1; off < 32; off <<= 1) t += __shfl_xor(t, off);
                ssum[r] = __builtin_amdgcn_rsqf(t * (1.0f / 256.0f) + EPS) * post; }
#pragma unroll
            for (int d = 0; d < 8; ++d) { const float g = subg[d * 32 + r32];
#pragma unroll
                for (int r = 0; r < 16; ++r) o[d][r] *= ssum[r] * g; }
            bf16_t* Ow = obuf + (size_t)(qrow0 + F.wave * 32) * LD_DM + h * 256;
            att::store_o_bf16(o, Ow, LD_DM, F.tid);
            att::store_o_bf16(o + 4, Ow + 128, LD_DM, F.tid);
        }
    }
}
#endif

#ifndef PHM
#define PHM 1023
#endif
#ifndef P4SUB
#define P4SUB 7
#endif
constexpr int PPL = 9, N_PHASES = 2 + PPL * DEPTH;
__global__ void __launch_bounds__(512, 2) mega_fwd(Args args) {
    extern __shared__ __attribute__((aligned(16))) unsigned char lds_raw[];
    Frame F;
    F.lds = (LAS unsigned char*)lds_raw;
    const int wave_s = __builtin_amdgcn_readfirstlane((int)threadIdx.x >> 6);
    F.tid = opq_tid(wave_s); F.lane = F.tid & 63; F.wave = wave_s;
    F.G = gridDim.x; { const int bx = blockIdx.x; F.bx = bx; F.vcu = (F.G % 8 == 0) ? (bx % 8) * (F.G / 8) + bx / 8 : bx; }
    F.ws = args.ws;
    unsigned char* ws = args.ws;
    volatile LAS unsigned* MISC = (volatile LAS unsigned*)(F.lds + MISC_OFF);
    for (int u = F.tid; u < (LDS_BYTES - 135168) / 4; u += 512) ((LAS unsigned*)(F.lds + 135168))[u] = 0u;
    __syncthreads();
#if MK_ONE_LAUNCH
    XcdBarrier bar = xcd_barrier_post((unsigned*)(ws + WS_CTL) + CW_BAR, MISC + 8, F.tid);
#define IN(k) true
#else
    const int lo = args.ph_lo, hi = args.ph_hi;
    XcdBarrier bar; bar.bar = (unsigned*)(ws + WS_CTL) + CW_BAR; bar.x = 0; bar.st = nullptr;
    if (hi - lo > 1) bar = xcd_barrier_post((unsigned*)(ws + WS_CTL) + CW_BAR, MISC + 8, F.tid);
#define IN(k) (lo <= (k) && (k) < hi)
#endif
#define REFRESH() Frame Fp = F; { const int t_ = opq_tid(wave_s); Fp.tid = t_; Fp.lane = t_ & 63; size_t z_ = 0; asm volatile("" : "+s"(z_)); Fp.ws = args.ws + z_; Fp.vcu = opq_s(F.vcu); Fp.G = opq_s(F.G); Fp.bx = opq_s(F.bx); } unsigned char* ws = Fp.ws; (void)ws
#define SEAM(k, kn) do { if (IN(k) && IN(kn)) { XcdBarrier b_; size_t z_ = 0; asm volatile("" : "+s"(z_)); b_.bar = (unsigned*)(args.ws + z_ + WS_CTL) + CW_BAR; b_.x = xb_xcc_id(); b_.st = MISC + 8; xcd_barrier(b_, opq_tid(wave_s)); } } while (0)
#define PTRS() bf16_t* hbf = (bf16_t*)(ws + WS_HBF); bf16_t* proj = (bf16_t*)(ws + WS_PROJ); bf16_t* qbuf = (bf16_t*)(ws + WS_QBUF); bf16_t* kvbuf = (bf16_t*)(ws + WS_KVBUF); \
    bf16_t* obuf = (bf16_t*)(ws + WS_OBUF); bf16_t* mbuf = (bf16_t*)(ws + WS_MBUF); bf16_t* act = (bf16_t*)(ws + WS_PROJ); \
    pg8::EpiCtx ec; ec.O = nullptr; ec.ldc = 0; ec.rs = (const float*)(ws + WS_RSTD); ec.statq = (float*)(ws + WS_STATQ); ec.statkv = (float*)(ws + WS_STATKV); \
    ec.flogT = (float*)(ws + WS_FLOG); ec.cosT = (const float*)(ws + WS_COS); ec.sinT = (const float*)(ws + WS_SIN); ec.statm = (float*)(ws + WS_STATM); ec.part = (float*)(ws + WS_PART); ec.cs = nullptr; ec.amaxp = (float*)(ws + WS_AMAXP); \
    (void)hbf; (void)proj; (void)qbuf; (void)kvbuf; (void)obuf; (void)mbuf; (void)act

#if PHM & 1
    if (IN(0)) { p0_prologue(args, F); }
#endif
    SEAM(0, 1);
#if PHM & 1
    if (IN(1)) { REFRESH(); cvt_items<1>(args, Fp); }
#endif
    SEAM(1, 2);
#define LAYER() opq_s(layer0)
#define BASE() (2 + PPL * layer0)
#define EVEN() ((LAYER() & 1) == 0)
#define DN8() (((I8_DN >> LAYER()) & 1) != 0)
#define REFRESH_L() REFRESH(); const int layer = LAYER(), e = layer >> 1; (void)e; (void)layer
    for (int layer0 = 0; layer0 < DEPTH; ++layer0) {
#if PHM & 2
        if (IN(BASE())) {
            REFRESH_L(); PTRS();
            if (EVEN() && !((I8_IN_EV >> e) & 1)) {
                pg8::Gemm g{hbf, (const bf16_t*)(ws + W_EVIN + e * SZ_EVIN), LD_DM, LD_DM, DM}; pg8::StaticOrder S; S.init(MPAD, EV_N, Fp.G, Fp.bx);
                pg8::Epi<1> E{ec}; E.c.O = proj; E.c.ldc = LD_EV;
                pg8::gemm_phase<pg8::Epi<1>, pg8::StaticOrder, true, true>(Fp.lds, g, S, E, Fp.tid);
            } else if (EVEN()) {
                pg8::Gemm g{(const bf16_t*)(ws + WS_OBUF), (const bf16_t*)(ws + W_EVIN + e * SZ_EVIN), LD8 / 2, LD8 / 2, DM / 2}; pg8::StaticOrder S; S.init(MPAD, EV_N, Fp.G, Fp.bx);
                pg8::Epi<9> E{ec}; E.c.O = proj; E.c.ldc = LD_EV; E.c.rs = (const float*)(ws + WS_RS8); E.c.cs = (const float*)(ws + WS_CTL + CTL_COLMAX_EV) + (size_t)e * EV_N;
                pg8::gemm_phase<pg8::Epi<9>, pg8::StaticOrder, true, true, 2>(Fp.lds, g, S, E, Fp.tid);
            } else if ((I8_IN_ODD >> e) & 1) {
                pg8::Gemm g{(const bf16_t*)(ws + WS_OBUF), (const bf16_t*)(ws + W_GU + (size_t)layer * SZ_GU + W_OD8_OFF), LD8 / 2, LD8 / 2, DM / 2}; pg8::StaticOrder S; S.init(MREAL, OD_N, Fp.G, Fp.bx);
                pg8::Epi<8> E{ec}; E.c.O = proj; E.c.ldc = LD_OD; E.c.rs = (const float*)(ws + WS_RS8); E.c.cs = (const float*)(ws + WS_CTL + CTL_COLMAX_OD) + (size_t)e * OD_N;
                pg8::gemm_phase<pg8::Epi<8>, pg8::StaticOrder, true, true, 2>(Fp.lds, g, S, E, Fp.tid);
            } else {
                pg8::Gemm g{hbf, (const bf16_t*)(ws + W_ODIN + e * SZ_ODIN), LD_DM, LD_DM, DM}; pg8::StaticOrder S; S.init(MREAL, OD_N, Fp.G, Fp.bx);
                pg8::Epi<0> E{ec}; E.c.O = proj; E.c.ldc = LD_OD;
                pg8::gemm_phase<pg8::Epi<0>, pg8::StaticOrder, true, true>(Fp.lds, g, S, E, Fp.tid);
            }
        }
        if (!EVEN() && IN(BASE())) {
            REFRESH_L(); PTRS();
            if ((I8_IN_ODD >> e) & 1) {
                pg8::Gemm g{(const bf16_t*)(ws + WS_OBUF), (const bf16_t*)(ws + W_GU + (size_t)layer * SZ_GU + W_OD8_OFF), LD8 / 2, LD8 / 2, 128}; pg8::SplitKOrder S; S.init(MREAL / 256, OD_N, DM / 256, 128, Fp.G, Fp.bx);
                pg8::Epi<6> E{ec}; E.c.ldc = OD_N;
                pg8::gemm_phase<pg8::Epi<6>, pg8::SplitKOrder, true, false, 2>(Fp.lds, g, S, E, Fp.tid);
            } else {
                pg8::Gemm g{hbf, (const bf16_t*)(ws + W_ODIN + e * SZ_ODIN), LD_DM, LD_DM, 256}; pg8::SplitKOrder S; S.init(MREAL / 256, OD_N, DM / 256, 256, Fp.G, Fp.bx);
                pg8::Epi<6> E{ec}; E.c.ldc = OD_N;
                pg8::gemm_phase<pg8::Epi<6>, pg8::SplitKOrder, true, false>(Fp.lds, g, S, E, Fp.tid);
            }
        }
#endif
        SEAM(BASE(), BASE() + 1);
#if PHM & 4
        if (EVEN() && IN(BASE() + 1)) {
#if P4SUB & 1
            REFRESH_L();
            scan_phase(args, Fp, e);
#endif
#if P4SUB & 2
            {   REFRESH_L(); PTRS();
                pg8::Gemm g{proj + EV_CQ, (const bf16_t*)(ws + W_UQ + e * SZ_UQ), LD_EV, LD_QR, QRANK}; pg8::StaticOrder S; S.init(MPAD, UQ_N, Fp.G, Fp.bx);
                pg8::Epi<2> E{ec}; E.c.O = qbuf; E.c.ldc = LD_UQ; E.c.rs = (const float*)(ws + WS_STATQ);
                pg8::gemm_phase<pg8::Epi<2>, pg8::StaticOrder, true, true>(Fp.lds, g, S, E, Fp.tid); }
#endif
#if P4SUB & 4
            {   REFRESH_L(); PTRS();
                pg8::Gemm g{proj + EV_CKV, (const bf16_t*)(ws + W_UKV + e * SZ_UKV), LD_EV, LD_KV, KVK}; pg8::StaticOrder S; S.init(MPAD, UKV_N, Fp.G, Fp.bx);
                pg8::Epi<3> E{ec}; E.c.O = kvbuf; E.c.ldc = LD_UKV; E.c.rs = (const float*)(ws + WS_STATKV);
                pg8::gemm_phase<pg8::Epi<3>, pg8::StaticOrder, true, true>(Fp.lds, g, S, E, Fp.tid); }
#endif
        }
#endif
        if (!EVEN() && IN(BASE() + 1)) { REFRESH_L(); fixup_odd_meta(Fp, e); }
        SEAM(BASE() + 1, BASE() + 2);
#if PHM & 8
        if (IN(BASE() + 2) && EVEN()) { REFRESH_L(); attn_even_phase(Fp); }
#endif
#if PHM & 16
        if (IN(BASE() + 2) && !EVEN()) { REFRESH_L(); attn_odd_phase(args, Fp, e); }
#endif
        SEAM(BASE() + 2, BASE() + 3);
#if PHM & 32
        if (IN(BASE() + 3)) {
            REFRESH_L(); PTRS();
            {   pg8::Gemm g{obuf, (const bf16_t*)(ws + (EVEN() ? W_EVOUT : W_ODOUT) + e * SZ_SQ), LD_DM, LD_DM, DM}; pg8::StaticOrder S; S.init(MREAL, DM, Fp.G, Fp.bx);
                pg8::Epi<4> E{ec}; E.c.O = mbuf; E.c.ldc = LD_DM;
                pg8::gemm_phase<pg8::Epi<4>, pg8::StaticOrder, true, true>(Fp.lds, g, S, E, Fp.tid); }
            {   REFRESH_L(); PTRS();
                pg8::Gemm g{obuf, (const bf16_t*)(ws + (EVEN() ? W_EVOUT : W_ODOUT) + e * SZ_SQ), LD_DM, LD_DM, 256}; pg8::SplitKOrder S; S.init(MREAL / 256, DM, DM / 256, 256, Fp.G, Fp.bx);
                pg8::Epi<6> E{ec}; E.c.ldc = DM;
                pg8::gemm_phase<pg8::Epi<6>, pg8::SplitKOrder, true, false>(Fp.lds, g, S, E, Fp.tid); }
        }
#endif
        SEAM(BASE() + 3, BASE() + 4);
#if PHM & 64
        if (IN(BASE() + 4)) { REFRESH_L(); ew_phase(args, Fp, layer, 0); }
#endif
        SEAM(BASE() + 4, BASE() + 5);
#if PHM & 128
        if (IN(BASE() + 5)) {
            REFRESH_L(); PTRS();
            pg8::Gemm g{(const bf16_t*)(ws + WS_A8), (const bf16_t*)(ws + W_GU + layer * SZ_GU), LD8 / 2, LD8 / 2, DM / 2}; pg8::StaticOrder S; S.init(MPAD, GU_N, Fp.G, Fp.bx, 4);
            pg8::Epi<7> E{ec}; E.c.O = act; E.c.ldc = LD_FF; E.c.rs = (const float*)(ws + WS_RS8); E.c.cs = (const float*)(ws + WS_CTL + CTL_COLMAX) + (size_t)layer * GU_N;
            pg8::gemm_phase<pg8::Epi<7>, pg8::StaticOrder, true, true, 2>(Fp.lds, g, S, E, Fp.tid);
        }
#endif
        if (DN8()) SEAM(BASE() + 5, BASE() + 6);
        if (DN8() && IN(BASE() + 6)) { REFRESH_L(); actq_phase(Fp); }
        SEAM(DN8() ? BASE() + 6 : BASE() + 5, BASE() + 7);
#if PHM & 256
        if (IN(BASE() + 7) && DN8()) {
            REFRESH_L(); PTRS();
            {   pg8::Gemm g{(const bf16_t*)(ws + WS_ACT8), (const bf16_t*)(ws + W_DN + layer * SZ_DN), LD8F / 2, LD8F / 2, DFF / 2}; pg8::StaticOrder S; S.init(MREAL, DM, Fp.G, Fp.bx);
                pg8::Epi<10> E{ec}; E.c.O = mbuf; E.c.ldc = LD_DM; E.c.rs = (const float*)(ws + WS_RSD); E.c.cs = (const float*)(ws + WS_CTL + CTL_COLMAX_DN) + (size_t)layer * DM;
                pg8::gemm_phase<pg8::Epi<10>, pg8::StaticOrder, true, true, 2>(Fp.lds, g, S, E, Fp.tid); }
            {   REFRESH_L(); PTRS();
                pg8::Gemm g{(const bf16_t*)(ws + WS_ACT8), (const bf16_t*)(ws + W_DN + layer * SZ_DN), LD8F / 2, LD8F / 2, 128}; pg8::SplitKOrder S; S.init(MREAL / 256, DM, DFF / 256, 128, Fp.G, Fp.bx);
                pg8::Epi<6> E{ec}; E.c.ldc = DM;
                pg8::gemm_phase<pg8::Epi<6>, pg8::SplitKOrder, true, false, 2>(Fp.lds, g, S, E, Fp.tid); }
        }
        if (IN(BASE() + 7) && !DN8()) {
            REFRESH_L(); PTRS();
            {   pg8::Gemm g{act, (const bf16_t*)(ws + W_DN + layer * SZ_DN), LD_FF, LD_FF, DFF}; pg8::StaticOrder S; S.init(MREAL, DM, Fp.G, Fp.bx);
                pg8::Epi<4> E{ec}; E.c.O = mbuf; E.c.ldc = LD_DM;
                pg8::gemm_phase<pg8::Epi<4>, pg8::StaticOrder, true, true>(Fp.lds, g, S, E, Fp.tid); }
            {   REFRESH_L(); PTRS();
                pg8::Gemm g{act, (const bf16_t*)(ws + W_DN + layer * SZ_DN), LD_FF, LD_FF, 256}; pg8::SplitKOrder S; S.init(MREAL / 256, DM, DFF / 256, 256, Fp.G, Fp.bx);
                pg8::Epi<6> E{ec}; E.c.ldc = DM;
                pg8::gemm_phase<pg8::Epi<6>, pg8::SplitKOrder, true, false>(Fp.lds, g, S, E, Fp.tid); }
        }
#endif
        SEAM(BASE() + 7, BASE() + 8);
#if PHM & 512
        if (IN(BASE() + 8)) { REFRESH_L(); ew_phase(args, Fp, layer, 1); }
#endif
        if (layer0 + 1 < DEPTH) SEAM(BASE() + 8, BASE() + 9);
    }
#ifdef PROBE_ATT
    if (IN(N_PHASES)) { REFRESH(); attn_odd_phase_probe<PROBE_ATT>(args, Fp, 1); }
#endif
#ifdef PROBE_EW
    if (IN(N_PHASES)) { REFRESH(); ew_phase(args, Fp, 1, 0); }
#endif
#ifdef PROBE_GEMM
    if (IN(N_PHASES)) {
        REFRESH(); PTRS();
#ifndef PROBE_LD
#define PROBE_LD LD_DM
#endif
        pg8::Gemm g{hbf, (const bf16_t*)(ws + W_GU), PROBE_LD, PROBE_LD, DM}; pg8::StaticOrder S; S.init(PROBE_LD ? MPAD : 256, PROBE_LD ? GU_N : 256 * 86 * 65, Fp.G, Fp.bx, PROBE_WGM);
        pg8::Epi<5> E{ec}; E.c.O = act; E.c.ldc = LD_FF;
        pg8::gemm_phase<pg8::Epi<5>, pg8::StaticOrder, PROBE_ALIGN, PROBE_SP2>(Fp.lds, g, S, E, Fp.tid);
    }
#endif
#undef PTRS
#undef REFRESH
#undef REFRESH_L
#undef LAYER
#undef BASE
#undef EVEN
#undef DN8
#undef IN
#undef SEAM
}

#ifndef MK_ONE_LAUNCH
#define MK_ONE_LAUNCH 1
#endif
extern "C" void kernel_launch(void* const* d_in, const int* in_sizes, int n_in, void* d_out, int out_size, void* d_ws, size_t ws_size, hipStream_t stream) {
    static int grid = 0;
    if (grid == 0) {
        if (n_in != 18 || in_sizes[0] != NB * SEQ * DM || out_size != NB * SEQ * DM || ws_size < WS_END) {
            fprintf(stderr, "kernel_launch: unexpected shapes or workspace (n_in %d, in0 %d, out %d, ws %zu < %zu); nothing launched\n", n_in, n_in > 0 ? in_sizes[0] : -1, out_size, ws_size, (size_t)WS_END); grid = -1; return; }
        int dev = 0, cus = 0;
        if (hipGetDevice(&dev) != hipSuccess || hipDeviceGetAttribute(&cus, hipDeviceAttributeMultiprocessorCount, dev) != hipSuccess || cus <= 0) { fprintf(stderr, "kernel_launch: device query failed\n"); grid = -1; return; }
        if (hipFuncSetAttribute((const void*)mega_fwd, hipFuncAttributeMaxDynamicSharedMemorySize, LDS_BYTES) != hipSuccess) { fprintf(stderr, "kernel_launch: hipFuncSetAttribute failed\n"); grid = -1; return; }
        int per_cu = 0;
        if (hipOccupancyMaxActiveBlocksPerMultiprocessor(&per_cu, (const void*)mega_fwd, 512, LDS_BYTES) != hipSuccess || per_cu < 1) fprintf(stderr, "kernel_launch: note: occupancy query reports %d workgroups per CU\n", per_cu);
        (void)hipGetLastError();
        grid = cus > 256 ? 256 : cus;
    }
    if (grid < 0) return;
    if (hipMemsetAsync((char*)d_ws + WS_CTL, 0, CTL_ZERO_BYTES, stream) != hipSuccess) { fprintf(stderr, "kernel_launch: memset failed\n"); return; }
    Args a{};
    for (int i = 0; i < 18; ++i) a.in[i] = (const float*)d_in[i];
    a.out = (float*)d_out; a.ws = (unsigned char*)d_ws;
    a.lam_init[0] = (float)(0.8 - 0.6 * exp(-0.3 * 1.0)); a.lam_init[1] = (float)(0.8 - 0.6 * exp(-0.3 * 3.0));
#if MK_ONE_LAUNCH
    a.ph_lo = 0; a.ph_hi = N_PHASES;
    hipLaunchKernelGGL(mega_fwd, dim3(grid), dim3(512), LDS_BYTES, stream, a);
#else
    for (int k = 0; k < N_PHASES; ++k) {
        a.ph_lo = k; a.ph_hi = k + 1;
        hipLaunchKernelGGL(mega_fwd, dim3(grid), dim3(512), LDS_BYTES, stream, a);
#ifdef PROBE_MASK
        { const int off = k < 2 ? 9 : ((k - 2) % PPL); if ((PROBE_MASK >> off) & 1) hipLaunchKernelGGL(mega_fwd, dim3(grid), dim3(512), LDS_BYTES, stream, a); }
#endif
    }
#if defined(PROBE_GEMM) || defined(PROBE_EW) || defined(PROBE_ATT)
    for (int r = 0; r < PROBE_REP; ++r) { a.ph_lo = N_PHASES; a.ph_hi = N_PHASES + 1; hipLaunchKernelGGL(mega_fwd, dim3(grid), dim3(512), LDS_BYTES, stream, a); }
#endif
#endif
}
```

```cpp
#define MK_ONE_LAUNCH 1
#include <hip/hip_runtime.h>
#include <cstdio>
#include <cstdint>
#include <cmath>

#define LAS __attribute__((address_space(3)))
#define GAS __attribute__((address_space(1)))
typedef unsigned short bf16_t;
typedef short bf16x8 __attribute__((ext_vector_type(8)));
typedef short s16x4 __attribute__((ext_vector_type(4)));
typedef float f32x2 __attribute__((ext_vector_type(2)));
typedef float f32x4 __attribute__((ext_vector_type(4)));
typedef float f32x16 __attribute__((ext_vector_type(16)));
typedef unsigned u32x2 __attribute__((ext_vector_type(2)));
typedef unsigned u32x4 __attribute__((ext_vector_type(4)));
typedef int i32x4 __attribute__((ext_vector_type(4)));
typedef int i32x8 __attribute__((ext_vector_type(8)));

constexpr int DM = 4096, NB = 4, SEQ = 4096, NMETA = 16, DEPTH = 4;
constexpr int MREAL = NB * SEQ;
constexpr int META0 = MREAL;
constexpr int MUSED = MREAL + NMETA;
constexpr int MPAD = 16640;
constexpr int DFF = 11008;
constexpr int NPOS = NMETA + SEQ;
constexpr float EPS = 1e-6f;
constexpr int EV_N = 7680, EV_QF = 0, EV_KF = 2048, EV_VF = 4096, EV_CQ = 6144, EV_CKV = 7040, EV_KR = 7360, EV_FL = 7424;
constexpr int QRANK = 896, KVRANK = 320, KVK = 384;
constexpr int UQ_N = 3072, UKV_N = 4096, OD_N = 12288, GU_N = 2 * DFF;
constexpr int EV_SRC_N = 7440;
constexpr int AMAXP_LD = 352;
constexpr int LD_DM = 4160, LD_FF = 11072, LD_EV = 7744, LD_OD = 12352, LD_UQ = 3136, LD_UKV = 4160, LD_QR = 960, LD_KV = 448;

__device__ __forceinline__ unsigned cvt_pk_bf16(float lo, float hi) { unsigned r; asm volatile("v_cvt_pk_bf16_f32 %0, %1, %2" : "=v"(r) : "v"(lo), "v"(hi)); return r; }
__device__ __forceinline__ float bf_lo(unsigned w) { return __uint_as_float(w << 16); }
__device__ __forceinline__ float bf_hi(unsigned w) { return __uint_as_float(w & 0xffff0000u); }
__device__ __forceinline__ float wave_sum(float v) {
#pragma unroll
    for (int o = 1; o < 64; o <<= 1) v += __shfl_xor(v, o);
    return v;
}

__device__ __forceinline__ int opq_tid(int wave) {
    int l; asm volatile("v_mbcnt_lo_u32_b32 %0, -1, 0\n\tv_mbcnt_hi_u32_b32 %0, -1, %0" : "=v"(l));
    return (wave << 6) | l;
}

__device__ __forceinline__ int opq_s(int v) { asm volatile("" : "+s"(v)); return v; }

namespace pg8 {
#define PG8_LAS __attribute__((address_space(3)))
constexpr int RS_LDS_OFF = 131072;
constexpr int BM = 256, BK = 64, HALF = 128, HTB = HALF * BK * 2  , STAGE_BYTES = 8 * HTB, NXCD = 8, WGM = 8;

__host__ __device__ __forceinline__ int lds_byte(int r, int c) { const int st = (r >> 4) * 2 + (c >> 5), rr = r & 15, cc = c & 31, ob = rr * 64 + cc * 2; return st * 1024 + (ob ^ (((ob >> 9) & 1) << 5)); }
__host__ __device__ __forceinline__ void stage_rc(int b, int& R, int& C) { const int st = b / 1024, sb = b % 1024, swz = sb ^ (((sb >> 9) & 1) << 5); R = (st >> 1) * 16 + swz / 64; C = (st & 1) * 32 + (swz % 64) / 2; }
__host__ __device__ __forceinline__ int perm32(int rho) { const int n = rho >> 4, i = rho & 15; return 8 * (i >> 2) + 4 * n + (i & 3); }

struct Unit { int pm, pn, ko, ks; };
struct Gemm { const bf16_t* A; const bf16_t* Bt; int lda, ldb, K; };

struct StaticOrder {
    int nM, nN, nwg, G, c, wgm;
    __host__ __device__ void init(int M, int N, int G_, int c_, int wgm_ = WGM) { nM = M / BM; nN = N / BM; nwg = nM * nN; G = G_; c = c_; wgm = wgm_; }
    __host__ __device__ bool next(int i, Unit& u) const {
        const long L = (long)i * G + c; if (L >= nwg) return false;
        int wgid = (int)L; { const int q = nwg / NXCD, r = nwg % NXCD, xcd = wgid % NXCD, off = wgid / NXCD; wgid = (xcd < r ? xcd * (q + 1) : r * (q + 1) + (xcd - r) * q) + off; }
        const int nig = wgm * nN, gid = wgid / nig, fm = gid * wgm, gsz = (nM - fm) < wgm ? (nM - fm) : wgm;
        u.pm = fm + ((wgid % nig) % gsz); u.pn = (wgid % nig) / gsz; u.ko = 0; u.ks = 0; return true;
    }
    __device__ __forceinline__ void a_ready(const Unit&) const {}
    __device__ __forceinline__ void done(const Unit&) const {}
};
struct SplitKOrder {
    int pm, nN, nS, kslice, G, c;
    __host__ __device__ void init(int pm_, int N, int nS_, int kslice_, int G_, int c_) { pm = pm_; nN = N / BM; nS = nS_; kslice = kslice_; G = G_; c = c_; }
    __host__ __device__ bool next(int i, Unit& u) const {
        const int L = i * G + c; if (L >= nN * nS) return false;
        u.pm = pm; u.pn = L % nN; u.ks = L / nN; u.ko = u.ks * kslice; return true;
    }
    __device__ __forceinline__ void a_ready(const Unit&) const {}
    __device__ __forceinline__ void done(const Unit&) const {}
};

struct EpiCtx {
    bf16_t* O; int ldc;
    const float* rs;
    float* statq; float* statkv;
    float* flogT;
    const float* cosT; const float* sinT;
    float* statm;
    float* part;
    const float* cs;
    float* amaxp;
};
__device__ __forceinline__ int row_pos(int row) { return row < MREAL ? NMETA + (row & (SEQ - 1)) : row - META0; }
__device__ __forceinline__ void store8(bf16_t* p, f32x4 v0, f32x4 v1) {
    u32x4 w; w.x = cvt_pk_bf16(v0[0], v0[1]); w.y = cvt_pk_bf16(v0[2], v0[3]); w.z = cvt_pk_bf16(v1[0], v1[1]); w.w = cvt_pk_bf16(v1[2], v1[3]);
    *(u32x4*)p = w;
}
__device__ __forceinline__ float sel4(const float (&a)[4], int i) { return i == 0 ? a[0] : (i == 1 ? a[1] : (i == 2 ? a[2] : a[3])); }
__device__ __forceinline__ float sq8(f32x4 a, f32x4 b) { return (a[0] * a[0] + a[1] * a[1]) + (a[2] * a[2] + a[3] * a[3]) + (b[0] * b[0] + b[1] * b[1]) + (b[2] * b[2] + b[3] * b[3]); }
__device__ __forceinline__ float silu_mul(float g, float u) { return g * __builtin_amdgcn_rcpf(1.0f + __builtin_amdgcn_exp2f(-1.4426950408889634f * g)) * u; }

__device__ __forceinline__ void fwht32_lanes(f32x4& a, f32x4& b, float s16, float s32) {
    f32x4 t;
    t = (f32x4){a[0] + a[1], a[0] - a[1], a[2] + a[3], a[2] - a[3]}; a = (f32x4){t[0] + t[2], t[1] + t[3], t[0] - t[2], t[1] - t[3]};
    t = (f32x4){b[0] + b[1], b[0] - b[1], b[2] + b[3], b[2] - b[3]}; b = (f32x4){t[0] + t[2], t[1] + t[3], t[0] - t[2], t[1] - t[3]};
    t = a + b; b = a - b; a = t;
#pragma unroll
    for (int j = 0; j < 4; ++j) {
        auto r = __builtin_amdgcn_permlane16_swap(__float_as_uint(a[j]), __float_as_uint(a[j]), false, false); a[j] = __builtin_fmaf(s16, __uint_as_float(r[1]), __uint_as_float(r[0]));
        auto q = __builtin_amdgcn_permlane16_swap(__float_as_uint(b[j]), __float_as_uint(b[j]), false, false); b[j] = __builtin_fmaf(s16, __uint_as_float(q[1]), __uint_as_float(q[0])); }
#pragma unroll
    for (int j = 0; j < 4; ++j) {
        auto r = __builtin_amdgcn_permlane32_swap(__float_as_uint(a[j]), __float_as_uint(a[j]), false, false); a[j] = __builtin_fmaf(s32, __uint_as_float(r[1]), __uint_as_float(r[0]));
        auto q = __builtin_amdgcn_permlane32_swap(__float_as_uint(b[j]), __float_as_uint(b[j]), false, false); b[j] = __builtin_fmaf(s32, __uint_as_float(q[1]), __uint_as_float(q[0])); }
}
template <int MODE> struct Epi {
    static constexpr bool PERM = true, AFTER_DRAIN = false;
    EpiCtx c;
    static constexpr bool EVM = (MODE == 1 || MODE == 9), I8M = (MODE == 8 || MODE == 9 || MODE == 10), OUTM = (MODE == 4 || MODE == 10);
    static constexpr bool RS_LDS = (MODE == 0 || MODE == 1 || MODE == 5 || MODE == 7 || MODE == 8 || MODE == 9 || MODE == 10), CS_LDS = (MODE == 7 || MODE == 8 || MODE == 9 || MODE == 10);
    __device__ __forceinline__ void pre(const Unit& u, PG8_LAS unsigned char* slot, int wid) const {
        if constexpr (RS_LDS) { if (wid < 4) { int l; asm volatile("v_mbcnt_lo_u32_b32 %0, -1, 0\n\tv_mbcnt_hi_u32_b32 %0, -1, %0" : "=v"(l));
            const char* b = (const char*)(c.rs + u.pm * BM + wid * 64); asm volatile("" : "+s"(b));
            __builtin_amdgcn_global_load_lds((const unsigned*)(b + (unsigned)(l * 4)), (PG8_LAS unsigned*)(slot + wid * 256), 4, 0, 0); } }
        if constexpr (CS_LDS) { if (wid >= 4) { int l; asm volatile("v_mbcnt_lo_u32_b32 %0, -1, 0\n\tv_mbcnt_hi_u32_b32 %0, -1, %0" : "=v"(l));
            const char* b = (const char*)(c.cs + u.pn * BM + (wid - 4) * 64); asm volatile("" : "+s"(b));
            __builtin_amdgcn_global_load_lds((const unsigned*)(b + (unsigned)(l * 4)), (PG8_LAS unsigned*)(slot + 2048 + (wid - 4) * 256), 4, 0, 0); } }
    }
    __device__ __forceinline__ void operator()(const f32x4 (&acc)[2][2][4][2], const Unit& u, int wr, int wc, int fr, int fq, const PG8_LAS float* rsl) const {
        int pm_ = u.pm, pn_ = u.pn; asm volatile("" : "+s"(pm_), "+s"(pn_));
        if constexpr (MODE == 6) {
            if (wr == 0) { float* P = c.part + (unsigned)((u.ks * 16 + fr) * c.ldc + pn_ * BM + wc * 32 + 8 * fq);
#pragma unroll
                for (int bj = 0; bj < 2; ++bj) { *(f32x4*)(P + bj * HALF) = acc[0][bj][0][0]; *(f32x4*)(P + bj * HALF + 4) = acc[0][bj][0][1]; } }
            return;
        }
        const Unit uu{pm_, pn_};
        const int row0 = uu.pm * BM + wr * 64 + fr;
        float s[2][4];
#pragma unroll
        for (int ai = 0; ai < 2; ++ai)
#pragma unroll
            for (int m = 0; m < 4; ++m) {
                const int row = row0 + ai * HALF + m * 16;
                if constexpr (RS_LDS) s[ai][m] = rsl[ai * HALF + wr * 64 + m * 16 + fr];
                else if constexpr (MODE == 2) { const f32x4* q = (const f32x4*)(c.rs + (unsigned)(row * 32)); f32x4 t = q[0];
#pragma unroll
                    for (int k = 1; k < 7; ++k) t += q[k];
                    s[ai][m] = __builtin_amdgcn_rsqf(((t[0] + t[1]) + (t[2] + t[3])) * (1.0f / QRANK) + EPS); }
                else if constexpr (MODE == 3) { const f32x4* q = (const f32x4*)(c.rs + (unsigned)(row * 16)); const f32x4 t = q[0] + q[1]; const f32x2 t2 = *(const f32x2*)(q + 2);
                    s[ai][m] = __builtin_amdgcn_rsqf((((t[0] + t[1]) + (t[2] + t[3])) + (t2[0] + t2[1])) * (1.0f / KVRANK) + EPS); }
                else s[ai][m] = 1.0f;
            }
        if constexpr (MODE == 7) {
            const int col0 = uu.pn * HALF + wc * 32 + 8 * fq;
            const PG8_LAS float* csl = rsl + 512 + wc * 32 + 8 * fq;
            const f32x4 cg0 = *(const PG8_LAS f32x4*)csl, cg1 = *(const PG8_LAS f32x4*)(csl + 4), cu0 = *(const PG8_LAS f32x4*)(csl + HALF), cu1 = *(const PG8_LAS f32x4*)(csl + HALF + 4);
#pragma unroll
            for (int ai = 0; ai < 2; ++ai)
#pragma unroll
                for (int m = 0; m < 4; ++m) {
                    const int row = row0 + ai * HALF + m * 16; const float sc = s[ai][m];
                    const f32x4 g0 = __builtin_convertvector(__builtin_bit_cast(i32x4, acc[ai][0][m][0]), f32x4) * (cg0 * sc), g1 = __builtin_convertvector(__builtin_bit_cast(i32x4, acc[ai][0][m][1]), f32x4) * (cg1 * sc);
                    const f32x4 u0 = __builtin_convertvector(__builtin_bit_cast(i32x4, acc[ai][1][m][0]), f32x4) * (cu0 * sc), u1 = __builtin_convertvector(__builtin_bit_cast(i32x4, acc[ai][1][m][1]), f32x4) * (cu1 * sc);
                    f32x4 e0 = g0 * -1.4426950408889634f, e1 = g1 * -1.4426950408889634f;
#pragma unroll
                    for (int j = 0; j < 4; ++j) { e0[j] = __builtin_amdgcn_exp2f(e0[j]); e1[j] = __builtin_amdgcn_exp2f(e1[j]); }
                    e0 = e0 + 1.0f; e1 = e1 + 1.0f;
                    const f32x4 p0 = g0 * u0, p1 = g1 * u1;
#pragma unroll
                    for (int j = 0; j < 4; ++j) { e0[j] = __builtin_amdgcn_rcpf(e0[j]); e1[j] = __builtin_amdgcn_rcpf(e1[j]); }
                    store8(c.O + (unsigned)(row * c.ldc + col0), p0 * e0, p1 * e1);
                }
            return;
        } else if constexpr (MODE == 5) {
            const int col0 = uu.pn * HALF + wc * 32 + 8 * fq;
#pragma unroll
            for (int ai = 0; ai < 2; ++ai)
#pragma unroll
                for (int m = 0; m < 4; ++m) {
                    const int row = row0 + ai * HALF + m * 16; const float sc = s[ai][m];
                    const f32x4 g0 = acc[ai][0][m][0] * sc, g1 = acc[ai][0][m][1] * sc, u0 = acc[ai][1][m][0] * sc, u1 = acc[ai][1][m][1] * sc;
                    f32x4 o0, o1;
#pragma unroll
                    for (int j = 0; j < 4; ++j) { o0[j] = silu_mul(g0[j], u0[j]); o1[j] = silu_mul(g1[j], u1[j]); }
                    store8(c.O + (unsigned)(row * c.ldc + col0), o0, o1);
                }
            return;
        } else {
            float ssm[2][4];
            if constexpr (OUTM) {
#pragma unroll
                for (int ai = 0; ai < 2; ++ai)
#pragma unroll
                    for (int m = 0; m < 4; ++m) ssm[ai][m] = 0.f;
            }
#pragma unroll
            for (int bj = 0; bj < 2; ++bj) {
                const int gcol = uu.pn * BM + bj * HALF + wc * 32;
                const int col0 = gcol + 8 * fq;
                bool rope = false; int i0 = 0;
                if constexpr (EVM) { rope = (gcol >= EV_KR && gcol < EV_FL); i0 = (col0 - EV_KR) >> 1; }
                if constexpr (MODE == 2) { rope = (gcol >= 2048); i0 = ((col0 - 2048) & 63) >> 1; }
                f32x4 c0 = {1.f, 1.f, 1.f, 1.f}, c1 = c0;
                if constexpr (I8M) { const PG8_LAS float* csl = rsl + 512 + bj * HALF + wc * 32 + 8 * fq; c0 = *(const PG8_LAS f32x4*)csl; c1 = *(const PG8_LAS f32x4*)(csl + 4); }
                if ((EVM || MODE == 2) && rope) {
#pragma unroll
                    for (int ai = 0; ai < 2; ++ai)
#pragma unroll
                        for (int m = 0; m < 4; ++m) {
                            const int row = row0 + ai * HALF + m * 16; const float sc = s[ai][m]; const int pos = row_pos(row);
                            const f32x4 cs = *(const f32x4*)(c.cosT + (unsigned)(pos * 32 + i0)), sn = *(const f32x4*)(c.sinT + (unsigned)(pos * 32 + i0));
                            f32x4 x1, x2;
                            if constexpr (I8M) { x1 = __builtin_convertvector(__builtin_bit_cast(i32x4, acc[ai][bj][m][0]), f32x4) * (c0 * sc); x2 = __builtin_convertvector(__builtin_bit_cast(i32x4, acc[ai][bj][m][1]), f32x4) * (c1 * sc); }
                            else { x1 = acc[ai][bj][m][0] * sc; x2 = acc[ai][bj][m][1] * sc; }
                            store8(c.O + (unsigned)(row * c.ldc + col0), x1 * cs - x2 * sn, x1 * sn + x2 * cs);
                            asm volatile("" ::: "memory");
                        }
                } else {
                    float ss[2][4];
#pragma unroll
                    for (int ai = 0; ai < 2; ++ai)
#pragma unroll
                        for (int m = 0; m < 4; ++m) {
                            const int row = row0 + ai * HALF + m * 16; const float sc = s[ai][m];
                            f32x4 v0, v1;
                            if constexpr (I8M) { v0 = __builtin_convertvector(__builtin_bit_cast(i32x4, acc[ai][bj][m][0]), f32x4) * (c0 * sc); v1 = __builtin_convertvector(__builtin_bit_cast(i32x4, acc[ai][bj][m][1]), f32x4) * (c1 * sc); }
                            else { v0 = acc[ai][bj][m][0] * sc; v1 = acc[ai][bj][m][1] * sc; }
                            store8(c.O + (unsigned)(row * c.ldc + col0), v0, v1);
                            if constexpr (EVM) {
                                ss[ai][m] = sq8(v0, v1);
                                if (gcol == EV_FL && fq < 2) {
#pragma unroll
                                    for (int j = 0; j < 4; ++j) { c.flogT[(unsigned)((8 * fq + j) * MPAD + row)] = v0[j]; c.flogT[(unsigned)((8 * fq + 4 + j) * MPAD + row)] = v1[j]; }
                                }
                            }
                            if constexpr (OUTM) ssm[ai][m] += sq8(v0, v1);
                            asm volatile("" ::: "memory");
                        }
                    if constexpr (EVM) {
                        if (gcol >= EV_CQ && gcol < EV_KR) {
                            const bool isq = gcol < EV_CKV; float* tgt = isq ? c.statq : c.statkv; const int ld = isq ? 32 : 16, slot = (gcol - (isq ? EV_CQ : EV_CKV)) >> 5;
#pragma unroll
                            for (int ai = 0; ai < 2; ++ai) {
#pragma unroll
                                for (int m = 0; m < 4; ++m) { ss[ai][m] += __shfl_xor(ss[ai][m], 16); ss[ai][m] += __shfl_xor(ss[ai][m], 32); }
                                tgt[(unsigned)((row0 + ai * HALF + fq * 16) * ld + slot)] = sel4(ss[ai], fq);
                            }
                        }
                    }
                }
            }
            if constexpr (OUTM) {
#pragma unroll
                for (int ai = 0; ai < 2; ++ai) {
#pragma unroll
                    for (int m = 0; m < 4; ++m) { ssm[ai][m] += __shfl_xor(ssm[ai][m], 16); ssm[ai][m] += __shfl_xor(ssm[ai][m], 32); }
                    c.statm[(unsigned)((row0 + ai * HALF + fq * 16) * 64 + uu.pn * 4 + wc)] = sel4(ssm[ai], fq);
                }
            }
        }
    }
};
template <int DT> __device__ __forceinline__ f32x4 mma_k2(const bf16x8 (&b)[2], const bf16x8 (&a)[2], f32x4 c) {
    if constexpr (DT == 1) {
        typedef short s16x16 __attribute__((ext_vector_type(16)));
        const s16x16 bb = __builtin_shufflevector(b[0], b[1], 0, 1, 2, 3, 4, 5, 6, 7, 8, 9, 10, 11, 12, 13, 14, 15), aa = __builtin_shufflevector(a[0], a[1], 0, 1, 2, 3, 4, 5, 6, 7, 8, 9, 10, 11, 12, 13, 14, 15);
        return __builtin_amdgcn_mfma_scale_f32_16x16x128_f8f6f4(__builtin_bit_cast(i32x8, bb), __builtin_bit_cast(i32x8, aa), c, 0, 0, 0, 0, 0, 0);
    } else if constexpr (DT == 2) {
        i32x4 ci = __builtin_bit_cast(i32x4, c);
        ci = __builtin_amdgcn_mfma_i32_16x16x64_i8(__builtin_bit_cast(i32x4, b[0]), __builtin_bit_cast(i32x4, a[0]), ci, 0, 0, 0);
        ci = __builtin_amdgcn_mfma_i32_16x16x64_i8(__builtin_bit_cast(i32x4, b[1]), __builtin_bit_cast(i32x4, a[1]), ci, 0, 0, 0);
        return __builtin_bit_cast(f32x4, ci);
    } else {
        c = __builtin_amdgcn_mfma_f32_16x16x32_bf16(b[0], a[0], c, 0, 0, 0);
        return __builtin_amdgcn_mfma_f32_16x16x32_bf16(b[1], a[1], c, 0, 0, 0);
    }
}
template <class Epi, class Sched, bool ALIGN_EPI = false, bool SP2 = false, int DT = 0>
__device__ __forceinline__ void gemm_phase(PG8_LAS unsigned char* lds, const Gemm g, const Sched& S, const Epi& E, const int tid) {
    const int wid = __builtin_amdgcn_readfirstlane(tid >> 6), lane = tid & 63, wr = wid >> 2, wc = wid & 3, fr = lane & 15, fq = lane >> 4;
    const int K = g.K; int nt = K / BK; if (K < 1024) asm volatile("" : "+s"(nt));
    unsigned voffA[2], voffB[2];
#pragma unroll
    for (int i = 0; i < 2; ++i) { int R, C; stage_rc(tid * 16 + i * 8192, R, C); const int Rb = Epi::PERM ? ((R & ~31) + perm32(R & 31)) : R;
        voffA[i] = (unsigned)(R * g.lda + C) * 2u; voffB[i] = (unsigned)(Rb * g.ldb + C) * 2u; }
    const size_t kstep = (size_t)(BK * 2);
    const size_t hstepA = (size_t)HALF * g.lda * 2, hstepB = (size_t)HALF * g.ldb * 2;
    const size_t tstepA = 2 * hstepA, tstepB = 2 * hstepB;
    const unsigned ldsw = (unsigned)wid * 1024u;
    const int aoff = lds_byte(wr * 64 + fr, fq * 8), boff = lds_byte(wc * 32 + fr, fq * 8);
#define PG8_SA(b, h) (((b) * 2 + (h)) * HTB)
#define PG8_SB(b, h) ((4 + (b) * 2 + (h)) * HTB)
#define PG8_STAGE(bufoff, gbase, voff) do { const char* _b = (const char*)(gbase); asm volatile("" : "+s"(_b));     \
        _Pragma("unroll") for (int _i = 0; _i < 2; ++_i) { unsigned _v = (voff)[_i]; asm volatile("" : "+v"(_v)); \
        __builtin_amdgcn_global_load_lds((const unsigned*)(_b + _v), (PG8_LAS unsigned*)(lds + (bufoff) + ldsw + _i * 8192), 16, 0, 0); } } while (0)
#define PG8_LDA(dst, b, h) do { _Pragma("unroll") for (int m = 0; m < 4; ++m) _Pragma("unroll") for (int k = 0; k < 2; ++k) dst[m][k] = *(const PG8_LAS bf16x8*)(lds + PG8_SA(b, h) + aoff + m * 2048 + k * 1024); } while (0)
#define PG8_LDB(dst, b, h) do { _Pragma("unroll") for (int n = 0; n < 2; ++n) _Pragma("unroll") for (int k = 0; k < 2; ++k) dst[n][k] = *(const PG8_LAS bf16x8*)(lds + PG8_SB(b, h) + boff + n * 2048 + k * 1024); } while (0)
#define PG8_MMA(ai, bj, At, Bt) do { __builtin_amdgcn_s_setprio(1); _Pragma("unroll") for (int m = 0; m < 4; ++m) _Pragma("unroll") for (int n = 0; n < 2; ++n) \
        acc[ai][bj][m][n] = mma_k2<DT>(Bt[n], At[m], acc[ai][bj][m][n]); __builtin_amdgcn_s_setprio(0); } while (0)
#define PG8_WAIT_V(n) asm volatile("s_waitcnt vmcnt(" #n ")" ::: "memory")
#define PG8_WAIT_L(n) asm volatile("s_waitcnt lgkmcnt(" #n ")" ::: "memory")
#define PG8_BAR __builtin_amdgcn_s_barrier()
#define PG8_SCHED __builtin_amdgcn_sched_barrier(0)
    Unit cur, nxt; int ui = 0;
    if (!S.next(0, cur)) return;
    f32x4 acc[2][2][4][2];
#pragma unroll
    for (int a = 0; a < 2; ++a)
#pragma unroll
        for (int b = 0; b < 2; ++b)
#pragma unroll
            for (int m = 0; m < 4; ++m)
#pragma unroll
                for (int n = 0; n < 2; ++n) acc[a][b][m][n] = (f32x4){0.f, 0.f, 0.f, 0.f};
    bf16x8 At[4][2], B0[2][2], B1[2][2];
    const char* cA = (const char*)g.A + (size_t)cur.pm * tstepA + (size_t)cur.ko * 2; const char* cB = (const char*)g.Bt + (size_t)cur.pn * tstepB + (size_t)cur.ko * 2;
    S.a_ready(cur);
    E.pre(cur, lds + RS_LDS_OFF, wid);
    if constexpr (SP2) {
        PG8_STAGE(PG8_SB(0, 0), cB, voffB); PG8_STAGE(PG8_SB(0, 1), cB + hstepB, voffB); PG8_STAGE(PG8_SA(0, 0), cA, voffA); PG8_STAGE(PG8_SA(0, 1), cA + hstepA, voffA);
        if (wr == 1) PG8_BAR;
        PG8_WAIT_V(2); PG8_BAR;
        PG8_STAGE(PG8_SB(1, 0), cB + kstep, voffB); PG8_STAGE(PG8_SA(1, 0), cA + kstep, voffA); PG8_STAGE(PG8_SB(1, 1), cB + hstepB + kstep, voffB);
        PG8_WAIT_V(6); PG8_BAR;
    } else {
        PG8_STAGE(PG8_SB(0, 0), cB, voffB); PG8_STAGE(PG8_SA(0, 0), cA, voffA); PG8_STAGE(PG8_SB(0, 1), cB + hstepB, voffB); PG8_STAGE(PG8_SA(0, 1), cA + hstepA, voffA);
        if (wr == 1) PG8_BAR;
        PG8_WAIT_V(4); PG8_BAR;
        PG8_STAGE(PG8_SB(1, 0), cB + kstep, voffB); PG8_STAGE(PG8_SA(1, 0), cA + kstep, voffA); PG8_STAGE(PG8_SB(1, 1), cB + hstepB + kstep, voffB);
        PG8_WAIT_V(6); PG8_BAR;
    }
    for (;;) {
        const bool has_next = S.next(ui + 1, nxt);
        const char* nA = has_next ? (const char*)g.A + (size_t)nxt.pm * tstepA + (size_t)nxt.ko * 2 : cA; const char* nB = has_next ? (const char*)g.Bt + (size_t)nxt.pn * tstepB + (size_t)nxt.ko * 2 : cB;
        for (int t = 0; t < nt; t += 2) {
            const bool last = (t == nt - 2);
            const char* a1 = cA + (size_t)(t + 1) * kstep;
            const char* a2 = last ? nA : cA + (size_t)(t + 2) * kstep; const char* b2 = last ? nB : cB + (size_t)(t + 2) * kstep;
            const char* a3 = a2 + kstep; const char* b3 = b2 + kstep;
            if (last && has_next) { S.a_ready(nxt); E.pre(nxt, lds + RS_LDS_OFF + ((ui + 1) & 1) * 1024, wid); }
            if constexpr (SP2) {
            PG8_LDB(B0, 0, 0); PG8_LDB(B1, 0, 1); PG8_SCHED; PG8_LDA(At, 0, 0); PG8_STAGE(PG8_SA(1, 1), a1 + hstepA, voffA);
            PG8_WAIT_V(8); PG8_WAIT_L(0); PG8_BAR; PG8_MMA(0, 0, At, B0); PG8_MMA(0, 1, At, B1); PG8_BAR; PG8_SCHED;
            PG8_LDA(At, 0, 1); PG8_STAGE(PG8_SB(0, 0), b2, voffB); PG8_STAGE(PG8_SB(0, 1), b2 + hstepB, voffB); PG8_STAGE(PG8_SA(0, 0), a2, voffA);
            PG8_WAIT_V(8); PG8_WAIT_L(0); PG8_BAR; PG8_MMA(1, 0, At, B0); PG8_MMA(1, 1, At, B1); PG8_BAR; PG8_SCHED;
            PG8_LDB(B0, 1, 0); PG8_LDB(B1, 1, 1); PG8_SCHED; PG8_LDA(At, 1, 0); PG8_STAGE(PG8_SA(0, 1), a2 + hstepA, voffA);
            PG8_WAIT_V(8); PG8_WAIT_L(0); PG8_BAR; PG8_MMA(0, 0, At, B0); PG8_MMA(0, 1, At, B1); PG8_BAR; PG8_SCHED;
            PG8_LDA(At, 1, 1); PG8_STAGE(PG8_SB(1, 0), b3, voffB); PG8_STAGE(PG8_SB(1, 1), b3 + hstepB, voffB); PG8_STAGE(PG8_SA(1, 0), a3, voffA);
            PG8_WAIT_V(8); PG8_WAIT_L(0); PG8_BAR; PG8_MMA(1, 0, At, B0); PG8_MMA(1, 1, At, B1); PG8_BAR; PG8_SCHED;
            } else {
            PG8_LDB(B0, 0, 0); PG8_SCHED; PG8_LDA(At, 0, 0); PG8_STAGE(PG8_SA(1, 1), a1 + hstepA, voffA);
            PG8_WAIT_L(8); PG8_BAR; PG8_WAIT_L(0); PG8_MMA(0, 0, At, B0); PG8_BAR; PG8_SCHED;
            PG8_LDB(B1, 0, 1); PG8_STAGE(PG8_SB(0, 0), b2, voffB);
            PG8_BAR; PG8_WAIT_L(0); PG8_MMA(0, 1, At, B1); PG8_BAR;
            PG8_LDA(At, 0, 1); PG8_STAGE(PG8_SA(0, 0), a2, voffA);
            PG8_BAR; PG8_WAIT_L(0); PG8_MMA(1, 0, At, B0); PG8_BAR; PG8_SCHED;
            PG8_STAGE(PG8_SB(0, 1), b2 + hstepB, voffB);
            PG8_WAIT_V(6); PG8_BAR; PG8_MMA(1, 1, At, B1); PG8_BAR;
            PG8_LDB(B0, 1, 0); PG8_SCHED; PG8_LDA(At, 1, 0); PG8_STAGE(PG8_SA(0, 1), a2 + hstepA, voffA);
            PG8_WAIT_L(8); PG8_BAR; PG8_WAIT_L(0); PG8_MMA(0, 0, At, B0); PG8_BAR; PG8_SCHED;
            PG8_LDB(B1, 1, 1); PG8_STAGE(PG8_SB(1, 0), b3, voffB);
            PG8_BAR; PG8_WAIT_L(0); PG8_MMA(0, 1, At, B1); PG8_BAR;
            PG8_LDA(At, 1, 1); PG8_STAGE(PG8_SA(1, 0), a3, voffA);
            PG8_BAR; PG8_WAIT_L(0); PG8_MMA(1, 0, At, B0); PG8_BAR; PG8_SCHED;
            PG8_STAGE(PG8_SB(1, 1), b3 + hstepB, voffB);
            PG8_WAIT_V(6); PG8_BAR; PG8_MMA(1, 1, At, B1); PG8_BAR;
            }
        }
        if constexpr (ALIGN_EPI) { if (wr == 0) PG8_BAR; }
        if constexpr (!Epi::AFTER_DRAIN) { int l2; asm volatile("v_mbcnt_lo_u32_b32 %0, -1, 0\n\tv_mbcnt_hi_u32_b32 %0, -1, %0" : "=v"(l2));
            E(acc, cur, wr, wc, l2 & 15, l2 >> 4, (const PG8_LAS float*)(lds + RS_LDS_OFF + (ui & 1) * 1024)); S.done(cur); }
        if (!has_next) break;
#pragma unroll
        for (int a = 0; a < 2; ++a)
#pragma unroll
            for (int b = 0; b < 2; ++b)
#pragma unroll
                for (int m = 0; m < 4; ++m)
#pragma unroll
                    for (int n = 0; n < 2; ++n) acc[a][b][m][n] = (f32x4){0.f, 0.f, 0.f, 0.f};
        cur = nxt; cA = nA; cB = nB; ++ui;
        if constexpr (ALIGN_EPI) { if (wr == 1) PG8_BAR; }
    }
    PG8_WAIT_V(0);
    if constexpr (!ALIGN_EPI) { if (wr == 0) PG8_BAR; }
    PG8_BAR;
    if constexpr (Epi::AFTER_DRAIN) { E.fused(acc, cur, wr, wc, fr, fq, lds, wid, lane); S.done(cur); }
#undef PG8_SA
#undef PG8_SB
#undef PG8_STAGE
#undef PG8_LDA
#undef PG8_LDB
#undef PG8_MMA
#undef PG8_WAIT_V
#undef PG8_WAIT_L
#undef PG8_BAR
#undef PG8_SCHED
}
}
using pg8::sq8; using pg8::store8;

namespace att {
constexpr int SHM_V = 16384, SHM_K = 16384, SHM_K2 = 8192;
constexpr int OFF_V = 0, OFF_K = 2 * SHM_V, OFF_K2 = OFF_K + 2 * SHM_K, OFF_BIAS = OFF_K2 + 2 * SHM_K2, OFF_TBL = OFF_BIAS + 512, OFF_WS = OFF_TBL + 512, LDS_END = OFF_WS + 8 * 256;
constexpr float THR = 8.f;
#define KSWZ(row, colB) ((row) * 256 + ((colB) ^ (((row) & 15) << 4)))
#define K2SWZ(row, colB) ((row) * 128 + ((colB) ^ ((((row) >> 1) & 7) << 4)))
#define SBAR() __builtin_amdgcn_sched_barrier(0)
__device__ __forceinline__ int v_st(int k, int c) { const int kk = (k & ~0xC) | ((k & 4) << 1) | ((k & 8) >> 1); return ((kk >> 3) * 4 + (c >> 5)) * 512 + ((kk & 7) * 32 + (c & 31)) * 2; }
__device__ __forceinline__ int v_rd_base(int lane) { return ((lane & 3) << 3) | (((lane >> 2) & 3) << 6) | (((lane >> 4) & 1) << 5) | (((lane >> 5) & 1) << 8); }
constexpr int v_rd_off(int d0, int ks, int half) { return d0 * 512 + ks * 4096 + half * 2048; }
__device__ __forceinline__ int crow(int r, int hi) { return (r & 3) + 8 * (r >> 2) + 4 * hi; }

template <int MODE> struct Cfg { static constexpr float SCALE = (MODE == 1) ? 0.07216878364870322f : 0.08838834764831845f; static constexpr int DK = (MODE == 1) ? 192 : 128; };

__device__ __forceinline__ void mask_tile(f32x16& p0, f32x16& p1, int lim) {
    const float NEG = -__builtin_inff();
#pragma unroll
    for (int r = 0; r < 16; ++r) {
        const int c = (r & 3) + 8 * (r >> 2);
        if (c > lim) p0[r] = NEG;
        if (c + 32 > lim) p1[r] = NEG;
    }
}
__device__ __forceinline__ void t5_bias(f32x16& p0, f32x16& p1, const LAS float* tbl, int dd) {
#pragma unroll
    for (int g = 0; g < 4; ++g) {
#pragma unroll
        for (int j = 0; j < 4; ++j) { const int r = 4 * g + j, c = (r & 3) + 8 * (r >> 2);
            int i0 = dd - c; i0 = i0 < 0 ? 0 : (i0 > 127 ? 127 : i0);
            int i1 = dd - c - 32; i1 = i1 < 0 ? 0 : (i1 > 127 ? 127 : i1);
            p0[r] += tbl[i0]; p1[r] += tbl[i1]; }
        asm volatile("" ::: "memory");
    }
}
template <int MODE>
__device__ __forceinline__ void partialSM(f32x16& p0, f32x16& p1, float& m_reg, float& mn, float& alpha) {
    constexpr float SCALE = Cfg<MODE>::SCALE;
    float pmax = p0[0];
#pragma unroll
    for (int r = 1; r < 16; ++r) pmax = fmaxf(pmax, p0[r]);
#pragma unroll
    for (int r = 0; r < 16; ++r) pmax = fmaxf(pmax, p1[r]);
    { auto rr = __builtin_amdgcn_permlane32_swap(__float_as_uint(pmax), __float_as_uint(pmax), false, false);
      pmax = fmaxf(__uint_as_float(rr[0]), __uint_as_float(rr[1])); }
    constexpr float C2 = 1.4426950408889634f * SCALE;
    if (__builtin_expect(__all((pmax - m_reg) * SCALE <= THR), 1)) { mn = m_reg; alpha = 1.f; }
    else { mn = fmaxf(m_reg, pmax); alpha = __builtin_amdgcn_exp2f((m_reg - mn) * C2); m_reg = mn; }
    const float mnL = -mn * C2;
#pragma unroll
    for (int r = 0; r < 16; ++r) p0[r] = fmaf(p0[r], C2, mnL);
#pragma unroll
    for (int r = 0; r < 16; ++r) p1[r] = fmaf(p1[r], C2, mnL);
#pragma unroll
    for (int r = 0; r < 16; ++r) p0[r] = __builtin_amdgcn_exp2f(p0[r]);
}
__device__ __forceinline__ void finishSM(f32x16& p0, f32x16& p1, float alpha, float& l_reg, bf16x8& pa0, bf16x8& pa1, bf16x8& pa2, bf16x8& pa3) {
#pragma unroll
    for (int r = 0; r < 16; ++r) p1[r] = __builtin_amdgcn_exp2f(p1[r]);
    float ps = 0;
#pragma unroll
    for (int r = 0; r < 16; ++r) ps += p0[r];
#pragma unroll
    for (int r = 0; r < 16; ++r) ps += p1[r];
    { auto rr = __builtin_amdgcn_permlane32_swap(__float_as_uint(ps), __float_as_uint(ps), false, false);
      ps = __uint_as_float(rr[0]) + __uint_as_float(rr[1]); }
    l_reg = l_reg * alpha + ps;
#define PK4(P, B_, OUT) do { unsigned a0 = cvt_pk_bf16(P[B_+0], P[B_+1]), a1 = cvt_pk_bf16(P[B_+2], P[B_+3]);                          \
        unsigned b0 = cvt_pk_bf16(P[B_+4], P[B_+5]), b1 = cvt_pk_bf16(P[B_+6], P[B_+7]);                                             \
        auto r0 = __builtin_amdgcn_permlane32_swap(a0, b0, false, false); auto r1 = __builtin_amdgcn_permlane32_swap(a1, b1, false, false); \
        u32x4 w = {r0[0], r1[0], r0[1], r1[1]}; OUT = *reinterpret_cast<bf16x8*>(&w); } while (0)
    PK4(p0, 0, pa0); PK4(p0, 8, pa1); PK4(p1, 0, pa2); PK4(p1, 8, pa3);
#undef PK4
}
template <int MODE>
__device__ __forceinline__ void qkt(f32x16& p0, f32x16& p1, const LAS char* Kt, const LAS char* K2t, const LAS float* biasL, int r32, int hi, const bf16x8* qr) {
    if constexpr (MODE == 0) {
        const LAS f32x4* bl = (const LAS f32x4*)biasL;
#pragma unroll
        for (int g = 0; g < 4; ++g) { const f32x4 a = bl[2 * g + hi], b = bl[8 + 2 * g + hi];
#pragma unroll
            for (int j = 0; j < 4; ++j) { p0[4 * g + j] = a[j]; p1[4 * g + j] = b[j]; } }
    } else { p0 = f32x16{}; p1 = f32x16{}; }
    const int kg_ = ((r32 & 15) << 4) ^ (hi << 4);
    const LAS char* kr_ = Kt + r32 * 256;
    __builtin_amdgcn_s_setprio(1);
#pragma unroll
    for (int d0 = 0; d0 < 8; ++d0) { const LAS char* a = kr_ + (kg_ ^ (d0 << 5));
        const bf16x8 b0 = *reinterpret_cast<const LAS bf16x8*>(a);
        const bf16x8 b1 = *reinterpret_cast<const LAS bf16x8*>(a + 32 * 256);
        p0 = __builtin_amdgcn_mfma_f32_32x32x16_bf16(b0, qr[d0], p0, 0, 0, 0);
        p1 = __builtin_amdgcn_mfma_f32_32x32x16_bf16(b1, qr[d0], p1, 0, 0, 0); }
    if constexpr (MODE == 1) {
#pragma unroll
        for (int d0 = 0; d0 < 4; ++d0) { const LAS char* a = K2t + K2SWZ(r32, (d0 * 16 + hi * 8) * 2);
            const bf16x8 b0 = *reinterpret_cast<const LAS bf16x8*>(a);
            const bf16x8 b1 = *reinterpret_cast<const LAS bf16x8*>(a + 32 * 128);
            p0 = __builtin_amdgcn_mfma_f32_32x32x16_bf16(b0, qr[8 + d0], p0, 0, 0, 0);
            p1 = __builtin_amdgcn_mfma_f32_32x32x16_bf16(b1, qr[8 + d0], p1, 0, 0, 0); }
    }
    __builtin_amdgcn_s_setprio(0);
}
__device__ __forceinline__ void pv_tile(f32x16* o, unsigned vb0, bf16x8 pa0, bf16x8 pa1, bf16x8 pa2, bf16x8 pa3) {
#define TRRD(dst, off) asm volatile("ds_read_b64_tr_b16 %0, %1 offset:%2" : "=&v"(dst) : "v"(vb0), "i"(off) : "memory")
#define PV_RD(S, d0) do { constexpr int b_ = v_rd_off(d0, 0, 0);     \
        TRRD(S##l0, b_); TRRD(S##h0, b_ + 2048); TRRD(S##l1, b_ + 4096); TRRD(S##h1, b_ + 6144); TRRD(S##l2, b_ + 8192); TRRD(S##h2, b_ + 10240); TRRD(S##l3, b_ + 12288); TRRD(S##h3, b_ + 14336); } while (0)
#define PV_MM(S, d0) do { \
        o[d0] = __builtin_amdgcn_mfma_f32_32x32x16_bf16(pa0, (bf16x8){S##l0[0], S##l0[1], S##l0[2], S##l0[3], S##h0[0], S##h0[1], S##h0[2], S##h0[3]}, o[d0], 0, 0, 0);   \
        o[d0] = __builtin_amdgcn_mfma_f32_32x32x16_bf16(pa1, (bf16x8){S##l1[0], S##l1[1], S##l1[2], S##l1[3], S##h1[0], S##h1[1], S##h1[2], S##h1[3]}, o[d0], 0, 0, 0);   \
        o[d0] = __builtin_amdgcn_mfma_f32_32x32x16_bf16(pa2, (bf16x8){S##l2[0], S##l2[1], S##l2[2], S##l2[3], S##h2[0], S##h2[1], S##h2[2], S##h2[3]}, o[d0], 0, 0, 0);   \
        o[d0] = __builtin_amdgcn_mfma_f32_32x32x16_bf16(pa3, (bf16x8){S##l3[0], S##l3[1], S##l3[2], S##l3[3], S##h3[0], S##h3[1], S##h3[2], S##h3[3]}, o[d0], 0, 0, 0); } while (0)
    s16x4 Al0, Al1, Al2, Al3, Ah0, Ah1, Ah2, Ah3, Bl0, Bl1, Bl2, Bl3, Bh0, Bh1, Bh2, Bh3;
    __builtin_amdgcn_s_setprio(1);
    PV_RD(A, 0);
    PV_RD(B, 1); asm volatile("s_waitcnt lgkmcnt(8)" ::: "memory"); SBAR(); PV_MM(A, 0); SBAR();
    PV_RD(A, 2); asm volatile("s_waitcnt lgkmcnt(8)" ::: "memory"); SBAR(); PV_MM(B, 1); SBAR();
    PV_RD(B, 3); asm volatile("s_waitcnt lgkmcnt(8)" ::: "memory"); SBAR(); PV_MM(A, 2); SBAR();
    asm volatile("s_waitcnt lgkmcnt(0)" ::: "memory"); SBAR(); PV_MM(B, 3);
    __builtin_amdgcn_s_setprio(0);
#undef PV_MM
#undef PV_RD
#undef TRRD
}

struct PassArgs {
    const bf16_t* Q; const bf16_t* Q2; const bf16_t* K; const bf16_t* K2; const bf16_t* V; const float* cum;
    int ldq, ldq2, ldk, ldk2, ldv;
    int krow0;
    int qvp0;
    int NT;
    int shift0;
};
template <int MODE>
__device__ __forceinline__ void attn_pass(const PassArgs& a, LAS char* lds, f32x16 (&o)[4], const int tid) {
    constexpr int DK = Cfg<MODE>::DK;
    constexpr float SCALE = Cfg<MODE>::SCALE, INV_SCALE = 1.0f / SCALE;
    const int wid = __builtin_amdgcn_readfirstlane(tid >> 6), lane = tid & 63, r32 = lane & 31, hi = lane >> 5;
    bf16x8 qr[DK / 16];
    { const bf16_t* qp = a.Q + (size_t)(wid * 32 + r32) * a.ldq + hi * 8;
#pragma unroll
      for (int d0 = 0; d0 < 8; ++d0) qr[d0] = *(const bf16x8*)(qp + d0 * 16);
      if constexpr (MODE == 1) { const bf16_t* qp2 = a.Q2 + (size_t)(wid * 32 + r32) * a.ldq2 + hi * 8;
#pragma unroll
          for (int d0 = 0; d0 < 4; ++d0) qr[8 + d0] = *(const bf16x8*)(qp2 + d0 * 16); } }
    const int sr = tid >> 4, sc = (tid & 15) * 8, kws = KSWZ(sr, sc * 2), vst0 = v_st(sr, sc), vst1 = v_st(32 + sr, sc);
    const int sr2 = tid >> 3, sc2 = (tid & 7) * 8, k2ws = K2SWZ(sr2, sc2 * 2);
    bf16x8 st_k0, st_k1, st_v0, st_v1, st_k2; float st_b = 0.f;
#define TROW(t) ((t) == 0 ? META0 : a.krow0 + ((t) - 1) * 64)
#define ISSUE(t) do { const int tr_ = TROW(t); const size_t r0_ = (size_t)(tr_ + sr);                                             \
        st_k0 = *(const bf16x8*)(a.K + r0_ * a.ldk + sc); st_k1 = *(const bf16x8*)(a.K + (r0_ + 32) * a.ldk + sc);                 \
        st_v0 = *(const bf16x8*)(a.V + r0_ * a.ldv + sc); st_v1 = *(const bf16x8*)(a.V + (r0_ + 32) * a.ldv + sc);                 \
        if constexpr (MODE == 1) st_k2 = *(const bf16x8*)(a.K2 + (size_t)(tr_ + sr2) * a.ldk2 + sc2);                              \
        if constexpr (MODE == 0) { if (tid < 64) st_b = a.cum[tr_ + tid]; } } while (0)
#define WRITE(bf) do { *(LAS bf16x8*)(lds + OFF_K + (bf) * SHM_K + kws) = st_k0; *(LAS bf16x8*)(lds + OFF_K + (bf) * SHM_K + kws + 32 * 256) = st_k1;   \
        *(LAS bf16x8*)(lds + OFF_V + (bf) * SHM_V + vst0) = st_v0; *(LAS bf16x8*)(lds + OFF_V + (bf) * SHM_V + vst1) = st_v1;                        \
        if constexpr (MODE == 1) *(LAS bf16x8*)(lds + OFF_K2 + (bf) * SHM_K2 + k2ws) = st_k2;                                                       \
        if constexpr (MODE == 0) { if (tid < 64) ((LAS float*)(lds + OFF_BIAS + (bf) * 256))[tid] = -st_b * INV_SCALE; } } while (0)
    ISSUE(0);
    WRITE(0);
    __syncthreads();
    float m_reg = -1e30f, l_reg = 0.f;
#pragma unroll
    for (int d = 0; d < 4; ++d) o[d] = f32x16{};
    const int qlo = a.qvp0 + wid * 32, qv = qlo + r32;
    LAS float* li_l = (LAS float*)(lds + OFF_WS + wid * 256); LAS float* al_l = li_l + 32;
    const LAS float* tbl = (const LAS float*)(lds + OFF_TBL);
    const unsigned vbase = (unsigned)(uintptr_t)(lds + OFF_V) + (unsigned)v_rd_base(lane);
    const int NT = a.NT;
    for (int t = 0; t < NT; ++t) {
        const int cur = t & 1;
        if (t + 1 < NT) ISSUE(t + 1);
        const int kb = 64 * t;
        if (t == 0 || kb <= qlo + 31) {
        f32x16 p0, p1;
        qkt<MODE>(p0, p1, lds + OFF_K + cur * SHM_K, lds + OFF_K2 + cur * SHM_K2, (const LAS float*)(lds + OFF_BIAS + cur * 256), r32, hi, qr);
        if constexpr (MODE == 2) { const int sh = t == 0 ? a.shift0 : 0; if (qlo - sh - (kb + 63) <= 112) t5_bias(p0, p1, tbl, qv - kb - sh - 4 * hi); }
        if (t == 0 || kb + 63 > qlo) { int lim = qv - kb; const int tm = t == 0 ? 15 : 63; lim = (lim < tm ? lim : tm) - 4 * hi; mask_tile(p0, p1, lim); }
        float mn, alpha;
        partialSM<MODE>(p0, p1, m_reg, mn, alpha);
        if (__any(alpha < 1.f)) { if (hi == 0) al_l[r32] = alpha; asm volatile("s_waitcnt lgkmcnt(0)" ::: "memory");
#pragma unroll
            for (int r = 0; r < 16; ++r) { const float av = al_l[crow(r, hi)];
#pragma unroll
                for (int d = 0; d < 4; ++d) o[d][r] *= av; } }
        bf16x8 pa0, pa1, pa2, pa3;
        finishSM(p0, p1, alpha, l_reg, pa0, pa1, pa2, pa3);
        pv_tile(o, vbase + (unsigned)(cur * SHM_V), pa0, pa1, pa2, pa3);
        }
        if (t + 1 < NT) WRITE(cur ^ 1);
        __syncthreads();
    }
    if (hi == 0) li_l[r32] = l_reg;
    asm volatile("s_waitcnt lgkmcnt(0)" ::: "memory");
#pragma unroll
    for (int r = 0; r < 16; ++r) { const float rl = __builtin_amdgcn_rcpf(li_l[crow(r, hi)]);
#pragma unroll
        for (int d = 0; d < 4; ++d) o[d][r] *= rl; }
#undef TROW
#undef ISSUE
#undef WRITE
}
template <int MODE>
__device__ __forceinline__ void attn_pass_dma(const PassArgs& a, LAS char* lds, f32x16 (&o)[4], const int tid) {
    constexpr int DK = Cfg<MODE>::DK;
    constexpr float SCALE = Cfg<MODE>::SCALE, INV_SCALE = 1.0f / SCALE;
    const int wid = __builtin_amdgcn_readfirstlane(tid >> 6);
    bf16x8 qr[DK / 16];
    { const int lane = tid & 63, r32 = lane & 31, hi = lane >> 5; const bf16_t* qp = a.Q + (size_t)(wid * 32 + r32) * a.ldq + hi * 8;
#pragma unroll
      for (int d0 = 0; d0 < 8; ++d0) qr[d0] = *(const bf16x8*)(qp + d0 * 16);
      if constexpr (MODE == 1) { const bf16_t* qp2 = a.Q2 + (size_t)(wid * 32 + r32) * a.ldq2 + hi * 8;
#pragma unroll
          for (int d0 = 0; d0 < 4; ++d0) qr[8 + d0] = *(const bf16x8*)(qp2 + d0 * 16); } }
    float st_b = 0.f;
#define TROW(t) ((t) == 0 ? META0 : a.krow0 + ((t) - 1) * 64)
#define DMA16(gp, ldsoff) __builtin_amdgcn_global_load_lds((const unsigned*)(gp), (LAS unsigned*)(lds + (ldsoff)), 16, 0, 0)
#define ISSUE_D(t, bf) do { int tl_ = tid; asm volatile("" : "+v"(tl_)); const int tr_ = TROW(t);                                         \
        const int krow = tl_ >> 4, kcol = ((tl_ & 15) ^ (krow & 15)) * 8;                                                                \
        const int vkk = ((tl_ >> 7) << 3) | ((tl_ & 31) >> 2), vrow = (vkk & ~0xC) | ((vkk & 4) << 1) | ((vkk & 8) >> 1), vcol = ((tl_ >> 5) & 3) * 32 + (tl_ & 3) * 8;   \
        _Pragma("unroll") for (int i_ = 0; i_ < 2; ++i_) DMA16(a.K + (size_t)(tr_ + krow + 32 * i_) * a.ldk + kcol, OFF_K + (bf) * SHM_K + i_ * 8192 + wid * 1024);   \
        _Pragma("unroll") for (int i_ = 0; i_ < 2; ++i_) DMA16(a.V + (size_t)(tr_ + vrow + 32 * i_) * a.ldv + vcol, OFF_V + (bf) * SHM_V + i_ * 8192 + wid * 1024);   \
        if constexpr (MODE == 1) { const int r2_ = tl_ >> 3, c2_ = ((tl_ & 7) ^ ((r2_ >> 1) & 7)) * 8; DMA16(a.K2 + (size_t)(tr_ + r2_) * a.ldk2 + c2_, OFF_K2 + (bf) * SHM_K2 + wid * 1024); } \
        if constexpr (MODE == 0) { if (tl_ < 64) st_b = a.cum[tr_ + tl_]; } } while (0)
#define WRITE_B(bf) do { if constexpr (MODE == 0) { int tl_ = tid; asm volatile("" : "+v"(tl_)); if (tl_ < 64) ((LAS float*)(lds + OFF_BIAS + (bf) * 256))[tl_] = -st_b * INV_SCALE; } } while (0)
    ISSUE_D(0, 0);
    WRITE_B(0);
    asm volatile("s_waitcnt vmcnt(0)" ::: "memory");
    __syncthreads();
    float m_reg = -1e30f, l_reg = 0.f;
#pragma unroll
    for (int d = 0; d < 4; ++d) o[d] = f32x16{};
    const int NT = a.NT;
    for (int t = 0; t < NT; ++t) {
        const int cur = t & 1;
        if (t + 1 < NT) ISSUE_D(t + 1, cur ^ 1);
        int tl = tid; asm volatile("" : "+v"(tl));
        const int lane = tl & 63, r32 = lane & 31, hi = lane >> 5;
        const int qlo = a.qvp0 + wid * 32, qv = qlo + r32;
        LAS float* al_l = (LAS float*)(lds + OFF_WS + wid * 256) + 32;
        const int kb = 64 * t;
        if (t == 0 || kb <= qlo + 31) {
        f32x16 p0, p1;
        qkt<MODE>(p0, p1, lds + OFF_K + cur * SHM_K, lds + OFF_K2 + cur * SHM_K2, (const LAS float*)(lds + OFF_BIAS + cur * 256), r32, hi, qr);
        if (t == 0 || kb + 63 > qlo) { int lim = qv - kb; const int tm = t == 0 ? 15 : 63; lim = (lim < tm ? lim : tm) - 4 * hi; mask_tile(p0, p1, lim); }
        float mn, alpha;
        partialSM<MODE>(p0, p1, m_reg, mn, alpha);
        if (__any(alpha < 1.f)) { if (hi == 0) al_l[r32] = alpha; asm volatile("s_waitcnt lgkmcnt(0)" ::: "memory");
#pragma unroll
            for (int r = 0; r < 16; ++r) { const float av = al_l[crow(r, hi)];
#pragma unroll
                for (int d = 0; d < 4; ++d) o[d][r] *= av; } }
        bf16x8 pa0, pa1, pa2, pa3;
        finishSM(p0, p1, alpha, l_reg, pa0, pa1, pa2, pa3);
        pv_tile(o, (unsigned)(uintptr_t)(lds + OFF_V) + (unsigned)v_rd_base(lane) + (unsigned)(cur * SHM_V), pa0, pa1, pa2, pa3);
        }
        if (t + 1 < NT) WRITE_B(cur ^ 1);
        asm volatile("s_waitcnt vmcnt(0)" ::: "memory");
        __syncthreads();
    }
    { int tl = tid; asm volatile("" : "+v"(tl));
      const int lane = tl & 63, r32 = lane & 31, hi = lane >> 5;
      LAS float* li_l = (LAS float*)(lds + OFF_WS + wid * 256);
      if (hi == 0) li_l[r32] = l_reg;
      asm volatile("s_waitcnt lgkmcnt(0)" ::: "memory");
#pragma unroll
      for (int r = 0; r < 16; ++r) { const float rl = __builtin_amdgcn_rcpf(li_l[crow(r, hi)]);
#pragma unroll
          for (int d = 0; d < 4; ++d) o[d][r] *= rl; } }
#undef TROW
#undef DMA16
#undef ISSUE_D
#undef WRITE_B
}
constexpr int D_OFF_V = 0  , D_OFF_K = 65536  , D_OFF_TBL = 98304, D_OFF_WS = D_OFF_TBL + 512, D_LDS_END = D_OFF_WS + 8 * 256;
__device__ __forceinline__ void attn_pass_diff(const PassArgs& a, LAS char* lds, f32x16 (&o)[8], const int tid) {
    const int wid = __builtin_amdgcn_readfirstlane(tid >> 6);
    bf16x8 qr[8];
    { const int lane = tid & 63, r32 = lane & 31, hi = lane >> 5; const bf16_t* qp = a.Q + (size_t)(wid * 32 + r32) * a.ldq + hi * 8;
#pragma unroll
      for (int d0 = 0; d0 < 8; ++d0) qr[d0] = *(const bf16x8*)(qp + d0 * 16); }
#define TROW(t) ((t) == 0 ? META0 : a.krow0 + ((t) - 1) * 64)
#define DMA16(gp, ldsoff) __builtin_amdgcn_global_load_lds((const unsigned*)(gp), (LAS unsigned*)(lds + (ldsoff)), 16, 0, 0)
#define ISSUE_D(t, bf) do { int tl_ = tid; asm volatile("" : "+v"(tl_)); const int tr_ = TROW(t);                                         \
        const int krow = tl_ >> 4, kcol = ((tl_ & 15) ^ (krow & 15)) * 8;                                                                \
        const int vkk = ((tl_ >> 7) << 3) | ((tl_ & 31) >> 2), vrow = (vkk & ~0xC) | ((vkk & 4) << 1) | ((vkk & 8) >> 1), vcol = ((tl_ >> 5) & 3) * 32 + (tl_ & 3) * 8;   \
        _Pragma("unroll") for (int i_ = 0; i_ < 2; ++i_) DMA16(a.K + (size_t)(tr_ + krow + 32 * i_) * a.ldk + kcol, D_OFF_K + (bf) * 16384 + i_ * 8192 + wid * 1024);   \
        _Pragma("unroll") for (int h_ = 0; h_ < 2; ++h_) _Pragma("unroll") for (int i_ = 0; i_ < 2; ++i_)                                 \
            DMA16(a.V + (size_t)(tr_ + vrow + 32 * i_) * a.ldv + h_ * 128 + vcol, D_OFF_V + (bf) * 32768 + h_ * 16384 + i_ * 8192 + wid * 1024); } while (0)
    ISSUE_D(0, 0);
    asm volatile("s_waitcnt vmcnt(0)" ::: "memory");
    __syncthreads();
    float m_reg = -1e30f, l_reg = 0.f;
#pragma unroll
    for (int d = 0; d < 8; ++d) o[d] = f32x16{};
    const int NT = a.NT;
    for (int t = 0; t < NT; ++t) {
        const int cur = t & 1;
        if (t + 1 < NT) ISSUE_D(t + 1, cur ^ 1);
        int tl = tid; asm volatile("" : "+v"(tl));
        const int lane = tl & 63, r32 = lane & 31, hi = lane >> 5;
        const int qlo = a.qvp0 + wid * 32, qv = qlo + r32;
        LAS float* al_l = (LAS float*)(lds + D_OFF_WS + wid * 256) + 32;
        const int kb = 64 * t;
        if (t == 0 || kb <= qlo + 31) {
        f32x16 p0, p1;
        qkt<2>(p0, p1, lds + D_OFF_K + cur * 16384, lds, (const LAS float*)lds, r32, hi, qr);
        { const int sh = t == 0 ? a.shift0 : 0; if (qlo - sh - (kb + 63) <= 112) t5_bias(p0, p1, (const LAS float*)(lds + D_OFF_TBL), qv - kb - sh - 4 * hi); }
        if (t == 0 || kb + 63 > qlo) { int lim = qv - kb; const int tm = t == 0 ? 15 : 63; lim = (lim < tm ? lim : tm) - 4 * hi; mask_tile(p0, p1, lim); }
        float mn, alpha;
        partialSM<2>(p0, p1, m_reg, mn, alpha);
        if (__any(alpha < 1.f)) { if (hi == 0) al_l[r32] = alpha; asm volatile("s_waitcnt lgkmcnt(0)" ::: "memory");
#pragma unroll
            for (int r = 0; r < 16; ++r) { const float av = al_l[crow(r, hi)];
#pragma unroll
                for (int d = 0; d < 8; ++d) o[d][r] *= av; } }
        bf16x8 pa0, pa1, pa2, pa3;
        finishSM(p0, p1, alpha, l_reg, pa0, pa1, pa2, pa3);
        const unsigned vbase = (unsigned)(uintptr_t)(lds + D_OFF_V) + (unsigned)v_rd_base(lane) + (unsigned)(cur * 32768);
        pv_tile(o, vbase, pa0, pa1, pa2, pa3);
        pv_tile(o + 4, vbase + 16384u, pa0, pa1, pa2, pa3);
        }
        asm volatile("s_waitcnt vmcnt(0)" ::: "memory");
        __syncthreads();
    }
    { int tl = tid; asm volatile("" : "+v"(tl));
      const int lane = tl & 63, r32 = lane & 31, hi = lane >> 5;
      LAS float* li_l = (LAS float*)(lds + D_OFF_WS + wid * 256);
      if (hi == 0) li_l[r32] = l_reg;
      asm volatile("s_waitcnt lgkmcnt(0)" ::: "memory");
#pragma unroll
      for (int r = 0; r < 16; ++r) { const float rl = __builtin_amdgcn_rcpf(li_l[crow(r, hi)]);
#pragma unroll
          for (int d = 0; d < 8; ++d) o[d][r] *= rl; } }
#undef TROW
#undef DMA16
#undef ISSUE_D
}
#ifdef PROBE_ATT
template <int PVAR  >
__device__ __forceinline__ void attn_pass_diff_probe(const PassArgs& a, LAS char* lds, f32x16 (&o)[8], const int tid) {
    const int wid = __builtin_amdgcn_readfirstlane(tid >> 6);
    bf16x8 qr[8];
    { const int lane = tid & 63, r32 = lane & 31, hi = lane >> 5; const bf16_t* qp = a.Q + (size_t)(wid * 32 + r32) * a.ldq + hi * 8;
#pragma unroll
      for (int d0 = 0; d0 < 8; ++d0) qr[d0] = *(const bf16x8*)(qp + d0 * 16); }
#define TROW(t) ((t) == 0 ? META0 : a.krow0 + ((t) - 1) * 64)
#define DMA16(gp, ldsoff) __builtin_amdgcn_global_load_lds((const unsigned*)(gp), (LAS unsigned*)(lds + (ldsoff)), 16, 0, 0)
#define ISSUE_D(t, bf) do { int tl_ = tid; asm volatile("" : "+v"(tl_)); const int tr_ = TROW(t);                                         \
        const int krow = tl_ >> 4, kcol = ((tl_ & 15) ^ (krow & 15)) * 8;                                                                \
        const int vkk = ((tl_ >> 7) << 3) | ((tl_ & 31) >> 2), vrow = (vkk & ~0xC) | ((vkk & 4) << 1) | ((vkk & 8) >> 1), vcol = ((tl_ >> 5) & 3) * 32 + (tl_ & 3) * 8;   \
        _Pragma("unroll") for (int i_ = 0; i_ < 2; ++i_) DMA16(a.K + (size_t)(tr_ + krow + 32 * i_) * a.ldk + kcol, D_OFF_K + (bf) * 16384 + i_ * 8192 + wid * 1024);   \
        _Pragma("unroll") for (int h_ = 0; h_ < 2; ++h_) _Pragma("unroll") for (int i_ = 0; i_ < 2; ++i_)                                 \
            DMA16(a.V + (size_t)(tr_ + vrow + 32 * i_) * a.ldv + h_ * 128 + vcol, D_OFF_V + (bf) * 32768 + h_ * 16384 + i_ * 8192 + wid * 1024); } while (0)
    ISSUE_D(0, 0);
    asm volatile("s_waitcnt vmcnt(0)" ::: "memory");
    __syncthreads();
    float m_reg = -1e30f, l_reg = 0.f;
#pragma unroll
    for (int d = 0; d < 8; ++d) o[d] = f32x16{};
    const int NT = a.NT;
    for (int t = 0; t < NT; ++t) {
        const int cur = t & 1;
        if constexpr (PVAR != 6 && PVAR != 8) { if (t + 1 < NT) ISSUE_D(t + 1, cur ^ 1); }
        int tl = tid; asm volatile("" : "+v"(tl));
        const int lane = tl & 63, r32 = lane & 31, hi = lane >> 5;
        const int qlo = a.qvp0 + wid * 32, qv = qlo + r32;
        LAS float* al_l = (LAS float*)(lds + D_OFF_WS + wid * 256) + 32;
        const int kb = 64 * t;
        if (t == 0 || kb <= qlo + 31) {
        f32x16 p0, p1;
        if constexpr (PVAR == 5 || PVAR == 7 || PVAR == 8) { p0 = f32x16{}; p1 = f32x16{};
#pragma unroll
            for (int d0 = 0; d0 < 8; ++d0) { p0 = __builtin_amdgcn_mfma_f32_32x32x16_bf16(qr[(d0 + 1) & 7], qr[d0], p0, 0, 0, 0); p1 = __builtin_amdgcn_mfma_f32_32x32x16_bf16(qr[(d0 + 3) & 7], qr[d0], p1, 0, 0, 0); } }
        else qkt<2>(p0, p1, lds + D_OFF_K + cur * 16384, lds, (const LAS float*)lds, r32, hi, qr);
        { const int sh = t == 0 ? a.shift0 : 0; if (qlo - sh - (kb + 63) <= 112) t5_bias(p0, p1, (const LAS float*)(lds + D_OFF_TBL), qv - kb - sh - 4 * hi); }
        if (t == 0 || kb + 63 > qlo) { int lim = qv - kb; const int tm = t == 0 ? 15 : 63; lim = (lim < tm ? lim : tm) - 4 * hi; mask_tile(p0, p1, lim); }
        float mn, alpha;
        partialSM<2>(p0, p1, m_reg, mn, alpha);
        if (__any(alpha < 1.f)) { if (hi == 0) al_l[r32] = alpha; asm volatile("s_waitcnt lgkmcnt(0)" ::: "memory");
#pragma unroll
            for (int r = 0; r < 16; ++r) { const float av = al_l[crow(r, hi)];
#pragma unroll
                for (int d = 0; d < 8; ++d) o[d][r] *= av; } }
        bf16x8 pa0, pa1, pa2, pa3;
        finishSM(p0, p1, alpha, l_reg, pa0, pa1, pa2, pa3);
        const unsigned vbase = (unsigned)(uintptr_t)(lds + D_OFF_V) + (unsigned)v_rd_base(lane) + (unsigned)(cur * 32768);
        if constexpr (PVAR == 4 || PVAR == 7 || PVAR == 8) {
#pragma unroll
            for (int d = 0; d < 8; ++d) { o[d] = __builtin_amdgcn_mfma_f32_32x32x16_bf16(pa0, pa1, o[d], 0, 0, 0); o[d] = __builtin_amdgcn_mfma_f32_32x32x16_bf16(pa1, pa2, o[d], 0, 0, 0);
                o[d] = __builtin_amdgcn_mfma_f32_32x32x16_bf16(pa2, pa3, o[d], 0, 0, 0); o[d] = __builtin_amdgcn_mfma_f32_32x32x16_bf16(pa3, pa0, o[d], 0, 0, 0); } }
        else { pv_tile(o, vbase, pa0, pa1, pa2, pa3); pv_tile(o + 4, vbase + 16384u, pa0, pa1, pa2, pa3); }
        }
        asm volatile("s_waitcnt vmcnt(0)" ::: "memory");
        __syncthreads();
    }
    { int tl = tid; asm volatile("" : "+v"(tl));
      const int lane = tl & 63, r32 = lane & 31, hi = lane >> 5;
      LAS float* li_l = (LAS float*)(lds + D_OFF_WS + wid * 256);
      if (hi == 0) li_l[r32] = l_reg;
      asm volatile("s_waitcnt lgkmcnt(0)" ::: "memory");
#pragma unroll
      for (int r = 0; r < 16; ++r) { const float rl = __builtin_amdgcn_rcpf(li_l[crow(r, hi)]);
#pragma unroll
          for (int d = 0; d < 8; ++d) o[d][r] *= rl; } }
#undef TROW
#undef DMA16
#undef ISSUE_D
}
#endif
__device__ __forceinline__ void store_o_bf16(const f32x16* o, bf16_t* Ow, int ldo, int tid) {
    asm volatile("" : "+v"(tid)); const int r32 = tid & 31, hi = (tid >> 5) & 1;
#pragma unroll
    for (int r = 0; r < 16; ++r) { const int orow = crow(r, hi);
#pragma unroll
        for (int d0 = 0; d0 < 4; ++d0) { const float v = o[d0][r]; const float vn = __shfl_xor(v, 1);
            if ((r32 & 1) == 0) *(GAS unsigned*)(Ow + (size_t)orow * ldo + d0 * 32 + r32) = cvt_pk_bf16(v, vn); }
        asm volatile("" ::: "memory"); }
}
}

constexpr size_t MiB = (size_t)1 << 20;
constexpr size_t WS_CTL = 0, CTL_ZERO_BYTES = 1 * MiB;
constexpr size_t WS_PRM = 1 * MiB;
constexpr size_t WS_COS = 2 * MiB, WS_SIN = 3 * MiB;
constexpr size_t WS_RSTD = 4 * MiB;
constexpr size_t WS_STATQ = 14 * MiB, WS_STATKV = 17 * MiB;
constexpr size_t WS_STATM = 5 * MiB;
constexpr size_t WS_FLOG = 10 * MiB, WS_CUM = 12 * MiB;
constexpr size_t WS_W = 20 * MiB;
constexpr size_t SZ_EVIN = 61 * MiB, SZ_UQ = 6 * MiB, SZ_UKV = 4 * MiB, SZ_SQ = 33 * MiB, SZ_ODIN = 98 * MiB, SZ_GU = 175 * MiB, SZ_DN = 87 * MiB;
constexpr size_t W_EVIN = WS_W, W_UQ = W_EVIN + 2 * SZ_EVIN, W_UKV = W_UQ + 2 * SZ_UQ, W_EVOUT = W_UKV + 2 * SZ_UKV, W_ODIN = W_EVOUT + 2 * SZ_SQ, W_ODOUT = W_ODIN + 2 * SZ_ODIN,
                 W_GU = W_ODOUT + 2 * SZ_SQ, W_DN = W_GU + DEPTH * SZ_GU;
constexpr size_t WS_HS = W_DN + DEPTH * SZ_DN;
constexpr size_t WS_HBF = WS_HS + 260 * MiB;
constexpr size_t WS_PROJ = WS_HBF + 133 * MiB;
constexpr size_t WS_QBUF = WS_PROJ + 246 * MiB, WS_KVBUF = WS_PROJ + 346 * MiB;
constexpr size_t WS_OBUF = WS_PROJ + 479 * MiB;
constexpr size_t WS_MBUF = WS_OBUF + 133 * MiB;
constexpr size_t WS_DSCR = WS_MBUF + 133 * MiB;
constexpr size_t WS_PART = WS_DSCR + 64 * MiB;
constexpr size_t WS_END = WS_PART + 12 * MiB;
static_assert((size_t)EV_N * LD_DM * 2 <= SZ_EVIN && (size_t)UQ_N * LD_QR * 2 <= SZ_UQ && (size_t)UKV_N * LD_KV * 2 <= SZ_UKV && (size_t)DM * LD_DM * 2 <= SZ_SQ && (size_t)OD_N * LD_DM * 2 <= SZ_ODIN && (size_t)GU_N * LD_DM * 2 <= SZ_GU && (size_t)DM * LD_FF * 2 <= SZ_DN, "weight sizes");
static_assert((size_t)MPAD * DM * 4 == 260 * MiB && (size_t)MPAD * LD_DM * 2 <= 133 * MiB && (size_t)MPAD * LD_EV * 2 <= 246 * MiB && (size_t)MPAD * LD_UQ * 2 <= 100 * MiB && (size_t)MPAD * LD_UKV * 2 <= 133 * MiB && (size_t)MPAD * LD_OD * 2 <= 479 * MiB && (size_t)MPAD * LD_FF * 2 <= 479 * MiB, "activation sizes");
constexpr int LD8 = 4224;
constexpr size_t WS_A8 = WS_PROJ + 352 * MiB, WS_RS8 = WS_RSTD + 512 * 1024;
constexpr size_t CTL_COLMAX = 65536;
constexpr int I8_IN_ODD = 3;
constexpr size_t CTL_COLMAX_OD = CTL_COLMAX + (size_t)DEPTH * GU_N * 4;
constexpr size_t W_OD8_OFF = 90 * MiB;
constexpr int I8_IN_EV = 2;
constexpr size_t CTL_COLMAX_EV = CTL_COLMAX_OD + 2 * (size_t)OD_N * 4;
static_assert(CTL_COLMAX_EV + 2 * (size_t)EV_N * 4 <= CTL_ZERO_BYTES && (size_t)EV_N * LD8 <= SZ_EVIN, "int8 even in-proj buffers");
static_assert(CTL_COLMAX_OD + 2 * (size_t)OD_N * 4 <= CTL_ZERO_BYTES && (size_t)GU_N * LD8 <= W_OD8_OFF && W_OD8_OFF + (size_t)OD_N * LD8 <= SZ_GU && (size_t)MPAD * LD8 <= 133 * MiB, "int8 in-proj buffers");
static_assert((size_t)MPAD * LD_FF * 2 <= 352 * MiB && 352 * MiB + (size_t)MPAD * LD8 <= 479 * MiB && (size_t)GU_N * LD8 <= SZ_GU && CTL_COLMAX + (size_t)DEPTH * GU_N * 4 <= CTL_ZERO_BYTES, "int8 buffers");
constexpr int I8_DN = 14;
constexpr int LD8F = 11136;
constexpr size_t CTL_COLMAX_DN = CTL_COLMAX_EV + 2 * (size_t)EV_N * 4;
constexpr size_t WS_ACT8 = WS_HS, WS_AMAXP = WS_HS + 180 * MiB, WS_RSD = WS_RSTD + 768 * 1024;
static_assert(CTL_COLMAX_DN + (size_t)DEPTH * DM * 4 <= CTL_ZERO_BYTES && (size_t)MPAD * LD8F <= 180 * MiB && 180 * MiB + (size_t)MPAD * AMAXP_LD * 4 <= 260 * MiB && (size_t)DM * LD8F <= SZ_DN && (GU_N / 256) * 4 <= AMAXP_LD, "int8 down buffers");
constexpr int CW_BAR = 4096;

constexpr int RING_BYTES = 131072;
constexpr int PRO_SCR_BYTES = 8 * 16640;
constexpr int MISC_OFF = 135168 + 320;
constexpr int LDS_BYTES = 147456;
static_assert(att::LDS_END <= RING_BYTES && att::D_LDS_END <= RING_BYTES && PRO_SCR_BYTES <= 135168 && MISC_OFF + 64 <= LDS_BYTES, "LDS map");

#define LDS_WAIT() asm volatile("s_waitcnt lgkmcnt(0)" ::: "memory")
#define VM_WAIT() asm volatile("s_waitcnt vmcnt(0)" ::: "memory")

#define XB_TMO      128
#define XB_XCNT(j)  (256  + 64 * (j))
#define XB_XSUB(j)  (1280 + 64 * (j))
#define XB_XGEN(j)  (2304 + 64 * (j))
#define XB_TOP      3328
#define XB_TOPGEN   3392
#define XCD_BAR_WORDS 3456
#define XB_SPIN_CAP (1u << 18)

__device__ __forceinline__ unsigned xb_ld(unsigned* p)              { return __hip_atomic_load(p, __ATOMIC_RELAXED, __HIP_MEMORY_SCOPE_AGENT); }
__device__ __forceinline__ unsigned xb_add(unsigned* p, unsigned v) { return __hip_atomic_fetch_add(p, v, __ATOMIC_RELAXED, __HIP_MEMORY_SCOPE_AGENT); }
__device__ __forceinline__ unsigned xb_xcc_id() { return (unsigned)__builtin_amdgcn_s_getreg((3 << 11) | 20) & 0xFu; }
#define XB_SPIN(cond, bar) do { unsigned _sp = 0; while (cond) { __builtin_amdgcn_s_sleep(1); \
    if ((++_sp & 255u) == 0u) { if (xb_ld(&(bar)[XB_TMO])) break; if (_sp > XB_SPIN_CAP) { atomicAdd(&(bar)[XB_TMO], 1u); break; } } } } while (0)

struct XcdBarrier {
    unsigned* bar; unsigned x;
    volatile LAS unsigned* st;
};

__device__ __forceinline__ XcdBarrier xcd_barrier_post(unsigned* bar, volatile LAS unsigned* st, int tid) {
    XcdBarrier b; b.bar = bar; b.x = xb_xcc_id(); b.st = st;
    if (tid == 0) (void)xb_add(&bar[XB_XCNT(b.x)], 1u);
    return b;
}
__device__ __forceinline__ void xcd_barrier_complete(unsigned* bar, unsigned x, unsigned& nloc, unsigned& nx) {
    const unsigned G = gridDim.x * gridDim.y * gridDim.z;
    unsigned sum, cnt, mine, sp = 0u;
    for (;;) {
        sum = 0u; cnt = 0u; mine = 0u;
#pragma unroll
        for (unsigned j = 0; j < 16; ++j) { const unsigned c = xb_ld(&bar[XB_XCNT(j)]); sum += c; cnt += (c > 0u) ? 1u : 0u; mine = (j == x) ? c : mine; }
        if (sum == G) break;
        __builtin_amdgcn_s_sleep(1);
        if ((++sp & 255u) == 0u) { if (xb_ld(&bar[XB_TMO])) break; if (sp > XB_SPIN_CAP) { atomicAdd(&bar[XB_TMO], 1u); break; } }
    }
    nloc = mine > 0u ? mine : 1u; nx = cnt > 0u ? cnt : 1u;
}

__device__ __forceinline__ void xcd_barrier(const XcdBarrier& b, int tid) {
    asm volatile("s_waitcnt vmcnt(0)" ::: "memory");
    __syncthreads();
    if (tid == 0) {
        unsigned* bar = b.bar;
        __builtin_amdgcn_s_waitcnt(0);
        unsigned nloc = b.st[0], nx = b.st[1];
        if (nloc == 0u) { xcd_barrier_complete(bar, b.x, nloc, nx); b.st[0] = nloc; b.st[1] = nx; }
        const unsigned old = xb_add(&bar[XB_XSUB(b.x)], 1u);
        const unsigned gen = old / nloc;
        if (old + 1u == (gen + 1u) * nloc) {
            __builtin_amdgcn_fence(__ATOMIC_RELEASE, "agent");
            asm volatile("s_waitcnt vmcnt(0)" ::: "memory");
            const unsigned og = xb_add(&bar[XB_TOP], 1u);
            const unsigned tg = og / nx;
            if (og + 1u == (tg + 1u) * nx) xb_add(&bar[XB_TOPGEN], 1u);
            else XB_SPIN(xb_ld(&bar[XB_TOPGEN]) == tg, bar);
            __builtin_amdgcn_fence(__ATOMIC_ACQUIRE, "agent");
            xb_add(&bar[XB_XGEN(b.x)], 1u);
            asm volatile("s_waitcnt vmcnt(0)" ::: "memory");
        } else {
            XB_SPIN(xb_ld(&bar[XB_XGEN(b.x)]) == gen, bar);
            __builtin_amdgcn_fence(__ATOMIC_ACQUIRE, "agent");
            asm volatile("s_waitcnt vmcnt(0)" ::: "memory");
        }
    }
    __syncthreads();
}

struct Args { const float* in[18]; float* out; unsigned char* ws; int ph_lo, ph_hi; float lam_init[2]; };
enum { IN_X = 0, IN_META, IN_RELB, IN_EVWIN, IN_EVBF, IN_EVQN, IN_EVKVN, IN_EVWUQ, IN_EVWUKV, IN_EVWOUT, IN_ODWIN, IN_ODLAM, IN_ODSUBLN, IN_ODWOUT, IN_NORMG, IN_WGATE, IN_WUP, IN_WDOWN };

struct Frame {
    LAS unsigned char* lds;
    int tid, lane, wave, vcu, G, bx;
    unsigned char* ws;
};

__device__ __forceinline__ int ropeperm(int j) { const int a = j >> 3, e = j & 7; return e < 4 ? 4 * a + e : 32 + 4 * a + (e - 4); }
struct CvtDesc { const float* W; int N, srccol; const float* gain; int Ksrc, k0; bf16_t* WT; int Kdst, dstrow0; const float* cmax; int had; };
__device__ __forceinline__ unsigned pk4_i8(float a, float b, float c, float d) {
    const float M = 12582912.0f;
    const unsigned ab = __builtin_amdgcn_perm(__float_as_uint(b + M), __float_as_uint(a + M), 0x0c0c0400u), cd = __builtin_amdgcn_perm(__float_as_uint(d + M), __float_as_uint(c + M), 0x0c0c0400u);
    return __builtin_amdgcn_perm(cd, ab, 0x05040100u);
}
typedef unsigned short u16x2 __attribute__((ext_vector_type(2)));
__device__ __forceinline__ unsigned pkmax(unsigned a, unsigned b) { return __builtin_bit_cast(unsigned, __builtin_elementwise_max(__builtin_bit_cast(u16x2, a), __builtin_bit_cast(u16x2, b))); }
__device__ __forceinline__ unsigned opq(unsigned v) { asm volatile("" : "+v"(v)); return v; }
__device__ __forceinline__ float wave_max(float v) {
#pragma unroll
    for (int o = 1; o < 64; o <<= 1) v = fmaxf(v, __shfl_xor(v, o));
    return v;
}
__device__ __forceinline__ void fwht8_32(float (&v)[8], int lane) {
    f32x2 a = {v[0], v[1]}, b = {v[2], v[3]}, c = {v[4], v[5]}, d = {v[6], v[7]}, t;
    t = a + c; c = a - c; a = t; t = b + d; d = b - d; b = t;
    t = a + b; b = a - b; a = t; t = c + d; d = c - d; c = t;
    a = (f32x2){a[0] + a[1], a[0] - a[1]}; b = (f32x2){b[0] + b[1], b[0] - b[1]}; c = (f32x2){c[0] + c[1], c[0] - c[1]}; d = (f32x2){d[0] + d[1], d[0] - d[1]};
    const float s1 = (lane & 1) ? -1.f : 1.f, s2 = (lane & 2) ? -1.f : 1.f;
#define FW_X(x, ctrl) __int_as_float(__builtin_amdgcn_update_dpp(0, __float_as_int(x), ctrl, 0xf, 0xf, true))
#define FW_ST(p, sg, ctrl) do { const f32x2 q_ = {FW_X(p[0], ctrl), FW_X(p[1], ctrl)}; p = p * (f32x2){sg, sg} + q_; } while (0)
    FW_ST(a, s1, 0xB1); FW_ST(b, s1, 0xB1); FW_ST(c, s1, 0xB1); FW_ST(d, s1, 0xB1);
    FW_ST(a, s2, 0x4E); FW_ST(b, s2, 0x4E); FW_ST(c, s2, 0x4E); FW_ST(d, s2, 0x4E);
#undef FW_ST
#undef FW_X
    v[0] = a[0]; v[1] = a[1]; v[2] = b[0]; v[3] = b[1]; v[4] = c[0]; v[5] = c[1]; v[6] = d[0]; v[7] = d[1];
}
__device__ __forceinline__ void cvt_load(const CvtDesc& d, f32x4 (&v)[16], int lane) {
    const int kq = lane >> 4;
#pragma unroll
    for (int i = 0; i < 16; ++i) { const int k = d.k0 + 4 * i + kq;
        v[i] = (d.srccol >= 0 && k < d.Ksrc) ? __builtin_nontemporal_load((const f32x4*)(d.W + (size_t)k * d.N + d.srccol)) : (f32x4){0.f, 0.f, 0.f, 0.f}; }
}
__device__ __forceinline__ void cvt_finish(const CvtDesc& d, f32x4 (&v)[16], LAS float* scr, int lane) {
    const int l16 = lane & 15, kq = lane >> 4;
    if (d.gain) {
#pragma unroll
        for (int i = 0; i < 16; ++i) { const int k = d.k0 + 4 * i + kq; if (k < d.Ksrc) v[i] = v[i] * d.gain[k]; } }
#pragma unroll
    for (int i = 0; i < 16; ++i) { LAS float* q = scr + (4 * i + kq) * 65 + 4 * l16; q[0] = v[i][0]; q[1] = v[i][1]; q[2] = v[i][2]; q[3] = v[i][3]; }
    LDS_WAIT(); asm volatile("" ::: "memory");
    const int c = lane & 7, nr = lane >> 3;
    if (d.cmax) {
#pragma unroll
        for (int j = 0; j < 8; ++j) { const int n = nr + 8 * j; const LAS float* t = scr + (8 * c) * 65 + n;
            const float cm = d.cmax[d.dstrow0 + n], inv = cm > 0.f ? 127.0f * __builtin_amdgcn_rcpf(cm) : 0.f;
            float v[8];
#pragma unroll
            for (int i = 0; i < 8; ++i) v[i] = t[i * 65];
            if (d.had) fwht8_32(v, lane);
            u32x2 o; o.x = pk4_i8(v[0] * inv, v[1] * inv, v[2] * inv, v[3] * inv); o.y = pk4_i8(v[4] * inv, v[5] * inv, v[6] * inv, v[7] * inv);
            __builtin_nontemporal_store(o, (u32x2*)((unsigned char*)d.WT + (size_t)(d.dstrow0 + n) * d.Kdst + d.k0 + 8 * c)); }
        LDS_WAIT(); asm volatile("" ::: "memory");
        return;
    }
    if (d.had) {
#pragma unroll
        for (int j = 0; j < 8; ++j) { const int n = nr + 8 * j; const LAS float* t = scr + (8 * c) * 65 + n;
            float v[8];
#pragma unroll
            for (int i = 0; i < 8; ++i) v[i] = t[i * 65];
            fwht8_32(v, lane);
            u32x4 o; o.x = cvt_pk_bf16(v[0] * 0.03125f, v[1] * 0.03125f); o.y = cvt_pk_bf16(v[2] * 0.03125f, v[3] * 0.03125f); o.z = cvt_pk_bf16(v[4] * 0.03125f, v[5] * 0.03125f); o.w = cvt_pk_bf16(v[6] * 0.03125f, v[7] * 0.03125f);
            __builtin_nontemporal_store(o, (u32x4*)(d.WT + (size_t)(d.dstrow0 + n) * d.Kdst + d.k0 + 8 * c)); }
        LDS_WAIT(); asm volatile("" ::: "memory");
        return;
    }
#pragma unroll
    for (int j = 0; j < 8; ++j) { const int n = nr + 8 * j; const LAS float* t = scr + (8 * c) * 65 + n;
        u32x4 o; o.x = cvt_pk_bf16(t[0 * 65], t[1 * 65]); o.y = cvt_pk_bf16(t[2 * 65], t[3 * 65]); o.z = cvt_pk_bf16(t[4 * 65], t[5 * 65]); o.w = cvt_pk_bf16(t[6 * 65], t[7 * 65]);
        __builtin_nontemporal_store(o, (u32x4*)(d.WT + (size_t)(d.dstrow0 + n) * d.Kdst + d.k0 + 8 * c)); }
    LDS_WAIT(); asm volatile("" ::: "memory");
}
constexpr int I_EVIN = 64 * (EV_N / 64), I_UQ = (QRANK / 64) * (UQ_N / 64), I_UKV = (KVK / 64) * (UKV_N / 64), I_SQ = 64 * (DM / 64), I_ODIN = 64 * (OD_N / 64);
constexpr int I_PAIR = I_EVIN + I_UQ + I_UKV + I_SQ + I_ODIN + I_SQ;
constexpr int I_GU = 64 * (GU_N / 64), I_DN = (DFF / 64) * (DM / 64), I_FFN = I_GU + I_DN;
constexpr int N_CVT_ITEMS = 2 * I_PAIR + DEPTH * I_FFN;

__device__ __forceinline__ CvtDesc cvt_describe(const Args& A, unsigned char* ws, int it, int lane) {
    const int l4 = 4 * (lane & 15);
    const float* ng = A.in[IN_NORMG];
    if (it < 2 * I_PAIR) {
        const int e = it / I_PAIR; int r = it - e * I_PAIR;
        if (r < I_EVIN) { const int nblk = EV_N / 64, kb = r / nblk, nb = r - kb * nblk, n = nb * 64 + l4;
            int sc;
            if (n < EV_CQ) sc = n; else if (n < EV_KR) sc = n + 16; else if (n < EV_FL) sc = 7376 + ropeperm(n - EV_KR); else if (n < EV_FL + 16) sc = 6144 + (n - EV_FL); else sc = -1;
            return CvtDesc{A.in[IN_EVWIN] + (size_t)e * DM * EV_SRC_N, EV_SRC_N, sc, ng + (size_t)(2 * e * 4 + 0) * DM, DM, kb * 64, (bf16_t*)(ws + W_EVIN + e * SZ_EVIN), LD_DM, nb * 64}; }
        r -= I_EVIN;
        if (r < I_UQ) { const int nblk = UQ_N / 64, kb = r / nblk, nb = r - kb * nblk, n = nb * 64 + l4;
            int sc; if (n < 2048) sc = (n >> 7) * 192 + (n & 127); else { const int j2 = n - 2048; sc = (j2 >> 6) * 192 + 128 + ropeperm(j2 & 63); }
            return CvtDesc{A.in[IN_EVWUQ] + (size_t)e * QRANK * UQ_N, UQ_N, sc, A.in[IN_EVQN] + e * QRANK, QRANK, kb * 64, (bf16_t*)(ws + W_UQ + e * SZ_UQ), LD_QR, nb * 64}; }
        r -= I_UQ;
        if (r < I_UKV) { const int nblk = UKV_N / 64, kb = r / nblk, nb = r - kb * nblk, n = nb * 64 + l4;
            int sc; if (n < 2048) sc = (n >> 7) * 256 + (n & 127); else { const int n2 = n - 2048; sc = (n2 >> 7) * 256 + 128 + (n2 & 127); }
            return CvtDesc{A.in[IN_EVWUKV] + (size_t)e * KVRANK * UKV_N, UKV_N, sc, A.in[IN_EVKVN] + e * KVRANK, KVRANK, kb * 64, (bf16_t*)(ws + W_UKV + e * SZ_UKV), LD_KV, nb * 64}; }
        r -= I_UKV;
        if (r < I_SQ) { const int nblk = DM / 64, kb = r / nblk, nb = r - kb * nblk;
            return CvtDesc{A.in[IN_EVWOUT] + (size_t)e * DM * DM, DM, nb * 64 + l4, nullptr, DM, kb * 64, (bf16_t*)(ws + W_EVOUT + e * SZ_SQ), LD_DM, nb * 64}; }
        r -= I_SQ;
        if (r < I_ODIN) { const int nblk = OD_N / 64, kb = r / nblk, nb = r - kb * nblk;
            return CvtDesc{A.in[IN_ODWIN] + (size_t)e * DM * OD_N, OD_N, nb * 64 + l4, ng + (size_t)((2 * e + 1) * 4 + 0) * DM, DM, kb * 64, (bf16_t*)(ws + W_ODIN + e * SZ_ODIN), LD_DM, nb * 64}; }
        r -= I_ODIN;
        { const int nblk = DM / 64, kb = r / nblk, nb = r - kb * nblk;
            return CvtDesc{A.in[IN_ODWOUT] + (size_t)e * DM * DM, DM, nb * 64 + l4, nullptr, DM, kb * 64, (bf16_t*)(ws + W_ODOUT + e * SZ_SQ), LD_DM, nb * 64}; }
    }
    it -= 2 * I_PAIR;
    const int L = it / I_FFN; int r = it - L * I_FFN;
    if (r < I_GU) { const int nblk = GU_N / 64, kb = r / nblk, nb = r - kb * nblk, n0 = nb * 64, tile = n0 >> 8, w = n0 & 255;
        const float* src = (w < 128 ? A.in[IN_WGATE] : A.in[IN_WUP]) + (size_t)L * DM * DFF;
        return CvtDesc{src, DFF, tile * 128 + (w & 127) + l4, ng + (size_t)(L * 4 + 2) * DM, DM, kb * 64, (bf16_t*)(ws + W_GU + L * SZ_GU), LD8, n0, (const float*)(ws + WS_CTL + CTL_COLMAX) + (size_t)L * GU_N}; }
    r -= I_GU;
    { const int nblk = DM / 64, kb = r / nblk, nb = r - kb * nblk;
        return CvtDesc{A.in[IN_WDOWN] + (size_t)L * DFF * DM, DM, nb * 64 + l4, nullptr, DFF, kb * 64, (bf16_t*)(ws + W_DN + L * SZ_DN), LD_FF, nb * 64}; }
}

__device__ __forceinline__ int ev_srccol(int n) {
    if (n < EV_CQ) return n; if (n < EV_KR) return n + 16; if (n < EV_FL) return 7376 + ropeperm(n - EV_KR); if (n < EV_FL + 16) return 6144 + (n - EV_FL); return -1;
}
__device__ __forceinline__ void row_to_bf16(const float* xrow, bf16_t* orow, float* rstd, int lane) {
    float ss = 0.f;
#pragma unroll
    for (int j = 0; j < 8; ++j) { const f32x4 a = *(const f32x4*)(xrow + 8 * lane + 512 * j), b = *(const f32x4*)(xrow + 8 * lane + 512 * j + 4);
        ss += sq8(a, b); store8(orow + 8 * lane + 512 * j, a, b); }
    ss = wave_sum(ss);
    if (lane == 0) *rstd = rsqrtf(ss * (1.0f / DM) + EPS);
}
__device__ __forceinline__ void row_to_i8(const float* xrow, unsigned char* orow, float* rs8, int lane) {
    f32x4 a[8], b[8]; float ss = 0.f, mx = 0.f;
#pragma unroll
    for (int j = 0; j < 8; ++j) { a[j] = *(const f32x4*)(xrow + 8 * lane + 512 * j); b[j] = *(const f32x4*)(xrow + 8 * lane + 512 * j + 4);
        ss += sq8(a[j], b[j]);
        mx = fmaxf(mx, fmaxf(fmaxf(fmaxf(fabsf(a[j][0]), fabsf(a[j][1])), fmaxf(fabsf(a[j][2]), fabsf(a[j][3]))), fmaxf(fmaxf(fabsf(b[j][0]), fabsf(b[j][1])), fmaxf(fabsf(b[j][2]), fabsf(b[j][3]))))); }
    ss = wave_sum(ss); mx = wave_max(mx);
    const float inv = mx > 0.f ? 127.0f * __builtin_amdgcn_rcpf(mx) : 0.f;
#pragma unroll
    for (int j = 0; j < 8; ++j) { u32x2 q; q.x = pk4_i8(a[j][0] * inv, a[j][1] * inv, a[j][2] * inv, a[j][3] * inv); q.y = pk4_i8(b[j][0] * inv, b[j][1] * inv, b[j][2] * inv, b[j][3] * inv);
        *(u32x2*)(orow + 8 * lane + 512 * j) = q; }
    if (lane == 0) *rs8 = rsqrtf(ss * (1.0f / DM) + EPS) * mx * (1.0f / 16129.0f);
}
constexpr int N_OD8 = ((I8_IN_ODD & 1) + ((I8_IN_ODD >> 1) & 1));
constexpr int I_PAIR0 = I_PAIR - I_EVIN;
constexpr int N_EV8 = ((I8_IN_EV & 1) + ((I8_IN_EV >> 1) & 1));
constexpr int NP0 = I_PAIR - ((I8_IN_EV & 1) ? I_EVIN : 0) - ((I8_IN_ODD & 1) ? I_ODIN : 0), NP1 = I_PAIR - ((I8_IN_EV & 2) ? I_EVIN : 0) - ((I8_IN_ODD & 2) ? I_ODIN : 0);
__device__ __forceinline__ int pair_item(int r, int e) {
    if (!((I8_IN_EV >> e) & 1)) { if (r < I_EVIN) return r; r -= I_EVIN; }
    if (r < I_UQ + I_UKV + I_SQ) return I_EVIN + r;
    r -= I_UQ + I_UKV + I_SQ;
    if (!((I8_IN_ODD >> e) & 1)) { if (r < I_ODIN) return I_EVIN + I_UQ + I_UKV + I_SQ + r; r -= I_ODIN; }
    return I_EVIN + I_UQ + I_UKV + I_SQ + I_ODIN + r;
}
constexpr int N_DN8 = (I8_DN & 1) + ((I8_DN >> 1) & 1) + ((I8_DN >> 2) & 1) + ((I8_DN >> 3) & 1);
__device__ __forceinline__ int nth_layer(int idx, int mask) {
    int L = 0;
#pragma unroll
    for (int b = 0; b < DEPTH; ++b) { if ((mask >> b) & 1) { if (idx == 0) L = b; --idx; } }
    return L;
}
template <int PH> __device__ __forceinline__ CvtDesc cvt_desc(const Args& A, unsigned char* ws, int j, int lane) {
    if constexpr (PH == 0) {
        if (j < NP0) return cvt_describe(A, ws, pair_item(j, 0), lane);
        if (j < NP0 + NP1) return cvt_describe(A, ws, I_PAIR + pair_item(j - NP0, 1), lane);
        const int q = j - NP0 - NP1, idx = q / I_DN, L = nth_layer(idx, ~I8_DN & ((1 << DEPTH) - 1)); return cvt_describe(A, ws, 2 * I_PAIR + L * I_FFN + I_GU + (q - idx * I_DN), lane); }
    else {
        const int q = j;
        const int idx = q / I_DN, r = q - idx * I_DN, L = nth_layer(idx, I8_DN), nblk = DM / 64, kb = r / nblk, nb = r - kb * nblk;
        return CvtDesc{A.in[IN_WDOWN] + (size_t)L * DFF * DM, DM, nb * 64 + 4 * (lane & 15), nullptr, DFF, kb * 64, (bf16_t*)(ws + W_DN + L * SZ_DN), LD8F, nb * 64, (const float*)(ws + WS_CTL + CTL_COLMAX_DN) + (size_t)L * DM, 1};
    }
}
template <int PH> __device__ __forceinline__ void cvt_items(const Args& A, Frame& F) {
    constexpr int NIT = PH == 0 ? NP0 + NP1 + (DEPTH - N_DN8) * I_DN : N_DN8 * I_DN;
    LAS float* scr = (LAS float*)(F.lds + F.wave * 16640);
    const int gw = F.vcu * 8 + F.wave, NGW = F.G * 8;
    unsigned char* ws = F.ws;
    f32x4 vA[16], vB[16]; CvtDesc dA{}, dB{};
    int it = gw;
    if (it < NIT) { dA = cvt_desc<PH>(A, ws, it, F.lane); cvt_load(dA, vA, F.lane); }
    for (; it < NIT; it += 2 * NGW) {
        const int it1 = it + NGW, it2 = it1 + NGW;
        if (it1 < NIT) { dB = cvt_desc<PH>(A, ws, it1, F.lane); cvt_load(dB, vB, F.lane); }
        cvt_finish(dA, vA, scr, F.lane);
        if (it2 < NIT) { dA = cvt_desc<PH>(A, ws, it2, F.lane); cvt_load(dA, vA, F.lane); }
        if (it1 < NIT) cvt_finish(dB, vB, scr, F.lane);
    }
}
__device__ __forceinline__ int ropeperm_inv(int d) { return d < 32 ? 8 * (d >> 2) + (d & 3) : 8 * ((d - 32) >> 2) + 4 + ((d - 32) & 3); }
__device__ __forceinline__ int ev_dstcol(int sc) { if (sc < 6144) return sc; if (sc < 6160) return EV_FL + (sc - 6144); if (sc < 7376) return sc - 16; return EV_KR + ropeperm_inv(sc - 7376); }
constexpr int NS_GU = DFF / 32, NS_OD = OD_N / 32, NS_EV = (EV_SRC_N + 31) / 32, N_STRIPS = DEPTH * 2 * NS_GU + N_OD8 * NS_OD + N_EV8 * NS_EV, STRIP_SLOTS = 135168;
__device__ __forceinline__ void strip_phase(const Args& A, Frame& F) {
    LAS unsigned char* lds = F.lds; unsigned char* ws = F.ws; const int tid = F.tid;
    int par = 0;
    for (int s = F.vcu; s < N_STRIPS; s += F.G, par ^= 1) {
        LAS unsigned* slots = (LAS unsigned*)(lds + STRIP_SLOTS) + 32 * par;
        const float* src; const float* gain; unsigned char* dst; float* cmx; int N, c0, kind, rbase = 0;
        if (s < DEPTH * 2 * NS_GU) { const int mi = s / NS_GU, cb = s - mi * NS_GU, L = mi >> 1, up = mi & 1; kind = 0; N = DFF; c0 = cb * 32;
            src = (up ? A.in[IN_WUP] : A.in[IN_WGATE]) + (size_t)L * DM * DFF; gain = A.in[IN_NORMG] + (size_t)(L * 4 + 2) * DM;
            dst = ws + W_GU + (size_t)L * SZ_GU; cmx = (float*)(ws + WS_CTL + CTL_COLMAX) + (size_t)L * GU_N; rbase = (c0 >> 7) * 256 + up * 128 + (c0 & 127); }
        else if (s < DEPTH * 2 * NS_GU + N_OD8 * NS_OD) { const int q = s - DEPTH * 2 * NS_GU, idx = q / NS_OD, cb = q - idx * NS_OD, e = (I8_IN_ODD & 1) ? idx : 1; kind = 1; N = OD_N; c0 = cb * 32;
            src = A.in[IN_ODWIN] + (size_t)e * DM * OD_N; gain = A.in[IN_NORMG] + (size_t)((2 * e + 1) * 4 + 0) * DM;
            dst = ws + W_GU + (size_t)(2 * e + 1) * SZ_GU + W_OD8_OFF; cmx = (float*)(ws + WS_CTL + CTL_COLMAX_OD) + (size_t)e * OD_N; rbase = c0; }
        else { const int q = s - DEPTH * 2 * NS_GU - N_OD8 * NS_OD, idx = q / NS_EV, cb = q - idx * NS_EV, e = (I8_IN_EV & 1) ? idx : 1; kind = 2; N = EV_SRC_N; c0 = cb * 32 + 32 <= EV_SRC_N ? cb * 32 : EV_SRC_N - 32;
            src = A.in[IN_EVWIN] + (size_t)e * DM * EV_SRC_N; gain = A.in[IN_NORMG] + (size_t)(2 * e * 4 + 0) * DM;
            dst = ws + W_EVIN + (size_t)e * SZ_EVIN; cmx = (float*)(ws + WS_CTL + CTL_COLMAX_EV) + (size_t)e * EV_N; }
        if (tid < 32) slots[tid] = 0u;
        __syncthreads();
        const int cg = tid & 7;
        unsigned m0 = 0u, m1 = 0u;
        {
            const float* sp = src + (size_t)(tid >> 3) * N + c0 + 4 * cg;
#pragma unroll 1
            for (int h = 0; h < 2; ++h) {
                f32x4 v[16];
#pragma unroll
                for (int i = 0; i < 16; ++i) v[i] = __builtin_nontemporal_load((const f32x4*)(sp + (size_t)(64 * (16 * h + i)) * N));
#pragma unroll
                for (int i = 0; i < 16; ++i) { const int k = (tid >> 3) + 64 * (16 * h + i); const float g = gain[k];
                    u32x2 w; w.x = cvt_pk_bf16(v[i][0] * g, v[i][1] * g); w.y = cvt_pk_bf16(v[i][2] * g, v[i][3] * g);
                    m0 = pkmax(m0, w.x & 0x7fff7fffu); m1 = pkmax(m1, w.y & 0x7fff7fffu);
                    *(LAS u32x2*)(lds + (k >> 2) * 264 + (k & 3) * 64 + cg * 8) = w; }
            }
        }
        u32x2 rg[4][8];
        {   const float* sp = src + (size_t)(2048 + 8 * (tid >> 3)) * N + c0 + 4 * cg;
#pragma unroll
            for (int jj = 0; jj < 2; ++jj) {
                f32x4 v[16];
#pragma unroll
                for (int i = 0; i < 16; ++i) v[i] = __builtin_nontemporal_load((const f32x4*)(sp + (size_t)(512 * (2 * jj + (i >> 3)) + (i & 7)) * N));
#pragma unroll
                for (int i = 0; i < 16; ++i) { const int k = 2048 + 8 * (tid >> 3) + 512 * (2 * jj + (i >> 3)) + (i & 7); const float g = gain[k];
                    u32x2 w; w.x = cvt_pk_bf16(v[i][0] * g, v[i][1] * g); w.y = cvt_pk_bf16(v[i][2] * g, v[i][3] * g);
                    m0 = pkmax(m0, w.x & 0x7fff7fffu); m1 = pkmax(m1, w.y & 0x7fff7fffu);
                    rg[2 * jj + (i >> 3)][i & 7] = w; }
            }
        }
        atomicMax((unsigned*)(slots + 4 * cg + 0), m0 << 16); atomicMax((unsigned*)(slots + 4 * cg + 1), m0 & 0xffff0000u);
        atomicMax((unsigned*)(slots + 4 * cg + 2), m1 << 16); atomicMax((unsigned*)(slots + 4 * cg + 3), m1 & 0xffff0000u);
        __syncthreads();
        {
            const int ch = tid >> 1, hf = tid & 1;
            u32x2 w[8][4];
#pragma unroll
            for (int r = 0; r < 8; ++r) { const LAS u32x2* cp = (const LAS u32x2*)(lds + (2 * ch + (r >> 2)) * 264 + (r & 3) * 64 + hf * 32);
#pragma unroll
                for (int j = 0; j < 4; ++j) w[r][j] = cp[j]; }
#pragma unroll
            for (int n = 0; n < 16; ++n) {
                const float cm = __uint_as_float(slots[16 * hf + n]), inv = cm > 0.f ? 127.0f * __builtin_amdgcn_rcpf(cm) : 0.f;
                float x[8];
#pragma unroll
                for (int r = 0; r < 8; ++r) { const unsigned word = (n & 2) ? w[r][n >> 2].y : w[r][n >> 2].x; x[r] = ((n & 1) ? bf_hi(word) : bf_lo(word)) * inv; }
                u32x2 q; q.x = pk4_i8(x[0], x[1], x[2], x[3]); q.y = pk4_i8(x[4], x[5], x[6], x[7]);
                const int col = 16 * hf + n, drow = kind == 2 ? ev_dstcol(c0 + col) : rbase + col;
                __builtin_nontemporal_store(q, (u32x2*)(dst + (size_t)drow * LD8 + 8 * ch));
            }
        }
        {
#pragma unroll
            for (int c = 0; c < 4; ++c) {
                const float cm = __uint_as_float(slots[4 * cg + c]), inv = cm > 0.f ? 127.0f * __builtin_amdgcn_rcpf(cm) : 0.f;
                const int col = 4 * cg + c, drow = kind == 2 ? ev_dstcol(c0 + col) : rbase + col;
#pragma unroll
                for (int j = 0; j < 4; ++j) {
                    float x[8];
#pragma unroll
                    for (int r = 0; r < 8; ++r) { const unsigned word = (c & 2) ? rg[j][r].y : rg[j][r].x; x[r] = ((c & 1) ? bf_hi(word) : bf_lo(word)) * inv; }
                    u32x2 q; q.x = pk4_i8(x[0], x[1], x[2], x[3]); q.y = pk4_i8(x[4], x[5], x[6], x[7]);
                    __builtin_nontemporal_store(q, (u32x2*)(dst + (size_t)drow * LD8 + 2048 + 8 * ((tid >> 3) + 64 * j)));
                }
            }
        }
        if (tid < 32) { const int drow = kind == 2 ? ev_dstcol(c0 + tid) : rbase + tid; cmx[drow] = __uint_as_float(slots[tid]); }
    }
    __syncthreads();
    { const int gw = F.vcu * 8 + F.wave, NGW = F.G * 8;
      for (int r = gw; r < N_EV8 * (EV_N - EV_SRC_N); r += NGW) { const int idx = r / (EV_N - EV_SRC_N), row = EV_SRC_N + (r - idx * (EV_N - EV_SRC_N)), e = (I8_IN_EV & 1) ? idx : 1;
          unsigned char* d = ws + W_EVIN + (size_t)e * SZ_EVIN + (size_t)row * LD8; const u32x4 z = {0u, 0u, 0u, 0u};
#pragma unroll
          for (int j = 0; j < 4; ++j) *(u32x4*)(d + 16 * F.lane + 1024 * j) = z; } }
}
__device__ __forceinline__ void colmax_dn_pass(const Args& A, Frame& F) {
    const int gw = F.vcu * 8 + F.wave, NGW = F.G * 8, lane = F.lane;
    constexpr int NKC = DFF / 256, NCB = DM / 256;
    for (int item = gw; item < N_DN8 * NKC * NCB; item += NGW) {
        const int cb = item % NCB, q = item / NCB, kc = q % NKC, L = nth_layer(q / NKC, I8_DN);
        const float* src = A.in[IN_WDOWN] + (size_t)L * DFF * DM + (size_t)(kc * 256) * DM + cb * 256 + 4 * lane;
        f32x4 mx = {0.f, 0.f, 0.f, 0.f};
#pragma unroll 1
        for (int g = 0; g < 8; ++g) {
            f32x4 w[32];
#pragma unroll
            for (int i = 0; i < 32; ++i) w[i] = __builtin_nontemporal_load((const f32x4*)(src + (size_t)(g * 32 + i) * DM));
#pragma unroll
            for (int h = 1; h < 32; h <<= 1)
#pragma unroll
                for (int i = 0; i < 32; ++i) if (!(i & h)) { const f32x4 x = w[i], y = w[i | h]; w[i] = x + y; w[i | h] = x - y; }
#pragma unroll
            for (int i = 0; i < 32; ++i) { mx[0] = fmaxf(mx[0], fabsf(w[i][0])); mx[1] = fmaxf(mx[1], fabsf(w[i][1])); mx[2] = fmaxf(mx[2], fabsf(w[i][2])); mx[3] = fmaxf(mx[3], fabsf(w[i][3])); }
        }
        unsigned* dstp = (unsigned*)(F.ws + WS_CTL + CTL_COLMAX_DN) + (size_t)L * DM + cb * 256 + 4 * lane;
#pragma unroll
        for (int e = 0; e < 4; ++e) atomicMax(dstp + e, __float_as_uint(mx[e]));
    }
}
__device__ __forceinline__ void actq_load(u32x4 (&w)[22], const bf16_t* act, int row, int lane) {
    const char* src = (const char*)(act + (size_t)row * LD_FF);
#pragma unroll
    for (int j = 0; j < 22; ++j) { w[j] = (u32x4){0u, 0u, 0u, 0u}; if (8 * lane + 512 * j < DFF) w[j] = __builtin_nontemporal_load((const u32x4*)(src + 16 * lane + 1024 * j)); }
}
__device__ __forceinline__ void actq_row(u32x4 (&w)[22], unsigned char* act8, float* rsd, int row, int lane) {
    unsigned char* dst = act8 + (size_t)row * LD8F;
    unsigned amx2 = 0u;
#pragma unroll
    for (int j = 0; j < 22; ++j) {
        float v[8] = {bf_lo(w[j].x), bf_hi(w[j].x), bf_lo(w[j].y), bf_hi(w[j].y), bf_lo(w[j].z), bf_hi(w[j].z), bf_lo(w[j].w), bf_hi(w[j].w)};
        fwht8_32(v, lane);
        w[j].x = cvt_pk_bf16(v[0], v[1]); w[j].y = cvt_pk_bf16(v[2], v[3]); w[j].z = cvt_pk_bf16(v[4], v[5]); w[j].w = cvt_pk_bf16(v[6], v[7]);
        amx2 = pkmax(pkmax(amx2, w[j].x & 0x7fff7fffu), pkmax(w[j].y & 0x7fff7fffu, pkmax(w[j].z & 0x7fff7fffu, w[j].w & 0x7fff7fffu)));
    }
    const float m = wave_max(fmaxf(bf_lo(amx2), bf_hi(amx2)));
    const float inv = m > 0.f ? 127.0f * __builtin_amdgcn_rcpf(m) : 0.f;
#pragma unroll
    for (int j = 0; j < 22; ++j) { if (8 * lane + 512 * j < DFF) { u32x2 q;
        q.x = pk4_i8(bf_lo(w[j].x) * inv, bf_hi(w[j].x) * inv, bf_lo(w[j].y) * inv, bf_hi(w[j].y) * inv); q.y = pk4_i8(bf_lo(w[j].z) * inv, bf_hi(w[j].z) * inv, bf_lo(w[j].w) * inv, bf_hi(w[j].w) * inv);
        *(u32x2*)(dst + 8 * lane + 512 * j) = q; } }
    if (lane == 0) rsd[row] = m * (1.0f / (16129.0f * 32.0f));
}
__device__ __forceinline__ void actq_phase(Frame& F) {
    unsigned char* ws = F.ws;
    const int gw = F.vcu * 8 + F.wave, NGW = F.G * 8, lane = F.lane;
    const bf16_t* act = (const bf16_t*)(ws + WS_PROJ); unsigned char* act8 = ws + WS_ACT8; float* rsd = (float*)(ws + WS_RSD);
    u32x4 wA[22], wB[22];
    int row = gw;
    if (row < MPAD) actq_load(wA, act, row, lane);
    for (; row < MPAD; row += 2 * NGW) {
        const int r1 = row + NGW, r2 = r1 + NGW;
        if (r1 < MPAD) actq_load(wB, act, r1, lane);
        actq_row(wA, act8, rsd, row, lane);
        if (r2 < MPAD) actq_load(wA, act, r2, lane);
        if (r1 < MPAD) actq_row(wB, act8, rsd, r1, lane);
    }
}
__device__ __forceinline__ void p0_prologue(const Args& A, Frame& F) {
    const int gw = F.vcu * 8 + F.wave, NGW = F.G * 8;
    unsigned char* ws = F.ws;
    strip_phase(A, F);
    colmax_dn_pass(A, F);
    cvt_items<0>(A, F);
    { float* cosT = (float*)(ws + WS_COS); float* sinT = (float*)(ws + WS_SIN);
      for (int idx = gw * 64 + F.lane; idx < NPOS * 32; idx += NGW * 64) { const int pos = idx >> 5, i = idx & 31;
          const float inv = powf(10000.0f, -(float)i * (1.0f / 32.0f)); const float ang = (float)pos * inv;
          cosT[idx] = cosf(ang); sinT[idx] = sinf(ang); } }
    if (gw == 0) { float* prm = (float*)(ws + WS_PRM);
        for (int o = 0; o < 2; ++o) { const float* l = A.in[IN_ODLAM] + o * 4 * 128;
            const float s01 = wave_sum(l[F.lane] * l[128 + F.lane] + l[64 + F.lane] * l[192 + F.lane]);
            const float s23 = wave_sum(l[256 + F.lane] * l[384 + F.lane] + l[320 + F.lane] * l[448 + F.lane]);
            if (F.lane == 0) prm[o] = expf(s01) - expf(s23) + A.lam_init[o]; } }
    bf16_t* hbf = (bf16_t*)(ws + WS_HBF); float* rstd = (float*)(ws + WS_RSTD); unsigned char* a8 = ws + WS_OBUF; float* rs8 = (float*)(ws + WS_RS8);
    for (int row = gw; row < MPAD; row += NGW) {
        if (row < MUSED) { const float* src = row < MREAL ? A.in[IN_X] + (size_t)row * DM : A.in[IN_META] + (size_t)(row - MREAL) * DM;
            if constexpr (I8_IN_EV & 1) row_to_i8(src, a8 + (size_t)row * LD8, rs8 + row, F.lane); else row_to_bf16(src, hbf + (size_t)row * LD_DM, rstd + row, F.lane); }
        else { const u32x4 z = {0u, 0u, 0u, 0u};
#pragma unroll
            for (int j = 0; j < 8; ++j) *(u32x4*)(hbf + (size_t)row * LD_DM + 8 * F.lane + 512 * j) = z;
#pragma unroll
            for (int j = 0; j < 4; ++j) *(u32x4*)(a8 + (size_t)row * LD8 + 16 * F.lane + 1024 * j) = z;
            if (F.lane == 0) { rstd[row] = 0.f; rs8[row] = 0.f; } }
    }
}

__device__ __forceinline__ void ew_phase(const Args& A, Frame& F, int layer, int which) {
    unsigned char* ws = F.ws;
    const int gw = F.vcu * 8 + F.wave, NGW = F.G * 8, lane = F.lane;
    const float* gpost = A.in[IN_NORMG] + (size_t)(layer * 4 + (which ? 3 : 1)) * DM;
    const bool first = (layer == 0 && which == 0), last = (layer == DEPTH - 1 && which == 1);
    const bf16_t* mbuf = (const bf16_t*)(ws + WS_MBUF); bf16_t* hbf = (bf16_t*)(ws + WS_HBF);
    float* rstd = (float*)(ws + WS_RSTD); const float* statm = (const float*)(ws + WS_STATM);
    const bool q8 = (which == 0) || (layer + 1 < DEPTH && (((((layer + 1) & 1) ? I8_IN_ODD : I8_IN_EV) >> ((layer + 1) >> 1)) & 1));
    unsigned char* a8 = ws + (which == 0 ? WS_A8 : WS_OBUF); float* rs8 = (float*)(ws + WS_RS8);
    if (q8) {
        for (int row = MUSED + gw; row < MPAD; row += NGW) { const u32x4 z = {0u, 0u, 0u, 0u};
#pragma unroll
            for (int j = 0; j < 4; ++j) *(u32x4*)(a8 + (size_t)row * LD8 + 16 * lane + 1024 * j) = z;
            if (lane == 0) rs8[row] = 0.f; }
    }
    if (F.vcu < NMETA && !last) {
        const int r = F.vcu, row = MREAL + r, nS = which ? (DFF / 256) : (DM / 256), c0 = F.wave * 512 + 8 * lane;
        const float* part = (const float*)(ws + WS_PART) + (size_t)r * DM + c0;
        LAS float* red = (LAS float*)F.lds;
        f32x4 ma = {0.f, 0.f, 0.f, 0.f}, mb = {0.f, 0.f, 0.f, 0.f};
        if (which && ((I8_DN >> layer) & 1)) {
            i32x4 ia = {0, 0, 0, 0}, ib = {0, 0, 0, 0};
#pragma unroll 16
            for (int ks = 0; ks < DFF / 256; ++ks) { ia += *(const i32x4*)(part + (size_t)ks * 16 * DM); ib += *(const i32x4*)(part + (size_t)ks * 16 * DM + 4); }
            const float* cs = (const float*)(ws + WS_CTL + CTL_COLMAX_DN) + (size_t)layer * DM + c0; const float rsc = ((const float*)(ws + WS_RSD))[row];
            ma = __builtin_convertvector(ia, f32x4) * (*(const f32x4*)cs * rsc); mb = __builtin_convertvector(ib, f32x4) * (*(const f32x4*)(cs + 4) * rsc);
        } else {
#pragma unroll 16
        for (int ks = 0; ks < nS; ++ks) { ma += *(const f32x4*)(part + (size_t)ks * 16 * DM); mb += *(const f32x4*)(part + (size_t)ks * 16 * DM + 4); }
        }
        const float s1 = wave_sum(sq8(ma, mb));
        if (lane == 0) red[F.wave] = s1;
        __syncthreads();
        const float rm = __builtin_amdgcn_rsqf((((red[0] + red[1]) + (red[2] + red[3])) + ((red[4] + red[5]) + (red[6] + red[7]))) * (1.0f / DM) + EPS);
        f32x4 ha, hb;
        if (first) { ha = *(const f32x4*)(A.in[IN_META] + (size_t)r * DM + c0); hb = *(const f32x4*)(A.in[IN_META] + (size_t)r * DM + c0 + 4); }
        else { const u32x4 wh = *(const u32x4*)(hbf + (size_t)row * LD_DM + c0);
            ha = (f32x4){bf_lo(wh.x), bf_hi(wh.x), bf_lo(wh.y), bf_hi(wh.y)}; hb = (f32x4){bf_lo(wh.z), bf_hi(wh.z), bf_lo(wh.w), bf_hi(wh.w)}; }
        const f32x4 ga = *(const f32x4*)(gpost + c0), gb = *(const f32x4*)(gpost + c0 + 4);
        ha = ha + ma * rm * ga; hb = hb + mb * rm * gb;
        const float s2 = wave_sum(sq8(ha, hb));
        const float mxw = wave_max(fmaxf(fmaxf(fmaxf(fabsf(ha[0]), fabsf(ha[1])), fmaxf(fabsf(ha[2]), fabsf(ha[3]))), fmaxf(fmaxf(fabsf(hb[0]), fabsf(hb[1])), fmaxf(fabsf(hb[2]), fabsf(hb[3])))));
        if (lane == 0) { red[8 + F.wave] = s2; red[16 + F.wave] = mxw; }
        __syncthreads();
        store8(hbf + (size_t)row * LD_DM + c0, ha, hb);
        const float amx = fmaxf(fmaxf(fmaxf(red[16], red[17]), fmaxf(red[18], red[19])), fmaxf(fmaxf(red[20], red[21]), fmaxf(red[22], red[23])));
        if (q8) { const float inv = amx > 0.f ? 127.0f * __builtin_amdgcn_rcpf(amx) : 0.f;
            u32x2 q; q.x = pk4_i8(ha[0] * inv, ha[1] * inv, ha[2] * inv, ha[3] * inv); q.y = pk4_i8(hb[0] * inv, hb[1] * inv, hb[2] * inv, hb[3] * inv); *(u32x2*)(a8 + (size_t)row * LD8 + c0) = q; }
        if (F.tid == 0) { const float rr = __builtin_amdgcn_rsqf((((red[8] + red[9]) + (red[10] + red[11])) + ((red[12] + red[13]) + (red[14] + red[15]))) * (1.0f / DM) + EPS);
            rstd[row] = rr; if (q8) rs8[row] = rr * amx * (1.0f / 16129.0f); }
        __syncthreads();
    }
    u32x4 mv[8], ha[8], hb[8]; float sq = 0.f;
    unsigned v16 = (unsigned)lane * 16u, v32 = (unsigned)lane * 32u, v8 = (unsigned)lane * 8u;
    asm volatile("" : "+v"(v16), "+v"(v32), "+v"(v8));
    const char* const mbufc = (const char*)mbuf; const char* const hbfc = (const char*)hbf; const char* const xc = (const char*)A.in[IN_X]; const char* const gpc = (const char*)gpost;
#define EW_FETCH(j_, row_) do { mv[j_] = __builtin_nontemporal_load((const u32x4*)(mbufc + ((size_t)(row_) * (LD_DM * 2) + 1024 * (j_)) + opq(v16)));           \
        if (first) { ha[j_] = *(const u32x4*)(xc + ((size_t)(row_) * (DM * 4) + 2048 * (j_)) + opq(v32)); hb[j_] = *(const u32x4*)(xc + ((size_t)(row_) * (DM * 4) + 2048 * (j_) + 16) + opq(v32)); } \
        else { ha[j_] = *(const u32x4*)(hbfc + ((size_t)(row_) * (LD_DM * 2) + 1024 * (j_)) + opq(v16)); } } while (0)
    LAS u32x4* const wst = (LAS u32x4*)(F.lds + 1024 + F.wave * 8192) + lane;
    int row = gw;
    if (row < MREAL) {
#pragma unroll
        for (int j = 0; j < 8; ++j) EW_FETCH(j, row);
        sq = *(const float*)((const char*)statm + (size_t)row * 256 + opq((unsigned)lane * 4u)); }
    for (; row < MREAL; row += NGW) {
        asm volatile("" : "+v"(v16), "+v"(v32), "+v"(v8));
        unsigned amx2 = 0u;
        const float rm = __builtin_amdgcn_rsqf(wave_sum(sq) * (1.0f / DM) + EPS);
        const int nrow = row + NGW; const bool more = nrow < MREAL;
        if (more) sq = *(const float*)((const char*)statm + (size_t)nrow * 256 + opq((unsigned)lane * 4u));
        float ss2 = 0.f;
        char* const hbw = (char*)hbf + (size_t)row * (LD_DM * 2); char* const outw = (char*)A.out + (size_t)row * (DM * 4);
#pragma unroll
        for (int j = 0; j < 8; ++j) { const f32x4 g0 = *(const f32x4*)(gpc + 2048 * j + opq(v32)), g1 = *(const f32x4*)(gpc + (2048 * j + 16) + opq(v32));
            const f32x4 m0 = {bf_lo(mv[j].x), bf_hi(mv[j].x), bf_lo(mv[j].y), bf_hi(mv[j].y)}, m1 = {bf_lo(mv[j].z), bf_hi(mv[j].z), bf_lo(mv[j].w), bf_hi(mv[j].w)};
            f32x4 h0, h1;
            if (first) { h0 = (f32x4){__uint_as_float(ha[j].x), __uint_as_float(ha[j].y), __uint_as_float(ha[j].z), __uint_as_float(ha[j].w)}; h1 = (f32x4){__uint_as_float(hb[j].x), __uint_as_float(hb[j].y), __uint_as_float(hb[j].z), __uint_as_float(hb[j].w)}; }
            else { h0 = (f32x4){bf_lo(ha[j].x), bf_hi(ha[j].x), bf_lo(ha[j].y), bf_hi(ha[j].y)}; h1 = (f32x4){bf_lo(ha[j].z), bf_hi(ha[j].z), bf_lo(ha[j].w), bf_hi(ha[j].w)}; }
            const f32x4 n0 = h0 + m0 * rm * g0, n1 = h1 + m1 * rm * g1; ss2 += sq8(n0, n1);
            if (last) { *(f32x4*)(outw + 2048 * j + opq(v32)) = n0; *(f32x4*)(outw + (2048 * j + 16) + opq(v32)) = n1; }
            else { u32x4 wh; wh.x = cvt_pk_bf16(n0[0], n0[1]); wh.y = cvt_pk_bf16(n0[2], n0[3]); wh.z = cvt_pk_bf16(n1[0], n1[1]); wh.w = cvt_pk_bf16(n1[2], n1[3]);
                *(u32x4*)(hbw + 1024 * j + opq(v16)) = wh;
                if (q8) { wst[j * 64] = wh;
                    amx2 = pkmax(pkmax(amx2, wh.x & 0x7fff7fffu), pkmax(wh.y & 0x7fff7fffu, pkmax(wh.z & 0x7fff7fffu, wh.w & 0x7fff7fffu))); } }
            if (more) EW_FETCH(j, nrow);
        }
        if (!last) { ss2 = wave_sum(ss2); const float rr = __builtin_amdgcn_rsqf(ss2 * (1.0f / DM) + EPS);
            if (lane == 0) rstd[row] = rr;
            if (q8) { const float amax = wave_max(fmaxf(bf_lo(amx2), bf_hi(amx2))); const float inv = amax > 0.f ? 127.0f * __builtin_amdgcn_rcpf(amax) : 0.f;
                if (lane == 0) rs8[row] = rr * amax * (1.0f / 16129.0f);
                char* const a8w = (char*)a8 + (size_t)row * LD8;
#pragma unroll
                for (int j = 0; j < 8; ++j) { u32x2 q; const u32x4 w = wst[j * 64];
                    q.x = pk4_i8(bf_lo(w.x) * inv, bf_hi(w.x) * inv, bf_lo(w.y) * inv, bf_hi(w.y) * inv); q.y = pk4_i8(bf_lo(w.z) * inv, bf_hi(w.z) * inv, bf_lo(w.w) * inv, bf_hi(w.w) * inv);
                    *(u32x2*)(a8w + 512 * j + opq(v8)) = q; } } }
    }
#undef EW_FETCH
}

__device__ __forceinline__ float logsig(float x) { return fminf(x, 0.f) - 0.6931471805599453f * __builtin_amdgcn_logf(1.0f + __builtin_amdgcn_exp2f(-1.4426950408889634f * fabsf(x))); }
__device__ __forceinline__ void scan_phase(const Args& A, Frame& F, int e) {
    const int gw = (F.G - 1 - F.vcu) * 8 + F.wave, lane = F.lane;
    if (gw >= NB * 16) return;
    const int b = gw >> 4, h = gw & 15;
    const float* flogT = (const float*)(F.ws + WS_FLOG) + (size_t)h * MPAD; float* cumT = (float*)(F.ws + WS_CUM) + (size_t)h * MPAD;
    const float bf = A.in[IN_EVBF][e * 16 + h];
    float cm = 0.f, mine = 0.f;
#pragma unroll 1
    for (int m = 0; m < NMETA; ++m) { cm += logsig(flogT[META0 + m] + bf); if (lane == m) mine = cm; }
    if (b == 0) cumT[META0 + lane] = lane < NMETA ? mine : 0.f;
    const float* src = flogT + b * SEQ + lane * 64; float* dst = cumT + b * SEQ + lane * 64;
    float s = 0.f;
#pragma unroll 1
    for (int i = 0; i < 16; ++i) { const f32x4 v = *(const f32x4*)(src + 4 * i); s += (logsig(v[0] + bf) + logsig(v[1] + bf)) + (logsig(v[2] + bf) + logsig(v[3] + bf)); }
    float inc = s;
#pragma unroll
    for (int off = 1; off < 64; off <<= 1) { const float t = __shfl_up(inc, off); if (lane >= off) inc += t; }
    float run = cm + (inc - s);
#pragma unroll 1
    for (int i = 0; i < 16; ++i) { const f32x4 v = *(const f32x4*)(src + 4 * i); f32x4 o;
        run += logsig(v[0] + bf); o[0] = run; run += logsig(v[1] + bf); o[1] = run; run += logsig(v[2] + bf); o[2] = run; run += logsig(v[3] + bf); o[3] = run;
        *(f32x4*)(dst + 4 * i) = o; }
}

__device__ __forceinline__ void fixup_odd_meta(Frame& F, int e) {
    unsigned char* ws = F.ws;
    const float* part = (const float*)(ws + WS_PART); const float* rstd = (const float*)(ws + WS_RSTD); bf16_t* proj = (bf16_t*)(ws + WS_PROJ);
    const bool i8 = (I8_IN_ODD >> e) & 1;
    const float* cs = (const float*)(ws + WS_CTL + CTL_COLMAX_OD) + (size_t)e * OD_N; const float* rs8 = (const float*)(ws + WS_RS8);
    constexpr int CG = OD_N / 8;
    for (int item = F.vcu * 512 + F.tid; item < 256 * CG; item += F.G * 512) {
        const int r = item / CG, col = (item - r * CG) * 8;
        f32x4 a = {0.f, 0.f, 0.f, 0.f}, b = {0.f, 0.f, 0.f, 0.f};
        if (r < NMETA) {
            if (i8) { i32x4 ia = {0, 0, 0, 0}, ib = {0, 0, 0, 0};
#pragma unroll 16
                for (int ks = 0; ks < DM / 256; ++ks) { ia += *(const i32x4*)(part + (size_t)(ks * 16 + r) * OD_N + col); ib += *(const i32x4*)(part + (size_t)(ks * 16 + r) * OD_N + col + 4); }
                const float sc = rs8[META0 + r]; a = __builtin_convertvector(ia, f32x4) * (*(const f32x4*)(cs + col) * sc); b = __builtin_convertvector(ib, f32x4) * (*(const f32x4*)(cs + col + 4) * sc);
            } else {
#pragma unroll 16
            for (int ks = 0; ks < DM / 256; ++ks) { a += *(const f32x4*)(part + (size_t)(ks * 16 + r) * OD_N + col); b += *(const f32x4*)(part + (size_t)(ks * 16 + r) * OD_N + col + 4); }
            const float sc = rstd[META0 + r]; a = a * sc; b = b * sc;
            }
        }
        pg8::store8(proj + (size_t)(META0 + r) * LD_OD + col, a, b);
    }
}

__device__ __forceinline__ int t5_bucket(int d) {
    if (d < 16) return d;
    return 16 + (d >= 19) + (d >= 21) + (d >= 24) + (d >= 27) + (d >= 31) + (d >= 35) + (d >= 40) + (d >= 46) + (d >= 52) + (d >= 59) + (d >= 67) + (d >= 77) + (d >= 87) + (d >= 99) + (d >= 113);
}
__device__ __forceinline__ void attn_even_phase(Frame& F) {
    unsigned char* ws = F.ws; LAS char* lds = (LAS char*)F.lds;
    const bf16_t* proj = (const bf16_t*)(ws + WS_PROJ); const bf16_t* qbuf = (const bf16_t*)(ws + WS_QBUF); const bf16_t* kvbuf = (const bf16_t*)(ws + WS_KVBUF);
    bf16_t* obuf = (bf16_t*)(ws + WS_OBUF); const float* cumT = (const float*)(ws + WS_CUM);
    for (int i = F.vcu; i < 512 + 16; i += F.G) {
        const bool meta = i >= 512; const int bh = i >> 3, p = i & 7, b = meta ? 0 : bh >> 4, h = meta ? i - 512 : bh & 15, nblk = meta ? 1 : 2;
        for (int k = 0; k < nblk; ++k) {
            const int qb = meta ? 0 : (k == 0 ? 15 - p : p), qrow0 = meta ? META0 : b * SEQ + qb * 256;
            att::PassArgs a;
            a.Q = proj + (size_t)qrow0 * LD_EV + EV_QF + h * 128; a.ldq = LD_EV; a.Q2 = nullptr; a.ldq2 = 0;
            a.K = proj + EV_KF + h * 128; a.ldk = LD_EV; a.K2 = nullptr; a.ldk2 = 0; a.V = proj + EV_VF + h * 128; a.ldv = LD_EV;
            a.cum = cumT + (size_t)h * MPAD; a.krow0 = b * SEQ; a.qvp0 = meta ? 0 : 64 + qb * 256; a.NT = meta ? 1 : 4 * qb + 5; a.shift0 = 0;
            f32x16 o[4];
            att::attn_pass_dma<0>(a, lds, o, F.tid);
            att::store_o_bf16(o, obuf + (size_t)(qrow0 + F.wave * 32) * LD_DM + h * 128, LD_DM, F.tid);
        }
    }
    for (int i = F.vcu; i < 512 + 16; i += F.G) {
        const bool meta = i >= 512; const int bh = i >> 3, p = i & 7, b = meta ? 0 : bh >> 4, h = meta ? i - 512 : bh & 15, nblk = meta ? 1 : 2;
        for (int k = 0; k < nblk; ++k) {
            const int qb = meta ? 0 : (k == 0 ? 15 - p : p), qrow0 = meta ? META0 : b * SEQ + qb * 256;
            att::PassArgs a;
            a.Q = qbuf + (size_t)qrow0 * LD_UQ + h * 128; a.ldq = LD_UQ; a.Q2 = qbuf + (size_t)qrow0 * LD_UQ + 2048 + h * 64; a.ldq2 = LD_UQ;
            a.K = kvbuf + h * 128; a.ldk = LD_UKV; a.K2 = proj + EV_KR; a.ldk2 = LD_EV; a.V = kvbuf + 2048 + h * 128; a.ldv = LD_UKV;
            a.cum = nullptr; a.krow0 = b * SEQ; a.qvp0 = meta ? 0 : 64 + qb * 256; a.NT = meta ? 1 : 4 * qb + 5; a.shift0 = 0;
            f32x16 o[4];
            att::attn_pass_dma<1>(a, lds, o, F.tid);
            att::store_o_bf16(o, obuf + (size_t)(qrow0 + F.wave * 32) * LD_DM + 2048 + h * 128, LD_DM, F.tid);
        }
    }
}
__device__ __forceinline__ void attn_odd_phase(const Args& A, Frame& F, int o_idx) {
    unsigned char* ws = F.ws; LAS char* lds = (LAS char*)F.lds;
    const bf16_t* proj = (const bf16_t*)(ws + WS_PROJ); bf16_t* obuf = (bf16_t*)(ws + WS_OBUF);
    const float post = 1.0f - A.lam_init[o_idx];
    const float* subg = A.in[IN_ODSUBLN] + o_idx * 256; const float* relb = A.in[IN_RELB];
    float* S1base = (float*)(ws + WS_DSCR) + (size_t)(F.vcu & 255) * 65536;
    constexpr float INV_SCALE = 1.0f / att::Cfg<2>::SCALE;
    for (int i = F.vcu; i < 512 + 16; i += F.G) {
        const bool meta = i >= 512; const int bh = i >> 3, p = i & 7, b = meta ? 0 : bh >> 4, h = meta ? i - 512 : bh & 15, nblk = meta ? 1 : 2;
        for (int k = 0; k < nblk; ++k) {
            const int qb = meta ? 0 : (k == 0 ? 15 - p : p), qrow0 = meta ? META0 : b * SEQ + qb * 256;
            { int tt = F.tid; asm volatile("" : "+v"(tt));
              if (tt < 128) ((LAS float*)(lds + att::D_OFF_TBL))[tt] = tt <= 112 ? (relb[t5_bucket(tt) * 16 + h] - relb[31 * 16 + h]) * INV_SCALE : 0.f; }
            f32x16 o[8];
            for (int br = 0; br < 2; ++br) {
                att::PassArgs a;
                a.Q = proj + (size_t)qrow0 * LD_OD + h * 256 + br * 128; a.ldq = LD_OD; a.Q2 = nullptr; a.ldq2 = 0;
                a.K = proj + 4096 + h * 256 + br * 128; a.ldk = LD_OD; a.K2 = nullptr; a.ldk2 = 0; a.V = proj + 8192 + h * 256; a.ldv = LD_OD;
                a.cum = nullptr; a.krow0 = b * SEQ; a.qvp0 = meta ? 0 : 64 + qb * 256; a.NT = meta ? 1 : 4 * qb + 5; a.shift0 = meta ? 0 : 48;
                att::attn_pass_diff(a, lds, o, F.tid);
                if (br == 0) {
                    int tq = F.tid; asm volatile("" : "+v"(tq));
                    float* S1 = S1base + (size_t)tq * 4;
#pragma unroll
                    for (int d = 0; d < 8; ++d) {
#pragma unroll
                        for (int q = 0; q < 4; ++q) *(f32x4*)(S1 + (d * 4 + q) * 2048) = (f32x4){o[d][4 * q], o[d][4 * q + 1], o[d][4 * q + 2], o[d][4 * q + 3]}; }
                }
            }
            {
                int tq = F.tid; asm volatile("" : "+v"(tq));
                const float* S1 = S1base + (size_t)tq * 4;
                const float lam = ((const float*)(ws + WS_PRM))[o_idx];
                VM_WAIT();
#pragma unroll
                for (int d = 0; d < 8; ++d) {
#pragma unroll
                    for (int q = 0; q < 4; ++q) { const f32x4 s1 = *(const f32x4*)(S1 + (d * 4 + q) * 2048);
#pragma unroll
                        for (int j = 0; j < 4; ++j) o[d][4 * q + j] = s1[j] - lam * o[d][4 * q + j]; }
                    asm volatile("" ::: "memory"); }
            }
            int tq2 = F.tid; asm volatile("" : "+v"(tq2));
            const int r32 = tq2 & 31;
            float ssum[16];
#pragma unroll
            for (int r = 0; r < 16; ++r) { float t = 0.f;
#pragma unroll
                for (int d = 0; d < 8; ++d) t += o[d][r] * o[d][r];
#pragma unroll
                for (int off = 1; off < 32; off <<= 1) t += __shfl_xor(t, off);
                ssum[r] = __builtin_amdgcn_rsqf(t * (1.0f / 256.0f) + EPS) * post; }
#pragma unroll
            for (int d = 0; d < 8; ++d) { const float g = subg[d * 32 + r32];
#pragma unroll
                for (int r = 0; r < 16; ++r) o[d][r] *= ssum[r] * g; }
            bf16_t* Ow = obuf + (size_t)(qrow0 + F.wave * 32) * LD_DM + h * 256;
            att::store_o_bf16(o, Ow, LD_DM, F.tid);
            att::store_o_bf16(o + 4, Ow + 128, LD_DM, F.tid);
        }
    }
}
#ifdef PROBE_ATT
template <int PVAR>
__device__ __forceinline__ void attn_odd_phase_probe(const Args& A, Frame& F, int o_idx) {
    unsigned char* ws = F.ws; LAS char* lds = (LAS char*)F.lds;
    const bf16_t* proj = (const bf16_t*)(ws + WS_PROJ); bf16_t* obuf = (bf16_t*)(ws + WS_OBUF);
    const float post = 1.0f - A.lam_init[o_idx];
    const float* subg = A.in[IN_ODSUBLN] + o_idx * 256; const float* relb = A.in[IN_RELB];
    float* S1base = (float*)(ws + WS_DSCR) + (size_t)(F.vcu & 255) * 65536;
    constexpr float INV_SCALE = 1.0f / att::Cfg<2>::SCALE;
    for (int i = F.vcu; i < 512 + 16; i += F.G) {
        const bool meta = i >= 512; const int bh = i >> 3, p = i & 7, b = meta ? 0 : bh >> 4, h = meta ? i - 512 : bh & 15, nblk = meta ? 1 : 2;
        for (int k = 0; k < nblk; ++k) {
            const int qb = meta ? 0 : (k == 0 ? 15 - p : p), qrow0 = meta ? META0 : b * SEQ + qb * 256;
            { int tt = F.tid; asm volatile("" : "+v"(tt));
              if (tt < 128) ((LAS float*)(lds + att::D_OFF_TBL))[tt] = tt <= 112 ? (relb[t5_bucket(tt) * 16 + h] - relb[31 * 16 + h]) * INV_SCALE : 0.f; }
            f32x16 o[8];
            for (int br = 0; br < 2; ++br) {
                att::PassArgs a;
                a.Q = proj + (size_t)qrow0 * LD_OD + h * 256 + br * 128; a.ldq = LD_OD; a.Q2 = nullptr; a.ldq2 = 0;
                a.K = proj + 4096 + h * 256 + br * 128; a.ldk = LD_OD; a.K2 = nullptr; a.ldk2 = 0; a.V = proj + 8192 + h * 256; a.ldv = LD_OD;
                a.cum = nullptr; a.krow0 = b * SEQ; a.qvp0 = meta ? 0 : 64 + qb * 256; a.NT = meta ? 1 : 4 * qb + 5; a.shift0 = meta ? 0 : 48;
                if constexpr (PVAR == 0) att::attn_pass_diff(a, lds, o, F.tid); else att::attn_pass_diff_probe<PVAR>(a, lds, o, F.tid);
                if (br == 0) {
                    int tq = F.tid; asm volatile("" : "+v"(tq));
                    float* S1 = S1base + (size_t)tq * 4;
#pragma unroll
                    for (int d = 0; d < 8; ++d) {
#pragma unroll
                        for (int q = 0; q < 4; ++q) *(f32x4*)(S1 + (d * 4 + q) * 2048) = (f32x4){o[d][4 * q], o[d][4 * q + 1], o[d][4 * q + 2], o[d][4 * q + 3]}; }
                }
            }
            {
                int tq = F.tid; asm volatile("" : "+v"(tq));
                const float* S1 = S1base + (size_t)tq * 4;
                const float lam = ((const float*)(ws + WS_PRM))[o_idx];
                VM_WAIT();
#pragma unroll
                for (int d = 0; d < 8; ++d) {
#pragma unroll
                    for (int q = 0; q < 4; ++q) { const f32x4 s1 = *(const f32x4*)(S1 + (d * 4 + q) * 2048);
#pragma unroll
                        for (int j = 0; j < 4; ++j) o[d][4 * q + j] = s1[j] - lam * o[d][4 * q + j]; }
                    asm volatile("" ::: "memory"); }
            }
            int tq2 = F.tid; asm volatile("" : "+v"(tq2));
            const int r32 = tq2 & 31;
            float ssum[16];
#pragma unroll
            for (int r = 0; r < 16; ++r) { float t = 0.f;
#pragma unroll
                for (int d = 0; d < 8; ++d) t += o[d][r] * o[d][r];
#pragma unroll
                for (int off = 1; off < 32; off <<= 1) t += __shfl_xor(t, off);
                ssum[r] = __builtin_amdgcn_rsqf(t * (1.0f / 256.0f) + EPS) * post; }
#pragma unroll
            for (int d = 0; d < 8; ++d) { const float g = subg[d * 32 + r32];
#pragma unroll
                for (int r = 0; r < 16; ++r) o[d][r] *= ssum[r] * g; }
            bf16_t* Ow = obuf + (size_t)(qrow0 + F.wave * 32) * LD_DM + h * 256;
            att::store_o_bf16(o, Ow, LD_DM, F.tid);
            att::store_o_bf16(o + 4, Ow + 128, LD_DM, F.tid);
        }
    }
}
#endif

#ifndef PHM
#define PHM 1023
#endif
#ifndef P4SUB
#define P4SUB 7
#endif
constexpr int PPL = 9, N_PHASES = 2 + PPL * DEPTH;
__global__ void __launch_bounds__(512, 2) mega_fwd(Args args) {
    extern __shared__ __attribute__((aligned(16))) unsigned char lds_raw[];
    Frame F;
    F.lds = (LAS unsigned char*)lds_raw;
    const int wave_s = __builtin_amdgcn_readfirstlane((int)threadIdx.x >> 6);
    F.tid = opq_tid(wave_s); F.lane = F.tid & 63; F.wave = wave_s;
    F.G = gridDim.x; { const int bx = blockIdx.x; F.bx = bx; F.vcu = (F.G % 8 == 0) ? (bx % 8) * (F.G / 8) + bx / 8 : bx; }
    F.ws = args.ws;
    unsigned char* ws = args.ws;
    volatile LAS unsigned* MISC = (volatile LAS unsigned*)(F.lds + MISC_OFF);
    for (int u = F.tid; u < (LDS_BYTES - 135168) / 4; u += 512) ((LAS unsigned*)(F.lds + 135168))[u] = 0u;
    __syncthreads();
#if MK_ONE_LAUNCH
    XcdBarrier bar = xcd_barrier_post((unsigned*)(ws + WS_CTL) + CW_BAR, MISC + 8, F.tid);
#define IN(k) true
#else
    const int lo = args.ph_lo, hi = args.ph_hi;
    XcdBarrier bar; bar.bar = (unsigned*)(ws + WS_CTL) + CW_BAR; bar.x = 0; bar.st = nullptr;
    if (hi - lo > 1) bar = xcd_barrier_post((unsigned*)(ws + WS_CTL) + CW_BAR, MISC + 8, F.tid);
#define IN(k) (lo <= (k) && (k) < hi)
#endif
#define REFRESH() Frame Fp = F; { const int t_ = opq_tid(wave_s); Fp.tid = t_; Fp.lane = t_ & 63; size_t z_ = 0; asm volatile("" : "+s"(z_)); Fp.ws = args.ws + z_; Fp.vcu = opq_s(F.vcu); Fp.G = opq_s(F.G); Fp.bx = opq_s(F.bx); } unsigned char* ws = Fp.ws; (void)ws
#define SEAM(k, kn) do { if (IN(k) && IN(kn)) { XcdBarrier b_; size_t z_ = 0; asm volatile("" : "+s"(z_)); b_.bar = (unsigned*)(args.ws + z_ + WS_CTL) + CW_BAR; b_.x = xb_xcc_id(); b_.st = MISC + 8; xcd_barrier(b_, opq_tid(wave_s)); } } while (0)
#define PTRS() bf16_t* hbf = (bf16_t*)(ws + WS_HBF); bf16_t* proj = (bf16_t*)(ws + WS_PROJ); bf16_t* qbuf = (bf16_t*)(ws + WS_QBUF); bf16_t* kvbuf = (bf16_t*)(ws + WS_KVBUF); \
    bf16_t* obuf = (bf16_t*)(ws + WS_OBUF); bf16_t* mbuf = (bf16_t*)(ws + WS_MBUF); bf16_t* act = (bf16_t*)(ws + WS_PROJ); \
    pg8::EpiCtx ec; ec.O = nullptr; ec.ldc = 0; ec.rs = (const float*)(ws + WS_RSTD); ec.statq = (float*)(ws + WS_STATQ); ec.statkv = (float*)(ws + WS_STATKV); \
    ec.flogT = (float*)(ws + WS_FLOG); ec.cosT = (const float*)(ws + WS_COS); ec.sinT = (const float*)(ws + WS_SIN); ec.statm = (float*)(ws + WS_STATM); ec.part = (float*)(ws + WS_PART); ec.cs = nullptr; ec.amaxp = (float*)(ws + WS_AMAXP); \
    (void)hbf; (void)proj; (void)qbuf; (void)kvbuf; (void)obuf; (void)mbuf; (void)act

#if PHM & 1
    if (IN(0)) { p0_prologue(args, F); }
#endif
    SEAM(0, 1);
#if PHM & 1
    if (IN(1)) { REFRESH(); cvt_items<1>(args, Fp); }
#endif
    SEAM(1, 2);
#define LAYER() opq_s(layer0)
#define BASE() (2 + PPL * layer0)
#define EVEN() ((LAYER() & 1) == 0)
#define DN8() (((I8_DN >> LAYER()) & 1) != 0)
#define REFRESH_L() REFRESH(); const int layer = LAYER(), e = layer >> 1; (void)e; (void)layer
    for (int layer0 = 0; layer0 < DEPTH; ++layer0) {
#if PHM & 2
        if (IN(BASE())) {
            REFRESH_L(); PTRS();
            if (EVEN() && !((I8_IN_EV >> e) & 1)) {
                pg8::Gemm g{hbf, (const bf16_t*)(ws + W_EVIN + e * SZ_EVIN), LD_DM, LD_DM, DM}; pg8::StaticOrder S; S.init(MPAD, EV_N, Fp.G, Fp.bx);
                pg8::Epi<1> E{ec}; E.c.O = proj; E.c.ldc = LD_EV;
                pg8::gemm_phase<pg8::Epi<1>, pg8::StaticOrder, true, true>(Fp.lds, g, S, E, Fp.tid);
            } else if (EVEN()) {
                pg8::Gemm g{(const bf16_t*)(ws + WS_OBUF), (const bf16_t*)(ws + W_EVIN + e * SZ_EVIN), LD8 / 2, LD8 / 2, DM / 2}; pg8::StaticOrder S; S.init(MPAD, EV_N, Fp.G, Fp.bx);
                pg8::Epi<9> E{ec}; E.c.O = proj; E.c.ldc = LD_EV; E.c.rs = (const float*)(ws + WS_RS8); E.c.cs = (const float*)(ws + WS_CTL + CTL_COLMAX_EV) + (size_t)e * EV_N;
                pg8::gemm_phase<pg8::Epi<9>, pg8::StaticOrder, true, true, 2>(Fp.lds, g, S, E, Fp.tid);
            } else if ((I8_IN_ODD >> e) & 1) {
                pg8::Gemm g{(const bf16_t*)(ws + WS_OBUF), (const bf16_t*)(ws + W_GU + (size_t)layer * SZ_GU + W_OD8_OFF), LD8 / 2, LD8 / 2, DM / 2}; pg8::StaticOrder S; S.init(MREAL, OD_N, Fp.G, Fp.bx);
                pg8::Epi<8> E{ec}; E.c.O = proj; E.c.ldc = LD_OD; E.c.rs = (const float*)(ws + WS_RS8); E.c.cs = (const float*)(ws + WS_CTL + CTL_COLMAX_OD) + (size_t)e * OD_N;
                pg8::gemm_phase<pg8::Epi<8>, pg8::StaticOrder, true, true, 2>(Fp.lds, g, S, E, Fp.tid);
            } else {
                pg8::Gemm g{hbf, (const bf16_t*)(ws + W_ODIN + e * SZ_ODIN), LD_DM, LD_DM, DM}; pg8::StaticOrder S; S.init(MREAL, OD_N, Fp.G, Fp.bx);
                pg8::Epi<0> E{ec}; E.c.O = proj; E.c.ldc = LD_OD;
                pg8::gemm_phase<pg8::Epi<0>, pg8::StaticOrder, true, true>(Fp.lds, g, S, E, Fp.tid);
            }
        }
        if (!EVEN() && IN(BASE())) {
            REFRESH_L(); PTRS();
            if ((I8_IN_ODD >> e) & 1) {
                pg8::Gemm g{(const bf16_t*)(ws + WS_OBUF), (const bf16_t*)(ws + W_GU + (size_t)layer * SZ_GU + W_OD8_OFF), LD8 / 2, LD8 / 2, 128}; pg8::SplitKOrder S; S.init(MREAL / 256, OD_N, DM / 256, 128, Fp.G, Fp.bx);
                pg8::Epi<6> E{ec}; E.c.ldc = OD_N;
                pg8::gemm_phase<pg8::Epi<6>, pg8::SplitKOrder, true, false, 2>(Fp.lds, g, S, E, Fp.tid);
            } else {
                pg8::Gemm g{hbf, (const bf16_t*)(ws + W_ODIN + e * SZ_ODIN), LD_DM, LD_DM, 256}; pg8::SplitKOrder S; S.init(MREAL / 256, OD_N, DM / 256, 256, Fp.G, Fp.bx);
                pg8::Epi<6> E{ec}; E.c.ldc = OD_N;
                pg8::gemm_phase<pg8::Epi<6>, pg8::SplitKOrder, true, false>(Fp.lds, g, S, E, Fp.tid);
            }
        }
#endif
        SEAM(BASE(), BASE() + 1);
#if PHM & 4
        if (EVEN() && IN(BASE() + 1)) {
#if P4SUB & 1
            REFRESH_L();
            scan_phase(args, Fp, e);
#endif
#if P4SUB & 2
            {   REFRESH_L(); PTRS();
                pg8::Gemm g{proj + EV_CQ, (const bf16_t*)(ws + W_UQ + e * SZ_UQ), LD_EV, LD_QR, QRANK}; pg8::StaticOrder S; S.init(MPAD, UQ_N, Fp.G, Fp.bx);
                pg8::Epi<2> E{ec}; E.c.O = qbuf; E.c.ldc = LD_UQ; E.c.rs = (const float*)(ws + WS_STATQ);
                pg8::gemm_phase<pg8::Epi<2>, pg8::StaticOrder, true, true>(Fp.lds, g, S, E, Fp.tid); }
#endif
#if P4SUB & 4
            {   REFRESH_L(); PTRS();
                pg8::Gemm g{proj + EV_CKV, (const bf16_t*)(ws + W_UKV + e * SZ_UKV), LD_EV, LD_KV, KVK}; pg8::StaticOrder S; S.init(MPAD, UKV_N, Fp.G, Fp.bx);
                pg8::Epi<3> E{ec}; E.c.O = kvbuf; E.c.ldc = LD_UKV; E.c.rs = (const float*)(ws + WS_STATKV);
                pg8::gemm_phase<pg8::Epi<3>, pg8::StaticOrder, true, true>(Fp.lds, g, S, E, Fp.tid); }
#endif
        }
#endif
        if (!EVEN() && IN(BASE() + 1)) { REFRESH_L(); fixup_odd_meta(Fp, e); }
        SEAM(BASE() + 1, BASE() + 2);
#if PHM & 8
        if (IN(BASE() + 2) && EVEN()) { REFRESH_L(); attn_even_phase(Fp); }
#endif
#if PHM & 16
        if (IN(BASE() + 2) && !EVEN()) { REFRESH_L(); attn_odd_phase(args, Fp, e); }
#endif
        SEAM(BASE() + 2, BASE() + 3);
#if PHM & 32
        if (IN(BASE() + 3)) {
            REFRESH_L(); PTRS();
            {   pg8::Gemm g{obuf, (const bf16_t*)(ws + (EVEN() ? W_EVOUT : W_ODOUT) + e * SZ_SQ), LD_DM, LD_DM, DM}; pg8::StaticOrder S; S.init(MREAL, DM, Fp.G, Fp.bx);
                pg8::Epi<4> E{ec}; E.c.O = mbuf; E.c.ldc = LD_DM;
                pg8::gemm_phase<pg8::Epi<4>, pg8::StaticOrder, true, true>(Fp.lds, g, S, E, Fp.tid); }
            {   REFRESH_L(); PTRS();
                pg8::Gemm g{obuf, (const bf16_t*)(ws + (EVEN() ? W_EVOUT : W_ODOUT) + e * SZ_SQ), LD_DM, LD_DM, 256}; pg8::SplitKOrder S; S.init(MREAL / 256, DM, DM / 256, 256, Fp.G, Fp.bx);
                pg8::Epi<6> E{ec}; E.c.ldc = DM;
                pg8::gemm_phase<pg8::Epi<6>, pg8::SplitKOrder, true, false>(Fp.lds, g, S, E, Fp.tid); }
        }
#endif
        SEAM(BASE() + 3, BASE() + 4);
#if PHM & 64
        if (IN(BASE() + 4)) { REFRESH_L(); ew_phase(args, Fp, layer, 0); }
#endif
        SEAM(BASE() + 4, BASE() + 5);
#if PHM & 128
        if (IN(BASE() + 5)) {
            REFRESH_L(); PTRS();
            pg8::Gemm g{(const bf16_t*)(ws + WS_A8), (const bf16_t*)(ws + W_GU + layer * SZ_GU), LD8 / 2, LD8 / 2, DM / 2}; pg8::StaticOrder S; S.init(MPAD, GU_N, Fp.G, Fp.bx, 4);
            pg8::Epi<7> E{ec}; E.c.O = act; E.c.ldc = LD_FF; E.c.rs = (const float*)(ws + WS_RS8); E.c.cs = (const float*)(ws + WS_CTL + CTL_COLMAX) + (size_t)layer * GU_N;
            pg8::gemm_phase<pg8::Epi<7>, pg8::StaticOrder, true, true, 2>(Fp.lds, g, S, E, Fp.tid);
        }
#endif
        if (DN8()) SEAM(BASE() + 5, BASE() + 6);
        if (DN8() && IN(BASE() + 6)) { REFRESH_L(); actq_phase(Fp); }
        SEAM(DN8() ? BASE() + 6 : BASE() + 5, BASE() + 7);
#if PHM & 256
        if (IN(BASE() + 7) && DN8()) {
            REFRESH_L(); PTRS();
            {   pg8::Gemm g{(const bf16_t*)(ws + WS_ACT8), (const bf16_t*)(ws + W_DN + layer * SZ_DN), LD8F / 2, LD8F / 2, DFF / 2}; pg8::StaticOrder S; S.init(MREAL, DM, Fp.G, Fp.bx);
                pg8::Epi<10> E{ec}; E.c.O = mbuf; E.c.ldc = LD_DM; E.c.rs = (const float*)(ws + WS_RSD); E.c.cs = (const float*)(ws + WS_CTL + CTL_COLMAX_DN) + (size_t)layer * DM;
                pg8::gemm_phase<pg8::Epi<10>, pg8::StaticOrder, true, true, 2>(Fp.lds, g, S, E, Fp.tid); }
            {   REFRESH_L(); PTRS();
                pg8::Gemm g{(const bf16_t*)(ws + WS_ACT8), (const bf16_t*)(ws + W_DN + layer * SZ_DN), LD8F / 2, LD8F / 2, 128}; pg8::SplitKOrder S; S.init(MREAL / 256, DM, DFF / 256, 128, Fp.G, Fp.bx);
                pg8::Epi<6> E{ec}; E.c.ldc = DM;
                pg8::gemm_phase<pg8::Epi<6>, pg8::SplitKOrder, true, false, 2>(Fp.lds, g, S, E, Fp.tid); }
        }
        if (IN(BASE() + 7) && !DN8()) {
            REFRESH_L(); PTRS();
            {   pg8::Gemm g{act, (const bf16_t*)(ws + W_DN + layer * SZ_DN), LD_FF, LD_FF, DFF}; pg8::StaticOrder S; S.init(MREAL, DM, Fp.G, Fp.bx);
                pg8::Epi<4> E{ec}; E.c.O = mbuf; E.c.ldc = LD_DM;
                pg8::gemm_phase<pg8::Epi<4>, pg8::StaticOrder, true, true>(Fp.lds, g, S, E, Fp.tid); }
            {   REFRESH_L(); PTRS();
                pg8::Gemm g{act, (const bf16_t*)(ws + W_DN + layer * SZ_DN), LD_FF, LD_FF, 256}; pg8::SplitKOrder S; S.init(MREAL / 256, DM, DFF / 256, 256, Fp.G, Fp.bx);
                pg8::Epi<6> E{ec}; E.c.ldc = DM;
                pg8::gemm_phase<pg8::Epi<6>, pg8::SplitKOrder, true, false>(Fp.lds, g, S, E, Fp.tid); }
        }
#endif
        SEAM(BASE() + 7, BASE() + 8);
#if PHM & 512
        if (IN(BASE() + 8)) { REFRESH_L(); ew_phase(args, Fp, layer, 1); }
#endif
        if (layer0 + 1 < DEPTH) SEAM(BASE() + 8, BASE() + 9);
    }
#ifdef PROBE_ATT
    if (IN(N_PHASES)) { REFRESH(); attn_odd_phase_probe<PROBE_ATT>(args, Fp, 1); }
#endif
#ifdef PROBE_EW
    if (IN(N_PHASES)) { REFRESH(); ew_phase(args, Fp, 1, 0); }
#endif
#ifdef PROBE_GEMM
    if (IN(N_PHASES)) {
        REFRESH(); PTRS();
#ifndef PROBE_LD
#define PROBE_LD LD_DM
#endif
        pg8::Gemm g{hbf, (const bf16_t*)(ws + W_GU), PROBE_LD, PROBE_LD, DM}; pg8::StaticOrder S; S.init(PROBE_LD ? MPAD : 256, PROBE_LD ? GU_N : 256 * 86 * 65, Fp.G, Fp.bx, PROBE_WGM);
        pg8::Epi<5> E{ec}; E.c.O = act; E.c.ldc = LD_FF;
        pg8::gemm_phase<pg8::Epi<5>, pg8::StaticOrder, PROBE_ALIGN, PROBE_SP2>(Fp.lds, g, S, E, Fp.tid);
    }
#endif
#undef PTRS
#undef REFRESH
#undef REFRESH_L
#undef LAYER
#undef BASE
#undef EVEN
#undef DN8
#undef IN
#undef SEAM
}

#ifndef MK_ONE_LAUNCH
#define MK_ONE_LAUNCH 1
#endif
extern "C" void kernel_launch(void* const* d_in, const int* in_sizes, int n_in, void* d_out, int out_size, void* d_ws, size_t ws_size, hipStream_t stream) {
    static int grid = 0;
    if (grid == 0) {
        if (n_in != 18 || in_sizes[0] != NB * SEQ * DM || out_size != NB * SEQ * DM || ws_size < WS_END) {
            fprintf(stderr, "kernel_launch: unexpected shapes or workspace (n_in %d, in0 %d, out %d, ws %zu < %zu); nothing launched\n", n_in, n_in > 0 ? in_sizes[0] : -1, out_size, ws_size, (size_t)WS_END); grid = -1; return; }
        int dev = 0, cus = 0;
        if (hipGetDevice(&dev) != hipSuccess || hipDeviceGetAttribute(&cus, hipDeviceAttributeMultiprocessorCount, dev) != hipSuccess || cus <= 0) { fprintf(stderr, "kernel_launch: device query failed\n"); grid = -1; return; }
        if (hipFuncSetAttribute((const void*)mega_fwd, hipFuncAttributeMaxDynamicSharedMemorySize, LDS_BYTES) != hipSuccess) { fprintf(stderr, "kernel_launch: hipFuncSetAttribute failed\n"); grid = -1; return; }
        int per_cu = 0;
        if (hipOccupancyMaxActiveBlocksPerMultiprocessor(&per_cu, (const void*)mega_fwd, 512, LDS_BYTES) != hipSuccess || per_cu < 1) fprintf(stderr, "kernel_launch: note: occupancy query reports %d workgroups per CU\n", per_cu);
        (void)hipGetLastError();
        grid = cus > 256 ? 256 : cus;
    }
    if (grid < 0) return;
    if (hipMemsetAsync((char*)d_ws + WS_CTL, 0, CTL_ZERO_BYTES, stream) != hipSuccess) { fprintf(stderr, "kernel_launch: memset failed\n"); return; }
    Args a{};
    for (int i = 0; i < 18; ++i) a.in[i] = (const float*)d_in[i];
    a.out = (float*)d_out; a.ws = (unsigned char*)d_ws;
    a.lam_init[0] = (float)(0.8 - 0.6 * exp(-0.3 * 1.0)); a.lam_init[1] = (float)(0.8 - 0.6 * exp(-0.3 * 3.0));
#if MK_ONE_LAUNCH
    a.ph_lo = 0; a.ph_hi = N_PHASES;
    hipLaunchKernelGGL(mega_fwd, dim3(grid), dim3(512), LDS_BYTES, stream, a);
#else
    for (int k = 0; k < N_PHASES; ++k) {
        a.ph_lo = k; a.ph_hi = k + 1;
        hipLaunchKernelGGL(mega_fwd, dim3(grid), dim3(512), LDS_BYTES, stream, a);
#ifdef PROBE_MASK
        { const int off = k < 2 ? 9 : ((k - 2) % PPL); if ((PROBE_MASK >> off) & 1) hipLaunchKernelGGL(mega_fwd, dim3(grid), dim3(512), LDS_BYTES, stream, a); }
#endif
    }
#if defined(PROBE_GEMM) || defined(PROBE_EW) || defined(PROBE_ATT)
    for (int r = 0; r < PROBE_REP; ++r) { a.ph_lo = N_PHASES; a.ph_hi = N_PHASES + 1; hipLaunchKernelGGL(mega_fwd, dim3(grid), dim3(512), LDS_BYTES, stream, a); }
#endif
#endif
}
```

```cpp
#define MK_ONE_LAUNCH 1
#include <hip/hip_runtime.h>
#include <cstdio>
#include <cstdint>
#include <cmath>

#define LAS __attribute__((address_space(3)))
#define GAS __attribute__((address_space(1)))
typedef unsigned short bf16_t;
typedef short bf16x8 __attribute__((ext_vector_type(8)));
typedef short s16x4 __attribute__((ext_vector_type(4)));
typedef float f32x2 __attribute__((ext_vector_type(2)));
typedef float f32x4 __attribute__((ext_vector_type(4)));
typedef float f32x16 __attribute__((ext_vector_type(16)));
typedef unsigned u32x2 __attribute__((ext_vector_type(2)));
typedef unsigned u32x4 __attribute__((ext_vector_type(4)));
typedef int i32x4 __attribute__((ext_vector_type(4)));
typedef int i32x8 __attribute__((ext_vector_type(8)));

constexpr int DM = 4096, NB = 4, SEQ = 4096, NMETA = 16, DEPTH = 4;
constexpr int MREAL = NB * SEQ;
constexpr int META0 = MREAL;
constexpr int MUSED = MREAL + NMETA;
constexpr int MPAD = 16640;
constexpr int DFF = 11008;
constexpr int NPOS = NMETA + SEQ;
constexpr float EPS = 1e-6f;
constexpr int EV_N = 7680, EV_QF = 0, EV_KF = 2048, EV_VF = 4096, EV_CQ = 6144, EV_CKV = 7040, EV_KR = 7360, EV_FL = 7424;
constexpr int QRANK = 896, KVRANK = 320, KVK = 384;
constexpr int UQ_N = 3072, UKV_N = 4096, OD_N = 12288, GU_N = 2 * DFF;
constexpr int EV_SRC_N = 7440;
constexpr int AMAXP_LD = 352;
constexpr int LD_DM = 4160, LD_FF = 11072, LD_EV = 7744, LD_OD = 12352, LD_UQ = 3136, LD_UKV = 4160, LD_QR = 960, LD_KV = 448;

__device__ __forceinline__ unsigned cvt_pk_bf16(float lo, float hi) { unsigned r; asm volatile("v_cvt_pk_bf16_f32 %0, %1, %2" : "=v"(r) : "v"(lo), "v"(hi)); return r; }
__device__ __forceinline__ float bf_lo(unsigned w) { return __uint_as_float(w << 16); }
__device__ __forceinline__ float bf_hi(unsigned w) { return __uint_as_float(w & 0xffff0000u); }
__device__ __forceinline__ float wave_sum(float v) {
#pragma unroll
    for (int o = 1; o < 64; o <<= 1) v += __shfl_xor(v, o);
    return v;
}

__device__ __forceinline__ int opq_tid(int wave) {
    int l; asm volatile("v_mbcnt_lo_u32_b32 %0, -1, 0\n\tv_mbcnt_hi_u32_b32 %0, -1, %0" : "=v"(l));
    return (wave << 6) | l;
}

__device__ __forceinline__ int opq_s(int v) { asm volatile("" : "+s"(v)); return v; }

namespace pg8 {
#define PG8_LAS __attribute__((address_space(3)))
constexpr int RS_LDS_OFF = 131072;
constexpr int BM = 256, BK = 64, HALF = 128, HTB = HALF * BK * 2  , STAGE_BYTES = 8 * HTB, NXCD = 8, WGM = 8;

__host__ __device__ __forceinline__ int lds_byte(int r, int c) { const int st = (r >> 4) * 2 + (c >> 5), rr = r & 15, cc = c & 31, ob = rr * 64 + cc * 2; return st * 1024 + (ob ^ (((ob >> 9) & 1) << 5)); }
__host__ __device__ __forceinline__ void stage_rc(int b, int& R, int& C) { const int st = b / 1024, sb = b % 1024, swz = sb ^ (((sb >> 9) & 1) << 5); R = (st >> 1) * 16 + swz / 64; C = (st & 1) * 32 + (swz % 64) / 2; }
__host__ __device__ __forceinline__ int perm32(int rho) { const int n = rho >> 4, i = rho & 15; return 8 * (i >> 2) + 4 * n + (i & 3); }

struct Unit { int pm, pn, ko, ks; };
struct Gemm { const bf16_t* A; const bf16_t* Bt; int lda, ldb, K; };

struct StaticOrder {
    int nM, nN, nwg, G, c, wgm;
    __host__ __device__ void init(int M, int N, int G_, int c_, int wgm_ = WGM) { nM = M / BM; nN = N / BM; nwg = nM * nN; G = G_; c = c_; wgm = wgm_; }
    __host__ __device__ bool next(int i, Unit& u) const {
        const long L = (long)i * G + c; if (L >= nwg) return false;
        int wgid = (int)L; { const int q = nwg / NXCD, r = nwg % NXCD, xcd = wgid % NXCD, off = wgid / NXCD; wgid = (xcd < r ? xcd * (q + 1) : r * (q + 1) + (xcd - r) * q) + off; }
        const int nig = wgm * nN, gid = wgid / nig, fm = gid * wgm, gsz = (nM - fm) < wgm ? (nM - fm) : wgm;
        u.pm = fm + ((wgid % nig) % gsz); u.pn = (wgid % nig) / gsz; u.ko = 0; u.ks = 0; return true;
    }
    __device__ __forceinline__ void a_ready(const Unit&) const {}
    __device__ __forceinline__ void done(const Unit&) const {}
};
struct SplitKOrder {
    int pm, nN, nS, kslice, G, c;
    __host__ __device__ void init(int pm_, int N, int nS_, int kslice_, int G_, int c_) { pm = pm_; nN = N / BM; nS = nS_; kslice = kslice_; G = G_; c = c_; }
    __host__ __device__ bool next(int i, Unit& u) const {
        const int L = i * G + c; if (L >= nN * nS) return false;
        u.pm = pm; u.pn = L % nN; u.ks = L / nN; u.ko = u.ks * kslice; return true;
    }
    __device__ __forceinline__ void a_ready(const Unit&) const {}
    __device__ __forceinline__ void done(const Unit&) const {}
};

struct EpiCtx {
    bf16_t* O; int ldc;
    const float* rs;
    float* statq; float* statkv;
    float* flogT;
    const float* cosT; const float* sinT;
    float* statm;
    float* part;
    const float* cs;
    float* amaxp;
};
__device__ __forceinline__ int row_pos(int row) { return row < MREAL ? NMETA + (row & (SEQ - 1)) : row - META0; }
__device__ __forceinline__ void store8(bf16_t* p, f32x4 v0, f32x4 v1) {
    u32x4 w; w.x = cvt_pk_bf16(v0[0], v0[1]); w.y = cvt_pk_bf16(v0[2], v0[3]); w.z = cvt_pk_bf16(v1[0], v1[1]); w.w = cvt_pk_bf16(v1[2], v1[3]);
    *(u32x4*)p = w;
}
__device__ __forceinline__ float sel4(const float (&a)[4], int i) { return i == 0 ? a[0] : (i == 1 ? a[1] : (i == 2 ? a[2] : a[3])); }
__device__ __forceinline__ float sq8(f32x4 a, f32x4 b) { return (a[0] * a[0] + a[1] * a[1]) + (a[2] * a[2] + a[3] * a[3]) + (b[0] * b[0] + b[1] * b[1]) + (b[2] * b[2] + b[3] * b[3]); }
__device__ __forceinline__ float silu_mul(float g, float u) { return g * __builtin_amdgcn_rcpf(1.0f + __builtin_amdgcn_exp2f(-1.4426950408889634f * g)) * u; }

__device__ __forceinline__ void fwht32_lanes(f32x4& a, f32x4& b, float s16, float s32) {
    f32x4 t;
    t = (f32x4){a[0] + a[1], a[0] - a[1], a[2] + a[3], a[2] - a[3]}; a = (f32x4){t[0] + t[2], t[1] + t[3], t[0] - t[2], t[1] - t[3]};
    t = (f32x4){b[0] + b[1], b[0] - b[1], b[2] + b[3], b[2] - b[3]}; b = (f32x4){t[0] + t[2], t[1] + t[3], t[0] - t[2], t[1] - t[3]};
    t = a + b; b = a - b; a = t;
#pragma unroll
    for (int j = 0; j < 4; ++j) {
        auto r = __builtin_amdgcn_permlane16_swap(__float_as_uint(a[j]), __float_as_uint(a[j]), false, false); a[j] = __builtin_fmaf(s16, __uint_as_float(r[1]), __uint_as_float(r[0]));
        auto q = __builtin_amdgcn_permlane16_swap(__float_as_uint(b[j]), __float_as_uint(b[j]), false, false); b[j] = __builtin_fmaf(s16, __uint_as_float(q[1]), __uint_as_float(q[0])); }
#pragma unroll
    for (int j = 0; j < 4; ++j) {
        auto r = __builtin_amdgcn_permlane32_swap(__float_as_uint(a[j]), __float_as_uint(a[j]), false, false); a[j] = __builtin_fmaf(s32, __uint_as_float(r[1]), __uint_as_float(r[0]));
        auto q = __builtin_amdgcn_permlane32_swap(__float_as_uint(b[j]), __float_as_uint(b[j]), false, false); b[j] = __builtin_fmaf(s32, __uint_as_float(q[1]), __uint_as_float(q[0])); }
}
template <int MODE> struct Epi {
    static constexpr bool PERM = true, AFTER_DRAIN = false;
    EpiCtx c;
    static constexpr bool EVM = (MODE == 1 || MODE == 9), I8M = (MODE == 8 || MODE == 9 || MODE == 10), OUTM = (MODE == 4 || MODE == 10);
    static constexpr bool RS_LDS = (MODE == 0 || MODE == 1 || MODE == 5 || MODE == 7 || MODE == 8 || MODE == 9 || MODE == 10), CS_LDS = (MODE == 7 || MODE == 8 || MODE == 9 || MODE == 10);
    __device__ __forceinline__ void pre(const Unit& u, PG8_LAS unsigned char* slot, int wid) const {
        if constexpr (RS_LDS) { if (wid < 4) { int l; asm volatile("v_mbcnt_lo_u32_b32 %0, -1, 0\n\tv_mbcnt_hi_u32_b32 %0, -1, %0" : "=v"(l));
            const char* b = (const char*)(c.rs + u.pm * BM + wid * 64); asm volatile("" : "+s"(b));
            __builtin_amdgcn_global_load_lds((const unsigned*)(b + (unsigned)(l * 4)), (PG8_LAS unsigned*)(slot + wid * 256), 4, 0, 0); } }
        if constexpr (CS_LDS) { if (wid >= 4) { int l; asm volatile("v_mbcnt_lo_u32_b32 %0, -1, 0\n\tv_mbcnt_hi_u32_b32 %0, -1, %0" : "=v"(l));
            const char* b = (const char*)(c.cs + u.pn * BM + (wid - 4) * 64); asm volatile("" : "+s"(b));
            __builtin_amdgcn_global_load_lds((const unsigned*)(b + (unsigned)(l * 4)), (PG8_LAS unsigned*)(slot + 2048 + (wid - 4) * 256), 4, 0, 0); } }
    }
    __device__ __forceinline__ void operator()(const f32x4 (&acc)[2][2][4][2], const Unit& u, int wr, int wc, int fr, int fq, const PG8_LAS float* rsl) const {
        int pm_ = u.pm, pn_ = u.pn; asm volatile("" : "+s"(pm_), "+s"(pn_));
        if constexpr (MODE == 6) {
            if (wr == 0) { float* P = c.part + (unsigned)((u.ks * 16 + fr) * c.ldc + pn_ * BM + wc * 32 + 8 * fq);
#pragma unroll
                for (int bj = 0; bj < 2; ++bj) { *(f32x4*)(P + bj * HALF) = acc[0][bj][0][0]; *(f32x4*)(P + bj * HALF + 4) = acc[0][bj][0][1]; } }
            return;
        }
        const Unit uu{pm_, pn_};
        const int row0 = uu.pm * BM + wr * 64 + fr;
        float s[2][4];
#pragma unroll
        for (int ai = 0; ai < 2; ++ai)
#pragma unroll
            for (int m = 0; m < 4; ++m) {
                const int row = row0 + ai * HALF + m * 16;
                if constexpr (RS_LDS) s[ai][m] = rsl[ai * HALF + wr * 64 + m * 16 + fr];
                else if constexpr (MODE == 2) { const f32x4* q = (const f32x4*)(c.rs + (unsigned)(row * 32)); f32x4 t = q[0];
#pragma unroll
                    for (int k = 1; k < 7; ++k) t += q[k];
                    s[ai][m] = __builtin_amdgcn_rsqf(((t[0] + t[1]) + (t[2] + t[3])) * (1.0f / QRANK) + EPS); }
                else if constexpr (MODE == 3) { const f32x4* q = (const f32x4*)(c.rs + (unsigned)(row * 16)); const f32x4 t = q[0] + q[1]; const f32x2 t2 = *(const f32x2*)(q + 2);
                    s[ai][m] = __builtin_amdgcn_rsqf((((t[0] + t[1]) + (t[2] + t[3])) + (t2[0] + t2[1])) * (1.0f / KVRANK) + EPS); }
                else s[ai][m] = 1.0f;
            }
        if constexpr (MODE == 7) {
            const int col0 = uu.pn * HALF + wc * 32 + 8 * fq;
            const PG8_LAS float* csl = rsl + 512 + wc * 32 + 8 * fq;
            const f32x4 cg0 = *(const PG8_LAS f32x4*)csl, cg1 = *(const PG8_LAS f32x4*)(csl + 4), cu0 = *(const PG8_LAS f32x4*)(csl + HALF), cu1 = *(const PG8_LAS f32x4*)(csl + HALF + 4);
#pragma unroll
            for (int ai = 0; ai < 2; ++ai)
#pragma unroll
                for (int m = 0; m < 4; ++m) {
                    const int row = row0 + ai * HALF + m * 16; const float sc = s[ai][m];
                    const f32x4 g0 = __builtin_convertvector(__builtin_bit_cast(i32x4, acc[ai][0][m][0]), f32x4) * (cg0 * sc), g1 = __builtin_convertvector(__builtin_bit_cast(i32x4, acc[ai][0][m][1]), f32x4) * (cg1 * sc);
                    const f32x4 u0 = __builtin_convertvector(__builtin_bit_cast(i32x4, acc[ai][1][m][0]), f32x4) * (cu0 * sc), u1 = __builtin_convertvector(__builtin_bit_cast(i32x4, acc[ai][1][m][1]), f32x4) * (cu1 * sc);
                    f32x4 e0 = g0 * -1.4426950408889634f, e1 = g1 * -1.4426950408889634f;
#pragma unroll
                    for (int j = 0; j < 4; ++j) { e0[j] = __builtin_amdgcn_exp2f(e0[j]); e1[j] = __builtin_amdgcn_exp2f(e1[j]); }
                    e0 = e0 + 1.0f; e1 = e1 + 1.0f;
                    const f32x4 p0 = g0 * u0, p1 = g1 * u1;
#pragma unroll
                    for (int j = 0; j < 4; ++j) { e0[j] = __builtin_amdgcn_rcpf(e0[j]); e1[j] = __builtin_amdgcn_rcpf(e1[j]); }
                    store8(c.O + (unsigned)(row * c.ldc + col0), p0 * e0, p1 * e1);
                }
            return;
        } else if constexpr (MODE == 5) {
            const int col0 = uu.pn * HALF + wc * 32 + 8 * fq;
#pragma unroll
            for (int ai = 0; ai < 2; ++ai)
#pragma unroll
                for (int m = 0; m < 4; ++m) {
                    const int row = row0 + ai * HALF + m * 16; const float sc = s[ai][m];
                    const f32x4 g0 = acc[ai][0][m][0] * sc, g1 = acc[ai][0][m][1] * sc, u0 = acc[ai][1][m][0] * sc, u1 = acc[ai][1][m][1] * sc;
                    f32x4 o0, o1;
#pragma unroll
                    for (int j = 0; j < 4; ++j) { o0[j] = silu_mul(g0[j], u0[j]); o1[j] = silu_mul(g1[j], u1[j]); }
                    store8(c.O + (unsigned)(row * c.ldc + col0), o0, o1);
                }
            return;
        } else {
            float ssm[2][4];
            if constexpr (OUTM) {
#pragma unroll
                for (int ai = 0; ai < 2; ++ai)
#pragma unroll
                    for (int m = 0; m < 4; ++m) ssm[ai][m] = 0.f;
            }
#pragma unroll
            for (int bj = 0; bj < 2; ++bj) {
                const int gcol = uu.pn * BM + bj * HALF + wc * 32;
                const int col0 = gcol + 8 * fq;
                bool rope = false; int i0 = 0;
                if constexpr (EVM) { rope = (gcol >= EV_KR && gcol < EV_FL); i0 = (col0 - EV_KR) >> 1; }
                if constexpr (MODE == 2) { rope = (gcol >= 2048); i0 = ((col0 - 2048) & 63) >> 1; }
                f32x4 c0 = {1.f, 1.f, 1.f, 1.f}, c1 = c0;
                if constexpr (I8M) { const PG8_LAS float* csl = rsl + 512 + bj * HALF + wc * 32 + 8 * fq; c0 = *(const PG8_LAS f32x4*)csl; c1 = *(const PG8_LAS f32x4*)(csl + 4); }
                if ((EVM || MODE == 2) && rope) {
#pragma unroll
                    for (int ai = 0; ai < 2; ++ai)
#pragma unroll
                        for (int m = 0; m < 4; ++m) {
                            const int row = row0 + ai * HALF + m * 16; const float sc = s[ai][m]; const int pos = row_pos(row);
                            const f32x4 cs = *(const f32x4*)(c.cosT + (unsigned)(pos * 32 + i0)), sn = *(const f32x4*)(c.sinT + (unsigned)(pos * 32 + i0));
                            f32x4 x1, x2;
                            if constexpr (I8M) { x1 = __builtin_convertvector(__builtin_bit_cast(i32x4, acc[ai][bj][m][0]), f32x4) * (c0 * sc); x2 = __builtin_convertvector(__builtin_bit_cast(i32x4, acc[ai][bj][m][1]), f32x4) * (c1 * sc); }
                            else { x1 = acc[ai][bj][m][0] * sc; x2 = acc[ai][bj][m][1] * sc; }
                            store8(c.O + (unsigned)(row * c.ldc + col0), x1 * cs - x2 * sn, x1 * sn + x2 * cs);
                            asm volatile("" ::: "memory");
                        }
                } else {
                    float ss[2][4];
#pragma unroll
                    for (int ai = 0; ai < 2; ++ai)
#pragma unroll
                        for (int m = 0; m < 4; ++m) {
                            const int row = row0 + ai * HALF + m * 16; const float sc = s[ai][m];
                            f32x4 v0, v1;
                            if constexpr (I8M) { v0 = __builtin_convertvector(__builtin_bit_cast(i32x4, acc[ai][bj][m][0]), f32x4) * (c0 * sc); v1 = __builtin_convertvector(__builtin_bit_cast(i32x4, acc[ai][bj][m][1]), f32x4) * (c1 * sc); }
                            else { v0 = acc[ai][bj][m][0] * sc; v1 = acc[ai][bj][m][1] * sc; }
                            store8(c.O + (unsigned)(row * c.ldc + col0), v0, v1);
                            if constexpr (EVM) {
                                ss[ai][m] = sq8(v0, v1);
                                if (gcol == EV_FL && fq < 2) {
#pragma unroll
                                    for (int j = 0; j < 4; ++j) { c.flogT[(unsigned)((8 * fq + j) * MPAD + row)] = v0[j]; c.flogT[(unsigned)((8 * fq + 4 + j) * MPAD + row)] = v1[j]; }
                                }
                            }
                            if constexpr (OUTM) ssm[ai][m] += sq8(v0, v1);
                            asm volatile("" ::: "memory");
                        }
                    if constexpr (EVM) {
                        if (gcol >= EV_CQ && gcol < EV_KR) {
                            const bool isq = gcol < EV_CKV; float* tgt = isq ? c.statq : c.statkv; const int ld = isq ? 32 : 16, slot = (gcol - (isq ? EV_CQ : EV_CKV)) >> 5;
#pragma unroll
                            for (int ai = 0; ai < 2; ++ai) {
#pragma unroll
                                for (int m = 0; m < 4; ++m) { ss[ai][m] += __shfl_xor(ss[ai][m], 16); ss[ai][m] += __shfl_xor(ss[ai][m], 32); }
                                tgt[(unsigned)((row0 + ai * HALF + fq * 16) * ld + slot)] = sel4(ss[ai], fq);
                            }
                        }
                    }
                }
            }
            if constexpr (OUTM) {
#pragma unroll
                for (int ai = 0; ai < 2; ++ai) {
#pragma unroll
                    for (int m = 0; m < 4; ++m) { ssm[ai][m] += __shfl_xor(ssm[ai][m], 16); ssm[ai][m] += __shfl_xor(ssm[ai][m], 32); }
                    c.statm[(unsigned)((row0 + ai * HALF + fq * 16) * 64 + uu.pn * 4 + wc)] = sel4(ssm[ai], fq);
                }
            }
        }
    }
};
template <int DT> __device__ __forceinline__ f32x4 mma_k2(const bf16x8 (&b)[2], const bf16x8 (&a)[2], f32x4 c) {
    if constexpr (DT == 1) {
        typedef short s16x16 __attribute__((ext_vector_type(16)));
        const s16x16 bb = __builtin_shufflevector(b[0], b[1], 0, 1, 2, 3, 4, 5, 6, 7, 8, 9, 10, 11, 12, 13, 14, 15), aa = __builtin_shufflevector(a[0], a[1], 0, 1, 2, 3, 4, 5, 6, 7, 8, 9, 10, 11, 12, 13, 14, 15);
        return __builtin_amdgcn_mfma_scale_f32_16x16x128_f8f6f4(__builtin_bit_cast(i32x8, bb), __builtin_bit_cast(i32x8, aa), c, 0, 0, 0, 0, 0, 0);
    } else if constexpr (DT == 2) {
        i32x4 ci = __builtin_bit_cast(i32x4, c);
        ci = __builtin_amdgcn_mfma_i32_16x16x64_i8(__builtin_bit_cast(i32x4, b[0]), __builtin_bit_cast(i32x4, a[0]), ci, 0, 0, 0);
        ci = __builtin_amdgcn_mfma_i32_16x16x64_i8(__builtin_bit_cast(i32x4, b[1]), __builtin_bit_cast(i32x4, a[1]), ci, 0, 0, 0);
        return __builtin_bit_cast(f32x4, ci);
    } else {
        c = __builtin_amdgcn_mfma_f32_16x16x32_bf16(b[0], a[0], c, 0, 0, 0);
        return __builtin_amdgcn_mfma_f32_16x16x32_bf16(b[1], a[1], c, 0, 0, 0);
    }
}
template <class Epi, class Sched, bool ALIGN_EPI = false, bool SP2 = false, int DT = 0>
__device__ __forceinline__ void gemm_phase(PG8_LAS unsigned char* lds, const Gemm g, const Sched& S, const Epi& E, const int tid) {
    const int wid = __builtin_amdgcn_readfirstlane(tid >> 6), lane = tid & 63, wr = wid >> 2, wc = wid & 3, fr = lane & 15, fq = lane >> 4;
    const int K = g.K; int nt = K / BK; if (K < 1024) asm volatile("" : "+s"(nt));
    unsigned voffA[2], voffB[2];
#pragma unroll
    for (int i = 0; i < 2; ++i) { int R, C; stage_rc(tid * 16 + i * 8192, R, C); const int Rb = Epi::PERM ? ((R & ~31) + perm32(R & 31)) : R;
        voffA[i] = (unsigned)(R * g.lda + C) * 2u; voffB[i] = (unsigned)(Rb * g.ldb + C) * 2u; }
    const size_t kstep = (size_t)(BK * 2);
    const size_t hstepA = (size_t)HALF * g.lda * 2, hstepB = (size_t)HALF * g.ldb * 2;
    const size_t tstepA = 2 * hstepA, tstepB = 2 * hstepB;
    const unsigned ldsw = (unsigned)wid * 1024u;
    const int aoff = lds_byte(wr * 64 + fr, fq * 8), boff = lds_byte(wc * 32 + fr, fq * 8);
#define PG8_SA(b, h) (((b) * 2 + (h)) * HTB)
#define PG8_SB(b, h) ((4 + (b) * 2 + (h)) * HTB)
#define PG8_STAGE(bufoff, gbase, voff) do { const char* _b = (const char*)(gbase); asm volatile("" : "+s"(_b));     \
        _Pragma("unroll") for (int _i = 0; _i < 2; ++_i) { unsigned _v = (voff)[_i]; asm volatile("" : "+v"(_v)); \
        __builtin_amdgcn_global_load_lds((const unsigned*)(_b + _v), (PG8_LAS unsigned*)(lds + (bufoff) + ldsw + _i * 8192), 16, 0, 0); } } while (0)
#define PG8_LDA(dst, b, h) do { _Pragma("unroll") for (int m = 0; m < 4; ++m) _Pragma("unroll") for (int k = 0; k < 2; ++k) dst[m][k] = *(const PG8_LAS bf16x8*)(lds + PG8_SA(b, h) + aoff + m * 2048 + k * 1024); } while (0)
#define PG8_LDB(dst, b, h) do { _Pragma("unroll") for (int n = 0; n < 2; ++n) _Pragma("unroll") for (int k = 0; k < 2; ++k) dst[n][k] = *(const PG8_LAS bf16x8*)(lds + PG8_SB(b, h) + boff + n * 2048 + k * 1024); } while (0)
#define PG8_MMA(ai, bj, At, Bt) do { __builtin_amdgcn_s_setprio(1); _Pragma("unroll") for (int m = 0; m < 4; ++m) _Pragma("unroll") for (int n = 0; n < 2; ++n) \
        acc[ai][bj][m][n] = mma_k2<DT>(Bt[n], At[m], acc[ai][bj][m][n]); __builtin_amdgcn_s_setprio(0); } while (0)
#define PG8_WAIT_V(n) asm volatile("s_waitcnt vmcnt(" #n ")" ::: "memory")
#define PG8_WAIT_L(n) asm volatile("s_waitcnt lgkmcnt(" #n ")" ::: "memory")
#define PG8_BAR __builtin_amdgcn_s_barrier()
#define PG8_SCHED __builtin_amdgcn_sched_barrier(0)
    Unit cur, nxt; int ui = 0;
    if (!S.next(0, cur)) return;
    f32x4 acc[2][2][4][2];
#pragma unroll
    for (int a = 0; a < 2; ++a)
#pragma unroll
        for (int b = 0; b < 2; ++b)
#pragma unroll
            for (int m = 0; m < 4; ++m)
#pragma unroll
                for (int n = 0; n < 2; ++n) acc[a][b][m][n] = (f32x4){0.f, 0.f, 0.f, 0.f};
    bf16x8 At[4][2], B0[2][2], B1[2][2];
    const char* cA = (const char*)g.A + (size_t)cur.pm * tstepA + (size_t)cur.ko * 2; const char* cB = (const char*)g.Bt + (size_t)cur.pn * tstepB + (size_t)cur.ko * 2;
    S.a_ready(cur);
    E.pre(cur, lds + RS_LDS_OFF, wid);
    if constexpr (SP2) {
        PG8_STAGE(PG8_SB(0, 0), cB, voffB); PG8_STAGE(PG8_SB(0, 1), cB + hstepB, voffB); PG8_STAGE(PG8_SA(0, 0), cA, voffA); PG8_STAGE(PG8_SA(0, 1), cA + hstepA, voffA);
        if (wr == 1) PG8_BAR;
        PG8_WAIT_V(2); PG8_BAR;
        PG8_STAGE(PG8_SB(1, 0), cB + kstep, voffB); PG8_STAGE(PG8_SA(1, 0), cA + kstep, voffA); PG8_STAGE(PG8_SB(1, 1), cB + hstepB + kstep, voffB);
        PG8_WAIT_V(6); PG8_BAR;
    } else {
        PG8_STAGE(PG8_SB(0, 0), cB, voffB); PG8_STAGE(PG8_SA(0, 0), cA, voffA); PG8_STAGE(PG8_SB(0, 1), cB + hstepB, voffB); PG8_STAGE(PG8_SA(0, 1), cA + hstepA, voffA);
        if (wr == 1) PG8_BAR;
        PG8_WAIT_V(4); PG8_BAR;
        PG8_STAGE(PG8_SB(1, 0), cB + kstep, voffB); PG8_STAGE(PG8_SA(1, 0), cA + kstep, voffA); PG8_STAGE(PG8_SB(1, 1), cB + hstepB + kstep, voffB);
        PG8_WAIT_V(6); PG8_BAR;
    }
    for (;;) {
        const bool has_next = S.next(ui + 1, nxt);
        const char* nA = has_next ? (const char*)g.A + (size_t)nxt.pm * tstepA + (size_t)nxt.ko * 2 : cA; const char* nB = has_next ? (const char*)g.Bt + (size_t)nxt.pn * tstepB + (size_t)nxt.ko * 2 : cB;
        for (int t = 0; t < nt; t += 2) {
            const bool last = (t == nt - 2);
            const char* a1 = cA + (size_t)(t + 1) * kstep;
            const char* a2 = last ? nA : cA + (size_t)(t + 2) * kstep; const char* b2 = last ? nB : cB + (size_t)(t + 2) * kstep;
            const char* a3 = a2 + kstep; const char* b3 = b2 + kstep;
            if (last && has_next) { S.a_ready(nxt); E.pre(nxt, lds + RS_LDS_OFF + ((ui + 1) & 1) * 1024, wid); }
            if constexpr (SP2) {
            PG8_LDB(B0, 0, 0); PG8_LDB(B1, 0, 1); PG8_SCHED; PG8_LDA(At, 0, 0); PG8_STAGE(PG8_SA(1, 1), a1 + hstepA, voffA);
            PG8_WAIT_V(8); PG8_WAIT_L(0); PG8_BAR; PG8_MMA(0, 0, At, B0); PG8_MMA(0, 1, At, B1); PG8_BAR; PG8_SCHED;
            PG8_LDA(At, 0, 1); PG8_STAGE(PG8_SB(0, 0), b2, voffB); PG8_STAGE(PG8_SB(0, 1), b2 + hstepB, voffB); PG8_STAGE(PG8_SA(0, 0), a2, voffA);
            PG8_WAIT_V(8); PG8_WAIT_L(0); PG8_BAR; PG8_MMA(1, 0, At, B0); PG8_MMA(1, 1, At, B1); PG8_BAR; PG8_SCHED;
            PG8_LDB(B0, 1, 0); PG8_LDB(B1, 1, 1); PG8_SCHED; PG8_LDA(At, 1, 0); PG8_STAGE(PG8_SA(0, 1), a2 + hstepA, voffA);
            PG8_WAIT_V(8); PG8_WAIT_L(0); PG8_BAR; PG8_MMA(0, 0, At, B0); PG8_MMA(0, 1, At, B1); PG8_BAR; PG8_SCHED;
            PG8_LDA(At, 1, 1); PG8_STAGE(PG8_SB(1, 0), b3, voffB); PG8_STAGE(PG8_SB(1, 1), b3 + hstepB, voffB); PG8_STAGE(PG8_SA(1, 0), a3, voffA);
            PG8_WAIT_V(8); PG8_WAIT_L(0); PG8_BAR; PG8_MMA(1, 0, At, B0); PG8_MMA(1, 1, At, B1); PG8_BAR; PG8_SCHED;
            } else {
            PG8_LDB(B0, 0, 0); PG8_SCHED; PG8_LDA(At, 0, 0); PG8_STAGE(PG8_SA(1, 1), a1 + hstepA, voffA);
            PG8_WAIT_L(8); PG8_BAR; PG8_WAIT_L(0); PG8_MMA(0, 0, At, B0); PG8_BAR; PG8_SCHED;
            PG8_LDB(B1, 0, 1); PG8_STAGE(PG8_SB(0, 0), b2, voffB);
            PG8_BAR; PG8_WAIT_L(0); PG8_MMA(0, 1, At, B1); PG8_BAR;
            PG8_LDA(At, 0, 1); PG8_STAGE(PG8_SA(0, 0), a2, voffA);
            PG8_BAR; PG8_WAIT_L(0); PG8_MMA(1, 0, At, B0); PG8_BAR; PG8_SCHED;
            PG8_STAGE(PG8_SB(0, 1), b2 + hstepB, voffB);
            PG8_WAIT_V(6); PG8_BAR; PG8_MMA(1, 1, At, B1); PG8_BAR;
            PG8_LDB(B0, 1, 0); PG8_SCHED; PG8_LDA(At, 1, 0); PG8_STAGE(PG8_SA(0, 1), a2 + hstepA, voffA);
            PG8_WAIT_L(8); PG8_BAR; PG8_WAIT_L(0); PG8_MMA(0, 0, At, B0); PG8_BAR; PG8_SCHED;
            PG8_LDB(B1, 1, 1); PG8_STAGE(PG8_SB(1, 0), b3, voffB);
            PG8_BAR; PG8_WAIT_L(0); PG8_MMA(0, 1, At, B1); PG8_BAR;
            PG8_LDA(At, 1, 1); PG8_STAGE(PG8_SA(1, 0), a3, voffA);
            PG8_BAR; PG8_WAIT_L(0); PG8_MMA(1, 0, At, B0); PG8_BAR; PG8_SCHED;
            PG8_STAGE(PG8_SB(1, 1), b3 + hstepB, voffB);
            PG8_WAIT_V(6); PG8_BAR; PG8_MMA(1, 1, At, B1); PG8_BAR;
            }
        }
        if constexpr (ALIGN_EPI) { if (wr == 0) PG8_BAR; }
        if constexpr (!Epi::AFTER_DRAIN) { int l2; asm volatile("v_mbcnt_lo_u32_b32 %0, -1, 0\n\tv_mbcnt_hi_u32_b32 %0, -1, %0" : "=v"(l2));
            E(acc, cur, wr, wc, l2 & 15, l2 >> 4, (const PG8_LAS float*)(lds + RS_LDS_OFF + (ui & 1) * 1024)); S.done(cur); }
        if (!has_next) break;
#pragma unroll
        for (int a = 0; a < 2; ++a)
#pragma unroll
            for (int b = 0; b < 2; ++b)
#pragma unroll
                for (int m = 0; m < 4; ++m)
#pragma unroll
                    for (int n = 0; n < 2; ++n) acc[a][b][m][n] = (f32x4){0.f, 0.f, 0.f, 0.f};
        cur = nxt; cA = nA; cB = nB; ++ui;
        if constexpr (ALIGN_EPI) { if (wr == 1) PG8_BAR; }
    }
    PG8_WAIT_V(0);
    if constexpr (!ALIGN_EPI) { if (wr == 0) PG8_BAR; }
    PG8_BAR;
    if constexpr (Epi::AFTER_DRAIN) { E.fused(acc, cur, wr, wc, fr, fq, lds, wid, lane); S.done(cur); }
#undef PG8_SA
#undef PG8_SB
#undef PG8_STAGE
#undef PG8_LDA
#undef PG8_LDB
#undef PG8_MMA
#undef PG8_WAIT_V
#undef PG8_WAIT_L
#undef PG8_BAR
#undef PG8_SCHED
}
}
using pg8::sq8; using pg8::store8;

namespace att {
constexpr int SHM_V = 16384, SHM_K = 16384, SHM_K2 = 8192;
constexpr int OFF_V = 0, OFF_K = 2 * SHM_V, OFF_K2 = OFF_K + 2 * SHM_K, OFF_BIAS = OFF_K2 + 2 * SHM_K2, OFF_TBL = OFF_BIAS + 512, OFF_WS = OFF_TBL + 512, LDS_END = OFF_WS + 8 * 256;
constexpr float THR = 8.f;
#define KSWZ(row, colB) ((row) * 256 + ((colB) ^ (((row) & 15) << 4)))
#define K2SWZ(row, colB) ((row) * 128 + ((colB) ^ ((((row) >> 1) & 7) << 4)))
#define SBAR() __builtin_amdgcn_sched_barrier(0)
__device__ __forceinline__ int v_st(int k, int c) { const int kk = (k & ~0xC) | ((k & 4) << 1) | ((k & 8) >> 1); return ((kk >> 3) * 4 + (c >> 5)) * 512 + ((kk & 7) * 32 + (c & 31)) * 2; }
__device__ __forceinline__ int v_rd_base(int lane) { return ((lane & 3) << 3) | (((lane >> 2) & 3) << 6) | (((lane >> 4) & 1) << 5) | (((lane >> 5) & 1) << 8); }
constexpr int v_rd_off(int d0, int ks, int half) { return d0 * 512 + ks * 4096 + half * 2048; }
__device__ __forceinline__ int crow(int r, int hi) { return (r & 3) + 8 * (r >> 2) + 4 * hi; }

template <int MODE> struct Cfg { static constexpr float SCALE = (MODE == 1) ? 0.07216878364870322f : 0.08838834764831845f; static constexpr int DK = (MODE == 1) ? 192 : 128; };

__device__ __forceinline__ void mask_tile(f32x16& p0, f32x16& p1, int lim) {
    const float NEG = -__builtin_inff();
#pragma unroll
    for (int r = 0; r < 16; ++r) {
        const int c = (r & 3) + 8 * (r >> 2);
        if (c > lim) p0[r] = NEG;
        if (c + 32 > lim) p1[r] = NEG;
    }
}
__device__ __forceinline__ void t5_bias(f32x16& p0, f32x16& p1, const LAS float* tbl, int dd) {
#pragma unroll
    for (int g = 0; g < 4; ++g) {
#pragma unroll
        for (int j = 0; j < 4; ++j) { const int r = 4 * g + j, c = (r & 3) + 8 * (r >> 2);
            int i0 = dd - c; i0 = i0 < 0 ? 0 : (i0 > 127 ? 127 : i0);
            int i1 = dd - c - 32; i1 = i1 < 0 ? 0 : (i1 > 127 ? 127 : i1);
            p0[r] += tbl[i0]; p1[r] += tbl[i1]; }
        asm volatile("" ::: "memory");
    }
}
template <int MODE>
__device__ __forceinline__ void partialSM(f32x16& p0, f32x16& p1, float& m_reg, float& mn, float& alpha) {
    constexpr float SCALE = Cfg<MODE>::SCALE;
    float pmax = p0[0];
#pragma unroll
    for (int r = 1; r < 16; ++r) pmax = fmaxf(pmax, p0[r]);
#pragma unroll
    for (int r = 0; r < 16; ++r) pmax = fmaxf(pmax, p1[r]);
    { auto rr = __builtin_amdgcn_permlane32_swap(__float_as_uint(pmax), __float_as_uint(pmax), false, false);
      pmax = fmaxf(__uint_as_float(rr[0]), __uint_as_float(rr[1])); }
    constexpr float C2 = 1.4426950408889634f * SCALE;
    if (__builtin_expect(__all((pmax - m_reg) * SCALE <= THR), 1)) { mn = m_reg; alpha = 1.f; }
    else { mn = fmaxf(m_reg, pmax); alpha = __builtin_amdgcn_exp2f((m_reg - mn) * C2); m_reg = mn; }
    const float mnL = -mn * C2;
#pragma unroll
    for (int r = 0; r < 16; ++r) p0[r] = fmaf(p0[r], C2, mnL);
#pragma unroll
    for (int r = 0; r < 16; ++r) p1[r] = fmaf(p1[r], C2, mnL);
#pragma unroll
    for (int r = 0; r < 16; ++r) p0[r] = __builtin_amdgcn_exp2f(p0[r]);
}
__device__ __forceinline__ void finishSM(f32x16& p0, f32x16& p1, float alpha, float& l_reg, bf16x8& pa0, bf16x8& pa1, bf16x8& pa2, bf16x8& pa3) {
#pragma unroll
    for (int r = 0; r < 16; ++r) p1[r] = __builtin_amdgcn_exp2f(p1[r]);
    float ps = 0;
#pragma unroll
    for (int r = 0; r < 16; ++r) ps += p0[r];
#pragma unroll
    for (int r = 0; r < 16; ++r) ps += p1[r];
    { auto rr = __builtin_amdgcn_permlane32_swap(__float_as_uint(ps), __float_as_uint(ps), false, false);
      ps = __uint_as_float(rr[0]) + __uint_as_float(rr[1]); }
    l_reg = l_reg * alpha + ps;
#define PK4(P, B_, OUT) do { unsigned a0 = cvt_pk_bf16(P[B_+0], P[B_+1]), a1 = cvt_pk_bf16(P[B_+2], P[B_+3]);                          \
        unsigned b0 = cvt_pk_bf16(P[B_+4], P[B_+5]), b1 = cvt_pk_bf16(P[B_+6], P[B_+7]);                                             \
        auto r0 = __builtin_amdgcn_permlane32_swap(a0, b0, false, false); auto r1 = __builtin_amdgcn_permlane32_swap(a1, b1, false, false); \
        u32x4 w = {r0[0], r1[0], r0[1], r1[1]}; OUT = *reinterpret_cast<bf16x8*>(&w); } while (0)
    PK4(p0, 0, pa0); PK4(p0, 8, pa1); PK4(p1, 0, pa2); PK4(p1, 8, pa3);
#undef PK4
}
template <int MODE>
__device__ __forceinline__ void qkt(f32x16& p0, f32x16& p1, const LAS char* Kt, const LAS char* K2t, const LAS float* biasL, int r32, int hi, const bf16x8* qr) {
    if constexpr (MODE == 0) {
        const LAS f32x4* bl = (const LAS f32x4*)biasL;
#pragma unroll
        for (int g = 0; g < 4; ++g) { const f32x4 a = bl[2 * g + hi], b = bl[8 + 2 * g + hi];
#pragma unroll
            for (int j = 0; j < 4; ++j) { p0[4 * g + j] = a[j]; p1[4 * g + j] = b[j]; } }
    } else { p0 = f32x16{}; p1 = f32x16{}; }
    const int kg_ = ((r32 & 15) << 4) ^ (hi << 4);
    const LAS char* kr_ = Kt + r32 * 256;
    __builtin_amdgcn_s_setprio(1);
#pragma unroll
    for (int d0 = 0; d0 < 8; ++d0) { const LAS char* a = kr_ + (kg_ ^ (d0 << 5));
        const bf16x8 b0 = *reinterpret_cast<const LAS bf16x8*>(a);
        const bf16x8 b1 = *reinterpret_cast<const LAS bf16x8*>(a + 32 * 256);
        p0 = __builtin_amdgcn_mfma_f32_32x32x16_bf16(b0, qr[d0], p0, 0, 0, 0);
        p1 = __builtin_amdgcn_mfma_f32_32x32x16_bf16(b1, qr[d0], p1, 0, 0, 0); }
    if constexpr (MODE == 1) {
#pragma unroll
        for (int d0 = 0; d0 < 4; ++d0) { const LAS char* a = K2t + K2SWZ(r32, (d0 * 16 + hi * 8) * 2);
            const bf16x8 b0 = *reinterpret_cast<const LAS bf16x8*>(a);
            const bf16x8 b1 = *reinterpret_cast<const LAS bf16x8*>(a + 32 * 128);
            p0 = __builtin_amdgcn_mfma_f32_32x32x16_bf16(b0, qr[8 + d0], p0, 0, 0, 0);
            p1 = __builtin_amdgcn_mfma_f32_32x32x16_bf16(b1, qr[8 + d0], p1, 0, 0, 0); }
    }
    __builtin_amdgcn_s_setprio(0);
}
__device__ __forceinline__ void pv_tile(f32x16* o, unsigned vb0, bf16x8 pa0, bf16x8 pa1, bf16x8 pa2, bf16x8 pa3) {
#define TRRD(dst, off) asm volatile("ds_read_b64_tr_b16 %0, %1 offset:%2" : "=&v"(dst) : "v"(vb0), "i"(off) : "memory")
#define PV_RD(S, d0) do { constexpr int b_ = v_rd_off(d0, 0, 0);     \
        TRRD(S##l0, b_); TRRD(S##h0, b_ + 2048); TRRD(S##l1, b_ + 4096); TRRD(S##h1, b_ + 6144); TRRD(S##l2, b_ + 8192); TRRD(S##h2, b_ + 10240); TRRD(S##l3, b_ + 12288); TRRD(S##h3, b_ + 14336); } while (0)
#define PV_MM(S, d0) do { \
        o[d0] = __builtin_amdgcn_mfma_f32_32x32x16_bf16(pa0, (bf16x8){S##l0[0], S##l0[1], S##l0[2], S##l0[3], S##h0[0], S##h0[1], S##h0[2], S##h0[3]}, o[d0], 0, 0, 0);   \
        o[d0] = __builtin_amdgcn_mfma_f32_32x32x16_bf16(pa1, (bf16x8){S##l1[0], S##l1[1], S##l1[2], S##l1[3], S##h1[0], S##h1[1], S##h1[2], S##h1[3]}, o[d0], 0, 0, 0);   \
        o[d0] = __builtin_amdgcn_mfma_f32_32x32x16_bf16(pa2, (bf16x8){S##l2[0], S##l2[1], S##l2[2], S##l2[3], S##h2[0], S##h2[1], S##h2[2], S##h2[3]}, o[d0], 0, 0, 0);   \
        o[d0] = __builtin_amdgcn_mfma_f32_32x32x16_bf16(pa3, (bf16x8){S##l3[0], S##l3[1], S##l3[2], S##l3[3], S##h3[0], S##h3[1], S##h3[2], S##h3[3]}, o[d0], 0, 0, 0); } while (0)
    s16x4 Al0, Al1, Al2, Al3, Ah0, Ah1, Ah2, Ah3, Bl0, Bl1, Bl2, Bl3, Bh0, Bh1, Bh2, Bh3;
    __builtin_amdgcn_s_setprio(1);
    PV_RD(A, 0);
    PV_RD(B, 1); asm volatile("s_waitcnt lgkmcnt(8)" ::: "memory"); SBAR(); PV_MM(A, 0); SBAR();
    PV_RD(A, 2); asm volatile("s_waitcnt lgkmcnt(8)" ::: "memory"); SBAR(); PV_MM(B, 1); SBAR();
    PV_RD(B, 3); asm volatile("s_waitcnt lgkmcnt(8)" ::: "memory"); SBAR(); PV_MM(A, 2); SBAR();
    asm volatile("s_waitcnt lgkmcnt(0)" ::: "memory"); SBAR(); PV_MM(B, 3);
    __builtin_amdgcn_s_setprio(0);
#undef PV_MM
#undef PV_RD
#undef TRRD
}

struct PassArgs {
    const bf16_t* Q; const bf16_t* Q2; const bf16_t* K; const bf16_t* K2; const bf16_t* V; const float* cum;
    int ldq, ldq2, ldk, ldk2, ldv;
    int krow0;
    int qvp0;
    int NT;
    int shift0;
};
template <int MODE>
__device__ __forceinline__ void attn_pass(const PassArgs& a, LAS char* lds, f32x16 (&o)[4], const int tid) {
    constexpr int DK = Cfg<MODE>::DK;
    constexpr float SCALE = Cfg<MODE>::SCALE, INV_SCALE = 1.0f / SCALE;
    const int wid = __builtin_amdgcn_readfirstlane(tid >> 6), lane = tid & 63, r32 = lane & 31, hi = lane >> 5;
    bf16x8 qr[DK / 16];
    { const bf16_t* qp = a.Q + (size_t)(wid * 32 + r32) * a.ldq + hi * 8;
#pragma unroll
      for (int d0 = 0; d0 < 8; ++d0) qr[d0] = *(const bf16x8*)(qp + d0 * 16);
      if constexpr (MODE == 1) { const bf16_t* qp2 = a.Q2 + (size_t)(wid * 32 + r32) * a.ldq2 + hi * 8;
#pragma unroll
          for (int d0 = 0; d0 < 4; ++d0) qr[8 + d0] = *(const bf16x8*)(qp2 + d0 * 16); } }
    const int sr = tid >> 4, sc = (tid & 15) * 8, kws = KSWZ(sr, sc * 2), vst0 = v_st(sr, sc), vst1 = v_st(32 + sr, sc);
    const int sr2 = tid >> 3, sc2 = (tid & 7) * 8, k2ws = K2SWZ(sr2, sc2 * 2);
    bf16x8 st_k0, st_k1, st_v0, st_v1, st_k2; float st_b = 0.f;
#define TROW(t) ((t) == 0 ? META0 : a.krow0 + ((t) - 1) * 64)
#define ISSUE(t) do { const int tr_ = TROW(t); const size_t r0_ = (size_t)(tr_ + sr);                                             \
        st_k0 = *(const bf16x8*)(a.K + r0_ * a.ldk + sc); st_k1 = *(const bf16x8*)(a.K + (r0_ + 32) * a.ldk + sc);                 \
        st_v0 = *(const bf16x8*)(a.V + r0_ * a.ldv + sc); st_v1 = *(const bf16x8*)(a.V + (r0_ + 32) * a.ldv + sc);                 \
        if constexpr (MODE == 1) st_k2 = *(const bf16x8*)(a.K2 + (size_t)(tr_ + sr2) * a.ldk2 + sc2);                              \
        if constexpr (MODE == 0) { if (tid < 64) st_b = a.cum[tr_ + tid]; } } while (0)
#define WRITE(bf) do { *(LAS bf16x8*)(lds + OFF_K + (bf) * SHM_K + kws) = st_k0; *(LAS bf16x8*)(lds + OFF_K + (bf) * SHM_K + kws + 32 * 256) = st_k1;   \
        *(LAS bf16x8*)(lds + OFF_V + (bf) * SHM_V + vst0) = st_v0; *(LAS bf16x8*)(lds + OFF_V + (bf) * SHM_V + vst1) = st_v1;                        \
        if constexpr (MODE == 1) *(LAS bf16x8*)(lds + OFF_K2 + (bf) * SHM_K2 + k2ws) = st_k2;                                                       \
        if constexpr (MODE == 0) { if (tid < 64) ((LAS float*)(lds + OFF_BIAS + (bf) * 256))[tid] = -st_b * INV_SCALE; } } while (0)
    ISSUE(0);
    WRITE(0);
    __syncthreads();
    float m_reg = -1e30f, l_reg = 0.f;
#pragma unroll
    for (int d = 0; d < 4; ++d) o[d] = f32x16{};
    const int qlo = a.qvp0 + wid * 32, qv = qlo + r32;
    LAS float* li_l = (LAS float*)(lds + OFF_WS + wid * 256); LAS float* al_l = li_l + 32;
    const LAS float* tbl = (const LAS float*)(lds + OFF_TBL);
    const unsigned vbase = (unsigned)(uintptr_t)(lds + OFF_V) + (unsigned)v_rd_base(lane);
    const int NT = a.NT;
    for (int t = 0; t < NT; ++t) {
        const int cur = t & 1;
        if (t + 1 < NT) ISSUE(t + 1);
        const int kb = 64 * t;
        if (t == 0 || kb <= qlo + 31) {
        f32x16 p0, p1;
        qkt<MODE>(p0, p1, lds + OFF_K + cur * SHM_K, lds + OFF_K2 + cur * SHM_K2, (const LAS float*)(lds + OFF_BIAS + cur * 256), r32, hi, qr);
        if constexpr (MODE == 2) { const int sh = t == 0 ? a.shift0 : 0; if (qlo - sh - (kb + 63) <= 112) t5_bias(p0, p1, tbl, qv - kb - sh - 4 * hi); }
        if (t == 0 || kb + 63 > qlo) { int lim = qv - kb; const int tm = t == 0 ? 15 : 63; lim = (lim < tm ? lim : tm) - 4 * hi; mask_tile(p0, p1, lim); }
        float mn, alpha;
        partialSM<MODE>(p0, p1, m_reg, mn, alpha);
        if (__any(alpha < 1.f)) { if (hi == 0) al_l[r32] = alpha; asm volatile("s_waitcnt lgkmcnt(0)" ::: "memory");
#pragma unroll
            for (int r = 0; r < 16; ++r) { const float av = al_l[crow(r, hi)];
#pragma unroll
                for (int d = 0; d < 4; ++d) o[d][r] *= av; } }
        bf16x8 pa0, pa1, pa2, pa3;
        finishSM(p0, p1, alpha, l_reg, pa0, pa1, pa2, pa3);
        pv_tile(o, vbase + (unsigned)(cur * SHM_V), pa0, pa1, pa2, pa3);
        }
        if (t + 1 < NT) WRITE(cur ^ 1);
        __syncthreads();
    }
    if (hi == 0) li_l[r32] = l_reg;
    asm volatile("s_waitcnt lgkmcnt(0)" ::: "memory");
#pragma unroll
    for (int r = 0; r < 16; ++r) { const float rl = __builtin_amdgcn_rcpf(li_l[crow(r, hi)]);
#pragma unroll
        for (int d = 0; d < 4; ++d) o[d][r] *= rl; }
#undef TROW
#undef ISSUE
#undef WRITE
}
template <int MODE>
__device__ __forceinline__ void attn_pass_dma(const PassArgs& a, LAS char* lds, f32x16 (&o)[4], const int tid) {
    constexpr int DK = Cfg<MODE>::DK;
    constexpr float SCALE = Cfg<MODE>::SCALE, INV_SCALE = 1.0f / SCALE;
    const int wid = __builtin_amdgcn_readfirstlane(tid >> 6);
    bf16x8 qr[DK / 16];
    { const int lane = tid & 63, r32 = lane & 31, hi = lane >> 5; const bf16_t* qp = a.Q + (size_t)(wid * 32 + r32) * a.ldq + hi * 8;
#pragma unroll
      for (int d0 = 0; d0 < 8; ++d0) qr[d0] = *(const bf16x8*)(qp + d0 * 16);
      if constexpr (MODE == 1) { const bf16_t* qp2 = a.Q2 + (size_t)(wid * 32 + r32) * a.ldq2 + hi * 8;
#pragma unroll
          for (int d0 = 0; d0 < 4; ++d0) qr[8 + d0] = *(const bf16x8*)(qp2 + d0 * 16); } }
    float st_b = 0.f;
#define TROW(t) ((t) == 0 ? META0 : a.krow0 + ((t) - 1) * 64)
#define DMA16(gp, ldsoff) __builtin_amdgcn_global_load_lds((const unsigned*)(gp), (LAS unsigned*)(lds + (ldsoff)), 16, 0, 0)
#define ISSUE_D(t, bf) do { int tl_ = tid; asm volatile("" : "+v"(tl_)); const int tr_ = TROW(t);                                         \
        const int krow = tl_ >> 4, kcol = ((tl_ & 15) ^ (krow & 15)) * 8;                                                                \
        const int vkk = ((tl_ >> 7) << 3) | ((tl_ & 31) >> 2), vrow = (vkk & ~0xC) | ((vkk & 4) << 1) | ((vkk & 8) >> 1), vcol = ((tl_ >> 5) & 3) * 32 + (tl_ & 3) * 8;   \
        _Pragma("unroll") for (int i_ = 0; i_ < 2; ++i_) DMA16(a.K + (size_t)(tr_ + krow + 32 * i_) * a.ldk + kcol, OFF_K + (bf) * SHM_K + i_ * 8192 + wid * 1024);   \
        _Pragma("unroll") for (int i_ = 0; i_ < 2; ++i_) DMA16(a.V + (size_t)(tr_ + vrow + 32 * i_) * a.ldv + vcol, OFF_V + (bf) * SHM_V + i_ * 8192 + wid * 1024);   \
        if constexpr (MODE == 1) { const int r2_ = tl_ >> 3, c2_ = ((tl_ & 7) ^ ((r2_ >> 1) & 7)) * 8; DMA16(a.K2 + (size_t)(tr_ + r2_) * a.ldk2 + c2_, OFF_K2 + (bf) * SHM_K2 + wid * 1024); } \
        if constexpr (MODE == 0) { if (tl_ < 64) st_b = a.cum[tr_ + tl_]; } } while (0)
#define WRITE_B(bf) do { if constexpr (MODE == 0) { int tl_ = tid; asm volatile("" : "+v"(tl_)); if (tl_ < 64) ((LAS float*)(lds + OFF_BIAS + (bf) * 256))[tl_] = -st_b * INV_SCALE; } } while (0)
    ISSUE_D(0, 0);
    WRITE_B(0);
    asm volatile("s_waitcnt vmcnt(0)" ::: "memory");
    __syncthreads();
    float m_reg = -1e30f, l_reg = 0.f;
#pragma unroll
    for (int d = 0; d < 4; ++d) o[d] = f32x16{};
    const int NT = a.NT;
    for (int t = 0; t < NT; ++t) {
        const int cur = t & 1;
        if (t + 1 < NT) ISSUE_D(t + 1, cur ^ 1);
        int tl = tid; asm volatile("" : "+v"(tl));
        const int lane = tl & 63, r32 = lane & 31, hi = lane >> 5;
        const int qlo = a.qvp0 + wid * 32, qv = qlo + r32;
        LAS float* al_l = (LAS float*)(lds + OFF_WS + wid * 256) + 32;
        const int kb = 64 * t;
        if (t == 0 || kb <= qlo + 31) {
        f32x16 p0, p1;
        qkt<MODE>(p0, p1, lds + OFF_K + cur * SHM_K, lds + OFF_K2 + cur * SHM_K2, (const LAS float*)(lds + OFF_BIAS + cur * 256), r32, hi, qr);
        if (t == 0 || kb + 63 > qlo) { int lim = qv - kb; const int tm = t == 0 ? 15 : 63; lim = (lim < tm ? lim : tm) - 4 * hi; mask_tile(p0, p1, lim); }
        float mn, alpha;
        partialSM<MODE>(p0, p1, m_reg, mn, alpha);
        if (__any(alpha < 1.f)) { if (hi == 0) al_l[r32] = alpha; asm volatile("s_waitcnt lgkmcnt(0)" ::: "memory");
#pragma unroll
            for (int r = 0; r < 16; ++r) { const float av = al_l[crow(r, hi)];
#pragma unroll
                for (int d = 0; d < 4; ++d) o[d][r] *= av; } }
        bf16x8 pa0, pa1, pa2, pa3;
        finishSM(p0, p1, alpha, l_reg, pa0, pa1, pa2, pa3);
        pv_tile(o, (unsigned)(uintptr_t)(lds + OFF_V) + (unsigned)v_rd_base(lane) + (unsigned)(cur * SHM_V), pa0, pa1, pa2, pa3);
        }
        if (t + 1 < NT) WRITE_B(cur ^ 1);
        asm volatile("s_waitcnt vmcnt(0)" ::: "memory");
        __syncthreads();
    }
    { int tl = tid; asm volatile("" : "+v"(tl));
      const int lane = tl & 63, r32 = lane & 31, hi = lane >> 5;
      LAS float* li_l = (LAS float*)(lds + OFF_WS + wid * 256);
      if (hi == 0) li_l[r32] = l_reg;
      asm volatile("s_waitcnt lgkmcnt(0)" ::: "memory");
#pragma unroll
      for (int r = 0; r < 16; ++r) { const float rl = __builtin_amdgcn_rcpf(li_l[crow(r, hi)]);
#pragma unroll
          for (int d = 0; d < 4; ++d) o[d][r] *= rl; } }
#undef TROW
#undef DMA16
#undef ISSUE_D
#undef WRITE_B
}
constexpr int D_OFF_V = 0  , D_OFF_K = 65536  , D_OFF_TBL = 98304, D_OFF_WS = D_OFF_TBL + 512, D_LDS_END = D_OFF_WS + 8 * 256;
__device__ __forceinline__ void attn_pass_diff(const PassArgs& a, LAS char* lds, f32x16 (&o)[8], const int tid) {
    const int wid = __builtin_amdgcn_readfirstlane(tid >> 6);
    bf16x8 qr[8];
    { const int lane = tid & 63, r32 = lane & 31, hi = lane >> 5; const bf16_t* qp = a.Q + (size_t)(wid * 32 + r32) * a.ldq + hi * 8;
#pragma unroll
      for (int d0 = 0; d0 < 8; ++d0) qr[d0] = *(const bf16x8*)(qp + d0 * 16); }
#define TROW(t) ((t) == 0 ? META0 : a.krow0 + ((t) - 1) * 64)
#define DMA16(gp, ldsoff) __builtin_amdgcn_global_load_lds((const unsigned*)(gp), (LAS unsigned*)(lds + (ldsoff)), 16, 0, 0)
#define ISSUE_D(t, bf) do { int tl_ = tid; asm volatile("" : "+v"(tl_)); const int tr_ = TROW(t);                                         \
        const int krow = tl_ >> 4, kcol = ((tl_ & 15) ^ (krow & 15)) * 8;                                                                \
        const int vkk = ((tl_ >> 7) << 3) | ((tl_ & 31) >> 2), vrow = (vkk & ~0xC) | ((vkk & 4) << 1) | ((vkk & 8) >> 1), vcol = ((tl_ >> 5) & 3) * 32 + (tl_ & 3) * 8;   \
        _Pragma("unroll") for (int i_ = 0; i_ < 2; ++i_) DMA16(a.K + (size_t)(tr_ + krow + 32 * i_) * a.ldk + kcol, D_OFF_K + (bf) * 16384 + i_ * 8192 + wid * 1024);   \
        _Pragma("unroll") for (int h_ = 0; h_ < 2; ++h_) _Pragma("unroll") for (int i_ = 0; i_ < 2; ++i_)                                 \
            DMA16(a.V + (size_t)(tr_ + vrow + 32 * i_) * a.ldv + h_ * 128 + vcol, D_OFF_V + (bf) * 32768 + h_ * 16384 + i_ * 8192 + wid * 1024); } while (0)
    ISSUE_D(0, 0);
    asm volatile("s_waitcnt vmcnt(0)" ::: "memory");
    __syncthreads();
    float m_reg = -1e30f, l_reg = 0.f;
#pragma unroll
    for (int d = 0; d < 8; ++d) o[d] = f32x16{};
    const int NT = a.NT;
    for (int t = 0; t < NT; ++t) {
        const int cur = t & 1;
        if (t + 1 < NT) ISSUE_D(t + 1, cur ^ 1);
        int tl = tid; asm volatile("" : "+v"(tl));
        const int lane = tl & 63, r32 = lane & 31, hi = lane >> 5;
        const int qlo = a.qvp0 + wid * 32, qv = qlo + r32;
        LAS float* al_l = (LAS float*)(lds + D_OFF_WS + wid * 256) + 32;
        const int kb = 64 * t;
        if (t == 0 || kb <= qlo + 31) {
        f32x16 p0, p1;
        qkt<2>(p0, p1, lds + D_OFF_K + cur * 16384, lds, (const LAS float*)lds, r32, hi, qr);
        { const int sh = t == 0 ? a.shift0 : 0; if (qlo - sh - (kb + 63) <= 112) t5_bias(p0, p1, (const LAS float*)(lds + D_OFF_TBL), qv - kb - sh - 4 * hi); }
        if (t == 0 || kb + 63 > qlo) { int lim = qv - kb; const int tm = t == 0 ? 15 : 63; lim = (lim < tm ? lim : tm) - 4 * hi; mask_tile(p0, p1, lim); }
        float mn, alpha;
        partialSM<2>(p0, p1, m_reg, mn, alpha);
        if (__any(alpha < 1.f)) { if (hi == 0) al_l[r32] = alpha; asm volatile("s_waitcnt lgkmcnt(0)" ::: "memory");
#pragma unroll
            for (int r = 0; r < 16; ++r) { const float av = al_l[crow(r, hi)];
#pragma unroll
                for (int d = 0; d < 8; ++d) o[d][r] *= av; } }
        bf16x8 pa0, pa1, pa2, pa3;
        finishSM(p0, p1, alpha, l_reg, pa0, pa1, pa2, pa3);
        const unsigned vbase = (unsigned)(uintptr_t)(lds + D_OFF_V) + (unsigned)v_rd_base(lane) + (unsigned)(cur * 32768);
        pv_tile(o, vbase, pa0, pa1, pa2, pa3);
        pv_tile(o + 4, vbase + 16384u, pa0, pa1, pa2, pa3);
        }
        asm volatile("s_waitcnt vmcnt(0)" ::: "memory");
        __syncthreads();
    }
    { int tl = tid; asm volatile("" : "+v"(tl));
      const int lane = tl & 63, r32 = lane & 31, hi = lane >> 5;
      LAS float* li_l = (LAS float*)(lds + D_OFF_WS + wid * 256);
      if (hi == 0) li_l[r32] = l_reg;
      asm volatile("s_waitcnt lgkmcnt(0)" ::: "memory");
#pragma unroll
      for (int r = 0; r < 16; ++r) { const float rl = __builtin_amdgcn_rcpf(li_l[crow(r, hi)]);
#pragma unroll
          for (int d = 0; d < 8; ++d) o[d][r] *= rl; } }
#undef TROW
#undef DMA16
#undef ISSUE_D
}
#ifdef PROBE_ATT
template <int PVAR  >
__device__ __forceinline__ void attn_pass_diff_probe(const PassArgs& a, LAS char* lds, f32x16 (&o)[8], const int tid) {
    const int wid = __builtin_amdgcn_readfirstlane(tid >> 6);
    bf16x8 qr[8];
    { const int lane = tid & 63, r32 = lane & 31, hi = lane >> 5; const bf16_t* qp = a.Q + (size_t)(wid * 32 + r32) * a.ldq + hi * 8;
#pragma unroll
      for (int d0 = 0; d0 < 8; ++d0) qr[d0] = *(const bf16x8*)(qp + d0 * 16); }
#define TROW(t) ((t) == 0 ? META0 : a.krow0 + ((t) - 1) * 64)
#define DMA16(gp, ldsoff) __builtin_amdgcn_global_load_lds((const unsigned*)(gp), (LAS unsigned*)(lds + (ldsoff)), 16, 0, 0)
#define ISSUE_D(t, bf) do { int tl_ = tid; asm volatile("" : "+v"(tl_)); const int tr_ = TROW(t);                                         \
        const int krow = tl_ >> 4, kcol = ((tl_ & 15) ^ (krow & 15)) * 8;                                                                \
        const int vkk = ((tl_ >> 7) << 3) | ((tl_ & 31) >> 2), vrow = (vkk & ~0xC) | ((vkk & 4) << 1) | ((vkk & 8) >> 1), vcol = ((tl_ >> 5) & 3) * 32 + (tl_ & 3) * 8;   \
        _Pragma("unroll") for (int i_ = 0; i_ < 2; ++i_) DMA16(a.K + (size_t)(tr_ + krow + 32 * i_) * a.ldk + kcol, D_OFF_K + (bf) * 16384 + i_ * 8192 + wid * 1024);   \
        _Pragma("unroll") for (int h_ = 0; h_ < 2; ++h_) _Pragma("unroll") for (int i_ = 0; i_ < 2; ++i_)                                 \
            DMA16(a.V + (size_t)(tr_ + vrow + 32 * i_) * a.ldv + h_ * 128 + vcol, D_OFF_V + (bf) * 32768 + h_ * 16384 + i_ * 8192 + wid * 1024); } while (0)
    ISSUE_D(0, 0);
    asm volatile("s_waitcnt vmcnt(0)" ::: "memory");
    __syncthreads();
    float m_reg = -1e30f, l_reg = 0.f;
#pragma unroll
    for (int d = 0; d < 8; ++d) o[d] = f32x16{};
    const int NT = a.NT;
    for (int t = 0; t < NT; ++t) {
        const int cur = t & 1;
        if constexpr (PVAR != 6 && PVAR != 8) { if (t + 1 < NT) ISSUE_D(t + 1, cur ^ 1); }
        int tl = tid; asm volatile("" : "+v"(tl));
        const int lane = tl & 63, r32 = lane & 31, hi = lane >> 5;
        const int qlo = a.qvp0 + wid * 32, qv = qlo + r32;
        LAS float* al_l = (LAS float*)(lds + D_OFF_WS + wid * 256) + 32;
        const int kb = 64 * t;
        if (t == 0 || kb <= qlo + 31) {
        f32x16 p0, p1;
        if constexpr (PVAR == 5 || PVAR == 7 || PVAR == 8) { p0 = f32x16{}; p1 = f32x16{};
#pragma unroll
            for (int d0 = 0; d0 < 8; ++d0) { p0 = __builtin_amdgcn_mfma_f32_32x32x16_bf16(qr[(d0 + 1) & 7], qr[d0], p0, 0, 0, 0); p1 = __builtin_amdgcn_mfma_f32_32x32x16_bf16(qr[(d0 + 3) & 7], qr[d0], p1, 0, 0, 0); } }
        else qkt<2>(p0, p1, lds + D_OFF_K + cur * 16384, lds, (const LAS float*)lds, r32, hi, qr);
        { const int sh = t == 0 ? a.shift0 : 0; if (qlo - sh - (kb + 63) <= 112) t5_bias(p0, p1, (const LAS float*)(lds + D_OFF_TBL), qv - kb - sh - 4 * hi); }
        if (t == 0 || kb + 63 > qlo) { int lim = qv - kb; const int tm = t == 0 ? 15 : 63; lim = (lim < tm ? lim : tm) - 4 * hi; mask_tile(p0, p1, lim); }
        float mn, alpha;
        partialSM<2>(p0, p1, m_reg, mn, alpha);
        if (__any(alpha < 1.f)) { if (hi == 0) al_l[r32] = alpha; asm volatile("s_waitcnt lgkmcnt(0)" ::: "memory");
#pragma unroll
            for (int r = 0; r < 16; ++r) { const float av = al_l[crow(r, hi)];
#pragma unroll
                for (int d = 0; d < 8; ++d) o[d][r] *= av; } }
        bf16x8 pa0, pa1, pa2, pa3;
        finishSM(p0, p1, alpha, l_reg, pa0, pa1, pa2, pa3);
        const unsigned vbase = (unsigned)(uintptr_t)(lds + D_OFF_V) + (unsigned)v_rd_base(lane) + (unsigned)(cur * 32768);
        if constexpr (PVAR == 4 || PVAR == 7 || PVAR == 8) {
#pragma unroll
            for (int d = 0; d < 8; ++d) { o[d] = __builtin_amdgcn_mfma_f32_32x32x16_bf16(pa0, pa1, o[d], 0, 0, 0); o[d] = __builtin_amdgcn_mfma_f32_32x32x16_bf16(pa1, pa2, o[d], 0, 0, 0);
                o[d] = __builtin_amdgcn_mfma_f32_32x32x16_bf16(pa2, pa3, o[d], 0, 0, 0); o[d] = __builtin_amdgcn_mfma_f32_32x32x16_bf16(pa3, pa0, o[d], 0, 0, 0); } }
        else { pv_tile(o, vbase, pa0, pa1, pa2, pa3); pv_tile(o + 4, vbase + 16384u, pa0, pa1, pa2, pa3); }
        }
        asm volatile("s_waitcnt vmcnt(0)" ::: "memory");
        __syncthreads();
    }
    { int tl = tid; asm volatile("" : "+v"(tl));
      const int lane = tl & 63, r32 = lane & 31, hi = lane >> 5;
      LAS float* li_l = (LAS float*)(lds + D_OFF_WS + wid * 256);
      if (hi == 0) li_l[r32] = l_reg;
      asm volatile("s_waitcnt lgkmcnt(0)" ::: "memory");
#pragma unroll
      for (int r = 0; r < 16; ++r) { const float rl = __builtin_amdgcn_rcpf(li_l[crow(r, hi)]);
#pragma unroll
          for (int d = 0; d < 8; ++d) o[d][r] *= rl; } }
#undef TROW
#undef DMA16
#undef ISSUE_D
}
#endif
__device__ __forceinline__ void store_o_bf16(const f32x16* o, bf16_t* Ow, int ldo, int tid) {
    asm volatile("" : "+v"(tid)); const int r32 = tid & 31, hi = (tid >> 5) & 1;
#pragma unroll
    for (int r = 0; r < 16; ++r) { const int orow = crow(r, hi);
#pragma unroll
        for (int d0 = 0; d0 < 4; ++d0) { const float v = o[d0][r]; const float vn = __shfl_xor(v, 1);
            if ((r32 & 1) == 0) *(GAS unsigned*)(Ow + (size_t)orow * ldo + d0 * 32 + r32) = cvt_pk_bf16(v, vn); }
        asm volatile("" ::: "memory"); }
}
}

constexpr size_t MiB = (size_t)1 << 20;
constexpr size_t WS_CTL = 0, CTL_ZERO_BYTES = 1 * MiB;
constexpr size_t WS_PRM = 1 * MiB;
constexpr size_t WS_COS = 2 * MiB, WS_SIN = 3 * MiB;
constexpr size_t WS_RSTD = 4 * MiB;
constexpr size_t WS_STATQ = 14 * MiB, WS_STATKV = 17 * MiB;
constexpr size_t WS_STATM = 5 * MiB;
constexpr size_t WS_FLOG = 10 * MiB, WS_CUM = 12 * MiB;
constexpr size_t WS_W = 20 * MiB;
constexpr size_t SZ_EVIN = 61 * MiB, SZ_UQ = 6 * MiB, SZ_UKV = 4 * MiB, SZ_SQ = 33 * MiB, SZ_ODIN = 98 * MiB, SZ_GU = 175 * MiB, SZ_DN = 87 * MiB;
constexpr size_t W_EVIN = WS_W, W_UQ = W_EVIN + 2 * SZ_EVIN, W_UKV = W_UQ + 2 * SZ_UQ, W_EVOUT = W_UKV + 2 * SZ_UKV, W_ODIN = W_EVOUT + 2 * SZ_SQ, W_ODOUT = W_ODIN + 2 * SZ_ODIN,
                 W_GU = W_ODOUT + 2 * SZ_SQ, W_DN = W_GU + DEPTH * SZ_GU;
constexpr size_t WS_HS = W_DN + DEPTH * SZ_DN;
constexpr size_t WS_HBF = WS_HS + 260 * MiB;
constexpr size_t WS_PROJ = WS_HBF + 133 * MiB;
constexpr size_t WS_QBUF = WS_PROJ + 246 * MiB, WS_KVBUF = WS_PROJ + 346 * MiB;
constexpr size_t WS_OBUF = WS_PROJ + 479 * MiB;
constexpr size_t WS_MBUF = WS_OBUF + 133 * MiB;
constexpr size_t WS_DSCR = WS_MBUF + 133 * MiB;
constexpr size_t WS_PART = WS_DSCR + 64 * MiB;
constexpr size_t WS_END = WS_PART + 12 * MiB;
static_assert((size_t)EV_N * LD_DM * 2 <= SZ_EVIN && (size_t)UQ_N * LD_QR * 2 <= SZ_UQ && (size_t)UKV_N * LD_KV * 2 <= SZ_UKV && (size_t)DM * LD_DM * 2 <= SZ_SQ && (size_t)OD_N * LD_DM * 2 <= SZ_ODIN && (size_t)GU_N * LD_DM * 2 <= SZ_GU && (size_t)DM * LD_FF * 2 <= SZ_DN, "weight sizes");
static_assert((size_t)MPAD * DM * 4 == 260 * MiB && (size_t)MPAD * LD_DM * 2 <= 133 * MiB && (size_t)MPAD * LD_EV * 2 <= 246 * MiB && (size_t)MPAD * LD_UQ * 2 <= 100 * MiB && (size_t)MPAD * LD_UKV * 2 <= 133 * MiB && (size_t)MPAD * LD_OD * 2 <= 479 * MiB && (size_t)MPAD * LD_FF * 2 <= 479 * MiB, "activation sizes");
constexpr int LD8 = 4224;
constexpr size_t WS_A8 = WS_PROJ + 352 * MiB, WS_RS8 = WS_RSTD + 512 * 1024;
constexpr size_t CTL_COLMAX = 65536;
constexpr int I8_IN_ODD = 3;
constexpr size_t CTL_COLMAX_OD = CTL_COLMAX + (size_t)DEPTH * GU_N * 4;
constexpr size_t W_OD8_OFF = 90 * MiB;
constexpr int I8_IN_EV = 2;
constexpr size_t CTL_COLMAX_EV = CTL_COLMAX_OD + 2 * (size_t)OD_N * 4;
static_assert(CTL_COLMAX_EV + 2 * (size_t)EV_N * 4 <= CTL_ZERO_BYTES && (size_t)EV_N * LD8 <= SZ_EVIN, "int8 even in-proj buffers");
static_assert(CTL_COLMAX_OD + 2 * (size_t)OD_N * 4 <= CTL_ZERO_BYTES && (size_t)GU_N * LD8 <= W_OD8_OFF && W_OD8_OFF + (size_t)OD_N * LD8 <= SZ_GU && (size_t)MPAD * LD8 <= 133 * MiB, "int8 in-proj buffers");
static_assert((size_t)MPAD * LD_FF * 2 <= 352 * MiB && 352 * MiB + (size_t)MPAD * LD8 <= 479 * MiB && (size_t)GU_N * LD8 <= SZ_GU && CTL_COLMAX + (size_t)DEPTH * GU_N * 4 <= CTL_ZERO_BYTES, "int8 buffers");
constexpr int I8_DN = 14;
constexpr int LD8F = 11136;
constexpr size_t CTL_COLMAX_DN = CTL_COLMAX_EV + 2 * (size_t)EV_N * 4;
constexpr size_t WS_ACT8 = WS_HS, WS_AMAXP = WS_HS + 180 * MiB, WS_RSD = WS_RSTD + 768 * 1024;
static_assert(CTL_COLMAX_DN + (size_t)DEPTH * DM * 4 <= CTL_ZERO_BYTES && (size_t)MPAD * LD8F <= 180 * MiB && 180 * MiB + (size_t)MPAD * AMAXP_LD * 4 <= 260 * MiB && (size_t)DM * LD8F <= SZ_DN && (GU_N / 256) * 4 <= AMAXP_LD, "int8 down buffers");
constexpr int I8_OUT = 8;
constexpr int N_OUT8 = (I8_OUT & 1) + ((I8_OUT >> 1) & 1) + ((I8_OUT >> 2) & 1) + ((I8_OUT >> 3) & 1);
constexpr size_t CTL_COLMAX_OUT = CTL_COLMAX_DN + (size_t)DEPTH * DM * 4;
static_assert(CTL_COLMAX_OUT + (size_t)DEPTH * DM * 4 <= CTL_ZERO_BYTES && (size_t)DM * LD8 <= SZ_SQ, "int8 out-projection buffers");
constexpr int CW_BAR = 4096;

constexpr int RING_BYTES = 131072;
constexpr int PRO_SCR_BYTES = 8 * 16640;
constexpr int MISC_OFF = 135168 + 320;
constexpr int LDS_BYTES = 147456;
static_assert(att::LDS_END <= RING_BYTES && att::D_LDS_END <= RING_BYTES && PRO_SCR_BYTES <= 135168 && MISC_OFF + 64 <= LDS_BYTES, "LDS map");

#define LDS_WAIT() asm volatile("s_waitcnt lgkmcnt(0)" ::: "memory")
#define VM_WAIT() asm volatile("s_waitcnt vmcnt(0)" ::: "memory")

#define XB_TMO      128
#define XB_XCNT(j)  (256  + 64 * (j))
#define XB_XSUB(j)  (1280 + 64 * (j))
#define XB_XGEN(j)  (2304 + 64 * (j))
#define XB_TOP      3328
#define XB_TOPGEN   3392
#define XCD_BAR_WORDS 3456
#define XB_SPIN_CAP (1u << 18)

__device__ __forceinline__ unsigned xb_ld(unsigned* p)              { return __hip_atomic_load(p, __ATOMIC_RELAXED, __HIP_MEMORY_SCOPE_AGENT); }
__device__ __forceinline__ unsigned xb_add(unsigned* p, unsigned v) { return __hip_atomic_fetch_add(p, v, __ATOMIC_RELAXED, __HIP_MEMORY_SCOPE_AGENT); }
__device__ __forceinline__ unsigned xb_xcc_id() { return (unsigned)__builtin_amdgcn_s_getreg((3 << 11) | 20) & 0xFu; }
#define XB_SPIN(cond, bar) do { unsigned _sp = 0; while (cond) { __builtin_amdgcn_s_sleep(1); \
    if ((++_sp & 255u) == 0u) { if (xb_ld(&(bar)[XB_TMO])) break; if (_sp > XB_SPIN_CAP) { atomicAdd(&(bar)[XB_TMO], 1u); break; } } } } while (0)

struct XcdBarrier {
    unsigned* bar; unsigned x;
    volatile LAS unsigned* st;
};

__device__ __forceinline__ XcdBarrier xcd_barrier_post(unsigned* bar, volatile LAS unsigned* st, int tid) {
    XcdBarrier b; b.bar = bar; b.x = xb_xcc_id(); b.st = st;
    if (tid == 0) (void)xb_add(&bar[XB_XCNT(b.x)], 1u);
    return b;
}
__device__ __forceinline__ void xcd_barrier_complete(unsigned* bar, unsigned x, unsigned& nloc, unsigned& nx) {
    const unsigned G = gridDim.x * gridDim.y * gridDim.z;
    unsigned sum, cnt, mine, sp = 0u;
    for (;;) {
        sum = 0u; cnt = 0u; mine = 0u;
#pragma unroll
        for (unsigned j = 0; j < 16; ++j) { const unsigned c = xb_ld(&bar[XB_XCNT(j)]); sum += c; cnt += (c > 0u) ? 1u : 0u; mine = (j == x) ? c : mine; }
        if (sum == G) break;
        __builtin_amdgcn_s_sleep(1);
        if ((++sp & 255u) == 0u) { if (xb_ld(&bar[XB_TMO])) break; if (sp > XB_SPIN_CAP) { atomicAdd(&bar[XB_TMO], 1u); break; } }
    }
    nloc = mine > 0u ? mine : 1u; nx = cnt > 0u ? cnt : 1u;
}

__device__ __forceinline__ void xcd_barrier(const XcdBarrier& b, int tid) {
    asm volatile("s_waitcnt vmcnt(0)" ::: "memory");
    __syncthreads();
    if (tid == 0) {
        unsigned* bar = b.bar;
        __builtin_amdgcn_s_waitcnt(0);
        unsigned nloc = b.st[0], nx = b.st[1];
        if (nloc == 0u) { xcd_barrier_complete(bar, b.x, nloc, nx); b.st[0] = nloc; b.st[1] = nx; }
        const unsigned old = xb_add(&bar[XB_XSUB(b.x)], 1u);
        const unsigned gen = old / nloc;
        if (old + 1u == (gen + 1u) * nloc) {
            __builtin_amdgcn_fence(__ATOMIC_RELEASE, "agent");
            asm volatile("s_waitcnt vmcnt(0)" ::: "memory");
            const unsigned og = xb_add(&bar[XB_TOP], 1u);
            const unsigned tg = og / nx;
            if (og + 1u == (tg + 1u) * nx) xb_add(&bar[XB_TOPGEN], 1u);
            else XB_SPIN(xb_ld(&bar[XB_TOPGEN]) == tg, bar);
            __builtin_amdgcn_fence(__ATOMIC_ACQUIRE, "agent");
            xb_add(&bar[XB_XGEN(b.x)], 1u);
            asm volatile("s_waitcnt vmcnt(0)" ::: "memory");
        } else {
            XB_SPIN(xb_ld(&bar[XB_XGEN(b.x)]) == gen, bar);
            __builtin_amdgcn_fence(__ATOMIC_ACQUIRE, "agent");
            asm volatile("s_waitcnt vmcnt(0)" ::: "memory");
        }
    }
    __syncthreads();
}

struct Args { const float* in[18]; float* out; unsigned char* ws; int ph_lo, ph_hi; float lam_init[2]; };
enum { IN_X = 0, IN_META, IN_RELB, IN_EVWIN, IN_EVBF, IN_EVQN, IN_EVKVN, IN_EVWUQ, IN_EVWUKV, IN_EVWOUT, IN_ODWIN, IN_ODLAM, IN_ODSUBLN, IN_ODWOUT, IN_NORMG, IN_WGATE, IN_WUP, IN_WDOWN };

struct Frame {
    LAS unsigned char* lds;
    int tid, lane, wave, vcu, G, bx;
    unsigned char* ws;
};

__device__ __forceinline__ int ropeperm(int j) { const int a = j >> 3, e = j & 7; return e < 4 ? 4 * a + e : 32 + 4 * a + (e - 4); }
struct CvtDesc { const float* W; int N, srccol; const float* gain; int Ksrc, k0; bf16_t* WT; int Kdst, dstrow0; const float* cmax; int had; };
__device__ __forceinline__ unsigned pk4_i8(float a, float b, float c, float d) {
    const float M = 12582912.0f;
    const unsigned ab = __builtin_amdgcn_perm(__float_as_uint(b + M), __float_as_uint(a + M), 0x0c0c0400u), cd = __builtin_amdgcn_perm(__float_as_uint(d + M), __float_as_uint(c + M), 0x0c0c0400u);
    return __builtin_amdgcn_perm(cd, ab, 0x05040100u);
}
typedef unsigned short u16x2 __attribute__((ext_vector_type(2)));
__device__ __forceinline__ unsigned pkmax(unsigned a, unsigned b) { return __builtin_bit_cast(unsigned, __builtin_elementwise_max(__builtin_bit_cast(u16x2, a), __builtin_bit_cast(u16x2, b))); }
__device__ __forceinline__ unsigned opq(unsigned v) { asm volatile("" : "+v"(v)); return v; }
__device__ __forceinline__ float wave_max(float v) {
#pragma unroll
    for (int o = 1; o < 64; o <<= 1) v = fmaxf(v, __shfl_xor(v, o));
    return v;
}
__device__ __forceinline__ void fwht8_32(float (&v)[8], int lane) {
    f32x2 a = {v[0], v[1]}, b = {v[2], v[3]}, c = {v[4], v[5]}, d = {v[6], v[7]}, t;
    t = a + c; c = a - c; a = t; t = b + d; d = b - d; b = t;
    t = a + b; b = a - b; a = t; t = c + d; d = c - d; c = t;
    a = (f32x2){a[0] + a[1], a[0] - a[1]}; b = (f32x2){b[0] + b[1], b[0] - b[1]}; c = (f32x2){c[0] + c[1], c[0] - c[1]}; d = (f32x2){d[0] + d[1], d[0] - d[1]};
    const float s1 = (lane & 1) ? -1.f : 1.f, s2 = (lane & 2) ? -1.f : 1.f;
#define FW_X(x, ctrl) __int_as_float(__builtin_amdgcn_update_dpp(0, __float_as_int(x), ctrl, 0xf, 0xf, true))
#define FW_ST(p, sg, ctrl) do { const f32x2 q_ = {FW_X(p[0], ctrl), FW_X(p[1], ctrl)}; p = p * (f32x2){sg, sg} + q_; } while (0)
    FW_ST(a, s1, 0xB1); FW_ST(b, s1, 0xB1); FW_ST(c, s1, 0xB1); FW_ST(d, s1, 0xB1);
    FW_ST(a, s2, 0x4E); FW_ST(b, s2, 0x4E); FW_ST(c, s2, 0x4E); FW_ST(d, s2, 0x4E);
#undef FW_ST
#undef FW_X
    v[0] = a[0]; v[1] = a[1]; v[2] = b[0]; v[3] = b[1]; v[4] = c[0]; v[5] = c[1]; v[6] = d[0]; v[7] = d[1];
}
__device__ __forceinline__ void cvt_load(const CvtDesc& d, f32x4 (&v)[16], int lane) {
    const int kq = lane >> 4;
#pragma unroll
    for (int i = 0; i < 16; ++i) { const int k = d.k0 + 4 * i + kq;
        v[i] = (d.srccol >= 0 && k < d.Ksrc) ? __builtin_nontemporal_load((const f32x4*)(d.W + (size_t)k * d.N + d.srccol)) : (f32x4){0.f, 0.f, 0.f, 0.f}; }
}
__device__ __forceinline__ void cvt_finish(const CvtDesc& d, f32x4 (&v)[16], LAS float* scr, int lane) {
    const int l16 = lane & 15, kq = lane >> 4;
    if (d.gain) {
#pragma unroll
        for (int i = 0; i < 16; ++i) { const int k = d.k0 + 4 * i + kq; if (k < d.Ksrc) v[i] = v[i] * d.gain[k]; } }
#pragma unroll
    for (int i = 0; i < 16; ++i) { LAS float* q = scr + (4 * i + kq) * 65 + 4 * l16; q[0] = v[i][0]; q[1] = v[i][1]; q[2] = v[i][2]; q[3] = v[i][3]; }
    LDS_WAIT(); asm volatile("" ::: "memory");
    const int c = lane & 7, nr = lane >> 3;
    if (d.cmax) {
#pragma unroll
        for (int j = 0; j < 8; ++j) { const int n = nr + 8 * j; const LAS float* t = scr + (8 * c) * 65 + n;
            const float cm = d.cmax[d.dstrow0 + n], inv = cm > 0.f ? 127.0f * __builtin_amdgcn_rcpf(cm) : 0.f;
            float v[8];
#pragma unroll
            for (int i = 0; i < 8; ++i) v[i] = t[i * 65];
            if (d.had) fwht8_32(v, lane);
            u32x2 o; o.x = pk4_i8(v[0] * inv, v[1] * inv, v[2] * inv, v[3] * inv); o.y = pk4_i8(v[4] * inv, v[5] * inv, v[6] * inv, v[7] * inv);
            __builtin_nontemporal_store(o, (u32x2*)((unsigned char*)d.WT + (size_t)(d.dstrow0 + n) * d.Kdst + d.k0 + 8 * c)); }
        LDS_WAIT(); asm volatile("" ::: "memory");
        return;
    }
    if (d.had) {
#pragma unroll
        for (int j = 0; j < 8; ++j) { const int n = nr + 8 * j; const LAS float* t = scr + (8 * c) * 65 + n;
            float v[8];
#pragma unroll
            for (int i = 0; i < 8; ++i) v[i] = t[i * 65];
            fwht8_32(v, lane);
            u32x4 o; o.x = cvt_pk_bf16(v[0] * 0.03125f, v[1] * 0.03125f); o.y = cvt_pk_bf16(v[2] * 0.03125f, v[3] * 0.03125f); o.z = cvt_pk_bf16(v[4] * 0.03125f, v[5] * 0.03125f); o.w = cvt_pk_bf16(v[6] * 0.03125f, v[7] * 0.03125f);
            __builtin_nontemporal_store(o, (u32x4*)(d.WT + (size_t)(d.dstrow0 + n) * d.Kdst + d.k0 + 8 * c)); }
        LDS_WAIT(); asm volatile("" ::: "memory");
        return;
    }
#pragma unroll
    for (int j = 0; j < 8; ++j) { const int n = nr + 8 * j; const LAS float* t = scr + (8 * c) * 65 + n;
        u32x4 o; o.x = cvt_pk_bf16(t[0 * 65], t[1 * 65]); o.y = cvt_pk_bf16(t[2 * 65], t[3 * 65]); o.z = cvt_pk_bf16(t[4 * 65], t[5 * 65]); o.w = cvt_pk_bf16(t[6 * 65], t[7 * 65]);
        __builtin_nontemporal_store(o, (u32x4*)(d.WT + (size_t)(d.dstrow0 + n) * d.Kdst + d.k0 + 8 * c)); }
    LDS_WAIT(); asm volatile("" ::: "memory");
}
constexpr int I_EVIN = 64 * (EV_N / 64), I_UQ = (QRANK / 64) * (UQ_N / 64), I_UKV = (KVK / 64) * (UKV_N / 64), I_SQ = 64 * (DM / 64), I_ODIN = 64 * (OD_N / 64);
constexpr int I_PAIR = I_EVIN + I_UQ + I_UKV + I_SQ + I_ODIN + I_SQ;
constexpr int I_GU = 64 * (GU_N / 64), I_DN = (DFF / 64) * (DM / 64), I_FFN = I_GU + I_DN;
constexpr int N_CVT_ITEMS = 2 * I_PAIR + DEPTH * I_FFN;

__device__ __forceinline__ CvtDesc cvt_describe(const Args& A, unsigned char* ws, int it, int lane) {
    const int l4 = 4 * (lane & 15);
    const float* ng = A.in[IN_NORMG];
    if (it < 2 * I_PAIR) {
        const int e = it / I_PAIR; int r = it - e * I_PAIR;
        if (r < I_EVIN) { const int nblk = EV_N / 64, kb = r / nblk, nb = r - kb * nblk, n = nb * 64 + l4;
            int sc;
            if (n < EV_CQ) sc = n; else if (n < EV_KR) sc = n + 16; else if (n < EV_FL) sc = 7376 + ropeperm(n - EV_KR); else if (n < EV_FL + 16) sc = 6144 + (n - EV_FL); else sc = -1;
            return CvtDesc{A.in[IN_EVWIN] + (size_t)e * DM * EV_SRC_N, EV_SRC_N, sc, ng + (size_t)(2 * e * 4 + 0) * DM, DM, kb * 64, (bf16_t*)(ws + W_EVIN + e * SZ_EVIN), LD_DM, nb * 64}; }
        r -= I_EVIN;
        if (r < I_UQ) { const int nblk = UQ_N / 64, kb = r / nblk, nb = r - kb * nblk, n = nb * 64 + l4;
            int sc; if (n < 2048) sc = (n >> 7) * 192 + (n & 127); else { const int j2 = n - 2048; sc = (j2 >> 6) * 192 + 128 + ropeperm(j2 & 63); }
            return CvtDesc{A.in[IN_EVWUQ] + (size_t)e * QRANK * UQ_N, UQ_N, sc, A.in[IN_EVQN] + e * QRANK, QRANK, kb * 64, (bf16_t*)(ws + W_UQ + e * SZ_UQ), LD_QR, nb * 64}; }
        r -= I_UQ;
        if (r < I_UKV) { const int nblk = UKV_N / 64, kb = r / nblk, nb = r - kb * nblk, n = nb * 64 + l4;
            int sc; if (n < 2048) sc = (n >> 7) * 256 + (n & 127); else { const int n2 = n - 2048; sc = (n2 >> 7) * 256 + 128 + (n2 & 127); }
            return CvtDesc{A.in[IN_EVWUKV] + (size_t)e * KVRANK * UKV_N, UKV_N, sc, A.in[IN_EVKVN] + e * KVRANK, KVRANK, kb * 64, (bf16_t*)(ws + W_UKV + e * SZ_UKV), LD_KV, nb * 64}; }
        r -= I_UKV;
        if (r < I_SQ) { const int nblk = DM / 64, kb = r / nblk, nb = r - kb * nblk;
            return CvtDesc{A.in[IN_EVWOUT] + (size_t)e * DM * DM, DM, nb * 64 + l4, nullptr, DM, kb * 64, (bf16_t*)(ws + W_EVOUT + e * SZ_SQ), LD_DM, nb * 64}; }
        r -= I_SQ;
        if (r < I_ODIN) { const int nblk = OD_N / 64, kb = r / nblk, nb = r - kb * nblk;
            return CvtDesc{A.in[IN_ODWIN] + (size_t)e * DM * OD_N, OD_N, nb * 64 + l4, ng + (size_t)((2 * e + 1) * 4 + 0) * DM, DM, kb * 64, (bf16_t*)(ws + W_ODIN + e * SZ_ODIN), LD_DM, nb * 64}; }
        r -= I_ODIN;
        { const int nblk = DM / 64, kb = r / nblk, nb = r - kb * nblk;
            return CvtDesc{A.in[IN_ODWOUT] + (size_t)e * DM * DM, DM, nb * 64 + l4, nullptr, DM, kb * 64, (bf16_t*)(ws + W_ODOUT + e * SZ_SQ), LD_DM, nb * 64}; }
    }
    it -= 2 * I_PAIR;
    const int L = it / I_FFN; int r = it - L * I_FFN;
    if (r < I_GU) { const int nblk = GU_N / 64, kb = r / nblk, nb = r - kb * nblk, n0 = nb * 64, tile = n0 >> 8, w = n0 & 255;
        const float* src = (w < 128 ? A.in[IN_WGATE] : A.in[IN_WUP]) + (size_t)L * DM * DFF;
        return CvtDesc{src, DFF, tile * 128 + (w & 127) + l4, ng + (size_t)(L * 4 + 2) * DM, DM, kb * 64, (bf16_t*)(ws + W_GU + L * SZ_GU), LD8, n0, (const float*)(ws + WS_CTL + CTL_COLMAX) + (size_t)L * GU_N}; }
    r -= I_GU;
    { const int nblk = DM / 64, kb = r / nblk, nb = r - kb * nblk;
        return CvtDesc{A.in[IN_WDOWN] + (size_t)L * DFF * DM, DM, nb * 64 + l4, nullptr, DFF, kb * 64, (bf16_t*)(ws + W_DN + L * SZ_DN), LD_FF, nb * 64}; }
}

__device__ __forceinline__ int ev_srccol(int n) {
    if (n < EV_CQ) return n; if (n < EV_KR) return n + 16; if (n < EV_FL) return 7376 + ropeperm(n - EV_KR); if (n < EV_FL + 16) return 6144 + (n - EV_FL); return -1;
}
__device__ __forceinline__ void row_to_bf16(const float* xrow, bf16_t* orow, float* rstd, int lane) {
    float ss = 0.f;
#pragma unroll
    for (int j = 0; j < 8; ++j) { const f32x4 a = *(const f32x4*)(xrow + 8 * lane + 512 * j), b = *(const f32x4*)(xrow + 8 * lane + 512 * j + 4);
        ss += sq8(a, b); store8(orow + 8 * lane + 512 * j, a, b); }
    ss = wave_sum(ss);
    if (lane == 0) *rstd = rsqrtf(ss * (1.0f / DM) + EPS);
}
__device__ __forceinline__ void row_to_i8(const float* xrow, unsigned char* orow, float* rs8, int lane) {
    f32x4 a[8], b[8]; float ss = 0.f, mx = 0.f;
#pragma unroll
    for (int j = 0; j < 8; ++j) { a[j] = *(const f32x4*)(xrow + 8 * lane + 512 * j); b[j] = *(const f32x4*)(xrow + 8 * lane + 512 * j + 4);
        ss += sq8(a[j], b[j]);
        mx = fmaxf(mx, fmaxf(fmaxf(fmaxf(fabsf(a[j][0]), fabsf(a[j][1])), fmaxf(fabsf(a[j][2]), fabsf(a[j][3]))), fmaxf(fmaxf(fabsf(b[j][0]), fabsf(b[j][1])), fmaxf(fabsf(b[j][2]), fabsf(b[j][3]))))); }
    ss = wave_sum(ss); mx = wave_max(mx);
    const float inv = mx > 0.f ? 127.0f * __builtin_amdgcn_rcpf(mx) : 0.f;
#pragma unroll
    for (int j = 0; j < 8; ++j) { u32x2 q; q.x = pk4_i8(a[j][0] * inv, a[j][1] * inv, a[j][2] * inv, a[j][3] * inv); q.y = pk4_i8(b[j][0] * inv, b[j][1] * inv, b[j][2] * inv, b[j][3] * inv);
        *(u32x2*)(orow + 8 * lane + 512 * j) = q; }
    if (lane == 0) *rs8 = rsqrtf(ss * (1.0f / DM) + EPS) * mx * (1.0f / 16129.0f);
}
constexpr int N_OD8 = ((I8_IN_ODD & 1) + ((I8_IN_ODD >> 1) & 1));
constexpr int I_PAIR0 = I_PAIR - I_EVIN;
constexpr int N_EV8 = ((I8_IN_EV & 1) + ((I8_IN_EV >> 1) & 1));
constexpr int NP0 = I_PAIR - ((I8_IN_EV & 1) ? I_EVIN : 0) - ((I8_IN_ODD & 1) ? I_ODIN : 0) - ((I8_OUT & 1) ? I_SQ : 0) - ((I8_OUT & 2) ? I_SQ : 0), NP1 = I_PAIR - ((I8_IN_EV & 2) ? I_EVIN : 0) - ((I8_IN_ODD & 2) ? I_ODIN : 0) - ((I8_OUT & 4) ? I_SQ : 0) - ((I8_OUT & 8) ? I_SQ : 0);
__device__ __forceinline__ int pair_item(int r, int e) {
    if (!((I8_IN_EV >> e) & 1)) { if (r < I_EVIN) return r; r -= I_EVIN; }
    if (r < I_UQ + I_UKV) return I_EVIN + r;
    r -= I_UQ + I_UKV;
    if (!((I8_OUT >> (2 * e)) & 1)) { if (r < I_SQ) return I_EVIN + I_UQ + I_UKV + r; r -= I_SQ; }
    if (!((I8_IN_ODD >> e) & 1)) { if (r < I_ODIN) return I_EVIN + I_UQ + I_UKV + I_SQ + r; r -= I_ODIN; }
    return I_EVIN + I_UQ + I_UKV + I_SQ + I_ODIN + r;
}
constexpr int N_DN8 = (I8_DN & 1) + ((I8_DN >> 1) & 1) + ((I8_DN >> 2) & 1) + ((I8_DN >> 3) & 1);
__device__ __forceinline__ int nth_layer(int idx, int mask) {
    int L = 0;
#pragma unroll
    for (int b = 0; b < DEPTH; ++b) { if ((mask >> b) & 1) { if (idx == 0) L = b; --idx; } }
    return L;
}
template <int PH> __device__ __forceinline__ CvtDesc cvt_desc(const Args& A, unsigned char* ws, int j, int lane) {
    if constexpr (PH == 0) {
        if (j < NP0) return cvt_describe(A, ws, pair_item(j, 0), lane);
        if (j < NP0 + NP1) return cvt_describe(A, ws, I_PAIR + pair_item(j - NP0, 1), lane);
        const int q = j - NP0 - NP1, idx = q / I_DN, L = nth_layer(idx, ~I8_DN & ((1 << DEPTH) - 1)); return cvt_describe(A, ws, 2 * I_PAIR + L * I_FFN + I_GU + (q - idx * I_DN), lane); }
    else {
        const int q = j;
        const int idx = q / I_DN, r = q - idx * I_DN, L = nth_layer(idx, I8_DN), nblk = DM / 64, kb = r / nblk, nb = r - kb * nblk;
        return CvtDesc{A.in[IN_WDOWN] + (size_t)L * DFF * DM, DM, nb * 64 + 4 * (lane & 15), nullptr, DFF, kb * 64, (bf16_t*)(ws + W_DN + L * SZ_DN), LD8F, nb * 64, (const float*)(ws + WS_CTL + CTL_COLMAX_DN) + (size_t)L * DM, 1};
    }
}
template <int PH> __device__ __forceinline__ void cvt_items(const Args& A, Frame& F) {
    constexpr int NIT = PH == 0 ? NP0 + NP1 + (DEPTH - N_DN8) * I_DN : N_DN8 * I_DN;
    LAS float* scr = (LAS float*)(F.lds + F.wave * 16640);
    const int gw = F.vcu * 8 + F.wave, NGW = F.G * 8;
    unsigned char* ws = F.ws;
    f32x4 vA[16], vB[16]; CvtDesc dA{}, dB{};
    int it = gw;
    if (it < NIT) { dA = cvt_desc<PH>(A, ws, it, F.lane); cvt_load(dA, vA, F.lane); }
    for (; it < NIT; it += 2 * NGW) {
        const int it1 = it + NGW, it2 = it1 + NGW;
        if (it1 < NIT) { dB = cvt_desc<PH>(A, ws, it1, F.lane); cvt_load(dB, vB, F.lane); }
        cvt_finish(dA, vA, scr, F.lane);
        if (it2 < NIT) { dA = cvt_desc<PH>(A, ws, it2, F.lane); cvt_load(dA, vA, F.lane); }
        if (it1 < NIT) cvt_finish(dB, vB, scr, F.lane);
    }
}
__device__ __forceinline__ int ropeperm_inv(int d) { return d < 32 ? 8 * (d >> 2) + (d & 3) : 8 * ((d - 32) >> 2) + 4 + ((d - 32) & 3); }
__device__ __forceinline__ int ev_dstcol(int sc) { if (sc < 6144) return sc; if (sc < 6160) return EV_FL + (sc - 6144); if (sc < 7376) return sc - 16; return EV_KR + ropeperm_inv(sc - 7376); }
constexpr int NS_GU = DFF / 32, NS_OD = OD_N / 32, NS_EV = (EV_SRC_N + 31) / 32, NS_OUT = DM / 32, N_STRIPS = DEPTH * 2 * NS_GU + N_OD8 * NS_OD + N_EV8 * NS_EV + N_OUT8 * NS_OUT, STRIP_SLOTS = 135168;
__device__ __forceinline__ void strip_phase(const Args& A, Frame& F) {
    LAS unsigned char* lds = F.lds; unsigned char* ws = F.ws; const int tid = F.tid;
    int par = 0;
    for (int s = F.vcu; s < N_STRIPS; s += F.G, par ^= 1) {
        LAS unsigned* slots = (LAS unsigned*)(lds + STRIP_SLOTS) + 32 * par;
        const float* src; const float* gain; unsigned char* dst; float* cmx; int N, c0, kind, rbase = 0;
        if (s < DEPTH * 2 * NS_GU) { const int mi = s / NS_GU, cb = s - mi * NS_GU, L = mi >> 1, up = mi & 1; kind = 0; N = DFF; c0 = cb * 32;
            src = (up ? A.in[IN_WUP] : A.in[IN_WGATE]) + (size_t)L * DM * DFF; gain = A.in[IN_NORMG] + (size_t)(L * 4 + 2) * DM;
            dst = ws + W_GU + (size_t)L * SZ_GU; cmx = (float*)(ws + WS_CTL + CTL_COLMAX) + (size_t)L * GU_N; rbase = (c0 >> 7) * 256 + up * 128 + (c0 & 127); }
        else if (s < DEPTH * 2 * NS_GU + N_OD8 * NS_OD) { const int q = s - DEPTH * 2 * NS_GU, idx = q / NS_OD, cb = q - idx * NS_OD, e = (I8_IN_ODD & 1) ? idx : 1; kind = 1; N = OD_N; c0 = cb * 32;
            src = A.in[IN_ODWIN] + (size_t)e * DM * OD_N; gain = A.in[IN_NORMG] + (size_t)((2 * e + 1) * 4 + 0) * DM;
            dst = ws + W_GU + (size_t)(2 * e + 1) * SZ_GU + W_OD8_OFF; cmx = (float*)(ws + WS_CTL + CTL_COLMAX_OD) + (size_t)e * OD_N; rbase = c0; }
        else if (s >= DEPTH * 2 * NS_GU + N_OD8 * NS_OD + N_EV8 * NS_EV) { const int q = s - (DEPTH * 2 * NS_GU + N_OD8 * NS_OD + N_EV8 * NS_EV), idx = q / NS_OUT, cb = q - idx * NS_OUT, L = nth_layer(idx, I8_OUT), e = L >> 1; kind = 1; N = DM; c0 = cb * 32;
            src = ((L & 1) ? A.in[IN_ODWOUT] : A.in[IN_EVWOUT]) + (size_t)e * DM * DM; gain = nullptr;
            dst = ws + ((L & 1) ? W_ODOUT : W_EVOUT) + (size_t)e * SZ_SQ; cmx = (float*)(ws + WS_CTL + CTL_COLMAX_OUT) + (size_t)L * DM; rbase = c0; }
        else { const int q = s - DEPTH * 2 * NS_GU - N_OD8 * NS_OD, idx = q / NS_EV, cb = q - idx * NS_EV, e = (I8_IN_EV & 1) ? idx : 1; kind = 2; N = EV_SRC_N; c0 = cb * 32 + 32 <= EV_SRC_N ? cb * 32 : EV_SRC_N - 32;
            src = A.in[IN_EVWIN] + (size_t)e * DM * EV_SRC_N; gain = A.in[IN_NORMG] + (size_t)(2 * e * 4 + 0) * DM;
            dst = ws + W_EVIN + (size_t)e * SZ_EVIN; cmx = (float*)(ws + WS_CTL + CTL_COLMAX_EV) + (size_t)e * EV_N; }
        if (tid < 32) slots[tid] = 0u;
        __syncthreads();
        const int cg = tid & 7;
        unsigned m0 = 0u, m1 = 0u;
        {
            const float* sp = src + (size_t)(tid >> 3) * N + c0 + 4 * cg;
#pragma unroll 1
            for (int h = 0; h < 2; ++h) {
                f32x4 v[16];
#pragma unroll
                for (int i = 0; i < 16; ++i) v[i] = __builtin_nontemporal_load((const f32x4*)(sp + (size_t)(64 * (16 * h + i)) * N));
#pragma unroll
                for (int i = 0; i < 16; ++i) { const int k = (tid >> 3) + 64 * (16 * h + i); const float g = gain ? gain[k] : 1.0f;
                    u32x2 w; w.x = cvt_pk_bf16(v[i][0] * g, v[i][1] * g); w.y = cvt_pk_bf16(v[i][2] * g, v[i][3] * g);
                    m0 = pkmax(m0, w.x & 0x7fff7fffu); m1 = pkmax(m1, w.y & 0x7fff7fffu);
                    *(LAS u32x2*)(lds + (k >> 2) * 264 + (k & 3) * 64 + cg * 8) = w; }
            }
        }
        u32x2 rg[4][8];
        {   const float* sp = src + (size_t)(2048 + 8 * (tid >> 3)) * N + c0 + 4 * cg;
#pragma unroll
            for (int jj = 0; jj < 2; ++jj) {
                f32x4 v[16];
#pragma unroll
                for (int i = 0; i < 16; ++i) v[i] = __builtin_nontemporal_load((const f32x4*)(sp + (size_t)(512 * (2 * jj + (i >> 3)) + (i & 7)) * N));
#pragma unroll
                for (int i = 0; i < 16; ++i) { const int k = 2048 + 8 * (tid >> 3) + 512 * (2 * jj + (i >> 3)) + (i & 7); const float g = gain ? gain[k] : 1.0f;
                    u32x2 w; w.x = cvt_pk_bf16(v[i][0] * g, v[i][1] * g); w.y = cvt_pk_bf16(v[i][2] * g, v[i][3] * g);
                    m0 = pkmax(m0, w.x & 0x7fff7fffu); m1 = pkmax(m1, w.y & 0x7fff7fffu);
                    rg[2 * jj + (i >> 3)][i & 7] = w; }
            }
        }
        atomicMax((unsigned*)(slots + 4 * cg + 0), m0 << 16); atomicMax((unsigned*)(slots + 4 * cg + 1), m0 & 0xffff0000u);
        atomicMax((unsigned*)(slots + 4 * cg + 2), m1 << 16); atomicMax((unsigned*)(slots + 4 * cg + 3), m1 & 0xffff0000u);
        __syncthreads();
        {
            const int ch = tid >> 1, hf = tid & 1;
            u32x2 w[8][4];
#pragma unroll
            for (int r = 0; r < 8; ++r) { const LAS u32x2* cp = (const LAS u32x2*)(lds + (2 * ch + (r >> 2)) * 264 + (r & 3) * 64 + hf * 32);
#pragma unroll
                for (int j = 0; j < 4; ++j) w[r][j] = cp[j]; }
#pragma unroll
            for (int n = 0; n < 16; ++n) {
                const float cm = __uint_as_float(slots[16 * hf + n]), inv = cm > 0.f ? 127.0f * __builtin_amdgcn_rcpf(cm) : 0.f;
                float x[8];
#pragma unroll
                for (int r = 0; r < 8; ++r) { const unsigned word = (n & 2) ? w[r][n >> 2].y : w[r][n >> 2].x; x[r] = ((n & 1) ? bf_hi(word) : bf_lo(word)) * inv; }
                u32x2 q; q.x = pk4_i8(x[0], x[1], x[2], x[3]); q.y = pk4_i8(x[4], x[5], x[6], x[7]);
                const int col = 16 * hf + n, drow = kind == 2 ? ev_dstcol(c0 + col) : rbase + col;
                __builtin_nontemporal_store(q, (u32x2*)(dst + (size_t)drow * LD8 + 8 * ch));
            }
        }
        {
#pragma unroll
            for (int c = 0; c < 4; ++c) {
                const float cm = __uint_as_float(slots[4 * cg + c]), inv = cm > 0.f ? 127.0f * __builtin_amdgcn_rcpf(cm) : 0.f;
                const int col = 4 * cg + c, drow = kind == 2 ? ev_dstcol(c0 + col) : rbase + col;
#pragma unroll
                for (int j = 0; j < 4; ++j) {
                    float x[8];
#pragma unroll
                    for (int r = 0; r < 8; ++r) { const unsigned word = (c & 2) ? rg[j][r].y : rg[j][r].x; x[r] = ((c & 1) ? bf_hi(word) : bf_lo(word)) * inv; }
                    u32x2 q; q.x = pk4_i8(x[0], x[1], x[2], x[3]); q.y = pk4_i8(x[4], x[5], x[6], x[7]);
                    __builtin_nontemporal_store(q, (u32x2*)(dst + (size_t)drow * LD8 + 2048 + 8 * ((tid >> 3) + 64 * j)));
                }
            }
        }
        if (tid < 32) { const int drow = kind == 2 ? ev_dstcol(c0 + tid) : rbase + tid; cmx[drow] = __uint_as_float(slots[tid]); }
    }
    __syncthreads();
    { const int gw = F.vcu * 8 + F.wave, NGW = F.G * 8;
      for (int r = gw; r < N_EV8 * (EV_N - EV_SRC_N); r += NGW) { const int idx = r / (EV_N - EV_SRC_N), row = EV_SRC_N + (r - idx * (EV_N - EV_SRC_N)), e = (I8_IN_EV & 1) ? idx : 1;
          unsigned char* d = ws + W_EVIN + (size_t)e * SZ_EVIN + (size_t)row * LD8; const u32x4 z = {0u, 0u, 0u, 0u};
#pragma unroll
          for (int j = 0; j < 4; ++j) *(u32x4*)(d + 16 * F.lane + 1024 * j) = z; } }
}
__device__ __forceinline__ void colmax_dn_pass(const Args& A, Frame& F) {
    const int gw = F.vcu * 8 + F.wave, NGW = F.G * 8, lane = F.lane;
    constexpr int NKC = DFF / 256, NCB = DM / 256;
    for (int item = gw; item < N_DN8 * NKC * NCB; item += NGW) {
        const int cb = item % NCB, q = item / NCB, kc = q % NKC, L = nth_layer(q / NKC, I8_DN);
        const float* src = A.in[IN_WDOWN] + (size_t)L * DFF * DM + (size_t)(kc * 256) * DM + cb * 256 + 4 * lane;
        f32x4 mx = {0.f, 0.f, 0.f, 0.f};
#pragma unroll 1
        for (int g = 0; g < 8; ++g) {
            f32x4 w[32];
#pragma unroll
            for (int i = 0; i < 32; ++i) w[i] = __builtin_nontemporal_load((const f32x4*)(src + (size_t)(g * 32 + i) * DM));
#pragma unroll
            for (int h = 1; h < 32; h <<= 1)
#pragma unroll
                for (int i = 0; i < 32; ++i) if (!(i & h)) { const f32x4 x = w[i], y = w[i | h]; w[i] = x + y; w[i | h] = x - y; }
#pragma unroll
            for (int i = 0; i < 32; ++i) { mx[0] = fmaxf(mx[0], fabsf(w[i][0])); mx[1] = fmaxf(mx[1], fabsf(w[i][1])); mx[2] = fmaxf(mx[2], fabsf(w[i][2])); mx[3] = fmaxf(mx[3], fabsf(w[i][3])); }
        }
        unsigned* dstp = (unsigned*)(F.ws + WS_CTL + CTL_COLMAX_DN) + (size_t)L * DM + cb * 256 + 4 * lane;
#pragma unroll
        for (int e = 0; e < 4; ++e) atomicMax(dstp + e, __float_as_uint(mx[e]));
    }
}
__device__ __forceinline__ void actq_load(u32x4 (&w)[22], const bf16_t* act, int row, int lane) {
    const char* src = (const char*)(act + (size_t)row * LD_FF);
#pragma unroll
    for (int j = 0; j < 22; ++j) { w[j] = (u32x4){0u, 0u, 0u, 0u}; if (8 * lane + 512 * j < DFF) w[j] = __builtin_nontemporal_load((const u32x4*)(src + 16 * lane + 1024 * j)); }
}
__device__ __forceinline__ void actq_row(u32x4 (&w)[22], unsigned char* act8, float* rsd, int row, int lane) {
    unsigned char* dst = act8 + (size_t)row * LD8F;
    unsigned amx2 = 0u;
#pragma unroll
    for (int j = 0; j < 22; ++j) {
        float v[8] = {bf_lo(w[j].x), bf_hi(w[j].x), bf_lo(w[j].y), bf_hi(w[j].y), bf_lo(w[j].z), bf_hi(w[j].z), bf_lo(w[j].w), bf_hi(w[j].w)};
        fwht8_32(v, lane);
        w[j].x = cvt_pk_bf16(v[0], v[1]); w[j].y = cvt_pk_bf16(v[2], v[3]); w[j].z = cvt_pk_bf16(v[4], v[5]); w[j].w = cvt_pk_bf16(v[6], v[7]);
        amx2 = pkmax(pkmax(amx2, w[j].x & 0x7fff7fffu), pkmax(w[j].y & 0x7fff7fffu, pkmax(w[j].z & 0x7fff7fffu, w[j].w & 0x7fff7fffu)));
    }
    const float m = wave_max(fmaxf(bf_lo(amx2), bf_hi(amx2)));
    const float inv = m > 0.f ? 127.0f * __builtin_amdgcn_rcpf(m) : 0.f;
#pragma unroll
    for (int j = 0; j < 22; ++j) { if (8 * lane + 512 * j < DFF) { u32x2 q;
        q.x = pk4_i8(bf_lo(w[j].x) * inv, bf_hi(w[j].x) * inv, bf_lo(w[j].y) * inv, bf_hi(w[j].y) * inv); q.y = pk4_i8(bf_lo(w[j].z) * inv, bf_hi(w[j].z) * inv, bf_lo(w[j].w) * inv, bf_hi(w[j].w) * inv);
        *(u32x2*)(dst + 8 * lane + 512 * j) = q; } }
    if (lane == 0) rsd[row] = m * (1.0f / (16129.0f * 32.0f));
}
__device__ __forceinline__ void actq_phase(Frame& F) {
    unsigned char* ws = F.ws;
    const int gw = F.vcu * 8 + F.wave, NGW = F.G * 8, lane = F.lane;
    const bf16_t* act = (const bf16_t*)(ws + WS_PROJ); unsigned char* act8 = ws + WS_ACT8; float* rsd = (float*)(ws + WS_RSD);
    u32x4 wA[22], wB[22];
    int row = gw;
    if (row < MPAD) actq_load(wA, act, row, lane);
    for (; row < MPAD; row += 2 * NGW) {
        const int r1 = row + NGW, r2 = r1 + NGW;
        if (r1 < MPAD) actq_load(wB, act, r1, lane);
        actq_row(wA, act8, rsd, row, lane);
        if (r2 < MPAD) actq_load(wA, act, r2, lane);
        if (r1 < MPAD) actq_row(wB, act8, rsd, r1, lane);
    }
}
__device__ __forceinline__ void oq_phase(Frame& F) {
    unsigned char* ws = F.ws;
    const int gw = F.vcu * 8 + F.wave, NGW = F.G * 8, lane = F.lane;
    const bf16_t* obuf = (const bf16_t*)(ws + WS_OBUF); unsigned char* a8 = ws + WS_A8; float* rs8 = (float*)(ws + WS_RS8);
    for (int row = gw; row < MPAD; row += NGW) {
        unsigned char* dst = a8 + (size_t)row * LD8;
        if (row >= MUSED) { const u32x4 z = {0u, 0u, 0u, 0u};
#pragma unroll
            for (int j = 0; j < 4; ++j) *(u32x4*)(dst + 16 * lane + 1024 * j) = z;
            if (lane == 0) rs8[row] = 0.f;
            continue; }
        const char* src = (const char*)(obuf + (size_t)row * LD_DM);
        u32x4 w[8]; unsigned amx2 = 0u;
#pragma unroll
        for (int j = 0; j < 8; ++j) w[j] = __builtin_nontemporal_load((const u32x4*)(src + 16 * lane + 1024 * j));
#pragma unroll
        for (int j = 0; j < 8; ++j) amx2 = pkmax(pkmax(amx2, w[j].x & 0x7fff7fffu), pkmax(w[j].y & 0x7fff7fffu, pkmax(w[j].z & 0x7fff7fffu, w[j].w & 0x7fff7fffu)));
        const float m = wave_max(fmaxf(bf_lo(amx2), bf_hi(amx2)));
        const float inv = m > 0.f ? 127.0f * __builtin_amdgcn_rcpf(m) : 0.f;
#pragma unroll
        for (int j = 0; j < 8; ++j) { u32x2 q;
            q.x = pk4_i8(bf_lo(w[j].x) * inv, bf_hi(w[j].x) * inv, bf_lo(w[j].y) * inv, bf_hi(w[j].y) * inv); q.y = pk4_i8(bf_lo(w[j].z) * inv, bf_hi(w[j].z) * inv, bf_lo(w[j].w) * inv, bf_hi(w[j].w) * inv);
            *(u32x2*)(dst + 8 * lane + 512 * j) = q; }
        if (lane == 0) rs8[row] = m * (1.0f / 16129.0f);
    }
}
__device__ __forceinline__ void p0_prologue(const Args& A, Frame& F) {
    const int gw = F.vcu * 8 + F.wave, NGW = F.G * 8;
    unsigned char* ws = F.ws;
    strip_phase(A, F);
    colmax_dn_pass(A, F);
    cvt_items<0>(A, F);
    { float* cosT = (float*)(ws + WS_COS); float* sinT = (float*)(ws + WS_SIN);
      for (int idx = gw * 64 + F.lane; idx < NPOS * 32; idx += NGW * 64) { const int pos = idx >> 5, i = idx & 31;
          const float inv = powf(10000.0f, -(float)i * (1.0f / 32.0f)); const float ang = (float)pos * inv;
          cosT[idx] = cosf(ang); sinT[idx] = sinf(ang); } }
    if (gw == 0) { float* prm = (float*)(ws + WS_PRM);
        for (int o = 0; o < 2; ++o) { const float* l = A.in[IN_ODLAM] + o * 4 * 128;
            const float s01 = wave_sum(l[F.lane] * l[128 + F.lane] + l[64 + F.lane] * l[192 + F.lane]);
            const float s23 = wave_sum(l[256 + F.lane] * l[384 + F.lane] + l[320 + F.lane] * l[448 + F.lane]);
            if (F.lane == 0) prm[o] = expf(s01) - expf(s23) + A.lam_init[o]; } }
    bf16_t* hbf = (bf16_t*)(ws + WS_HBF); float* rstd = (float*)(ws + WS_RSTD); unsigned char* a8 = ws + WS_OBUF; float* rs8 = (float*)(ws + WS_RS8);
    for (int row = gw; row < MPAD; row += NGW) {
        if (row < MUSED) { const float* src = row < MREAL ? A.in[IN_X] + (size_t)row * DM : A.in[IN_META] + (size_t)(row - MREAL) * DM;
            if constexpr (I8_IN_EV & 1) row_to_i8(src, a8 + (size_t)row * LD8, rs8 + row, F.lane); else row_to_bf16(src, hbf + (size_t)row * LD_DM, rstd + row, F.lane); }
        else { const u32x4 z = {0u, 0u, 0u, 0u};
#pragma unroll
            for (int j = 0; j < 8; ++j) *(u32x4*)(hbf + (size_t)row * LD_DM + 8 * F.lane + 512 * j) = z;
#pragma unroll
            for (int j = 0; j < 4; ++j) *(u32x4*)(a8 + (size_t)row * LD8 + 16 * F.lane + 1024 * j) = z;
            if (F.lane == 0) { rstd[row] = 0.f; rs8[row] = 0.f; } }
    }
}

__device__ __forceinline__ void ew_phase(const Args& A, Frame& F, int layer, int which) {
    unsigned char* ws = F.ws;
    const int gw = F.vcu * 8 + F.wave, NGW = F.G * 8, lane = F.lane;
    const float* gpost = A.in[IN_NORMG] + (size_t)(layer * 4 + (which ? 3 : 1)) * DM;
    const bool first = (layer == 0 && which == 0), last = (layer == DEPTH - 1 && which == 1);
    const bf16_t* mbuf = (const bf16_t*)(ws + WS_MBUF); bf16_t* hbf = (bf16_t*)(ws + WS_HBF);
    float* rstd = (float*)(ws + WS_RSTD); const float* statm = (const float*)(ws + WS_STATM);
    const bool q8 = (which == 0) || (layer + 1 < DEPTH && (((((layer + 1) & 1) ? I8_IN_ODD : I8_IN_EV) >> ((layer + 1) >> 1)) & 1));
    unsigned char* a8 = ws + (which == 0 ? WS_A8 : WS_OBUF); float* rs8 = (float*)(ws + WS_RS8);
    if (q8) {
        for (int row = MUSED + gw; row < MPAD; row += NGW) { const u32x4 z = {0u, 0u, 0u, 0u};
#pragma unroll
            for (int j = 0; j < 4; ++j) *(u32x4*)(a8 + (size_t)row * LD8 + 16 * lane + 1024 * j) = z;
            if (lane == 0) rs8[row] = 0.f; }
    }
    if (F.vcu < NMETA && !last) {
        const int r = F.vcu, row = MREAL + r, nS = which ? (DFF / 256) : (DM / 256), c0 = F.wave * 512 + 8 * lane;
        const float* part = (const float*)(ws + WS_PART) + (size_t)r * DM + c0;
        LAS float* red = (LAS float*)F.lds;
        f32x4 ma = {0.f, 0.f, 0.f, 0.f}, mb = {0.f, 0.f, 0.f, 0.f};
        if (!which && ((I8_OUT >> layer) & 1)) {
            i32x4 ia = {0, 0, 0, 0}, ib = {0, 0, 0, 0};
#pragma unroll 16
            for (int ks = 0; ks < DM / 256; ++ks) { ia += *(const i32x4*)(part + (size_t)ks * 16 * DM); ib += *(const i32x4*)(part + (size_t)ks * 16 * DM + 4); }
            const float* cs = (const float*)(ws + WS_CTL + CTL_COLMAX_OUT) + (size_t)layer * DM + c0; const float rsc = ((const float*)(ws + WS_RS8))[row];
            ma = __builtin_convertvector(ia, f32x4) * (*(const f32x4*)cs * rsc); mb = __builtin_convertvector(ib, f32x4) * (*(const f32x4*)(cs + 4) * rsc);
        } else if (which && ((I8_DN >> layer) & 1)) {
            i32x4 ia = {0, 0, 0, 0}, ib = {0, 0, 0, 0};
#pragma unroll 16
            for (int ks = 0; ks < DFF / 256; ++ks) { ia += *(const i32x4*)(part + (size_t)ks * 16 * DM); ib += *(const i32x4*)(part + (size_t)ks * 16 * DM + 4); }
            const float* cs = (const float*)(ws + WS_CTL + CTL_COLMAX_DN) + (size_t)layer * DM + c0; const float rsc = ((const float*)(ws + WS_RSD))[row];
            ma = __builtin_convertvector(ia, f32x4) * (*(const f32x4*)cs * rsc); mb = __builtin_convertvector(ib, f32x4) * (*(const f32x4*)(cs + 4) * rsc);
        } else {
#pragma unroll 16
        for (int ks = 0; ks < nS; ++ks) { ma += *(const f32x4*)(part + (size_t)ks * 16 * DM); mb += *(const f32x4*)(part + (size_t)ks * 16 * DM + 4); }
        }
        const float s1 = wave_sum(sq8(ma, mb));
        if (lane == 0) red[F.wave] = s1;
        __syncthreads();
        const float rm = __builtin_amdgcn_rsqf((((red[0] + red[1]) + (red[2] + red[3])) + ((red[4] + red[5]) + (red[6] + red[7]))) * (1.0f / DM) + EPS);
        f32x4 ha, hb;
        if (first) { ha = *(const f32x4*)(A.in[IN_META] + (size_t)r * DM + c0); hb = *(const f32x4*)(A.in[IN_META] + (size_t)r * DM + c0 + 4); }
        else { const u32x4 wh = *(const u32x4*)(hbf + (size_t)row * LD_DM + c0);
            ha = (f32x4){bf_lo(wh.x), bf_hi(wh.x), bf_lo(wh.y), bf_hi(wh.y)}; hb = (f32x4){bf_lo(wh.z), bf_hi(wh.z), bf_lo(wh.w), bf_hi(wh.w)}; }
        const f32x4 ga = *(const f32x4*)(gpost + c0), gb = *(const f32x4*)(gpost + c0 + 4);
        ha = ha + ma * rm * ga; hb = hb + mb * rm * gb;
        const float s2 = wave_sum(sq8(ha, hb));
        const float mxw = wave_max(fmaxf(fmaxf(fmaxf(fabsf(ha[0]), fabsf(ha[1])), fmaxf(fabsf(ha[2]), fabsf(ha[3]))), fmaxf(fmaxf(fabsf(hb[0]), fabsf(hb[1])), fmaxf(fabsf(hb[2]), fabsf(hb[3])))));
        if (lane == 0) { red[8 + F.wave] = s2; red[16 + F.wave] = mxw; }
        __syncthreads();
        store8(hbf + (size_t)row * LD_DM + c0, ha, hb);
        const float amx = fmaxf(fmaxf(fmaxf(red[16], red[17]), fmaxf(red[18], red[19])), fmaxf(fmaxf(red[20], red[21]), fmaxf(red[22], red[23])));
        if (q8) { const float inv = amx > 0.f ? 127.0f * __builtin_amdgcn_rcpf(amx) : 0.f;
            u32x2 q; q.x = pk4_i8(ha[0] * inv, ha[1] * inv, ha[2] * inv, ha[3] * inv); q.y = pk4_i8(hb[0] * inv, hb[1] * inv, hb[2] * inv, hb[3] * inv); *(u32x2*)(a8 + (size_t)row * LD8 + c0) = q; }
        if (F.tid == 0) { const float rr = __builtin_amdgcn_rsqf((((red[8] + red[9]) + (red[10] + red[11])) + ((red[12] + red[13]) + (red[14] + red[15]))) * (1.0f / DM) + EPS);
            rstd[row] = rr; if (q8) rs8[row] = rr * amx * (1.0f / 16129.0f); }
        __syncthreads();
    }
    u32x4 mv[8], ha[8], hb[8]; float sq = 0.f;
    unsigned v16 = (unsigned)lane * 16u, v32 = (unsigned)lane * 32u, v8 = (unsigned)lane * 8u;
    asm volatile("" : "+v"(v16), "+v"(v32), "+v"(v8));
    const char* const mbufc = (const char*)mbuf; const char* const hbfc = (const char*)hbf; const char* const xc = (const char*)A.in[IN_X]; const char* const gpc = (const char*)gpost;
#define EW_FETCH(j_, row_) do { mv[j_] = __builtin_nontemporal_load((const u32x4*)(mbufc + ((size_t)(row_) * (LD_DM * 2) + 1024 * (j_)) + opq(v16)));           \
        if (first) { ha[j_] = *(const u32x4*)(xc + ((size_t)(row_) * (DM * 4) + 2048 * (j_)) + opq(v32)); hb[j_] = *(const u32x4*)(xc + ((size_t)(row_) * (DM * 4) + 2048 * (j_) + 16) + opq(v32)); } \
        else { ha[j_] = *(const u32x4*)(hbfc + ((size_t)(row_) * (LD_DM * 2) + 1024 * (j_)) + opq(v16)); } } while (0)
    LAS u32x4* const wst = (LAS u32x4*)(F.lds + 1024 + F.wave * 8192) + lane;
    int row = gw;
    if (row < MREAL) {
#pragma unroll
        for (int j = 0; j < 8; ++j) EW_FETCH(j, row);
        sq = *(const float*)((const char*)statm + (size_t)row * 256 + opq((unsigned)lane * 4u)); }
    for (; row < MREAL; row += NGW) {
        asm volatile("" : "+v"(v16), "+v"(v32), "+v"(v8));
        unsigned amx2 = 0u;
        const float rm = __builtin_amdgcn_rsqf(wave_sum(sq) * (1.0f / DM) + EPS);
        const int nrow = row + NGW; const bool more = nrow < MREAL;
        if (more) sq = *(const float*)((const char*)statm + (size_t)nrow * 256 + opq((unsigned)lane * 4u));
        float ss2 = 0.f;
        char* const hbw = (char*)hbf + (size_t)row * (LD_DM * 2); char* const outw = (char*)A.out + (size_t)row * (DM * 4);
#pragma unroll
        for (int j = 0; j < 8; ++j) { const f32x4 g0 = *(const f32x4*)(gpc + 2048 * j + opq(v32)), g1 = *(const f32x4*)(gpc + (2048 * j + 16) + opq(v32));
            const f32x4 m0 = {bf_lo(mv[j].x), bf_hi(mv[j].x), bf_lo(mv[j].y), bf_hi(mv[j].y)}, m1 = {bf_lo(mv[j].z), bf_hi(mv[j].z), bf_lo(mv[j].w), bf_hi(mv[j].w)};
            f32x4 h0, h1;
            if (first) { h0 = (f32x4){__uint_as_float(ha[j].x), __uint_as_float(ha[j].y), __uint_as_float(ha[j].z), __uint_as_float(ha[j].w)}; h1 = (f32x4){__uint_as_float(hb[j].x), __uint_as_float(hb[j].y), __uint_as_float(hb[j].z), __uint_as_float(hb[j].w)}; }
            else { h0 = (f32x4){bf_lo(ha[j].x), bf_hi(ha[j].x), bf_lo(ha[j].y), bf_hi(ha[j].y)}; h1 = (f32x4){bf_lo(ha[j].z), bf_hi(ha[j].z), bf_lo(ha[j].w), bf_hi(ha[j].w)}; }
            const f32x4 n0 = h0 + m0 * rm * g0, n1 = h1 + m1 * rm * g1; ss2 += sq8(n0, n1);
            if (last) { *(f32x4*)(outw + 2048 * j + opq(v32)) = n0; *(f32x4*)(outw + (2048 * j + 16) + opq(v32)) = n1; }
            else { u32x4 wh; wh.x = cvt_pk_bf16(n0[0], n0[1]); wh.y = cvt_pk_bf16(n0[2], n0[3]); wh.z = cvt_pk_bf16(n1[0], n1[1]); wh.w = cvt_pk_bf16(n1[2], n1[3]);
                *(u32x4*)(hbw + 1024 * j + opq(v16)) = wh;
                if (q8) { wst[j * 64] = wh;
                    amx2 = pkmax(pkmax(amx2, wh.x & 0x7fff7fffu), pkmax(wh.y & 0x7fff7fffu, pkmax(wh.z & 0x7fff7fffu, wh.w & 0x7fff7fffu))); } }
            if (more) EW_FETCH(j, nrow);
        }
        if (!last) { ss2 = wave_sum(ss2); const float rr = __builtin_amdgcn_rsqf(ss2 * (1.0f / DM) + EPS);
            if (lane == 0) rstd[row] = rr;
            if (q8) { const float amax = wave_max(fmaxf(bf_lo(amx2), bf_hi(amx2))); const float inv = amax > 0.f ? 127.0f * __builtin_amdgcn_rcpf(amax) : 0.f;
                if (lane == 0) rs8[row] = rr * amax * (1.0f / 16129.0f);
                char* const a8w = (char*)a8 + (size_t)row * LD8;
#pragma unroll
                for (int j = 0; j < 8; ++j) { u32x2 q; const u32x4 w = wst[j * 64];
                    q.x = pk4_i8(bf_lo(w.x) * inv, bf_hi(w.x) * inv, bf_lo(w.y) * inv, bf_hi(w.y) * inv); q.y = pk4_i8(bf_lo(w.z) * inv, bf_hi(w.z) * inv, bf_lo(w.w) * inv, bf_hi(w.w) * inv);
                    *(u32x2*)(a8w + 512 * j + opq(v8)) = q; } } }
    }
#undef EW_FETCH
}

__device__ __forceinline__ float logsig(float x) { return fminf(x, 0.f) - 0.6931471805599453f * __builtin_amdgcn_logf(1.0f + __builtin_amdgcn_exp2f(-1.4426950408889634f * fabsf(x))); }
__device__ __forceinline__ void scan_phase(const Args& A, Frame& F, int e) {
    const int gw = (F.G - 1 - F.vcu) * 8 + F.wave, lane = F.lane;
    if (gw >= NB * 16) return;
    const int b = gw >> 4, h = gw & 15;
    const float* flogT = (const float*)(F.ws + WS_FLOG) + (size_t)h * MPAD; float* cumT = (float*)(F.ws + WS_CUM) + (size_t)h * MPAD;
    const float bf = A.in[IN_EVBF][e * 16 + h];
    float cm = 0.f, mine = 0.f;
#pragma unroll 1
    for (int m = 0; m < NMETA; ++m) { cm += logsig(flogT[META0 + m] + bf); if (lane == m) mine = cm; }
    if (b == 0) cumT[META0 + lane] = lane < NMETA ? mine : 0.f;
    const float* src = flogT + b * SEQ + lane * 64; float* dst = cumT + b * SEQ + lane * 64;
    float s = 0.f;
#pragma unroll 1
    for (int i = 0; i < 16; ++i) { const f32x4 v = *(const f32x4*)(src + 4 * i); s += (logsig(v[0] + bf) + logsig(v[1] + bf)) + (logsig(v[2] + bf) + logsig(v[3] + bf)); }
    float inc = s;
#pragma unroll
    for (int off = 1; off < 64; off <<= 1) { const float t = __shfl_up(inc, off); if (lane >= off) inc += t; }
    float run = cm + (inc - s);
#pragma unroll 1
    for (int i = 0; i < 16; ++i) { const f32x4 v = *(const f32x4*)(src + 4 * i); f32x4 o;
        run += logsig(v[0] + bf); o[0] = run; run += logsig(v[1] + bf); o[1] = run; run += logsig(v[2] + bf); o[2] = run; run += logsig(v[3] + bf); o[3] = run;
        *(f32x4*)(dst + 4 * i) = o; }
}

__device__ __forceinline__ void fixup_odd_meta(Frame& F, int e) {
    unsigned char* ws = F.ws;
    const float* part = (const float*)(ws + WS_PART); const float* rstd = (const float*)(ws + WS_RSTD); bf16_t* proj = (bf16_t*)(ws + WS_PROJ);
    const bool i8 = (I8_IN_ODD >> e) & 1;
    const float* cs = (const float*)(ws + WS_CTL + CTL_COLMAX_OD) + (size_t)e * OD_N; const float* rs8 = (const float*)(ws + WS_RS8);
    constexpr int CG = OD_N / 8;
    for (int item = F.vcu * 512 + F.tid; item < 256 * CG; item += F.G * 512) {
        const int r = item / CG, col = (item - r * CG) * 8;
        f32x4 a = {0.f, 0.f, 0.f, 0.f}, b = {0.f, 0.f, 0.f, 0.f};
        if (r < NMETA) {
            if (i8) { i32x4 ia = {0, 0, 0, 0}, ib = {0, 0, 0, 0};
#pragma unroll 16
                for (int ks = 0; ks < DM / 256; ++ks) { ia += *(const i32x4*)(part + (size_t)(ks * 16 + r) * OD_N + col); ib += *(const i32x4*)(part + (size_t)(ks * 16 + r) * OD_N + col + 4); }
                const float sc = rs8[META0 + r]; a = __builtin_convertvector(ia, f32x4) * (*(const f32x4*)(cs + col) * sc); b = __builtin_convertvector(ib, f32x4) * (*(const f32x4*)(cs + col + 4) * sc);
            } else {
#pragma unroll 16
            for (int ks = 0; ks < DM / 256; ++ks) { a += *(const f32x4*)(part + (size_t)(ks * 16 + r) * OD_N + col); b += *(const f32x4*)(part + (size_t)(ks * 16 + r) * OD_N + col + 4); }
            const float sc = rstd[META0 + r]; a = a * sc; b = b * sc;
            }
        }
        pg8::store8(proj + (size_t)(META0 + r) * LD_OD + col, a, b);
    }
}

__device__ __forceinline__ int t5_bucket(int d) {
    if (d < 16) return d;
    return 16 + (d >= 19) + (d >= 21) + (d >= 24) + (d >= 27) + (d >= 31) + (d >= 35) + (d >= 40) + (d >= 46) + (d >= 52) + (d >= 59) + (d >= 67) + (d >= 77) + (d >= 87) + (d >= 99) + (d >= 113);
}
__device__ __forceinline__ void attn_even_phase(Frame& F) {
    unsigned char* ws = F.ws; LAS char* lds = (LAS char*)F.lds;
    const bf16_t* proj = (const bf16_t*)(ws + WS_PROJ); const bf16_t* qbuf = (const bf16_t*)(ws + WS_QBUF); const bf16_t* kvbuf = (const bf16_t*)(ws + WS_KVBUF);
    bf16_t* obuf = (bf16_t*)(ws + WS_OBUF); const float* cumT = (const float*)(ws + WS_CUM);
    for (int i = F.vcu; i < 512 + 16; i += F.G) {
        const bool meta = i >= 512; const int bh = i >> 3, p = i & 7, b = meta ? 0 : bh >> 4, h = meta ? i - 512 : bh & 15, nblk = meta ? 1 : 2;
        for (int k = 0; k < nblk; ++k) {
            const int qb = meta ? 0 : (k == 0 ? 15 - p : p), qrow0 = meta ? META0 : b * SEQ + qb * 256;
            att::PassArgs a;
            a.Q = proj + (size_t)qrow0 * LD_EV + EV_QF + h * 128; a.ldq = LD_EV; a.Q2 = nullptr; a.ldq2 = 0;
            a.K = proj + EV_KF + h * 128; a.ldk = LD_EV; a.K2 = nullptr; a.ldk2 = 0; a.V = proj + EV_VF + h * 128; a.ldv = LD_EV;
            a.cum = cumT + (size_t)h * MPAD; a.krow0 = b * SEQ; a.qvp0 = meta ? 0 : 64 + qb * 256; a.NT = meta ? 1 : 4 * qb + 5; a.shift0 = 0;
            f32x16 o[4];
            att::attn_pass_dma<0>(a, lds, o, F.tid);
            att::store_o_bf16(o, obuf + (size_t)(qrow0 + F.wave * 32) * LD_DM + h * 128, LD_DM, F.tid);
        }
    }
    for (int i = F.vcu; i < 512 + 16; i += F.G) {
        const bool meta = i >= 512; const int bh = i >> 3, p = i & 7, b = meta ? 0 : bh >> 4, h = meta ? i - 512 : bh & 15, nblk = meta ? 1 : 2;
        for (int k = 0; k < nblk; ++k) {
            const int qb = meta ? 0 : (k == 0 ? 15 - p : p), qrow0 = meta ? META0 : b * SEQ + qb * 256;
            att::PassArgs a;
            a.Q = qbuf + (size_t)qrow0 * LD_UQ + h * 128; a.ldq = LD_UQ; a.Q2 = qbuf + (size_t)qrow0 * LD_UQ + 2048 + h * 64; a.ldq2 = LD_UQ;
            a.K = kvbuf + h * 128; a.ldk = LD_UKV; a.K2 = proj + EV_KR; a.ldk2 = LD_EV; a.V = kvbuf + 2048 + h * 128; a.ldv = LD_UKV;
            a.cum = nullptr; a.krow0 = b * SEQ; a.qvp0 = meta ? 0 : 64 + qb * 256; a.NT = meta ? 1 : 4 * qb + 5; a.shift0 = 0;
            f32x16 o[4];
            att::attn_pass_dma<1>(a, lds, o, F.tid);
            att::store_o_bf16(o, obuf + (size_t)(qrow0 + F.wave * 32) * LD_DM + 2048 + h * 128, LD_DM, F.tid);
        }
    }
}
__device__ __forceinline__ void attn_odd_phase(const Args& A, Frame& F, int o_idx) {
    unsigned char* ws = F.ws; LAS char* lds = (LAS char*)F.lds;
    const bf16_t* proj = (const bf16_t*)(ws + WS_PROJ); bf16_t* obuf = (bf16_t*)(ws + WS_OBUF);
    const float post = 1.0f - A.lam_init[o_idx];
    const float* subg = A.in[IN_ODSUBLN] + o_idx * 256; const float* relb = A.in[IN_RELB];
    float* S1base = (float*)(ws + WS_DSCR) + (size_t)(F.vcu & 255) * 65536;
    constexpr float INV_SCALE = 1.0f / att::Cfg<2>::SCALE;
    for (int i = F.vcu; i < 512 + 16; i += F.G) {
        const bool meta = i >= 512; const int bh = i >> 3, p = i & 7, b = meta ? 0 : bh >> 4, h = meta ? i - 512 : bh & 15, nblk = meta ? 1 : 2;
        for (int k = 0; k < nblk; ++k) {
            const int qb = meta ? 0 : (k == 0 ? 15 - p : p), qrow0 = meta ? META0 : b * SEQ + qb * 256;
            { int tt = F.tid; asm volatile("" : "+v"(tt));
              if (tt < 128) ((LAS float*)(lds + att::D_OFF_TBL))[tt] = tt <= 112 ? (relb[t5_bucket(tt) * 16 + h] - relb[31 * 16 + h]) * INV_SCALE : 0.f; }
            f32x16 o[8];
            for (int br = 0; br < 2; ++br) {
                att::PassArgs a;
                a.Q = proj + (size_t)qrow0 * LD_OD + h * 256 + br * 128; a.ldq = LD_OD; a.Q2 = nullptr; a.ldq2 = 0;
                a.K = proj + 4096 + h * 256 + br * 128; a.ldk = LD_OD; a.K2 = nullptr; a.ldk2 = 0; a.V = proj + 8192 + h * 256; a.ldv = LD_OD;
                a.cum = nullptr; a.krow0 = b * SEQ; a.qvp0 = meta ? 0 : 64 + qb * 256; a.NT = meta ? 1 : 4 * qb + 5; a.shift0 = meta ? 0 : 48;
                att::attn_pass_diff(a, lds, o, F.tid);
                if (br == 0) {
                    int tq = F.tid; asm volatile("" : "+v"(tq));
                    float* S1 = S1base + (size_t)tq * 4;
#pragma unroll
                    for (int d = 0; d < 8; ++d) {
#pragma unroll
                        for (int q = 0; q < 4; ++q) *(f32x4*)(S1 + (d * 4 + q) * 2048) = (f32x4){o[d][4 * q], o[d][4 * q + 1], o[d][4 * q + 2], o[d][4 * q + 3]}; }
                }
            }
            {
                int tq = F.tid; asm volatile("" : "+v"(tq));
                const float* S1 = S1base + (size_t)tq * 4;
                const float lam = ((const float*)(ws + WS_PRM))[o_idx];
                VM_WAIT();
#pragma unroll
                for (int d = 0; d < 8; ++d) {
#pragma unroll
                    for (int q = 0; q < 4; ++q) { const f32x4 s1 = *(const f32x4*)(S1 + (d * 4 + q) * 2048);
#pragma unroll
                        for (int j = 0; j < 4; ++j) o[d][4 * q + j] = s1[j] - lam * o[d][4 * q + j]; }
                    asm volatile("" ::: "memory"); }
            }
            int tq2 = F.tid; asm volatile("" : "+v"(tq2));
            const int r32 = tq2 & 31;
            float ssum[16];
#pragma unroll
            for (int r = 0; r < 16; ++r) { float t = 0.f;
#pragma unroll
                for (int d = 0; d < 8; ++d) t += o[d][r] * o[d][r];
#pragma unroll
                for (int off = 1; off < 32; off <<= 1) t += __shfl_xor(t, off);
                ssum[r] = __builtin_amdgcn_rsqf(t * (1.0f / 256.0f) + EPS) * post; }
#pragma unroll
            for (int d = 0; d < 8; ++d) { const float g = subg[d * 32 + r32];
#pragma unroll
                for (int r = 0; r < 16; ++r) o[d][r] *= ssum[r] * g; }
            bf16_t* Ow = obuf + (size_t)(qrow0 + F.wave * 32) * LD_DM + h * 256;
            att::store_o_bf16(o, Ow, LD_DM, F.tid);
            att::store_o_bf16(o + 4, Ow + 128, LD_DM, F.tid);
        }
    }
}
#ifdef PROBE_ATT
template <int PVAR>
__device__ __forceinline__ void attn_odd_phase_probe(const Args& A, Frame& F, int o_idx) {
    unsigned char* ws = F.ws; LAS char* lds = (LAS char*)F.lds;
    const bf16_t* proj = (const bf16_t*)(ws + WS_PROJ); bf16_t* obuf = (bf16_t*)(ws + WS_OBUF);
    const float post = 1.0f - A.lam_init[o_idx];
    const float* subg = A.in[IN_ODSUBLN] + o_idx * 256; const float* relb = A.in[IN_RELB];
    float* S1base = (float*)(ws + WS_DSCR) + (size_t)(F.vcu & 255) * 65536;
    constexpr float INV_SCALE = 1.0f / att::Cfg<2>::SCALE;
    for (int i = F.vcu; i < 512 + 16; i += F.G) {
        const bool meta = i >= 512; const int bh = i >> 3, p = i & 7, b = meta ? 0 : bh >> 4, h = meta ? i - 512 : bh & 15, nblk = meta ? 1 : 2;
        for (int k = 0; k < nblk; ++k) {
            const int qb = meta ? 0 : (k == 0 ? 15 - p : p), qrow0 = meta ? META0 : b * SEQ + qb * 256;
            { int tt = F.tid; asm volatile("" : "+v"(tt));
              if (tt < 128) ((LAS float*)(lds + att::D_OFF_TBL))[tt] = tt <= 112 ? (relb[t5_bucket(tt) * 16 + h] - relb[31 * 16 + h]) * INV_SCALE : 0.f; }
            f32x16 o[8];
            for (int br = 0; br < 2; ++br) {
                att::PassArgs a;
                a.Q = proj + (size_t)qrow0 * LD_OD + h * 256 + br * 128; a.ldq = LD_OD; a.Q2 = nullptr; a.ldq2 = 0;
                a.K = proj + 4096 + h * 256 + br * 128; a.ldk = LD_OD; a.K2 = nullptr; a.ldk2 = 0; a.V = proj + 8192 + h * 256; a.ldv = LD_OD;
                a.cum = nullptr; a.krow0 = b * SEQ; a.qvp0 = meta ? 0 : 64 + qb * 256; a.NT = meta ? 1 : 4 * qb + 5; a.shift0 = meta ? 0 : 48;
                if constexpr (PVAR == 0) att::attn_pass_diff(a, lds, o, F.tid); else att::attn_pass_diff_probe<PVAR>(a, lds, o, F.tid);
                if (br == 0) {
                    int tq = F.tid; asm volatile("" : "+v"(tq));
                    float* S1 = S1base + (size_t)tq * 4;
#pragma unroll
                    for (int d = 0; d < 8; ++d) {
#pragma unroll
                        for (int q = 0; q < 4; ++q) *(f32x4*)(S1 + (d * 4 + q) * 2048) = (f32x4){o[d][4 * q], o[d][4 * q + 1], o[d][4 * q + 2], o[d][4 * q + 3]}; }
                }
            }
            {
                int tq = F.tid; asm volatile("" : "+v"(tq));
                const float* S1 = S1base + (size_t)tq * 4;
                const float lam = ((const float*)(ws + WS_PRM))[o_idx];
                VM_WAIT();
#pragma unroll
                for (int d = 0; d < 8; ++d) {
#pragma unroll
                    for (int q = 0; q < 4; ++q) { const f32x4 s1 = *(const f32x4*)(S1 + (d * 4 + q) * 2048);
#pragma unroll
                        for (int j = 0; j < 4; ++j) o[d][4 * q + j] = s1[j] - lam * o[d][4 * q + j]; }
                    asm volatile("" ::: "memory"); }
            }
            int tq2 = F.tid; asm volatile("" : "+v"(tq2));
            const int r32 = tq2 & 31;
            float ssum[16];
#pragma unroll
            for (int r = 0; r < 16; ++r) { float t = 0.f;
#pragma unroll
                for (int d = 0; d < 8; ++d) t += o[d][r] * o[d][r];
#pragma unroll
                for (int off = 1; off < 32; off <<= 1) t += __shfl_xor(t, off);
                ssum[r] = __builtin_amdgcn_rsqf(t * (1.0f / 256.0f) + EPS) * post; }
#pragma unroll
            for (int d = 0; d < 8; ++d) { const float g = subg[d * 32 + r32];
#pragma unroll
                for (int r = 0; r < 16; ++r) o[d][r] *= ssum[r] * g; }
            bf16_t* Ow = obuf + (size_t)(qrow0 + F.wave * 32) * LD_DM + h * 256;
            att::store_o_bf16(o, Ow, LD_DM, F.tid);
            att::store_o_bf16(o + 4, Ow + 128, LD_DM, F.tid);
        }
    }
}
#endif

#ifndef PHM
#define PHM 1023
#endif
#ifndef P4SUB
#define P4SUB 7
#endif
constexpr int PPL = 10, N_PHASES = 2 + PPL * DEPTH;
__global__ void __launch_bounds__(512, 2) mega_fwd(Args args) {
    extern __shared__ __attribute__((aligned(16))) unsigned char lds_raw[];
    Frame F;
    F.lds = (LAS unsigned char*)lds_raw;
    const int wave_s = __builtin_amdgcn_readfirstlane((int)threadIdx.x >> 6);
    F.tid = opq_tid(wave_s); F.lane = F.tid & 63; F.wave = wave_s;
    F.G = gridDim.x; { const int bx = blockIdx.x; F.bx = bx; F.vcu = (F.G % 8 == 0) ? (bx % 8) * (F.G / 8) + bx / 8 : bx; }
    F.ws = args.ws;
    unsigned char* ws = args.ws;
    volatile LAS unsigned* MISC = (volatile LAS unsigned*)(F.lds + MISC_OFF);
    for (int u = F.tid; u < (LDS_BYTES - 135168) / 4; u += 512) ((LAS unsigned*)(F.lds + 135168))[u] = 0u;
    __syncthreads();
#if MK_ONE_LAUNCH
    XcdBarrier bar = xcd_barrier_post((unsigned*)(ws + WS_CTL) + CW_BAR, MISC + 8, F.tid);
#define IN(k) true
#else
    const int lo = args.ph_lo, hi = args.ph_hi;
    XcdBarrier bar; bar.bar = (unsigned*)(ws + WS_CTL) + CW_BAR; bar.x = 0; bar.st = nullptr;
    if (hi - lo > 1) bar = xcd_barrier_post((unsigned*)(ws + WS_CTL) + CW_BAR, MISC + 8, F.tid);
#define IN(k) (lo <= (k) && (k) < hi)
#endif
#define REFRESH() Frame Fp = F; { const int t_ = opq_tid(wave_s); Fp.tid = t_; Fp.lane = t_ & 63; size_t z_ = 0; asm volatile("" : "+s"(z_)); Fp.ws = args.ws + z_; Fp.vcu = opq_s(F.vcu); Fp.G = opq_s(F.G); Fp.bx = opq_s(F.bx); } unsigned char* ws = Fp.ws; (void)ws
#define SEAM(k, kn) do { if (IN(k) && IN(kn)) { XcdBarrier b_; size_t z_ = 0; asm volatile("" : "+s"(z_)); b_.bar = (unsigned*)(args.ws + z_ + WS_CTL) + CW_BAR; b_.x = xb_xcc_id(); b_.st = MISC + 8; xcd_barrier(b_, opq_tid(wave_s)); } } while (0)
#define PTRS() bf16_t* hbf = (bf16_t*)(ws + WS_HBF); bf16_t* proj = (bf16_t*)(ws + WS_PROJ); bf16_t* qbuf = (bf16_t*)(ws + WS_QBUF); bf16_t* kvbuf = (bf16_t*)(ws + WS_KVBUF); \
    bf16_t* obuf = (bf16_t*)(ws + WS_OBUF); bf16_t* mbuf = (bf16_t*)(ws + WS_MBUF); bf16_t* act = (bf16_t*)(ws + WS_PROJ); \
    pg8::EpiCtx ec; ec.O = nullptr; ec.ldc = 0; ec.rs = (const float*)(ws + WS_RSTD); ec.statq = (float*)(ws + WS_STATQ); ec.statkv = (float*)(ws + WS_STATKV); \
    ec.flogT = (float*)(ws + WS_FLOG); ec.cosT = (const float*)(ws + WS_COS); ec.sinT = (const float*)(ws + WS_SIN); ec.statm = (float*)(ws + WS_STATM); ec.part = (float*)(ws + WS_PART); ec.cs = nullptr; ec.amaxp = (float*)(ws + WS_AMAXP); \
    (void)hbf; (void)proj; (void)qbuf; (void)kvbuf; (void)obuf; (void)mbuf; (void)act

#if PHM & 1
    if (IN(0)) { p0_prologue(args, F); }
#endif
    SEAM(0, 1);
#if PHM & 1
    if (IN(1)) { REFRESH(); cvt_items<1>(args, Fp); }
#endif
    SEAM(1, 2);
#define LAYER() opq_s(layer0)
#define BASE() (2 + PPL * layer0)
#define EVEN() ((LAYER() & 1) == 0)
#define DN8() (((I8_DN >> LAYER()) & 1) != 0)
#define OUT8() (((I8_OUT >> LAYER()) & 1) != 0)
#define REFRESH_L() REFRESH(); const int layer = LAYER(), e = layer >> 1; (void)e; (void)layer
    for (int layer0 = 0; layer0 < DEPTH; ++layer0) {
#if PHM & 2
        if (IN(BASE())) {
            REFRESH_L(); PTRS();
            if (EVEN() && !((I8_IN_EV >> e) & 1)) {
                pg8::Gemm g{hbf, (const bf16_t*)(ws + W_EVIN + e * SZ_EVIN), LD_DM, LD_DM, DM}; pg8::StaticOrder S; S.init(MPAD, EV_N, Fp.G, Fp.bx);
                pg8::Epi<1> E{ec}; E.c.O = proj; E.c.ldc = LD_EV;
                pg8::gemm_phase<pg8::Epi<1>, pg8::StaticOrder, true, true>(Fp.lds, g, S, E, Fp.tid);
            } else if (EVEN()) {
                pg8::Gemm g{(const bf16_t*)(ws + WS_OBUF), (const bf16_t*)(ws + W_EVIN + e * SZ_EVIN), LD8 / 2, LD8 / 2, DM / 2}; pg8::StaticOrder S; S.init(MPAD, EV_N, Fp.G, Fp.bx);
                pg8::Epi<9> E{ec}; E.c.O = proj; E.c.ldc = LD_EV; E.c.rs = (const float*)(ws + WS_RS8); E.c.cs = (const float*)(ws + WS_CTL + CTL_COLMAX_EV) + (size_t)e * EV_N;
                pg8::gemm_phase<pg8::Epi<9>, pg8::StaticOrder, true, true, 2>(Fp.lds, g, S, E, Fp.tid);
            } else if ((I8_IN_ODD >> e) & 1) {
                pg8::Gemm g{(const bf16_t*)(ws + WS_OBUF), (const bf16_t*)(ws + W_GU + (size_t)layer * SZ_GU + W_OD8_OFF), LD8 / 2, LD8 / 2, DM / 2}; pg8::StaticOrder S; S.init(MREAL, OD_N, Fp.G, Fp.bx);
                pg8::Epi<8> E{ec}; E.c.O = proj; E.c.ldc = LD_OD; E.c.rs = (const float*)(ws + WS_RS8); E.c.cs = (const float*)(ws + WS_CTL + CTL_COLMAX_OD) + (size_t)e * OD_N;
                pg8::gemm_phase<pg8::Epi<8>, pg8::StaticOrder, true, true, 2>(Fp.lds, g, S, E, Fp.tid);
            } else {
                pg8::Gemm g{hbf, (const bf16_t*)(ws + W_ODIN + e * SZ_ODIN), LD_DM, LD_DM, DM}; pg8::StaticOrder S; S.init(MREAL, OD_N, Fp.G, Fp.bx);
                pg8::Epi<0> E{ec}; E.c.O = proj; E.c.ldc = LD_OD;
                pg8::gemm_phase<pg8::Epi<0>, pg8::StaticOrder, true, true>(Fp.lds, g, S, E, Fp.tid);
            }
        }
        if (!EVEN() && IN(BASE())) {
            REFRESH_L(); PTRS();
            if ((I8_IN_ODD >> e) & 1) {
                pg8::Gemm g{(const bf16_t*)(ws + WS_OBUF), (const bf16_t*)(ws + W_GU + (size_t)layer * SZ_GU + W_OD8_OFF), LD8 / 2, LD8 / 2, 128}; pg8::SplitKOrder S; S.init(MREAL / 256, OD_N, DM / 256, 128, Fp.G, Fp.bx);
                pg8::Epi<6> E{ec}; E.c.ldc = OD_N;
                pg8::gemm_phase<pg8::Epi<6>, pg8::SplitKOrder, true, false, 2>(Fp.lds, g, S, E, Fp.tid);
            } else {
                pg8::Gemm g{hbf, (const bf16_t*)(ws + W_ODIN + e * SZ_ODIN), LD_DM, LD_DM, 256}; pg8::SplitKOrder S; S.init(MREAL / 256, OD_N, DM / 256, 256, Fp.G, Fp.bx);
                pg8::Epi<6> E{ec}; E.c.ldc = OD_N;
                pg8::gemm_phase<pg8::Epi<6>, pg8::SplitKOrder, true, false>(Fp.lds, g, S, E, Fp.tid);
            }
        }
#endif
        SEAM(BASE(), BASE() + 1);
#if PHM & 4
        if (EVEN() && IN(BASE() + 1)) {
#if P4SUB & 1
            REFRESH_L();
            scan_phase(args, Fp, e);
#endif
#if P4SUB & 2
            {   REFRESH_L(); PTRS();
                pg8::Gemm g{proj + EV_CQ, (const bf16_t*)(ws + W_UQ + e * SZ_UQ), LD_EV, LD_QR, QRANK}; pg8::StaticOrder S; S.init(MPAD, UQ_N, Fp.G, Fp.bx);
                pg8::Epi<2> E{ec}; E.c.O = qbuf; E.c.ldc = LD_UQ; E.c.rs = (const float*)(ws + WS_STATQ);
                pg8::gemm_phase<pg8::Epi<2>, pg8::StaticOrder, true, true>(Fp.lds, g, S, E, Fp.tid); }
#endif
#if P4SUB & 4
            {   REFRESH_L(); PTRS();
                pg8::Gemm g{proj + EV_CKV, (const bf16_t*)(ws + W_UKV + e * SZ_UKV), LD_EV, LD_KV, KVK}; pg8::StaticOrder S; S.init(MPAD, UKV_N, Fp.G, Fp.bx);
                pg8::Epi<3> E{ec}; E.c.O = kvbuf; E.c.ldc = LD_UKV; E.c.rs = (const float*)(ws + WS_STATKV);
                pg8::gemm_phase<pg8::Epi<3>, pg8::StaticOrder, true, true>(Fp.lds, g, S, E, Fp.tid); }
#endif
        }
#endif
        if (!EVEN() && IN(BASE() + 1)) { REFRESH_L(); fixup_odd_meta(Fp, e); }
        SEAM(BASE() + 1, BASE() + 2);
#if PHM & 8
        if (IN(BASE() + 2) && EVEN()) { REFRESH_L(); attn_even_phase(Fp); }
#endif
#if PHM & 16
        if (IN(BASE() + 2) && !EVEN()) { REFRESH_L(); attn_odd_phase(args, Fp, e); }
#endif
        if (OUT8()) SEAM(BASE() + 2, BASE() + 3);
        if (OUT8() && IN(BASE() + 3)) { REFRESH_L(); oq_phase(Fp); }
        SEAM(OUT8() ? BASE() + 3 : BASE() + 2, BASE() + 4);
#if PHM & 32
        if (IN(BASE() + 4) && OUT8()) {
            REFRESH_L(); PTRS();
            const bf16_t* w8 = (const bf16_t*)(ws + (EVEN() ? W_EVOUT : W_ODOUT) + e * SZ_SQ);
            {   pg8::Gemm g{(const bf16_t*)(ws + WS_A8), w8, LD8 / 2, LD8 / 2, DM / 2}; pg8::StaticOrder S; S.init(MREAL, DM, Fp.G, Fp.bx);
                pg8::Epi<10> E{ec}; E.c.O = mbuf; E.c.ldc = LD_DM; E.c.rs = (const float*)(ws + WS_RS8); E.c.cs = (const float*)(ws + WS_CTL + CTL_COLMAX_OUT) + (size_t)layer * DM;
                pg8::gemm_phase<pg8::Epi<10>, pg8::StaticOrder, true, true, 2>(Fp.lds, g, S, E, Fp.tid); }
            {   REFRESH_L(); PTRS();
                const bf16_t* w8b = (const bf16_t*)(ws + (EVEN() ? W_EVOUT : W_ODOUT) + e * SZ_SQ);
                pg8::Gemm g{(const bf16_t*)(ws + WS_A8), w8b, LD8 / 2, LD8 / 2, 128}; pg8::SplitKOrder S; S.init(MREAL / 256, DM, DM / 256, 128, Fp.G, Fp.bx);
                pg8::Epi<6> E{ec}; E.c.ldc = DM;
                pg8::gemm_phase<pg8::Epi<6>, pg8::SplitKOrder, true, false, 2>(Fp.lds, g, S, E, Fp.tid); }
        }
        if (IN(BASE() + 4) && !OUT8()) {
            REFRESH_L(); PTRS();
            {   pg8::Gemm g{obuf, (const bf16_t*)(ws + (EVEN() ? W_EVOUT : W_ODOUT) + e * SZ_SQ), LD_DM, LD_DM, DM}; pg8::StaticOrder S; S.init(MREAL, DM, Fp.G, Fp.bx);
                pg8::Epi<4> E{ec}; E.c.O = mbuf; E.c.ldc = LD_DM;
                pg8::gemm_phase<pg8::Epi<4>, pg8::StaticOrder, true, true>(Fp.lds, g, S, E, Fp.tid); }
            {   REFRESH_L(); PTRS();
                pg8::Gemm g{obuf, (const bf16_t*)(ws + (EVEN() ? W_EVOUT : W_ODOUT) + e * SZ_SQ), LD_DM, LD_DM, 256}; pg8::SplitKOrder S; S.init(MREAL / 256, DM, DM / 256, 256, Fp.G, Fp.bx);
                pg8::Epi<6> E{ec}; E.c.ldc = DM;
                pg8::gemm_phase<pg8::Epi<6>, pg8::SplitKOrder, true, false>(Fp.lds, g, S, E, Fp.tid); }
        }
#endif
        SEAM(BASE() + 4, BASE() + 5);
#if PHM & 64
        if (IN(BASE() + 5)) { REFRESH_L(); ew_phase(args, Fp, layer, 0); }
#endif
        SEAM(BASE() + 5, BASE() + 6);
#if PHM & 128
        if (IN(BASE() + 6)) {
            REFRESH_L(); PTRS();
            pg8::Gemm g{(const bf16_t*)(ws + WS_A8), (const bf16_t*)(ws + W_GU + layer * SZ_GU), LD8 / 2, LD8 / 2, DM / 2}; pg8::StaticOrder S; S.init(MPAD, GU_N, Fp.G, Fp.bx, 4);
            pg8::Epi<7> E{ec}; E.c.O = act; E.c.ldc = LD_FF; E.c.rs = (const float*)(ws + WS_RS8); E.c.cs = (const float*)(ws + WS_CTL + CTL_COLMAX) + (size_t)layer * GU_N;
            pg8::gemm_phase<pg8::Epi<7>, pg8::StaticOrder, true, true, 2>(Fp.lds, g, S, E, Fp.tid);
        }
#endif
        if (DN8()) SEAM(BASE() + 6, BASE() + 7);
        if (DN8() && IN(BASE() + 7)) { REFRESH_L(); actq_phase(Fp); }
        SEAM(DN8() ? BASE() + 7 : BASE() + 6, BASE() + 8);
#if PHM & 256
        if (IN(BASE() + 8) && DN8()) {
            REFRESH_L(); PTRS();
            {   pg8::Gemm g{(const bf16_t*)(ws + WS_ACT8), (const bf16_t*)(ws + W_DN + layer * SZ_DN), LD8F / 2, LD8F / 2, DFF / 2}; pg8::StaticOrder S; S.init(MREAL, DM, Fp.G, Fp.bx);
                pg8::Epi<10> E{ec}; E.c.O = mbuf; E.c.ldc = LD_DM; E.c.rs = (const float*)(ws + WS_RSD); E.c.cs = (const float*)(ws + WS_CTL + CTL_COLMAX_DN) + (size_t)layer * DM;
                pg8::gemm_phase<pg8::Epi<10>, pg8::StaticOrder, true, true, 2>(Fp.lds, g, S, E, Fp.tid); }
            {   REFRESH_L(); PTRS();
                pg8::Gemm g{(const bf16_t*)(ws + WS_ACT8), (const bf16_t*)(ws + W_DN + layer * SZ_DN), LD8F / 2, LD8F / 2, 128}; pg8::SplitKOrder S; S.init(MREAL / 256, DM, DFF / 256, 128, Fp.G, Fp.bx);
                pg8::Epi<6> E{ec}; E.c.ldc = DM;
                pg8::gemm_phase<pg8::Epi<6>, pg8::SplitKOrder, true, false, 2>(Fp.lds, g, S, E, Fp.tid); }
        }
        if (IN(BASE() + 8) && !DN8()) {
            REFRESH_L(); PTRS();
            {   pg8::Gemm g{act, (const bf16_t*)(ws + W_DN + layer * SZ_DN), LD_FF, LD_FF, DFF}; pg8::StaticOrder S; S.init(MREAL, DM, Fp.G, Fp.bx);
                pg8::Epi<4> E{ec}; E.c.O = mbuf; E.c.ldc = LD_DM;
                pg8::gemm_phase<pg8::Epi<4>, pg8::StaticOrder, true, true>(Fp.lds, g, S, E, Fp.tid); }
            {   REFRESH_L(); PTRS();
                pg8::Gemm g{act, (const bf16_t*)(ws + W_DN + layer * SZ_DN), LD_FF, LD_FF, 256}; pg8::SplitKOrder S; S.init(MREAL / 256, DM, DFF / 256, 256, Fp.G, Fp.bx);
                pg8::Epi<6> E{ec}; E.c.ldc = DM;
                pg8::gemm_phase<pg8::Epi<6>, pg8::SplitKOrder, true, false>(Fp.lds, g, S, E, Fp.tid); }
        }
#endif
        SEAM(BASE() + 8, BASE() + 9);
#if PHM & 512
        if (IN(BASE() + 9)) { REFRESH_L(); ew_phase(args, Fp, layer, 1); }
#endif
        if (layer0 + 1 < DEPTH) SEAM(BASE() + 9, BASE() + 10);
    }
#ifdef PROBE_ATT
    if (IN(N_PHASES)) { REFRESH(); attn_odd_phase_probe<PROBE_ATT>(args, Fp, 1); }
#endif
#ifdef PROBE_EW
    if (IN(N_PHASES)) { REFRESH(); ew_phase(args, Fp, 1, 0); }
#endif
#ifdef PROBE_GEMM
    if (IN(N_PHASES)) {
        REFRESH(); PTRS();
#ifndef PROBE_LD
#define PROBE_LD LD_DM
#endif
        pg8::Gemm g{hbf, (const bf16_t*)(ws + W_GU), PROBE_LD, PROBE_LD, DM}; pg8::StaticOrder S; S.init(PROBE_LD ? MPAD : 256, PROBE_LD ? GU_N : 256 * 86 * 65, Fp.G, Fp.bx, PROBE_WGM);
        pg8::Epi<5> E{ec}; E.c.O = act; E.c.ldc = LD_FF;
        pg8::gemm_phase<pg8::Epi<5>, pg8::StaticOrder, PROBE_ALIGN, PROBE_SP2>(Fp.lds, g, S, E, Fp.tid);
    }
#endif
#undef PTRS
#undef REFRESH
#undef REFRESH_L
#undef LAYER
#undef BASE
#undef EVEN
#undef DN8
#undef OUT8
#undef IN
#undef SEAM
}

#ifndef MK_ONE_LAUNCH
#define MK_ONE_LAUNCH 1
#endif
extern "C" void kernel_launch(void* const* d_in, const int* in_sizes, int n_in, void* d_out, int out_size, void* d_ws, size_t ws_size, hipStream_t stream) {
    static int grid = 0;
    if (grid == 0) {
        if (n_in != 18 || in_sizes[0] != NB * SEQ * DM || out_size != NB * SEQ * DM || ws_size < WS_END) {
            fprintf(stderr, "kernel_launch: unexpected shapes or workspace (n_in %d, in0 %d, out %d, ws %zu < %zu); nothing launched\n", n_in, n_in > 0 ? in_sizes[0] : -1, out_size, ws_size, (size_t)WS_END); grid = -1; return; }
        int dev = 0, cus = 0;
        if (hipGetDevice(&dev) != hipSuccess || hipDeviceGetAttribute(&cus, hipDeviceAttributeMultiprocessorCount, dev) != hipSuccess || cus <= 0) { fprintf(stderr, "kernel_launch: device query failed\n"); grid = -1; return; }
        if (hipFuncSetAttribute((const void*)mega_fwd, hipFuncAttributeMaxDynamicSharedMemorySize, LDS_BYTES) != hipSuccess) { fprintf(stderr, "kernel_launch: hipFuncSetAttribute failed\n"); grid = -1; return; }
        int per_cu = 0;
        if (hipOccupancyMaxActiveBlocksPerMultiprocessor(&per_cu, (const void*)mega_fwd, 512, LDS_BYTES) != hipSuccess || per_cu < 1) fprintf(stderr, "kernel_launch: note: occupancy query reports %d workgroups per CU\n", per_cu);
        (void)hipGetLastError();
        grid = cus > 256 ? 256 : cus;
    }
    if (grid < 0) return;
    if (hipMemsetAsync((char*)d_ws + WS_CTL, 0, CTL_ZERO_BYTES, stream) != hipSuccess) { fprintf(stderr, "kernel_launch: memset failed\n"); return; }
    Args a{};
    for (int i = 0; i < 18; ++i) a.in[i] = (const float*)d_in[i];
    a.out = (float*)d_out; a.ws = (unsigned char*)d_ws;
    a.lam_init[0] = (float)(0.8 - 0.6 * exp(-0.3 * 1.0)); a.lam_init[1] = (float)(0.8 - 0.6 * exp(-0.3 * 3.0));
#if MK_ONE_LAUNCH
    a.ph_lo = 0; a.ph_hi = N_PHASES;
    hipLaunchKernelGGL(mega_fwd, dim3(grid), dim3(512), LDS_BYTES, stream, a);
#else
    for (int k = 0; k < N_PHASES; ++k) {
        a.ph_lo = k; a.ph_hi = k + 1;
        hipLaunchKernelGGL(mega_fwd, dim3(grid), dim3(512), LDS_BYTES, stream, a);
#ifdef PROBE_MASK
        { const int off = k < 2 ? 10 : ((k - 2) % PPL); if ((PROBE_MASK >> off) & 1) hipLaunchKernelGGL(mega_fwd, dim3(grid), dim3(512), LDS_BYTES, stream, a); }
#endif
    }
#if defined(PROBE_GEMM) || defined(PROBE_EW) || defined(PROBE_ATT)
    for (int r = 0; r < PROBE_REP; ++r) { a.ph_lo = N_PHASES; a.ph_hi = N_PHASES + 1; hipLaunchKernelGGL(mega_fwd, dim3(grid), dim3(512), LDS_BYTES, stream, a); }
#endif
#endif
}
```

```cpp
#define MK_ONE_LAUNCH 1
#include <hip/hip_runtime.h>
#include <cstdio>
#include <cstdint>
#include <cmath>

#define LAS __attribute__((address_space(3)))
#define GAS __attribute__((address_space(1)))
typedef unsigned short bf16_t;
typedef short bf16x8 __attribute__((ext_vector_type(8)));
typedef short s16x4 __attribute__((ext_vector_type(4)));
typedef float f32x2 __attribute__((ext_vector_type(2)));
typedef float f32x4 __attribute__((ext_vector_type(4)));
typedef float f32x16 __attribute__((ext_vector_type(16)));
typedef unsigned u32x2 __attribute__((ext_vector_type(2)));
typedef unsigned u32x4 __attribute__((ext_vector_type(4)));
typedef int i32x4 __attribute__((ext_vector_type(4)));
typedef int i32x8 __attribute__((ext_vector_type(8)));

constexpr int DM = 4096, NB = 4, SEQ = 4096, NMETA = 16, DEPTH = 4;
constexpr int MREAL = NB * SEQ;
constexpr int META0 = MREAL;
constexpr int MUSED = MREAL + NMETA;
constexpr int MPAD = 16640;
constexpr int DFF = 11008;
constexpr int NPOS = NMETA + SEQ;
constexpr float EPS = 1e-6f;
constexpr int EV_N = 7680, EV_QF = 0, EV_KF = 2048, EV_VF = 4096, EV_CQ = 6144, EV_CKV = 7040, EV_KR = 7360, EV_FL = 7424;
constexpr int QRANK = 896, KVRANK = 320, KVK = 384;
constexpr int UQ_N = 3072, UKV_N = 4096, OD_N = 12288, GU_N = 2 * DFF;
constexpr int EV_SRC_N = 7440;
constexpr int AMAXP_LD = 352;
constexpr int LD_DM = 4160, LD_FF = 11072, LD_EV = 7744, LD_OD = 12352, LD_UQ = 3136, LD_UKV = 4160, LD_QR = 960, LD_KV = 448;

__device__ __forceinline__ unsigned cvt_pk_bf16(float lo, float hi) { unsigned r; asm volatile("v_cvt_pk_bf16_f32 %0, %1, %2" : "=v"(r) : "v"(lo), "v"(hi)); return r; }
__device__ __forceinline__ float bf_lo(unsigned w) { return __uint_as_float(w << 16); }
__device__ __forceinline__ float bf_hi(unsigned w) { return __uint_as_float(w & 0xffff0000u); }
__device__ __forceinline__ float wave_sum(float v) {
#pragma unroll
    for (int o = 1; o < 64; o <<= 1) v += __shfl_xor(v, o);
    return v;
}

__device__ __forceinline__ int opq_tid(int wave) {
    int l; asm volatile("v_mbcnt_lo_u32_b32 %0, -1, 0\n\tv_mbcnt_hi_u32_b32 %0, -1, %0" : "=v"(l));
    return (wave << 6) | l;
}

__device__ __forceinline__ int opq_s(int v) { asm volatile("" : "+s"(v)); return v; }

namespace pg8 {
#define PG8_LAS __attribute__((address_space(3)))
constexpr int RS_LDS_OFF = 131072;
constexpr int BM = 256, BK = 64, HALF = 128, HTB = HALF * BK * 2  , STAGE_BYTES = 8 * HTB, NXCD = 8, WGM = 8;

__host__ __device__ __forceinline__ int lds_byte(int r, int c) { const int st = (r >> 4) * 2 + (c >> 5), rr = r & 15, cc = c & 31, ob = rr * 64 + cc * 2; return st * 1024 + (ob ^ (((ob >> 9) & 1) << 5)); }
__host__ __device__ __forceinline__ void stage_rc(int b, int& R, int& C) { const int st = b / 1024, sb = b % 1024, swz = sb ^ (((sb >> 9) & 1) << 5); R = (st >> 1) * 16 + swz / 64; C = (st & 1) * 32 + (swz % 64) / 2; }
__host__ __device__ __forceinline__ int perm32(int rho) { const int n = rho >> 4, i = rho & 15; return 8 * (i >> 2) + 4 * n + (i & 3); }

struct Unit { int pm, pn, ko, ks; };
struct Gemm { const bf16_t* A; const bf16_t* Bt; int lda, ldb, K; };

struct StaticOrder {
    int nM, nN, nwg, G, c, wgm;
    __host__ __device__ void init(int M, int N, int G_, int c_, int wgm_ = WGM) { nM = M / BM; nN = N / BM; nwg = nM * nN; G = G_; c = c_; wgm = wgm_; }
    __host__ __device__ bool next(int i, Unit& u) const {
        const long L = (long)i * G + c; if (L >= nwg) return false;
        int wgid = (int)L; { const int q = nwg / NXCD, r = nwg % NXCD, xcd = wgid % NXCD, off = wgid / NXCD; wgid = (xcd < r ? xcd * (q + 1) : r * (q + 1) + (xcd - r) * q) + off; }
        const int nig = wgm * nN, gid = wgid / nig, fm = gid * wgm, gsz = (nM - fm) < wgm ? (nM - fm) : wgm;
        u.pm = fm + ((wgid % nig) % gsz); u.pn = (wgid % nig) / gsz; u.ko = 0; u.ks = 0; return true;
    }
    __device__ __forceinline__ void a_ready(const Unit&) const {}
    __device__ __forceinline__ void done(const Unit&) const {}
};
struct SplitKOrder {
    int pm, nN, nS, kslice, G, c;
    __host__ __device__ void init(int pm_, int N, int nS_, int kslice_, int G_, int c_) { pm = pm_; nN = N / BM; nS = nS_; kslice = kslice_; G = G_; c = c_; }
    __host__ __device__ bool next(int i, Unit& u) const {
        const int L = i * G + c; if (L >= nN * nS) return false;
        u.pm = pm; u.pn = L % nN; u.ks = L / nN; u.ko = u.ks * kslice; return true;
    }
    __device__ __forceinline__ void a_ready(const Unit&) const {}
    __device__ __forceinline__ void done(const Unit&) const {}
};

struct EpiCtx {
    bf16_t* O; int ldc;
    const float* rs;
    float* statq; float* statkv;
    float* flogT;
    const float* cosT; const float* sinT;
    float* statm;
    float* part;
    const float* cs;
    float* amaxp;
};
__device__ __forceinline__ int row_pos(int row) { return row < MREAL ? NMETA + (row & (SEQ - 1)) : row - META0; }
__device__ __forceinline__ void store8(bf16_t* p, f32x4 v0, f32x4 v1) {
    u32x4 w; w.x = cvt_pk_bf16(v0[0], v0[1]); w.y = cvt_pk_bf16(v0[2], v0[3]); w.z = cvt_pk_bf16(v1[0], v1[1]); w.w = cvt_pk_bf16(v1[2], v1[3]);
    *(u32x4*)p = w;
}
__device__ __forceinline__ float sel4(const float (&a)[4], int i) { return i == 0 ? a[0] : (i == 1 ? a[1] : (i == 2 ? a[2] : a[3])); }
__device__ __forceinline__ float sq8(f32x4 a, f32x4 b) { return (a[0] * a[0] + a[1] * a[1]) + (a[2] * a[2] + a[3] * a[3]) + (b[0] * b[0] + b[1] * b[1]) + (b[2] * b[2] + b[3] * b[3]); }
__device__ __forceinline__ float silu_mul(float g, float u) { return g * __builtin_amdgcn_rcpf(1.0f + __builtin_amdgcn_exp2f(-1.4426950408889634f * g)) * u; }

__device__ __forceinline__ void fwht32_lanes(f32x4& a, f32x4& b, float s16, float s32) {
    f32x4 t;
    t = (f32x4){a[0] + a[1], a[0] - a[1], a[2] + a[3], a[2] - a[3]}; a = (f32x4){t[0] + t[2], t[1] + t[3], t[0] - t[2], t[1] - t[3]};
    t = (f32x4){b[0] + b[1], b[0] - b[1], b[2] + b[3], b[2] - b[3]}; b = (f32x4){t[0] + t[2], t[1] + t[3], t[0] - t[2], t[1] - t[3]};
    t = a + b; b = a - b; a = t;
#pragma unroll
    for (int j = 0; j < 4; ++j) {
        auto r = __builtin_amdgcn_permlane16_swap(__float_as_uint(a[j]), __float_as_uint(a[j]), false, false); a[j] = __builtin_fmaf(s16, __uint_as_float(r[1]), __uint_as_float(r[0]));
        auto q = __builtin_amdgcn_permlane16_swap(__float_as_uint(b[j]), __float_as_uint(b[j]), false, false); b[j] = __builtin_fmaf(s16, __uint_as_float(q[1]), __uint_as_float(q[0])); }
#pragma unroll
    for (int j = 0; j < 4; ++j) {
        auto r = __builtin_amdgcn_permlane32_swap(__float_as_uint(a[j]), __float_as_uint(a[j]), false, false); a[j] = __builtin_fmaf(s32, __uint_as_float(r[1]), __uint_as_float(r[0]));
        auto q = __builtin_amdgcn_permlane32_swap(__float_as_uint(b[j]), __float_as_uint(b[j]), false, false); b[j] = __builtin_fmaf(s32, __uint_as_float(q[1]), __uint_as_float(q[0])); }
}
template <int MODE> struct Epi {
    static constexpr bool PERM = true, AFTER_DRAIN = false;
    EpiCtx c;
    static constexpr bool EVM = (MODE == 1 || MODE == 9), I8M = (MODE == 8 || MODE == 9 || MODE == 10), OUTM = (MODE == 4 || MODE == 10);
    static constexpr bool RS_LDS = (MODE == 0 || MODE == 1 || MODE == 5 || MODE == 7 || MODE == 8 || MODE == 9 || MODE == 10), CS_LDS = (MODE == 7 || MODE == 8 || MODE == 9 || MODE == 10);
    __device__ __forceinline__ void pre(const Unit& u, PG8_LAS unsigned char* slot, int wid) const {
        if constexpr (RS_LDS) { if (wid < 4) { int l; asm volatile("v_mbcnt_lo_u32_b32 %0, -1, 0\n\tv_mbcnt_hi_u32_b32 %0, -1, %0" : "=v"(l));
            const char* b = (const char*)(c.rs + u.pm * BM + wid * 64); asm volatile("" : "+s"(b));
            __builtin_amdgcn_global_load_lds((const unsigned*)(b + (unsigned)(l * 4)), (PG8_LAS unsigned*)(slot + wid * 256), 4, 0, 0); } }
        if constexpr (CS_LDS) { if (wid >= 4) { int l; asm volatile("v_mbcnt_lo_u32_b32 %0, -1, 0\n\tv_mbcnt_hi_u32_b32 %0, -1, %0" : "=v"(l));
            const char* b = (const char*)(c.cs + u.pn * BM + (wid - 4) * 64); asm volatile("" : "+s"(b));
            __builtin_amdgcn_global_load_lds((const unsigned*)(b + (unsigned)(l * 4)), (PG8_LAS unsigned*)(slot + 2048 + (wid - 4) * 256), 4, 0, 0); } }
    }
    __device__ __forceinline__ void operator()(const f32x4 (&acc)[2][2][4][2], const Unit& u, int wr, int wc, int fr, int fq, const PG8_LAS float* rsl) const {
        int pm_ = u.pm, pn_ = u.pn; asm volatile("" : "+s"(pm_), "+s"(pn_));
        if constexpr (MODE == 6) {
            if (wr == 0) { float* P = c.part + (unsigned)((u.ks * 16 + fr) * c.ldc + pn_ * BM + wc * 32 + 8 * fq);
#pragma unroll
                for (int bj = 0; bj < 2; ++bj) { *(f32x4*)(P + bj * HALF) = acc[0][bj][0][0]; *(f32x4*)(P + bj * HALF + 4) = acc[0][bj][0][1]; } }
            return;
        }
        const Unit uu{pm_, pn_};
        const int row0 = uu.pm * BM + wr * 64 + fr;
        float s[2][4];
#pragma unroll
        for (int ai = 0; ai < 2; ++ai)
#pragma unroll
            for (int m = 0; m < 4; ++m) {
                const int row = row0 + ai * HALF + m * 16;
                if constexpr (RS_LDS) s[ai][m] = rsl[ai * HALF + wr * 64 + m * 16 + fr];
                else if constexpr (MODE == 2) { const f32x4* q = (const f32x4*)(c.rs + (unsigned)(row * 32)); f32x4 t = q[0];
#pragma unroll
                    for (int k = 1; k < 7; ++k) t += q[k];
                    s[ai][m] = __builtin_amdgcn_rsqf(((t[0] + t[1]) + (t[2] + t[3])) * (1.0f / QRANK) + EPS); }
                else if constexpr (MODE == 3) { const f32x4* q = (const f32x4*)(c.rs + (unsigned)(row * 16)); const f32x4 t = q[0] + q[1]; const f32x2 t2 = *(const f32x2*)(q + 2);
                    s[ai][m] = __builtin_amdgcn_rsqf((((t[0] + t[1]) + (t[2] + t[3])) + (t2[0] + t2[1])) * (1.0f / KVRANK) + EPS); }
                else s[ai][m] = 1.0f;
            }
        if constexpr (MODE == 7) {
            const int col0 = uu.pn * HALF + wc * 32 + 8 * fq;
            const PG8_LAS float* csl = rsl + 512 + wc * 32 + 8 * fq;
            const f32x4 cg0 = *(const PG8_LAS f32x4*)csl, cg1 = *(const PG8_LAS f32x4*)(csl + 4), cu0 = *(const PG8_LAS f32x4*)(csl + HALF), cu1 = *(const PG8_LAS f32x4*)(csl + HALF + 4);
#pragma unroll
            for (int ai = 0; ai < 2; ++ai)
#pragma unroll
                for (int m = 0; m < 4; ++m) {
                    const int row = row0 + ai * HALF + m * 16; const float sc = s[ai][m];
                    const f32x4 g0 = __builtin_convertvector(__builtin_bit_cast(i32x4, acc[ai][0][m][0]), f32x4) * (cg0 * sc), g1 = __builtin_convertvector(__builtin_bit_cast(i32x4, acc[ai][0][m][1]), f32x4) * (cg1 * sc);
                    const f32x4 u0 = __builtin_convertvector(__builtin_bit_cast(i32x4, acc[ai][1][m][0]), f32x4) * (cu0 * sc), u1 = __builtin_convertvector(__builtin_bit_cast(i32x4, acc[ai][1][m][1]), f32x4) * (cu1 * sc);
                    f32x4 e0 = g0 * -1.4426950408889634f, e1 = g1 * -1.4426950408889634f;
#pragma unroll
                    for (int j = 0; j < 4; ++j) { e0[j] = __builtin_amdgcn_exp2f(e0[j]); e1[j] = __builtin_amdgcn_exp2f(e1[j]); }
                    e0 = e0 + 1.0f; e1 = e1 + 1.0f;
                    const f32x4 p0 = g0 * u0, p1 = g1 * u1;
#pragma unroll
                    for (int j = 0; j < 4; ++j) { e0[j] = __builtin_amdgcn_rcpf(e0[j]); e1[j] = __builtin_amdgcn_rcpf(e1[j]); }
                    store8(c.O + (unsigned)(row * c.ldc + col0), p0 * e0, p1 * e1);
                }
            return;
        } else if constexpr (MODE == 5) {
            const int col0 = uu.pn * HALF + wc * 32 + 8 * fq;
#pragma unroll
            for (int ai = 0; ai < 2; ++ai)
#pragma unroll
                for (int m = 0; m < 4; ++m) {
                    const int row = row0 + ai * HALF + m * 16; const float sc = s[ai][m];
                    const f32x4 g0 = acc[ai][0][m][0] * sc, g1 = acc[ai][0][m][1] * sc, u0 = acc[ai][1][m][0] * sc, u1 = acc[ai][1][m][1] * sc;
                    f32x4 o0, o1;
#pragma unroll
                    for (int j = 0; j < 4; ++j) { o0[j] = silu_mul(g0[j], u0[j]); o1[j] = silu_mul(g1[j], u1[j]); }
                    store8(c.O + (unsigned)(row * c.ldc + col0), o0, o1);
                }
            return;
        } else {
            float ssm[2][4];
            if constexpr (OUTM) {
#pragma unroll
                for (int ai = 0; ai < 2; ++ai)
#pragma unroll
                    for (int m = 0; m < 4; ++m) ssm[ai][m] = 0.f;
            }
#pragma unroll
            for (int bj = 0; bj < 2; ++bj) {
                const int gcol = uu.pn * BM + bj * HALF + wc * 32;
                const int col0 = gcol + 8 * fq;
                bool rope = false; int i0 = 0;
                if constexpr (EVM) { rope = (gcol >= EV_KR && gcol < EV_FL); i0 = (col0 - EV_KR) >> 1; }
                if constexpr (MODE == 2) { rope = (gcol >= 2048); i0 = ((col0 - 2048) & 63) >> 1; }
                f32x4 c0 = {1.f, 1.f, 1.f, 1.f}, c1 = c0;
                if constexpr (I8M) { const PG8_LAS float* csl = rsl + 512 + bj * HALF + wc * 32 + 8 * fq; c0 = *(const PG8_LAS f32x4*)csl; c1 = *(const PG8_LAS f32x4*)(csl + 4); }
                if ((EVM || MODE == 2) && rope) {
#pragma unroll
                    for (int ai = 0; ai < 2; ++ai)
#pragma unroll
                        for (int m = 0; m < 4; ++m) {
                            const int row = row0 + ai * HALF + m * 16; const float sc = s[ai][m]; const int pos = row_pos(row);
                            const f32x4 cs = *(const f32x4*)(c.cosT + (unsigned)(pos * 32 + i0)), sn = *(const f32x4*)(c.sinT + (unsigned)(pos * 32 + i0));
                            f32x4 x1, x2;
                            if constexpr (I8M) { x1 = __builtin_convertvector(__builtin_bit_cast(i32x4, acc[ai][bj][m][0]), f32x4) * (c0 * sc); x2 = __builtin_convertvector(__builtin_bit_cast(i32x4, acc[ai][bj][m][1]), f32x4) * (c1 * sc); }
                            else { x1 = acc[ai][bj][m][0] * sc; x2 = acc[ai][bj][m][1] * sc; }
                            store8(c.O + (unsigned)(row * c.ldc + col0), x1 * cs - x2 * sn, x1 * sn + x2 * cs);
                            asm volatile("" ::: "memory");
                        }
                } else {
                    float ss[2][4];
#pragma unroll
                    for (int ai = 0; ai < 2; ++ai)
#pragma unroll
                        for (int m = 0; m < 4; ++m) {
                            const int row = row0 + ai * HALF + m * 16; const float sc = s[ai][m];
                            f32x4 v0, v1;
                            if constexpr (I8M) { v0 = __builtin_convertvector(__builtin_bit_cast(i32x4, acc[ai][bj][m][0]), f32x4) * (c0 * sc); v1 = __builtin_convertvector(__builtin_bit_cast(i32x4, acc[ai][bj][m][1]), f32x4) * (c1 * sc); }
                            else { v0 = acc[ai][bj][m][0] * sc; v1 = acc[ai][bj][m][1] * sc; }
                            store8(c.O + (unsigned)(row * c.ldc + col0), v0, v1);
                            if constexpr (EVM) {
                                ss[ai][m] = sq8(v0, v1);
                                if (gcol == EV_FL && fq < 2) {
#pragma unroll
                                    for (int j = 0; j < 4; ++j) { c.flogT[(unsigned)((8 * fq + j) * MPAD + row)] = v0[j]; c.flogT[(unsigned)((8 * fq + 4 + j) * MPAD + row)] = v1[j]; }
                                }
                            }
                            if constexpr (OUTM) ssm[ai][m] += sq8(v0, v1);
                            asm volatile("" ::: "memory");
                        }
                    if constexpr (EVM) {
                        if (gcol >= EV_CQ && gcol < EV_KR) {
                            const bool isq = gcol < EV_CKV; float* tgt = isq ? c.statq : c.statkv; const int ld = isq ? 32 : 16, slot = (gcol - (isq ? EV_CQ : EV_CKV)) >> 5;
#pragma unroll
                            for (int ai = 0; ai < 2; ++ai) {
#pragma unroll
                                for (int m = 0; m < 4; ++m) { ss[ai][m] += __shfl_xor(ss[ai][m], 16); ss[ai][m] += __shfl_xor(ss[ai][m], 32); }
                                tgt[(unsigned)((row0 + ai * HALF + fq * 16) * ld + slot)] = sel4(ss[ai], fq);
                            }
                        }
                    }
                }
            }
            if constexpr (OUTM) {
#pragma unroll
                for (int ai = 0; ai < 2; ++ai) {
#pragma unroll
                    for (int m = 0; m < 4; ++m) { ssm[ai][m] += __shfl_xor(ssm[ai][m], 16); ssm[ai][m] += __shfl_xor(ssm[ai][m], 32); }
                    c.statm[(unsigned)((row0 + ai * HALF + fq * 16) * 64 + uu.pn * 4 + wc)] = sel4(ssm[ai], fq);
                }
            }
        }
    }
};
template <int DT> __device__ __forceinline__ f32x4 mma_k2(const bf16x8 (&b)[2], const bf16x8 (&a)[2], f32x4 c) {
    if constexpr (DT == 1) {
        typedef short s16x16 __attribute__((ext_vector_type(16)));
        const s16x16 bb = __builtin_shufflevector(b[0], b[1], 0, 1, 2, 3, 4, 5, 6, 7, 8, 9, 10, 11, 12, 13, 14, 15), aa = __builtin_shufflevector(a[0], a[1], 0, 1, 2, 3, 4, 5, 6, 7, 8, 9, 10, 11, 12, 13, 14, 15);
        return __builtin_amdgcn_mfma_scale_f32_16x16x128_f8f6f4(__builtin_bit_cast(i32x8, bb), __builtin_bit_cast(i32x8, aa), c, 0, 0, 0, 0, 0, 0);
    } else if constexpr (DT == 2) {
        i32x4 ci = __builtin_bit_cast(i32x4, c);
        ci = __builtin_amdgcn_mfma_i32_16x16x64_i8(__builtin_bit_cast(i32x4, b[0]), __builtin_bit_cast(i32x4, a[0]), ci, 0, 0, 0);
        ci = __builtin_amdgcn_mfma_i32_16x16x64_i8(__builtin_bit_cast(i32x4, b[1]), __builtin_bit_cast(i32x4, a[1]), ci, 0, 0, 0);
        return __builtin_bit_cast(f32x4, ci);
    } else {
        c = __builtin_amdgcn_mfma_f32_16x16x32_bf16(b[0], a[0], c, 0, 0, 0);
        return __builtin_amdgcn_mfma_f32_16x16x32_bf16(b[1], a[1], c, 0, 0, 0);
    }
}
template <class Epi, class Sched, bool ALIGN_EPI = false, bool SP2 = false, int DT = 0>
__device__ __forceinline__ void gemm_phase(PG8_LAS unsigned char* lds, const Gemm g, const Sched& S, const Epi& E, const int tid) {
    const int wid = __builtin_amdgcn_readfirstlane(tid >> 6), lane = tid & 63, wr = wid >> 2, wc = wid & 3, fr = lane & 15, fq = lane >> 4;
    const int K = g.K; int nt = K / BK; if (K < 1024) asm volatile("" : "+s"(nt));
    unsigned voffA[2], voffB[2];
#pragma unroll
    for (int i = 0; i < 2; ++i) { int R, C; stage_rc(tid * 16 + i * 8192, R, C); const int Rb = Epi::PERM ? ((R & ~31) + perm32(R & 31)) : R;
        voffA[i] = (unsigned)(R * g.lda + C) * 2u; voffB[i] = (unsigned)(Rb * g.ldb + C) * 2u; }
    const size_t kstep = (size_t)(BK * 2);
    const size_t hstepA = (size_t)HALF * g.lda * 2, hstepB = (size_t)HALF * g.ldb * 2;
    const size_t tstepA = 2 * hstepA, tstepB = 2 * hstepB;
    const unsigned ldsw = (unsigned)wid * 1024u;
    const int aoff = lds_byte(wr * 64 + fr, fq * 8), boff = lds_byte(wc * 32 + fr, fq * 8);
#define PG8_SA(b, h) (((b) * 2 + (h)) * HTB)
#define PG8_SB(b, h) ((4 + (b) * 2 + (h)) * HTB)
#define PG8_STAGE(bufoff, gbase, voff) do { const char* _b = (const char*)(gbase); asm volatile("" : "+s"(_b));     \
        _Pragma("unroll") for (int _i = 0; _i < 2; ++_i) { unsigned _v = (voff)[_i]; asm volatile("" : "+v"(_v)); \
        __builtin_amdgcn_global_load_lds((const unsigned*)(_b + _v), (PG8_LAS unsigned*)(lds + (bufoff) + ldsw + _i * 8192), 16, 0, 0); } } while (0)
#define PG8_LDA(dst, b, h) do { _Pragma("unroll") for (int m = 0; m < 4; ++m) _Pragma("unroll") for (int k = 0; k < 2; ++k) dst[m][k] = *(const PG8_LAS bf16x8*)(lds + PG8_SA(b, h) + aoff + m * 2048 + k * 1024); } while (0)
#define PG8_LDB(dst, b, h) do { _Pragma("unroll") for (int n = 0; n < 2; ++n) _Pragma("unroll") for (int k = 0; k < 2; ++k) dst[n][k] = *(const PG8_LAS bf16x8*)(lds + PG8_SB(b, h) + boff + n * 2048 + k * 1024); } while (0)
#define PG8_MMA(ai, bj, At, Bt) do { __builtin_amdgcn_s_setprio(1); _Pragma("unroll") for (int m = 0; m < 4; ++m) _Pragma("unroll") for (int n = 0; n < 2; ++n) \
        acc[ai][bj][m][n] = mma_k2<DT>(Bt[n], At[m], acc[ai][bj][m][n]); __builtin_amdgcn_s_setprio(0); } while (0)
#define PG8_WAIT_V(n) asm volatile("s_waitcnt vmcnt(" #n ")" ::: "memory")
#define PG8_WAIT_L(n) asm volatile("s_waitcnt lgkmcnt(" #n ")" ::: "memory")
#define PG8_BAR __builtin_amdgcn_s_barrier()
#define PG8_SCHED __builtin_amdgcn_sched_barrier(0)
    Unit cur, nxt; int ui = 0;
    if (!S.next(0, cur)) return;
    f32x4 acc[2][2][4][2];
#pragma unroll
    for (int a = 0; a < 2; ++a)
#pragma unroll
        for (int b = 0; b < 2; ++b)
#pragma unroll
            for (int m = 0; m < 4; ++m)
#pragma unroll
                for (int n = 0; n < 2; ++n) acc[a][b][m][n] = (f32x4){0.f, 0.f, 0.f, 0.f};
    bf16x8 At[4][2], B0[2][2], B1[2][2];
    const char* cA = (const char*)g.A + (size_t)cur.pm * tstepA + (size_t)cur.ko * 2; const char* cB = (const char*)g.Bt + (size_t)cur.pn * tstepB + (size_t)cur.ko * 2;
    S.a_ready(cur);
    E.pre(cur, lds + RS_LDS_OFF, wid);
    if constexpr (SP2) {
        PG8_STAGE(PG8_SB(0, 0), cB, voffB); PG8_STAGE(PG8_SB(0, 1), cB + hstepB, voffB); PG8_STAGE(PG8_SA(0, 0), cA, voffA); PG8_STAGE(PG8_SA(0, 1), cA + hstepA, voffA);
        if (wr == 1) PG8_BAR;
        PG8_WAIT_V(2); PG8_BAR;
        PG8_STAGE(PG8_SB(1, 0), cB + kstep, voffB); PG8_STAGE(PG8_SA(1, 0), cA + kstep, voffA); PG8_STAGE(PG8_SB(1, 1), cB + hstepB + kstep, voffB);
        PG8_WAIT_V(6); PG8_BAR;
    } else {
        PG8_STAGE(PG8_SB(0, 0), cB, voffB); PG8_STAGE(PG8_SA(0, 0), cA, voffA); PG8_STAGE(PG8_SB(0, 1), cB + hstepB, voffB); PG8_STAGE(PG8_SA(0, 1), cA + hstepA, voffA);
        if (wr == 1) PG8_BAR;
        PG8_WAIT_V(4); PG8_BAR;
        PG8_STAGE(PG8_SB(1, 0), cB + kstep, voffB); PG8_STAGE(PG8_SA(1, 0), cA + kstep, voffA); PG8_STAGE(PG8_SB(1, 1), cB + hstepB + kstep, voffB);
        PG8_WAIT_V(6); PG8_BAR;
    }
    for (;;) {
        const bool has_next = S.next(ui + 1, nxt);
        const char* nA = has_next ? (const char*)g.A + (size_t)nxt.pm * tstepA + (size_t)nxt.ko * 2 : cA; const char* nB = has_next ? (const char*)g.Bt + (size_t)nxt.pn * tstepB + (size_t)nxt.ko * 2 : cB;
        for (int t = 0; t < nt; t += 2) {
            const bool last = (t == nt - 2);
            const char* a1 = cA + (size_t)(t + 1) * kstep;
            const char* a2 = last ? nA : cA + (size_t)(t + 2) * kstep; const char* b2 = last ? nB : cB + (size_t)(t + 2) * kstep;
            const char* a3 = a2 + kstep; const char* b3 = b2 + kstep;
            if (last && has_next) { S.a_ready(nxt); E.pre(nxt, lds + RS_LDS_OFF + ((ui + 1) & 1) * 1024, wid); }
            if constexpr (SP2) {
            PG8_LDB(B0, 0, 0); PG8_LDB(B1, 0, 1); PG8_SCHED; PG8_LDA(At, 0, 0); PG8_STAGE(PG8_SA(1, 1), a1 + hstepA, voffA);
            PG8_WAIT_V(8); PG8_WAIT_L(0); PG8_BAR; PG8_MMA(0, 0, At, B0); PG8_MMA(0, 1, At, B1); PG8_BAR; PG8_SCHED;
            PG8_LDA(At, 0, 1); PG8_STAGE(PG8_SB(0, 0), b2, voffB); PG8_STAGE(PG8_SB(0, 1), b2 + hstepB, voffB); PG8_STAGE(PG8_SA(0, 0), a2, voffA);
            PG8_WAIT_V(8); PG8_WAIT_L(0); PG8_BAR; PG8_MMA(1, 0, At, B0); PG8_MMA(1, 1, At, B1); PG8_BAR; PG8_SCHED;
            PG8_LDB(B0, 1, 0); PG8_LDB(B1, 1, 1); PG8_SCHED; PG8_LDA(At, 1, 0); PG8_STAGE(PG8_SA(0, 1), a2 + hstepA, voffA);
            PG8_WAIT_V(8); PG8_WAIT_L(0); PG8_BAR; PG8_MMA(0, 0, At, B0); PG8_MMA(0, 1, At, B1); PG8_BAR; PG8_SCHED;
            PG8_LDA(At, 1, 1); PG8_STAGE(PG8_SB(1, 0), b3, voffB); PG8_STAGE(PG8_SB(1, 1), b3 + hstepB, voffB); PG8_STAGE(PG8_SA(1, 0), a3, voffA);
            PG8_WAIT_V(8); PG8_WAIT_L(0); PG8_BAR; PG8_MMA(1, 0, At, B0); PG8_MMA(1, 1, At, B1); PG8_BAR; PG8_SCHED;
            } else {
            PG8_LDB(B0, 0, 0); PG8_SCHED; PG8_LDA(At, 0, 0); PG8_STAGE(PG8_SA(1, 1), a1 + hstepA, voffA);
            PG8_WAIT_L(8); PG8_BAR; PG8_WAIT_L(0); PG8_MMA(0, 0, At, B0); PG8_BAR; PG8_SCHED;
            PG8_LDB(B1, 0, 1); PG8_STAGE(PG8_SB(0, 0), b2, voffB);
            PG8_BAR; PG8_WAIT_L(0); PG8_MMA(0, 1, At, B1); PG8_BAR;
            PG8_LDA(At, 0, 1); PG8_STAGE(PG8_SA(0, 0), a2, voffA);
            PG8_BAR; PG8_WAIT_L(0); PG8_MMA(1, 0, At, B0); PG8_BAR; PG8_SCHED;
            PG8_STAGE(PG8_SB(0, 1), b2 + hstepB, voffB);
            PG8_WAIT_V(6); PG8_BAR; PG8_MMA(1, 1, At, B1); PG8_BAR;
            PG8_LDB(B0, 1, 0); PG8_SCHED; PG8_LDA(At, 1, 0); PG8_STAGE(PG8_SA(0, 1), a2 + hstepA, voffA);
            PG8_WAIT_L(8); PG8_BAR; PG8_WAIT_L(0); PG8_MMA(0, 0, At, B0); PG8_BAR; PG8_SCHED;
            PG8_LDB(B1, 1, 1); PG8_STAGE(PG8_SB(1, 0), b3, voffB);
            PG8_BAR; PG8_WAIT_L(0); PG8_MMA(0, 1, At, B1); PG8_BAR;
            PG8_LDA(At, 1, 1); PG8_STAGE(PG8_SA(1, 0), a3, voffA);
            PG8_BAR; PG8_WAIT_L(0); PG8_MMA(1, 0, At, B0); PG8_BAR; PG8_SCHED;
            PG8_STAGE(PG8_SB(1, 1), b3 + hstepB, voffB);
            PG8_WAIT_V(6); PG8_BAR; PG8_MMA(1, 1, At, B1); PG8_BAR;
            }
        }
        if constexpr (ALIGN_EPI) { if (wr == 0) PG8_BAR; }
        if constexpr (!Epi::AFTER_DRAIN) { int l2; asm volatile("v_mbcnt_lo_u32_b32 %0, -1, 0\n\tv_mbcnt_hi_u32_b32 %0, -1, %0" : "=v"(l2));
            E(acc, cur, wr, wc, l2 & 15, l2 >> 4, (const PG8_LAS float*)(lds + RS_LDS_OFF + (ui & 1) * 1024)); S.done(cur); }
        if (!has_next) break;
#pragma unroll
        for (int a = 0; a < 2; ++a)
#pragma unroll
            for (int b = 0; b < 2; ++b)
#pragma unroll
                for (int m = 0; m < 4; ++m)
#pragma unroll
                    for (int n = 0; n < 2; ++n) acc[a][b][m][n] = (f32x4){0.f, 0.f, 0.f, 0.f};
        cur = nxt; cA = nA; cB = nB; ++ui;
        if constexpr (ALIGN_EPI) { if (wr == 1) PG8_BAR; }
    }
    PG8_WAIT_V(0);
    if constexpr (!ALIGN_EPI) { if (wr == 0) PG8_BAR; }
    PG8_BAR;
    if constexpr (Epi::AFTER_DRAIN) { E.fused(acc, cur, wr, wc, fr, fq, lds, wid, lane); S.done(cur); }
#undef PG8_SA
#undef PG8_SB
#undef PG8_STAGE
#undef PG8_LDA
#undef PG8_LDB
#undef PG8_MMA
#undef PG8_WAIT_V
#undef PG8_WAIT_L
#undef PG8_BAR
#undef PG8_SCHED
}
}
using pg8::sq8; using pg8::store8;

namespace att {
constexpr int SHM_V = 16384, SHM_K = 16384, SHM_K2 = 8192;
constexpr int OFF_V = 0, OFF_K = 2 * SHM_V, OFF_K2 = OFF_K + 2 * SHM_K, OFF_BIAS = OFF_K2 + 2 * SHM_K2, OFF_TBL = OFF_BIAS + 512, OFF_WS = OFF_TBL + 512, LDS_END = OFF_WS + 8 * 256;
constexpr float THR = 8.f;
#define KSWZ(row, colB) ((row) * 256 + ((colB) ^ (((row) & 15) << 4)))
#define K2SWZ(row, colB) ((row) * 128 + ((colB) ^ ((((row) >> 1) & 7) << 4)))
#define SBAR() __builtin_amdgcn_sched_barrier(0)
__device__ __forceinline__ int v_st(int k, int c) { const int kk = (k & ~0xC) | ((k & 4) << 1) | ((k & 8) >> 1); return ((kk >> 3) * 4 + (c >> 5)) * 512 + ((kk & 7) * 32 + (c & 31)) * 2; }
__device__ __forceinline__ int v_rd_base(int lane) { return ((lane & 3) << 3) | (((lane >> 2) & 3) << 6) | (((lane >> 4) & 1) << 5) | (((lane >> 5) & 1) << 8); }
constexpr int v_rd_off(int d0, int ks, int half) { return d0 * 512 + ks * 4096 + half * 2048; }
__device__ __forceinline__ int crow(int r, int hi) { return (r & 3) + 8 * (r >> 2) + 4 * hi; }

template <int MODE> struct Cfg { static constexpr float SCALE = (MODE == 1) ? 0.07216878364870322f : 0.08838834764831845f; static constexpr int DK = (MODE == 1) ? 192 : 128; };

__device__ __forceinline__ void mask_tile(f32x16& p0, f32x16& p1, int lim) {
    const float NEG = -__builtin_inff();
#pragma unroll
    for (int r = 0; r < 16; ++r) {
        const int c = (r & 3) + 8 * (r >> 2);
        if (c > lim) p0[r] = NEG;
        if (c + 32 > lim) p1[r] = NEG;
    }
}
__device__ __forceinline__ void t5_bias(f32x16& p0, f32x16& p1, const LAS float* tbl, int dd) {
#pragma unroll
    for (int g = 0; g < 4; ++g) {
#pragma unroll
        for (int j = 0; j < 4; ++j) { const int r = 4 * g + j, c = (r & 3) + 8 * (r >> 2);
            int i0 = dd - c; i0 = i0 < 0 ? 0 : (i0 > 127 ? 127 : i0);
            int i1 = dd - c - 32; i1 = i1 < 0 ? 0 : (i1 > 127 ? 127 : i1);
            p0[r] += tbl[i0]; p1[r] += tbl[i1]; }
        asm volatile("" ::: "memory");
    }
}
template <int MODE>
__device__ __forceinline__ void partialSM(f32x16& p0, f32x16& p1, float& m_reg, float& mn, float& alpha) {
    constexpr float SCALE = Cfg<MODE>::SCALE;
    float pmax = p0[0];
#pragma unroll
    for (int r = 1; r < 16; ++r) pmax = fmaxf(pmax, p0[r]);
#pragma unroll
    for (int r = 0; r < 16; ++r) pmax = fmaxf(pmax, p1[r]);
    { auto rr = __builtin_amdgcn_permlane32_swap(__float_as_uint(pmax), __float_as_uint(pmax), false, false);
      pmax = fmaxf(__uint_as_float(rr[0]), __uint_as_float(rr[1])); }
    constexpr float C2 = 1.4426950408889634f * SCALE;
    if (__builtin_expect(__all((pmax - m_reg) * SCALE <= THR), 1)) { mn = m_reg; alpha = 1.f; }
    else { mn = fmaxf(m_reg, pmax); alpha = __builtin_amdgcn_exp2f((m_reg - mn) * C2); m_reg = mn; }
    const float mnL = -mn * C2;
#pragma unroll
    for (int r = 0; r < 16; ++r) p0[r] = fmaf(p0[r], C2, mnL);
#pragma unroll
    for (int r = 0; r < 16; ++r) p1[r] = fmaf(p1[r], C2, mnL);
#pragma unroll
    for (int r = 0; r < 16; ++r) p0[r] = __builtin_amdgcn_exp2f(p0[r]);
}
__device__ __forceinline__ void finishSM(f32x16& p0, f32x16& p1, float alpha, float& l_reg, bf16x8& pa0, bf16x8& pa1, bf16x8& pa2, bf16x8& pa3) {
#pragma unroll
    for (int r = 0; r < 16; ++r) p1[r] = __builtin_amdgcn_exp2f(p1[r]);
    float ps = 0;
#pragma unroll
    for (int r = 0; r < 16; ++r) ps += p0[r];
#pragma unroll
    for (int r = 0; r < 16; ++r) ps += p1[r];
    { auto rr = __builtin_amdgcn_permlane32_swap(__float_as_uint(ps), __float_as_uint(ps), false, false);
      ps = __uint_as_float(rr[0]) + __uint_as_float(rr[1]); }
    l_reg = l_reg * alpha + ps;
#define PK4(P, B_, OUT) do { unsigned a0 = cvt_pk_bf16(P[B_+0], P[B_+1]), a1 = cvt_pk_bf16(P[B_+2], P[B_+3]);                          \
        unsigned b0 = cvt_pk_bf16(P[B_+4], P[B_+5]), b1 = cvt_pk_bf16(P[B_+6], P[B_+7]);                                             \
        auto r0 = __builtin_amdgcn_permlane32_swap(a0, b0, false, false); auto r1 = __builtin_amdgcn_permlane32_swap(a1, b1, false, false); \
        u32x4 w = {r0[0], r1[0], r0[1], r1[1]}; OUT = *reinterpret_cast<bf16x8*>(&w); } while (0)
    PK4(p0, 0, pa0); PK4(p0, 8, pa1); PK4(p1, 0, pa2); PK4(p1, 8, pa3);
#undef PK4
}
template <int MODE>
__device__ __forceinline__ void qkt(f32x16& p0, f32x16& p1, const LAS char* Kt, const LAS char* K2t, const LAS float* biasL, int r32, int hi, const bf16x8* qr) {
    if constexpr (MODE == 0) {
        const LAS f32x4* bl = (const LAS f32x4*)biasL;
#pragma unroll
        for (int g = 0; g < 4; ++g) { const f32x4 a = bl[2 * g + hi], b = bl[8 + 2 * g + hi];
#pragma unroll
            for (int j = 0; j < 4; ++j) { p0[4 * g + j] = a[j]; p1[4 * g + j] = b[j]; } }
    } else { p0 = f32x16{}; p1 = f32x16{}; }
    const int kg_ = ((r32 & 15) << 4) ^ (hi << 4);
    const LAS char* kr_ = Kt + r32 * 256;
#pragma unroll
    for (int d0 = 0; d0 < 8; ++d0) { const LAS char* a = kr_ + (kg_ ^ (d0 << 5));
        const bf16x8 b0 = *reinterpret_cast<const LAS bf16x8*>(a);
        const bf16x8 b1 = *reinterpret_cast<const LAS bf16x8*>(a + 32 * 256);
        p0 = __builtin_amdgcn_mfma_f32_32x32x16_bf16(b0, qr[d0], p0, 0, 0, 0);
        p1 = __builtin_amdgcn_mfma_f32_32x32x16_bf16(b1, qr[d0], p1, 0, 0, 0); }
    if constexpr (MODE == 1) {
#pragma unroll
        for (int d0 = 0; d0 < 4; ++d0) { const LAS char* a = K2t + K2SWZ(r32, (d0 * 16 + hi * 8) * 2);
            const bf16x8 b0 = *reinterpret_cast<const LAS bf16x8*>(a);
            const bf16x8 b1 = *reinterpret_cast<const LAS bf16x8*>(a + 32 * 128);
            p0 = __builtin_amdgcn_mfma_f32_32x32x16_bf16(b0, qr[8 + d0], p0, 0, 0, 0);
            p1 = __builtin_amdgcn_mfma_f32_32x32x16_bf16(b1, qr[8 + d0], p1, 0, 0, 0); }
    }
}
__device__ __forceinline__ void pv_tile(f32x16* o, unsigned vb0, bf16x8 pa0, bf16x8 pa1, bf16x8 pa2, bf16x8 pa3) {
#define TRRD(dst, off) asm volatile("ds_read_b64_tr_b16 %0, %1 offset:%2" : "=&v"(dst) : "v"(vb0), "i"(off) : "memory")
#define PV_RD(S, d0) do { constexpr int b_ = v_rd_off(d0, 0, 0);     \
        TRRD(S##l0, b_); TRRD(S##h0, b_ + 2048); TRRD(S##l1, b_ + 4096); TRRD(S##h1, b_ + 6144); TRRD(S##l2, b_ + 8192); TRRD(S##h2, b_ + 10240); TRRD(S##l3, b_ + 12288); TRRD(S##h3, b_ + 14336); } while (0)
#define PV_MM(S, d0) do { \
        o[d0] = __builtin_amdgcn_mfma_f32_32x32x16_bf16(pa0, (bf16x8){S##l0[0], S##l0[1], S##l0[2], S##l0[3], S##h0[0], S##h0[1], S##h0[2], S##h0[3]}, o[d0], 0, 0, 0);   \
        o[d0] = __builtin_amdgcn_mfma_f32_32x32x16_bf16(pa1, (bf16x8){S##l1[0], S##l1[1], S##l1[2], S##l1[3], S##h1[0], S##h1[1], S##h1[2], S##h1[3]}, o[d0], 0, 0, 0);   \
        o[d0] = __builtin_amdgcn_mfma_f32_32x32x16_bf16(pa2, (bf16x8){S##l2[0], S##l2[1], S##l2[2], S##l2[3], S##h2[0], S##h2[1], S##h2[2], S##h2[3]}, o[d0], 0, 0, 0);   \
        o[d0] = __builtin_amdgcn_mfma_f32_32x32x16_bf16(pa3, (bf16x8){S##l3[0], S##l3[1], S##l3[2], S##l3[3], S##h3[0], S##h3[1], S##h3[2], S##h3[3]}, o[d0], 0, 0, 0); } while (0)
    s16x4 Al0, Al1, Al2, Al3, Ah0, Ah1, Ah2, Ah3, Bl0, Bl1, Bl2, Bl3, Bh0, Bh1, Bh2, Bh3;
    PV_RD(A, 0);
    PV_RD(B, 1); asm volatile("s_waitcnt lgkmcnt(8)" ::: "memory"); SBAR(); PV_MM(A, 0); SBAR();
    PV_RD(A, 2); asm volatile("s_waitcnt lgkmcnt(8)" ::: "memory"); SBAR(); PV_MM(B, 1); SBAR();
    PV_RD(B, 3); asm volatile("s_waitcnt lgkmcnt(8)" ::: "memory"); SBAR(); PV_MM(A, 2); SBAR();
    asm volatile("s_waitcnt lgkmcnt(0)" ::: "memory"); SBAR(); PV_MM(B, 3);
#undef PV_MM
#undef PV_RD
#undef TRRD
}

struct PassArgs {
    const bf16_t* Q; const bf16_t* Q2; const bf16_t* K; const bf16_t* K2; const bf16_t* V; const float* cum;
    int ldq, ldq2, ldk, ldk2, ldv;
    int krow0;
    int qvp0;
    int NT;
    int shift0;
};
template <int MODE>
__device__ __forceinline__ void attn_pass(const PassArgs& a, LAS char* lds, f32x16 (&o)[4], const int tid) {
    constexpr int DK = Cfg<MODE>::DK;
    constexpr float SCALE = Cfg<MODE>::SCALE, INV_SCALE = 1.0f / SCALE;
    const int wid = __builtin_amdgcn_readfirstlane(tid >> 6), lane = tid & 63, r32 = lane & 31, hi = lane >> 5;
    bf16x8 qr[DK / 16];
    { const bf16_t* qp = a.Q + (size_t)(wid * 32 + r32) * a.ldq + hi * 8;
#pragma unroll
      for (int d0 = 0; d0 < 8; ++d0) qr[d0] = *(const bf16x8*)(qp + d0 * 16);
      if constexpr (MODE == 1) { const bf16_t* qp2 = a.Q2 + (size_t)(wid * 32 + r32) * a.ldq2 + hi * 8;
#pragma unroll
          for (int d0 = 0; d0 < 4; ++d0) qr[8 + d0] = *(const bf16x8*)(qp2 + d0 * 16); } }
    const int sr = tid >> 4, sc = (tid & 15) * 8, kws = KSWZ(sr, sc * 2), vst0 = v_st(sr, sc), vst1 = v_st(32 + sr, sc);
    const int sr2 = tid >> 3, sc2 = (tid & 7) * 8, k2ws = K2SWZ(sr2, sc2 * 2);
    bf16x8 st_k0, st_k1, st_v0, st_v1, st_k2; float st_b = 0.f;
#define TROW(t) ((t) == 0 ? META0 : a.krow0 + ((t) - 1) * 64)
#define ISSUE(t) do { const int tr_ = TROW(t); const size_t r0_ = (size_t)(tr_ + sr);                                             \
        st_k0 = *(const bf16x8*)(a.K + r0_ * a.ldk + sc); st_k1 = *(const bf16x8*)(a.K + (r0_ + 32) * a.ldk + sc);                 \
        st_v0 = *(const bf16x8*)(a.V + r0_ * a.ldv + sc); st_v1 = *(const bf16x8*)(a.V + (r0_ + 32) * a.ldv + sc);                 \
        if constexpr (MODE == 1) st_k2 = *(const bf16x8*)(a.K2 + (size_t)(tr_ + sr2) * a.ldk2 + sc2);                              \
        if constexpr (MODE == 0) { if (tid < 64) st_b = a.cum[tr_ + tid]; } } while (0)
#define WRITE(bf) do { *(LAS bf16x8*)(lds + OFF_K + (bf) * SHM_K + kws) = st_k0; *(LAS bf16x8*)(lds + OFF_K + (bf) * SHM_K + kws + 32 * 256) = st_k1;   \
        *(LAS bf16x8*)(lds + OFF_V + (bf) * SHM_V + vst0) = st_v0; *(LAS bf16x8*)(lds + OFF_V + (bf) * SHM_V + vst1) = st_v1;                        \
        if constexpr (MODE == 1) *(LAS bf16x8*)(lds + OFF_K2 + (bf) * SHM_K2 + k2ws) = st_k2;                                                       \
        if constexpr (MODE == 0) { if (tid < 64) ((LAS float*)(lds + OFF_BIAS + (bf) * 256))[tid] = -st_b * INV_SCALE; } } while (0)
    ISSUE(0);
    WRITE(0);
    __syncthreads();
    float m_reg = -1e30f, l_reg = 0.f;
#pragma unroll
    for (int d = 0; d < 4; ++d) o[d] = f32x16{};
    const int qlo = a.qvp0 + wid * 32, qv = qlo + r32;
    LAS float* li_l = (LAS float*)(lds + OFF_WS + wid * 256); LAS float* al_l = li_l + 32;
    const LAS float* tbl = (const LAS float*)(lds + OFF_TBL);
    const unsigned vbase = (unsigned)(uintptr_t)(lds + OFF_V) + (unsigned)v_rd_base(lane);
    const int NT = a.NT;
    for (int t = 0; t < NT; ++t) {
        const int cur = t & 1;
        if (t + 1 < NT) ISSUE(t + 1);
        const int kb = 64 * t;
        if (t == 0 || kb <= qlo + 31) {
        f32x16 p0, p1;
        qkt<MODE>(p0, p1, lds + OFF_K + cur * SHM_K, lds + OFF_K2 + cur * SHM_K2, (const LAS float*)(lds + OFF_BIAS + cur * 256), r32, hi, qr);
        if constexpr (MODE == 2) { const int sh = t == 0 ? a.shift0 : 0; if (qlo - sh - (kb + 63) <= 112) t5_bias(p0, p1, tbl, qv - kb - sh - 4 * hi); }
        if (t == 0 || kb + 63 > qlo) { int lim = qv - kb; const int tm = t == 0 ? 15 : 63; lim = (lim < tm ? lim : tm) - 4 * hi; mask_tile(p0, p1, lim); }
        float mn, alpha;
        partialSM<MODE>(p0, p1, m_reg, mn, alpha);
        if (__any(alpha < 1.f)) { if (hi == 0) al_l[r32] = alpha; asm volatile("s_waitcnt lgkmcnt(0)" ::: "memory");
#pragma unroll
            for (int r = 0; r < 16; ++r) { const float av = al_l[crow(r, hi)];
#pragma unroll
                for (int d = 0; d < 4; ++d) o[d][r] *= av; } }
        bf16x8 pa0, pa1, pa2, pa3;
        finishSM(p0, p1, alpha, l_reg, pa0, pa1, pa2, pa3);
        pv_tile(o, vbase + (unsigned)(cur * SHM_V), pa0, pa1, pa2, pa3);
        }
        if (t + 1 < NT) WRITE(cur ^ 1);
        __syncthreads();
    }
    if (hi == 0) li_l[r32] = l_reg;
    asm volatile("s_waitcnt lgkmcnt(0)" ::: "memory");
#pragma unroll
    for (int r = 0; r < 16; ++r) { const float rl = __builtin_amdgcn_rcpf(li_l[crow(r, hi)]);
#pragma unroll
        for (int d = 0; d < 4; ++d) o[d][r] *= rl; }
#undef TROW
#undef ISSUE
#undef WRITE
}
template <int MODE>
__device__ __forceinline__ void attn_pass_dma(const PassArgs& a, LAS char* lds, f32x16 (&o)[4], const int tid) {
    constexpr int DK = Cfg<MODE>::DK;
    constexpr float SCALE = Cfg<MODE>::SCALE, INV_SCALE = 1.0f / SCALE;
    const int wid = __builtin_amdgcn_readfirstlane(tid >> 6);
    if (wid >= 4) __builtin_amdgcn_s_setprio(1);
    bf16x8 qr[DK / 16];
    { const int lane = tid & 63, r32 = lane & 31, hi = lane >> 5; const bf16_t* qp = a.Q + (size_t)(wid * 32 + r32) * a.ldq + hi * 8;
#pragma unroll
      for (int d0 = 0; d0 < 8; ++d0) qr[d0] = *(const bf16x8*)(qp + d0 * 16);
      if constexpr (MODE == 1) { const bf16_t* qp2 = a.Q2 + (size_t)(wid * 32 + r32) * a.ldq2 + hi * 8;
#pragma unroll
          for (int d0 = 0; d0 < 4; ++d0) qr[8 + d0] = *(const bf16x8*)(qp2 + d0 * 16); } }
    float st_b = 0.f;
#define TROW(t) ((t) == 0 ? META0 : a.krow0 + ((t) - 1) * 64)
#define DMA16(gp, ldsoff) __builtin_amdgcn_global_load_lds((const unsigned*)(gp), (LAS unsigned*)(lds + (ldsoff)), 16, 0, 0)
#define ISSUE_D(t, bf) do { int tl_ = tid; asm volatile("" : "+v"(tl_)); const int tr_ = TROW(t);                                         \
        const int krow = tl_ >> 4, kcol = ((tl_ & 15) ^ (krow & 15)) * 8;                                                                \
        const int vkk = ((tl_ >> 7) << 3) | ((tl_ & 31) >> 2), vrow = (vkk & ~0xC) | ((vkk & 4) << 1) | ((vkk & 8) >> 1), vcol = ((tl_ >> 5) & 3) * 32 + (tl_ & 3) * 8;   \
        _Pragma("unroll") for (int i_ = 0; i_ < 2; ++i_) DMA16(a.K + (size_t)(tr_ + krow + 32 * i_) * a.ldk + kcol, OFF_K + (bf) * SHM_K + i_ * 8192 + wid * 1024);   \
        _Pragma("unroll") for (int i_ = 0; i_ < 2; ++i_) DMA16(a.V + (size_t)(tr_ + vrow + 32 * i_) * a.ldv + vcol, OFF_V + (bf) * SHM_V + i_ * 8192 + wid * 1024);   \
        if constexpr (MODE == 1) { const int r2_ = tl_ >> 3, c2_ = ((tl_ & 7) ^ ((r2_ >> 1) & 7)) * 8; DMA16(a.K2 + (size_t)(tr_ + r2_) * a.ldk2 + c2_, OFF_K2 + (bf) * SHM_K2 + wid * 1024); } \
        if constexpr (MODE == 0) { if (tl_ < 64) st_b = a.cum[tr_ + tl_]; } } while (0)
#define WRITE_B(bf) do { if constexpr (MODE == 0) { int tl_ = tid; asm volatile("" : "+v"(tl_)); if (tl_ < 64) ((LAS float*)(lds + OFF_BIAS + (bf) * 256))[tl_] = -st_b * INV_SCALE; } } while (0)
    ISSUE_D(0, 0);
    WRITE_B(0);
    asm volatile("s_waitcnt vmcnt(0)" ::: "memory");
    __syncthreads();
    float m_reg = -1e30f, l_reg = 0.f;
#pragma unroll
    for (int d = 0; d < 4; ++d) o[d] = f32x16{};
    const int NT = a.NT;
    for (int t = 0; t < NT; ++t) {
        const int cur = t & 1;
        if (t + 1 < NT) ISSUE_D(t + 1, cur ^ 1);
        int tl = tid; asm volatile("" : "+v"(tl));
        const int lane = tl & 63, r32 = lane & 31, hi = lane >> 5;
        const int qlo = a.qvp0 + wid * 32, qv = qlo + r32;
        LAS float* al_l = (LAS float*)(lds + OFF_WS + wid * 256) + 32;
        const int kb = 64 * t;
        if (t == 0 || kb <= qlo + 31) {
        f32x16 p0, p1;
        qkt<MODE>(p0, p1, lds + OFF_K + cur * SHM_K, lds + OFF_K2 + cur * SHM_K2, (const LAS float*)(lds + OFF_BIAS + cur * 256), r32, hi, qr);
        if (t == 0 || kb + 63 > qlo) { int lim = qv - kb; const int tm = t == 0 ? 15 : 63; lim = (lim < tm ? lim : tm) - 4 * hi; mask_tile(p0, p1, lim); }
        float mn, alpha;
        partialSM<MODE>(p0, p1, m_reg, mn, alpha);
        if (__any(alpha < 1.f)) { if (hi == 0) al_l[r32] = alpha; asm volatile("s_waitcnt lgkmcnt(0)" ::: "memory");
#pragma unroll
            for (int r = 0; r < 16; ++r) { const float av = al_l[crow(r, hi)];
#pragma unroll
                for (int d = 0; d < 4; ++d) o[d][r] *= av; } }
        bf16x8 pa0, pa1, pa2, pa3;
        finishSM(p0, p1, alpha, l_reg, pa0, pa1, pa2, pa3);
        pv_tile(o, (unsigned)(uintptr_t)(lds + OFF_V) + (unsigned)v_rd_base(lane) + (unsigned)(cur * SHM_V), pa0, pa1, pa2, pa3);
        }
        if (t + 1 < NT) WRITE_B(cur ^ 1);
        asm volatile("s_waitcnt vmcnt(0)" ::: "memory");
        __syncthreads();
    }
    { int tl = tid; asm volatile("" : "+v"(tl));
      const int lane = tl & 63, r32 = lane & 31, hi = lane >> 5;
      LAS float* li_l = (LAS float*)(lds + OFF_WS + wid * 256);
      if (hi == 0) li_l[r32] = l_reg;
      asm volatile("s_waitcnt lgkmcnt(0)" ::: "memory");
#pragma unroll
      for (int r = 0; r < 16; ++r) { const float rl = __builtin_amdgcn_rcpf(li_l[crow(r, hi)]);
#pragma unroll
          for (int d = 0; d < 4; ++d) o[d][r] *= rl; } }
    __builtin_amdgcn_s_setprio(0);
#undef TROW
#undef DMA16
#undef ISSUE_D
#undef WRITE_B
}
constexpr int D_OFF_V = 0  , D_OFF_K = 65536  , D_OFF_TBL = 98304, D_OFF_WS = D_OFF_TBL + 512, D_LDS_END = D_OFF_WS + 8 * 256;
__device__ __forceinline__ void attn_pass_diff(const PassArgs& a, LAS char* lds, f32x16 (&o)[8], const int tid) {
    const int wid = __builtin_amdgcn_readfirstlane(tid >> 6);
    if (wid >= 4) __builtin_amdgcn_s_setprio(1);
    bf16x8 qr[8];
    { const int lane = tid & 63, r32 = lane & 31, hi = lane >> 5; const bf16_t* qp = a.Q + (size_t)(wid * 32 + r32) * a.ldq + hi * 8;
#pragma unroll
      for (int d0 = 0; d0 < 8; ++d0) qr[d0] = *(const bf16x8*)(qp + d0 * 16); }
#define TROW(t) ((t) == 0 ? META0 : a.krow0 + ((t) - 1) * 64)
#define DMA16(gp, ldsoff) __builtin_amdgcn_global_load_lds((const unsigned*)(gp), (LAS unsigned*)(lds + (ldsoff)), 16, 0, 0)
#define ISSUE_D(t, bf) do { int tl_ = tid; asm volatile("" : "+v"(tl_)); const int tr_ = TROW(t);                                         \
        const int krow = tl_ >> 4, kcol = ((tl_ & 15) ^ (krow & 15)) * 8;                                                                \
        const int vkk = ((tl_ >> 7) << 3) | ((tl_ & 31) >> 2), vrow = (vkk & ~0xC) | ((vkk & 4) << 1) | ((vkk & 8) >> 1), vcol = ((tl_ >> 5) & 3) * 32 + (tl_ & 3) * 8;   \
        _Pragma("unroll") for (int i_ = 0; i_ < 2; ++i_) DMA16(a.K + (size_t)(tr_ + krow + 32 * i_) * a.ldk + kcol, D_OFF_K + (bf) * 16384 + i_ * 8192 + wid * 1024);   \
        _Pragma("unroll") for (int h_ = 0; h_ < 2; ++h_) _Pragma("unroll") for (int i_ = 0; i_ < 2; ++i_)                                 \
            DMA16(a.V + (size_t)(tr_ + vrow + 32 * i_) * a.ldv + h_ * 128 + vcol, D_OFF_V + (bf) * 32768 + h_ * 16384 + i_ * 8192 + wid * 1024); } while (0)
    ISSUE_D(0, 0);
    asm volatile("s_waitcnt vmcnt(0)" ::: "memory");
    __syncthreads();
    float m_reg = -1e30f, l_reg = 0.f;
#pragma unroll
    for (int d = 0; d < 8; ++d) o[d] = f32x16{};
    const int NT = a.NT;
    for (int t = 0; t < NT; ++t) {
        const int cur = t & 1;
        if (t + 1 < NT) ISSUE_D(t + 1, cur ^ 1);
        int tl = tid; asm volatile("" : "+v"(tl));
        const int lane = tl & 63, r32 = lane & 31, hi = lane >> 5;
        const int qlo = a.qvp0 + wid * 32, qv = qlo + r32;
        LAS float* al_l = (LAS float*)(lds + D_OFF_WS + wid * 256) + 32;
        const int kb = 64 * t;
        if (t == 0 || kb <= qlo + 31) {
        f32x16 p0, p1;
        qkt<2>(p0, p1, lds + D_OFF_K + cur * 16384, lds, (const LAS float*)lds, r32, hi, qr);
        { const int sh = t == 0 ? a.shift0 : 0; if (qlo - sh - (kb + 63) <= 112) t5_bias(p0, p1, (const LAS float*)(lds + D_OFF_TBL), qv - kb - sh - 4 * hi); }
        if (t == 0 || kb + 63 > qlo) { int lim = qv - kb; const int tm = t == 0 ? 15 : 63; lim = (lim < tm ? lim : tm) - 4 * hi; mask_tile(p0, p1, lim); }
        float mn, alpha;
        partialSM<2>(p0, p1, m_reg, mn, alpha);
        if (__any(alpha < 1.f)) { if (hi == 0) al_l[r32] = alpha; asm volatile("s_waitcnt lgkmcnt(0)" ::: "memory");
#pragma unroll
            for (int r = 0; r < 16; ++r) { const float av = al_l[crow(r, hi)];
#pragma unroll
                for (int d = 0; d < 8; ++d) o[d][r] *= av; } }
        bf16x8 pa0, pa1, pa2, pa3;
        finishSM(p0, p1, alpha, l_reg, pa0, pa1, pa2, pa3);
        const unsigned vbase = (unsigned)(uintptr_t)(lds + D_OFF_V) + (unsigned)v_rd_base(lane) + (unsigned)(cur * 32768);
        pv_tile(o, vbase, pa0, pa1, pa2, pa3);
        pv_tile(o + 4, vbase + 16384u, pa0, pa1, pa2, pa3);
        }
        asm volatile("s_waitcnt vmcnt(0)" ::: "memory");
        __syncthreads();
    }
    { int tl = tid; asm volatile("" : "+v"(tl));
      const int lane = tl & 63, r32 = lane & 31, hi = lane >> 5;
      LAS float* li_l = (LAS float*)(lds + D_OFF_WS + wid * 256);
      if (hi == 0) li_l[r32] = l_reg;
      asm volatile("s_waitcnt lgkmcnt(0)" ::: "memory");
#pragma unroll
      for (int r = 0; r < 16; ++r) { const float rl = __builtin_amdgcn_rcpf(li_l[crow(r, hi)]);
#pragma unroll
          for (int d = 0; d < 8; ++d) o[d][r] *= rl; } }
    __builtin_amdgcn_s_setprio(0);
#undef TROW
#undef DMA16
#undef ISSUE_D
}
#ifdef PROBE_ATT
template <int PVAR  >
__device__ __forceinline__ void attn_pass_diff_probe(const PassArgs& a, LAS char* lds, f32x16 (&o)[8], const int tid) {
    const int wid = __builtin_amdgcn_readfirstlane(tid >> 6);
    bf16x8 qr[8];
    { const int lane = tid & 63, r32 = lane & 31, hi = lane >> 5; const bf16_t* qp = a.Q + (size_t)(wid * 32 + r32) * a.ldq + hi * 8;
#pragma unroll
      for (int d0 = 0; d0 < 8; ++d0) qr[d0] = *(const bf16x8*)(qp + d0 * 16); }
#define TROW(t) ((t) == 0 ? META0 : a.krow0 + ((t) - 1) * 64)
#define DMA16(gp, ldsoff) __builtin_amdgcn_global_load_lds((const unsigned*)(gp), (LAS unsigned*)(lds + (ldsoff)), 16, 0, 0)
#define ISSUE_D(t, bf) do { int tl_ = tid; asm volatile("" : "+v"(tl_)); const int tr_ = TROW(t);                                         \
        const int krow = tl_ >> 4, kcol = ((tl_ & 15) ^ (krow & 15)) * 8;                                                                \
        const int vkk = ((tl_ >> 7) << 3) | ((tl_ & 31) >> 2), vrow = (vkk & ~0xC) | ((vkk & 4) << 1) | ((vkk & 8) >> 1), vcol = ((tl_ >> 5) & 3) * 32 + (tl_ & 3) * 8;   \
        _Pragma("unroll") for (int i_ = 0; i_ < 2; ++i_) DMA16(a.K + (size_t)(tr_ + krow + 32 * i_) * a.ldk + kcol, D_OFF_K + (bf) * 16384 + i_ * 8192 + wid * 1024);   \
        _Pragma("unroll") for (int h_ = 0; h_ < 2; ++h_) _Pragma("unroll") for (int i_ = 0; i_ < 2; ++i_)                                 \
            DMA16(a.V + (size_t)(tr_ + vrow + 32 * i_) * a.ldv + h_ * 128 + vcol, D_OFF_V + (bf) * 32768 + h_ * 16384 + i_ * 8192 + wid * 1024); } while (0)
    ISSUE_D(0, 0);
    asm volatile("s_waitcnt vmcnt(0)" ::: "memory");
    __syncthreads();
    float m_reg = -1e30f, l_reg = 0.f;
#pragma unroll
    for (int d = 0; d < 8; ++d) o[d] = f32x16{};
    const int NT = a.NT;
    for (int t = 0; t < NT; ++t) {
        const int cur = t & 1;
        if constexpr (PVAR != 6 && PVAR != 8) { if (t + 1 < NT) ISSUE_D(t + 1, cur ^ 1); }
        int tl = tid; asm volatile("" : "+v"(tl));
        const int lane = tl & 63, r32 = lane & 31, hi = lane >> 5;
        const int qlo = a.qvp0 + wid * 32, qv = qlo + r32;
        LAS float* al_l = (LAS float*)(lds + D_OFF_WS + wid * 256) + 32;
        const int kb = 64 * t;
        if (t == 0 || kb <= qlo + 31) {
        f32x16 p0, p1;
        if constexpr (PVAR == 5 || PVAR == 7 || PVAR == 8) { p0 = f32x16{}; p1 = f32x16{};
#pragma unroll
            for (int d0 = 0; d0 < 8; ++d0) { p0 = __builtin_amdgcn_mfma_f32_32x32x16_bf16(qr[(d0 + 1) & 7], qr[d0], p0, 0, 0, 0); p1 = __builtin_amdgcn_mfma_f32_32x32x16_bf16(qr[(d0 + 3) & 7], qr[d0], p1, 0, 0, 0); } }
        else qkt<2>(p0, p1, lds + D_OFF_K + cur * 16384, lds, (const LAS float*)lds, r32, hi, qr);
        { const int sh = t == 0 ? a.shift0 : 0; if (qlo - sh - (kb + 63) <= 112) t5_bias(p0, p1, (const LAS float*)(lds + D_OFF_TBL), qv - kb - sh - 4 * hi); }
        if (t == 0 || kb + 63 > qlo) { int lim = qv - kb; const int tm = t == 0 ? 15 : 63; lim = (lim < tm ? lim : tm) - 4 * hi; mask_tile(p0, p1, lim); }
        float mn, alpha;
        partialSM<2>(p0, p1, m_reg, mn, alpha);
        if (__any(alpha < 1.f)) { if (hi == 0) al_l[r32] = alpha; asm volatile("s_waitcnt lgkmcnt(0)" ::: "memory");
#pragma unroll
            for (int r = 0; r < 16; ++r) { const float av = al_l[crow(r, hi)];
#pragma unroll
                for (int d = 0; d < 8; ++d) o[d][r] *= av; } }
        bf16x8 pa0, pa1, pa2, pa3;
        finishSM(p0, p1, alpha, l_reg, pa0, pa1, pa2, pa3);
        const unsigned vbase = (unsigned)(uintptr_t)(lds + D_OFF_V) + (unsigned)v_rd_base(lane) + (unsigned)(cur * 32768);
        if constexpr (PVAR == 4 || PVAR == 7 || PVAR == 8) {
#pragma unroll
            for (int d = 0; d < 8; ++d) { o[d] = __builtin_amdgcn_mfma_f32_32x32x16_bf16(pa0, pa1, o[d], 0, 0, 0); o[d] = __builtin_amdgcn_mfma_f32_32x32x16_bf16(pa1, pa2, o[d], 0, 0, 0);
                o[d] = __builtin_amdgcn_mfma_f32_32x32x16_bf16(pa2, pa3, o[d], 0, 0, 0); o[d] = __builtin_amdgcn_mfma_f32_32x32x16_bf16(pa3, pa0, o[d], 0, 0, 0); } }
        else { pv_tile(o, vbase, pa0, pa1, pa2, pa3); pv_tile(o + 4, vbase + 16384u, pa0, pa1, pa2, pa3); }
        }
        asm volatile("s_waitcnt vmcnt(0)" ::: "memory");
        __syncthreads();
    }
    { int tl = tid; asm volatile("" : "+v"(tl));
      const int lane = tl & 63, r32 = lane & 31, hi = lane >> 5;
      LAS float* li_l = (LAS float*)(lds + D_OFF_WS + wid * 256);
      if (hi == 0) li_l[r32] = l_reg;
      asm volatile("s_waitcnt lgkmcnt(0)" ::: "memory");
#pragma unroll
      for (int r = 0; r < 16; ++r) { const float rl = __builtin_amdgcn_rcpf(li_l[crow(r, hi)]);
#pragma unroll
          for (int d = 0; d < 8; ++d) o[d][r] *= rl; } }
#undef TROW
#undef DMA16
#undef ISSUE_D
}
#endif
__device__ __forceinline__ void store_o_bf16(const f32x16* o, bf16_t* Ow, int ldo, int tid) {
    asm volatile("" : "+v"(tid)); const int r32 = tid & 31, hi = (tid >> 5) & 1;
#pragma unroll
    for (int r = 0; r < 16; ++r) { const int orow = crow(r, hi);
#pragma unroll
        for (int d0 = 0; d0 < 4; ++d0) { const float v = o[d0][r]; const float vn = __shfl_xor(v, 1);
            if ((r32 & 1) == 0) *(GAS unsigned*)(Ow + (size_t)orow * ldo + d0 * 32 + r32) = cvt_pk_bf16(v, vn); }
        asm volatile("" ::: "memory"); }
}
}

constexpr size_t MiB = (size_t)1 << 20;
constexpr size_t WS_CTL = 0, CTL_ZERO_BYTES = 1 * MiB;
constexpr size_t WS_PRM = 1 * MiB;
constexpr size_t WS_COS = 2 * MiB, WS_SIN = 3 * MiB;
constexpr size_t WS_RSTD = 4 * MiB;
constexpr size_t WS_STATQ = 14 * MiB, WS_STATKV = 17 * MiB;
constexpr size_t WS_STATM = 5 * MiB;
constexpr size_t WS_FLOG = 10 * MiB, WS_CUM = 12 * MiB;
constexpr size_t WS_W = 20 * MiB;
constexpr size_t SZ_EVIN = 61 * MiB, SZ_UQ = 6 * MiB, SZ_UKV = 4 * MiB, SZ_SQ = 33 * MiB, SZ_ODIN = 98 * MiB, SZ_GU = 175 * MiB, SZ_DN = 87 * MiB;
constexpr size_t W_EVIN = WS_W, W_UQ = W_EVIN + 2 * SZ_EVIN, W_UKV = W_UQ + 2 * SZ_UQ, W_EVOUT = W_UKV + 2 * SZ_UKV, W_ODIN = W_EVOUT + 2 * SZ_SQ, W_ODOUT = W_ODIN + 2 * SZ_ODIN,
                 W_GU = W_ODOUT + 2 * SZ_SQ, W_DN = W_GU + DEPTH * SZ_GU;
constexpr size_t WS_HS = W_DN + DEPTH * SZ_DN;
constexpr size_t WS_HBF = WS_HS + 260 * MiB;
constexpr size_t WS_PROJ = WS_HBF + 133 * MiB;
constexpr size_t WS_QBUF = WS_PROJ + 246 * MiB, WS_KVBUF = WS_PROJ + 346 * MiB;
constexpr size_t WS_OBUF = WS_PROJ + 479 * MiB;
constexpr size_t WS_MBUF = WS_OBUF + 133 * MiB;
constexpr size_t WS_DSCR = WS_MBUF + 133 * MiB;
constexpr size_t WS_PART = WS_DSCR + 64 * MiB;
constexpr size_t WS_END = WS_PART + 12 * MiB;
static_assert((size_t)EV_N * LD_DM * 2 <= SZ_EVIN && (size_t)UQ_N * LD_QR * 2 <= SZ_UQ && (size_t)UKV_N * LD_KV * 2 <= SZ_UKV && (size_t)DM * LD_DM * 2 <= SZ_SQ && (size_t)OD_N * LD_DM * 2 <= SZ_ODIN && (size_t)GU_N * LD_DM * 2 <= SZ_GU && (size_t)DM * LD_FF * 2 <= SZ_DN, "weight sizes");
static_assert((size_t)MPAD * DM * 4 == 260 * MiB && (size_t)MPAD * LD_DM * 2 <= 133 * MiB && (size_t)MPAD * LD_EV * 2 <= 246 * MiB && (size_t)MPAD * LD_UQ * 2 <= 100 * MiB && (size_t)MPAD * LD_UKV * 2 <= 133 * MiB && (size_t)MPAD * LD_OD * 2 <= 479 * MiB && (size_t)MPAD * LD_FF * 2 <= 479 * MiB, "activation sizes");
constexpr int LD8 = 4224;
constexpr size_t WS_A8 = WS_PROJ + 352 * MiB, WS_RS8 = WS_RSTD + 512 * 1024;
constexpr size_t CTL_COLMAX = 65536;
constexpr int I8_IN_ODD = 3;
constexpr size_t CTL_COLMAX_OD = CTL_COLMAX + (size_t)DEPTH * GU_N * 4;
constexpr size_t W_OD8_OFF = 90 * MiB;
constexpr int I8_IN_EV = 2;
constexpr size_t CTL_COLMAX_EV = CTL_COLMAX_OD + 2 * (size_t)OD_N * 4;
static_assert(CTL_COLMAX_EV + 2 * (size_t)EV_N * 4 <= CTL_ZERO_BYTES && (size_t)EV_N * LD8 <= SZ_EVIN, "int8 even in-proj buffers");
static_assert(CTL_COLMAX_OD + 2 * (size_t)OD_N * 4 <= CTL_ZERO_BYTES && (size_t)GU_N * LD8 <= W_OD8_OFF && W_OD8_OFF + (size_t)OD_N * LD8 <= SZ_GU && (size_t)MPAD * LD8 <= 133 * MiB, "int8 in-proj buffers");
static_assert((size_t)MPAD * LD_FF * 2 <= 352 * MiB && 352 * MiB + (size_t)MPAD * LD8 <= 479 * MiB && (size_t)GU_N * LD8 <= SZ_GU && CTL_COLMAX + (size_t)DEPTH * GU_N * 4 <= CTL_ZERO_BYTES, "int8 buffers");
constexpr int I8_DN = 14;
constexpr int LD8F = 11136;
constexpr size_t CTL_COLMAX_DN = CTL_COLMAX_EV + 2 * (size_t)EV_N * 4;
constexpr size_t WS_ACT8 = WS_HS, WS_AMAXP = WS_HS + 180 * MiB, WS_RSD = WS_RSTD + 768 * 1024;
static_assert(CTL_COLMAX_DN + (size_t)DEPTH * DM * 4 <= CTL_ZERO_BYTES && (size_t)MPAD * LD8F <= 180 * MiB && 180 * MiB + (size_t)MPAD * AMAXP_LD * 4 <= 260 * MiB && (size_t)DM * LD8F <= SZ_DN && (GU_N / 256) * 4 <= AMAXP_LD, "int8 down buffers");
constexpr int I8_OUT = 8;
constexpr int N_OUT8 = (I8_OUT & 1) + ((I8_OUT >> 1) & 1) + ((I8_OUT >> 2) & 1) + ((I8_OUT >> 3) & 1);
constexpr size_t CTL_COLMAX_OUT = CTL_COLMAX_DN + (size_t)DEPTH * DM * 4;
static_assert(CTL_COLMAX_OUT + (size_t)DEPTH * DM * 4 <= CTL_ZERO_BYTES && (size_t)DM * LD8 <= SZ_SQ, "int8 out-projection buffers");
constexpr int CW_BAR = 4096;

constexpr int RING_BYTES = 131072;
constexpr int PRO_SCR_BYTES = 8 * 16640;
constexpr int MISC_OFF = 135168 + 320;
constexpr int LDS_BYTES = 147456;
static_assert(att::LDS_END <= RING_BYTES && att::D_LDS_END <= RING_BYTES && PRO_SCR_BYTES <= 135168 && MISC_OFF + 64 <= LDS_BYTES, "LDS map");

#define LDS_WAIT() asm volatile("s_waitcnt lgkmcnt(0)" ::: "memory")
#define VM_WAIT() asm volatile("s_waitcnt vmcnt(0)" ::: "memory")

#define XB_TMO      128
#define XB_XCNT(j)  (256  + 64 * (j))
#define XB_XSUB(j)  (1280 + 64 * (j))
#define XB_XGEN(j)  (2304 + 64 * (j))
#define XB_TOP      3328
#define XB_TOPGEN   3392
#define XCD_BAR_WORDS 3456
#define XB_SPIN_CAP (1u << 18)

__device__ __forceinline__ unsigned xb_ld(unsigned* p)              { return __hip_atomic_load(p, __ATOMIC_RELAXED, __HIP_MEMORY_SCOPE_AGENT); }
__device__ __forceinline__ unsigned xb_add(unsigned* p, unsigned v) { return __hip_atomic_fetch_add(p, v, __ATOMIC_RELAXED, __HIP_MEMORY_SCOPE_AGENT); }
__device__ __forceinline__ unsigned xb_xcc_id() { return (unsigned)__builtin_amdgcn_s_getreg((3 << 11) | 20) & 0xFu; }
#define XB_SPIN(cond, bar) do { unsigned _sp = 0; while (cond) { __builtin_amdgcn_s_sleep(1); \
    if ((++_sp & 255u) == 0u) { if (xb_ld(&(bar)[XB_TMO])) break; if (_sp > XB_SPIN_CAP) { atomicAdd(&(bar)[XB_TMO], 1u); break; } } } } while (0)

struct XcdBarrier {
    unsigned* bar; unsigned x;
    volatile LAS unsigned* st;
};

__device__ __forceinline__ XcdBarrier xcd_barrier_post(unsigned* bar, volatile LAS unsigned* st, int tid) {
    XcdBarrier b; b.bar = bar; b.x = xb_xcc_id(); b.st = st;
    if (tid == 0) (void)xb_add(&bar[XB_XCNT(b.x)], 1u);
    return b;
}
__device__ __forceinline__ void xcd_barrier_complete(unsigned* bar, unsigned x, unsigned& nloc, unsigned& nx) {
    const unsigned G = gridDim.x * gridDim.y * gridDim.z;
    unsigned sum, cnt, mine, sp = 0u;
    for (;;) {
        sum = 0u; cnt = 0u; mine = 0u;
#pragma unroll
        for (unsigned j = 0; j < 16; ++j) { const unsigned c = xb_ld(&bar[XB_XCNT(j)]); sum += c; cnt += (c > 0u) ? 1u : 0u; mine = (j == x) ? c : mine; }
        if (sum == G) break;
        __builtin_amdgcn_s_sleep(1);
        if ((++sp & 255u) == 0u) { if (xb_ld(&bar[XB_TMO])) break; if (sp > XB_SPIN_CAP) { atomicAdd(&bar[XB_TMO], 1u); break; } }
    }
    nloc = mine > 0u ? mine : 1u; nx = cnt > 0u ? cnt : 1u;
}

__device__ __forceinline__ void xcd_barrier(const XcdBarrier& b, int tid) {
    asm volatile("s_waitcnt vmcnt(0)" ::: "memory");
    __syncthreads();
    if (tid == 0) {
        unsigned* bar = b.bar;
        __builtin_amdgcn_s_waitcnt(0);
        unsigned nloc = b.st[0], nx = b.st[1];
        if (nloc == 0u) { xcd_barrier_complete(bar, b.x, nloc, nx); b.st[0] = nloc; b.st[1] = nx; }
        const unsigned old = xb_add(&bar[XB_XSUB(b.x)], 1u);
        const unsigned gen = old / nloc;
        if (old + 1u == (gen + 1u) * nloc) {
            __builtin_amdgcn_fence(__ATOMIC_RELEASE, "agent");
            asm volatile("s_waitcnt vmcnt(0)" ::: "memory");
            const unsigned og = xb_add(&bar[XB_TOP], 1u);
            const unsigned tg = og / nx;
            if (og + 1u == (tg + 1u) * nx) xb_add(&bar[XB_TOPGEN], 1u);
            else XB_SPIN(xb_ld(&bar[XB_TOPGEN]) == tg, bar);
            __builtin_amdgcn_fence(__ATOMIC_ACQUIRE, "agent");
            xb_add(&bar[XB_XGEN(b.x)], 1u);
            asm volatile("s_waitcnt vmcnt(0)" ::: "memory");
        } else {
            XB_SPIN(xb_ld(&bar[XB_XGEN(b.x)]) == gen, bar);
            __builtin_amdgcn_fence(__ATOMIC_ACQUIRE, "agent");
            asm volatile("s_waitcnt vmcnt(0)" ::: "memory");
        }
    }
    __syncthreads();
}

struct Args { const float* in[18]; float* out; unsigned char* ws; int ph_lo, ph_hi; float lam_init[2]; };
enum { IN_X = 0, IN_META, IN_RELB, IN_EVWIN, IN_EVBF, IN_EVQN, IN_EVKVN, IN_EVWUQ, IN_EVWUKV, IN_EVWOUT, IN_ODWIN, IN_ODLAM, IN_ODSUBLN, IN_ODWOUT, IN_NORMG, IN_WGATE, IN_WUP, IN_WDOWN };

struct Frame {
    LAS unsigned char* lds;
    int tid, lane, wave, vcu, G, bx;
    unsigned char* ws;
};

__device__ __forceinline__ int ropeperm(int j) { const int a = j >> 3, e = j & 7; return e < 4 ? 4 * a + e : 32 + 4 * a + (e - 4); }
struct CvtDesc { const float* W; int N, srccol; const float* gain; int Ksrc, k0; bf16_t* WT; int Kdst, dstrow0; const float* cmax; int had; };
__device__ __forceinline__ unsigned pk4_i8(float a, float b, float c, float d) {
    const float M = 12582912.0f;
    const unsigned ab = __builtin_amdgcn_perm(__float_as_uint(b + M), __float_as_uint(a + M), 0x0c0c0400u), cd = __builtin_amdgcn_perm(__float_as_uint(d + M), __float_as_uint(c + M), 0x0c0c0400u);
    return __builtin_amdgcn_perm(cd, ab, 0x05040100u);
}
typedef unsigned short u16x2 __attribute__((ext_vector_type(2)));
__device__ __forceinline__ unsigned pkmax(unsigned a, unsigned b) { return __builtin_bit_cast(unsigned, __builtin_elementwise_max(__builtin_bit_cast(u16x2, a), __builtin_bit_cast(u16x2, b))); }
__device__ __forceinline__ unsigned opq(unsigned v) { asm volatile("" : "+v"(v)); return v; }
__device__ __forceinline__ float wave_max(float v) {
#pragma unroll
    for (int o = 1; o < 64; o <<= 1) v = fmaxf(v, __shfl_xor(v, o));
    return v;
}
__device__ __forceinline__ void fwht8_32(float (&v)[8], int lane) {
    f32x2 a = {v[0], v[1]}, b = {v[2], v[3]}, c = {v[4], v[5]}, d = {v[6], v[7]}, t;
    t = a + c; c = a - c; a = t; t = b + d; d = b - d; b = t;
    t = a + b; b = a - b; a = t; t = c + d; d = c - d; c = t;
    a = (f32x2){a[0] + a[1], a[0] - a[1]}; b = (f32x2){b[0] + b[1], b[0] - b[1]}; c = (f32x2){c[0] + c[1], c[0] - c[1]}; d = (f32x2){d[0] + d[1], d[0] - d[1]};
    const float s1 = (lane & 1) ? -1.f : 1.f, s2 = (lane & 2) ? -1.f : 1.f;
#define FW_X(x, ctrl) __int_as_float(__builtin_amdgcn_update_dpp(0, __float_as_int(x), ctrl, 0xf, 0xf, true))
#define FW_ST(p, sg, ctrl) do { const f32x2 q_ = {FW_X(p[0], ctrl), FW_X(p[1], ctrl)}; p = p * (f32x2){sg, sg} + q_; } while (0)
    FW_ST(a, s1, 0xB1); FW_ST(b, s1, 0xB1); FW_ST(c, s1, 0xB1); FW_ST(d, s1, 0xB1);
    FW_ST(a, s2, 0x4E); FW_ST(b, s2, 0x4E); FW_ST(c, s2, 0x4E); FW_ST(d, s2, 0x4E);
#undef FW_ST
#undef FW_X
    v[0] = a[0]; v[1] = a[1]; v[2] = b[0]; v[3] = b[1]; v[4] = c[0]; v[5] = c[1]; v[6] = d[0]; v[7] = d[1];
}
__device__ __forceinline__ void cvt_load(const CvtDesc& d, f32x4 (&v)[16], int lane) {
    const int kq = lane >> 4;
#pragma unroll
    for (int i = 0; i < 16; ++i) { const int k = d.k0 + 4 * i + kq;
        v[i] = (d.srccol >= 0 && k < d.Ksrc) ? __builtin_nontemporal_load((const f32x4*)(d.W + (size_t)k * d.N + d.srccol)) : (f32x4){0.f, 0.f, 0.f, 0.f}; }
}
__device__ __forceinline__ void cvt_finish(const CvtDesc& d, f32x4 (&v)[16], LAS float* scr, int lane) {
    const int l16 = lane & 15, kq = lane >> 4;
    if (d.gain) {
#pragma unroll
        for (int i = 0; i < 16; ++i) { const int k = d.k0 + 4 * i + kq; if (k < d.Ksrc) v[i] = v[i] * d.gain[k]; } }
#pragma unroll
    for (int i = 0; i < 16; ++i) { LAS float* q = scr + (4 * i + kq) * 65 + 4 * l16; q[0] = v[i][0]; q[1] = v[i][1]; q[2] = v[i][2]; q[3] = v[i][3]; }
    LDS_WAIT(); asm volatile("" ::: "memory");
    const int c = lane & 7, nr = lane >> 3;
    if (d.cmax) {
#pragma unroll
        for (int j = 0; j < 8; ++j) { const int n = nr + 8 * j; const LAS float* t = scr + (8 * c) * 65 + n;
            const float cm = d.cmax[d.dstrow0 + n], inv = cm > 0.f ? 127.0f * __builtin_amdgcn_rcpf(cm) : 0.f;
            float v[8];
#pragma unroll
            for (int i = 0; i < 8; ++i) v[i] = t[i * 65];
            if (d.had) fwht8_32(v, lane);
            u32x2 o; o.x = pk4_i8(v[0] * inv, v[1] * inv, v[2] * inv, v[3] * inv); o.y = pk4_i8(v[4] * inv, v[5] * inv, v[6] * inv, v[7] * inv);
            __builtin_nontemporal_store(o, (u32x2*)((unsigned char*)d.WT + (size_t)(d.dstrow0 + n) * d.Kdst + d.k0 + 8 * c)); }
        LDS_WAIT(); asm volatile("" ::: "memory");
        return;
    }
    if (d.had) {
#pragma unroll
        for (int j = 0; j < 8; ++j) { const int n = nr + 8 * j; const LAS float* t = scr + (8 * c) * 65 + n;
            float v[8];
#pragma unroll
            for (int i = 0; i < 8; ++i) v[i] = t[i * 65];
            fwht8_32(v, lane);
            u32x4 o; o.x = cvt_pk_bf16(v[0] * 0.03125f, v[1] * 0.03125f); o.y = cvt_pk_bf16(v[2] * 0.03125f, v[3] * 0.03125f); o.z = cvt_pk_bf16(v[4] * 0.03125f, v[5] * 0.03125f); o.w = cvt_pk_bf16(v[6] * 0.03125f, v[7] * 0.03125f);
            __builtin_nontemporal_store(o, (u32x4*)(d.WT + (size_t)(d.dstrow0 + n) * d.Kdst + d.k0 + 8 * c)); }
        LDS_WAIT(); asm volatile("" ::: "memory");
        return;
    }
#pragma unroll
    for (int j = 0; j < 8; ++j) { const int n = nr + 8 * j; const LAS float* t = scr + (8 * c) * 65 + n;
        u32x4 o; o.x = cvt_pk_bf16(t[0 * 65], t[1 * 65]); o.y = cvt_pk_bf16(t[2 * 65], t[3 * 65]); o.z = cvt_pk_bf16(t[4 * 65], t[5 * 65]); o.w = cvt_pk_bf16(t[6 * 65], t[7 * 65]);
        __builtin_nontemporal_store(o, (u32x4*)(d.WT + (size_t)(d.dstrow0 + n) * d.Kdst + d.k0 + 8 * c)); }
    LDS_WAIT(); asm volatile("" ::: "memory");
}
constexpr int I_EVIN = 64 * (EV_N / 64), I_UQ = (QRANK / 64) * (UQ_N / 64), I_UKV = (KVK / 64) * (UKV_N / 64), I_SQ = 64 * (DM / 64), I_ODIN = 64 * (OD_N / 64);
constexpr int I_PAIR = I_EVIN + I_UQ + I_UKV + I_SQ + I_ODIN + I_SQ;
constexpr int I_GU = 64 * (GU_N / 64), I_DN = (DFF / 64) * (DM / 64), I_FFN = I_GU + I_DN;
constexpr int N_CVT_ITEMS = 2 * I_PAIR + DEPTH * I_FFN;

__device__ __forceinline__ CvtDesc cvt_describe(const Args& A, unsigned char* ws, int it, int lane) {
    const int l4 = 4 * (lane & 15);
    const float* ng = A.in[IN_NORMG];
    if (it < 2 * I_PAIR) {
        const int e = it / I_PAIR; int r = it - e * I_PAIR;
        if (r < I_EVIN) { const int nblk = EV_N / 64, kb = r / nblk, nb = r - kb * nblk, n = nb * 64 + l4;
            int sc;
            if (n < EV_CQ) sc = n; else if (n < EV_KR) sc = n + 16; else if (n < EV_FL) sc = 7376 + ropeperm(n - EV_KR); else if (n < EV_FL + 16) sc = 6144 + (n - EV_FL); else sc = -1;
            return CvtDesc{A.in[IN_EVWIN] + (size_t)e * DM * EV_SRC_N, EV_SRC_N, sc, ng + (size_t)(2 * e * 4 + 0) * DM, DM, kb * 64, (bf16_t*)(ws + W_EVIN + e * SZ_EVIN), LD_DM, nb * 64}; }
        r -= I_EVIN;
        if (r < I_UQ) { const int nblk = UQ_N / 64, kb = r / nblk, nb = r - kb * nblk, n = nb * 64 + l4;
            int sc; if (n < 2048) sc = (n >> 7) * 192 + (n & 127); else { const int j2 = n - 2048; sc = (j2 >> 6) * 192 + 128 + ropeperm(j2 & 63); }
            return CvtDesc{A.in[IN_EVWUQ] + (size_t)e * QRANK * UQ_N, UQ_N, sc, A.in[IN_EVQN] + e * QRANK, QRANK, kb * 64, (bf16_t*)(ws + W_UQ + e * SZ_UQ), LD_QR, nb * 64}; }
        r -= I_UQ;
        if (r < I_UKV) { const int nblk = UKV_N / 64, kb = r / nblk, nb = r - kb * nblk, n = nb * 64 + l4;
            int sc; if (n < 2048) sc = (n >> 7) * 256 + (n & 127); else { const int n2 = n - 2048; sc = (n2 >> 7) * 256 + 128 + (n2 & 127); }
            return CvtDesc{A.in[IN_EVWUKV] + (size_t)e * KVRANK * UKV_N, UKV_N, sc, A.in[IN_EVKVN] + e * KVRANK, KVRANK, kb * 64, (bf16_t*)(ws + W_UKV + e * SZ_UKV), LD_KV, nb * 64}; }
        r -= I_UKV;
        if (r < I_SQ) { const int nblk = DM / 64, kb = r / nblk, nb = r - kb * nblk;
            return CvtDesc{A.in[IN_EVWOUT] + (size_t)e * DM * DM, DM, nb * 64 + l4, nullptr, DM, kb * 64, (bf16_t*)(ws + W_EVOUT + e * SZ_SQ), LD_DM, nb * 64}; }
        r -= I_SQ;
        if (r < I_ODIN) { const int nblk = OD_N / 64, kb = r / nblk, nb = r - kb * nblk;
            return CvtDesc{A.in[IN_ODWIN] + (size_t)e * DM * OD_N, OD_N, nb * 64 + l4, ng + (size_t)((2 * e + 1) * 4 + 0) * DM, DM, kb * 64, (bf16_t*)(ws + W_ODIN + e * SZ_ODIN), LD_DM, nb * 64}; }
        r -= I_ODIN;
        { const int nblk = DM / 64, kb = r / nblk, nb = r - kb * nblk;
            return CvtDesc{A.in[IN_ODWOUT] + (size_t)e * DM * DM, DM, nb * 64 + l4, nullptr, DM, kb * 64, (bf16_t*)(ws + W_ODOUT + e * SZ_SQ), LD_DM, nb * 64}; }
    }
    it -= 2 * I_PAIR;
    const int L = it / I_FFN; int r = it - L * I_FFN;
    if (r < I_GU) { const int nblk = GU_N / 64, kb = r / nblk, nb = r - kb * nblk, n0 = nb * 64, tile = n0 >> 8, w = n0 & 255;
        const float* src = (w < 128 ? A.in[IN_WGATE] : A.in[IN_WUP]) + (size_t)L * DM * DFF;
        return CvtDesc{src, DFF, tile * 128 + (w & 127) + l4, ng + (size_t)(L * 4 + 2) * DM, DM, kb * 64, (bf16_t*)(ws + W_GU + L * SZ_GU), LD8, n0, (const float*)(ws + WS_CTL + CTL_COLMAX) + (size_t)L * GU_N}; }
    r -= I_GU;
    { const int nblk = DM / 64, kb = r / nblk, nb = r - kb * nblk;
        return CvtDesc{A.in[IN_WDOWN] + (size_t)L * DFF * DM, DM, nb * 64 + l4, nullptr, DFF, kb * 64, (bf16_t*)(ws + W_DN + L * SZ_DN), LD_FF, nb * 64}; }
}

__device__ __forceinline__ int ev_srccol(int n) {
    if (n < EV_CQ) return n; if (n < EV_KR) return n + 16; if (n < EV_FL) return 7376 + ropeperm(n - EV_KR); if (n < EV_FL + 16) return 6144 + (n - EV_FL); return -1;
}
__device__ __forceinline__ void row_to_bf16(const float* xrow, bf16_t* orow, float* rstd, int lane) {
    float ss = 0.f;
#pragma unroll
    for (int j = 0; j < 8; ++j) { const f32x4 a = *(const f32x4*)(xrow + 8 * lane + 512 * j), b = *(const f32x4*)(xrow + 8 * lane + 512 * j + 4);
        ss += sq8(a, b); store8(orow + 8 * lane + 512 * j, a, b); }
    ss = wave_sum(ss);
    if (lane == 0) *rstd = rsqrtf(ss * (1.0f / DM) + EPS);
}
__device__ __forceinline__ void row_to_i8(const float* xrow, unsigned char* orow, float* rs8, int lane) {
    f32x4 a[8], b[8]; float ss = 0.f, mx = 0.f;
#pragma unroll
    for (int j = 0; j < 8; ++j) { a[j] = *(const f32x4*)(xrow + 8 * lane + 512 * j); b[j] = *(const f32x4*)(xrow + 8 * lane + 512 * j + 4);
        ss += sq8(a[j], b[j]);
        mx = fmaxf(mx, fmaxf(fmaxf(fmaxf(fabsf(a[j][0]), fabsf(a[j][1])), fmaxf(fabsf(a[j][2]), fabsf(a[j][3]))), fmaxf(fmaxf(fabsf(b[j][0]), fabsf(b[j][1])), fmaxf(fabsf(b[j][2]), fabsf(b[j][3]))))); }
    ss = wave_sum(ss); mx = wave_max(mx);
    const float inv = mx > 0.f ? 127.0f * __builtin_amdgcn_rcpf(mx) : 0.f;
#pragma unroll
    for (int j = 0; j < 8; ++j) { u32x2 q; q.x = pk4_i8(a[j][0] * inv, a[j][1] * inv, a[j][2] * inv, a[j][3] * inv); q.y = pk4_i8(b[j][0] * inv, b[j][1] * inv, b[j][2] * inv, b[j][3] * inv);
        *(u32x2*)(orow + 8 * lane + 512 * j) = q; }
    if (lane == 0) *rs8 = rsqrtf(ss * (1.0f / DM) + EPS) * mx * (1.0f / 16129.0f);
}
constexpr int N_OD8 = ((I8_IN_ODD & 1) + ((I8_IN_ODD >> 1) & 1));
constexpr int I_PAIR0 = I_PAIR - I_EVIN;
constexpr int N_EV8 = ((I8_IN_EV & 1) + ((I8_IN_EV >> 1) & 1));
constexpr int NP0 = I_PAIR - ((I8_IN_EV & 1) ? I_EVIN : 0) - ((I8_IN_ODD & 1) ? I_ODIN : 0) - ((I8_OUT & 1) ? I_SQ : 0) - ((I8_OUT & 2) ? I_SQ : 0), NP1 = I_PAIR - ((I8_IN_EV & 2) ? I_EVIN : 0) - ((I8_IN_ODD & 2) ? I_ODIN : 0) - ((I8_OUT & 4) ? I_SQ : 0) - ((I8_OUT & 8) ? I_SQ : 0);
__device__ __forceinline__ int pair_item(int r, int e) {
    if (!((I8_IN_EV >> e) & 1)) { if (r < I_EVIN) return r; r -= I_EVIN; }
    if (r < I_UQ + I_UKV) return I_EVIN + r;
    r -= I_UQ + I_UKV;
    if (!((I8_OUT >> (2 * e)) & 1)) { if (r < I_SQ) return I_EVIN + I_UQ + I_UKV + r; r -= I_SQ; }
    if (!((I8_IN_ODD >> e) & 1)) { if (r < I_ODIN) return I_EVIN + I_UQ + I_UKV + I_SQ + r; r -= I_ODIN; }
    return I_EVIN + I_UQ + I_UKV + I_SQ + I_ODIN + r;
}
constexpr int N_DN8 = (I8_DN & 1) + ((I8_DN >> 1) & 1) + ((I8_DN >> 2) & 1) + ((I8_DN >> 3) & 1);
__device__ __forceinline__ int nth_layer(int idx, int mask) {
    int L = 0;
#pragma unroll
    for (int b = 0; b < DEPTH; ++b) { if ((mask >> b) & 1) { if (idx == 0) L = b; --idx; } }
    return L;
}
template <int PH> __device__ __forceinline__ CvtDesc cvt_desc(const Args& A, unsigned char* ws, int j, int lane) {
    if constexpr (PH == 0) {
        if (j < NP0) return cvt_describe(A, ws, pair_item(j, 0), lane);
        if (j < NP0 + NP1) return cvt_describe(A, ws, I_PAIR + pair_item(j - NP0, 1), lane);
        const int q = j - NP0 - NP1, idx = q / I_DN, L = nth_layer(idx, ~I8_DN & ((1 << DEPTH) - 1)); return cvt_describe(A, ws, 2 * I_PAIR + L * I_FFN + I_GU + (q - idx * I_DN), lane); }
    else {
        const int q = j;
        const int idx = q / I_DN, r = q - idx * I_DN, L = nth_layer(idx, I8_DN), nblk = DM / 64, kb = r / nblk, nb = r - kb * nblk;
        return CvtDesc{A.in[IN_WDOWN] + (size_t)L * DFF * DM, DM, nb * 64 + 4 * (lane & 15), nullptr, DFF, kb * 64, (bf16_t*)(ws + W_DN + L * SZ_DN), LD8F, nb * 64, (const float*)(ws + WS_CTL + CTL_COLMAX_DN) + (size_t)L * DM, 1};
    }
}
template <int PH> __device__ __forceinline__ void cvt_items(const Args& A, Frame& F) {
    constexpr int NIT = PH == 0 ? NP0 + NP1 + (DEPTH - N_DN8) * I_DN : N_DN8 * I_DN;
    LAS float* scr = (LAS float*)(F.lds + F.wave * 16640);
    const int gw = F.vcu * 8 + F.wave, NGW = F.G * 8;
    unsigned char* ws = F.ws;
    f32x4 vA[16], vB[16]; CvtDesc dA{}, dB{};
    int it = gw;
    if (it < NIT) { dA = cvt_desc<PH>(A, ws, it, F.lane); cvt_load(dA, vA, F.lane); }
    for (; it < NIT; it += 2 * NGW) {
        const int it1 = it + NGW, it2 = it1 + NGW;
        if (it1 < NIT) { dB = cvt_desc<PH>(A, ws, it1, F.lane); cvt_load(dB, vB, F.lane); }
        cvt_finish(dA, vA, scr, F.lane);
        if (it2 < NIT) { dA = cvt_desc<PH>(A, ws, it2, F.lane); cvt_load(dA, vA, F.lane); }
        if (it1 < NIT) cvt_finish(dB, vB, scr, F.lane);
    }
}
__device__ __forceinline__ int ropeperm_inv(int d) { return d < 32 ? 8 * (d >> 2) + (d & 3) : 8 * ((d - 32) >> 2) + 4 + ((d - 32) & 3); }
__device__ __forceinline__ int ev_dstcol(int sc) { if (sc < 6144) return sc; if (sc < 6160) return EV_FL + (sc - 6144); if (sc < 7376) return sc - 16; return EV_KR + ropeperm_inv(sc - 7376); }
constexpr int NS_GU = DFF / 32, NS_OD = OD_N / 32, NS_EV = (EV_SRC_N + 31) / 32, NS_OUT = DM / 32, N_STRIPS = DEPTH * 2 * NS_GU + N_OD8 * NS_OD + N_EV8 * NS_EV + N_OUT8 * NS_OUT, STRIP_SLOTS = 135168;
__device__ __forceinline__ void strip_phase(const Args& A, Frame& F) {
    LAS unsigned char* lds = F.lds; unsigned char* ws = F.ws; const int tid = F.tid;
    int par = 0;
    for (int s = F.vcu; s < N_STRIPS; s += F.G, par ^= 1) {
        LAS unsigned* slots = (LAS unsigned*)(lds + STRIP_SLOTS) + 32 * par;
        const float* src; const float* gain; unsigned char* dst; float* cmx; int N, c0, kind, rbase = 0;
        if (s < DEPTH * 2 * NS_GU) { const int mi = s / NS_GU, cb = s - mi * NS_GU, L = mi >> 1, up = mi & 1; kind = 0; N = DFF; c0 = cb * 32;
            src = (up ? A.in[IN_WUP] : A.in[IN_WGATE]) + (size_t)L * DM * DFF; gain = A.in[IN_NORMG] + (size_t)(L * 4 + 2) * DM;
            dst = ws + W_GU + (size_t)L * SZ_GU; cmx = (float*)(ws + WS_CTL + CTL_COLMAX) + (size_t)L * GU_N; rbase = (c0 >> 7) * 256 + up * 128 + (c0 & 127); }
        else if (s < DEPTH * 2 * NS_GU + N_OD8 * NS_OD) { const int q = s - DEPTH * 2 * NS_GU, idx = q / NS_OD, cb = q - idx * NS_OD, e = (I8_IN_ODD & 1) ? idx : 1; kind = 1; N = OD_N; c0 = cb * 32;
            src = A.in[IN_ODWIN] + (size_t)e * DM * OD_N; gain = A.in[IN_NORMG] + (size_t)((2 * e + 1) * 4 + 0) * DM;
            dst = ws + W_GU + (size_t)(2 * e + 1) * SZ_GU + W_OD8_OFF; cmx = (float*)(ws + WS_CTL + CTL_COLMAX_OD) + (size_t)e * OD_N; rbase = c0; }
        else if (s >= DEPTH * 2 * NS_GU + N_OD8 * NS_OD + N_EV8 * NS_EV) { const int q = s - (DEPTH * 2 * NS_GU + N_OD8 * NS_OD + N_EV8 * NS_EV), idx = q / NS_OUT, cb = q - idx * NS_OUT, L = nth_layer(idx, I8_OUT), e = L >> 1; kind = 1; N = DM; c0 = cb * 32;
            src = ((L & 1) ? A.in[IN_ODWOUT] : A.in[IN_EVWOUT]) + (size_t)e * DM * DM; gain = nullptr;
            dst = ws + ((L & 1) ? W_ODOUT : W_EVOUT) + (size_t)e * SZ_SQ; cmx = (float*)(ws + WS_CTL + CTL_COLMAX_OUT) + (size_t)L * DM; rbase = c0; }
        else { const int q = s - DEPTH * 2 * NS_GU - N_OD8 * NS_OD, idx = q / NS_EV, cb = q - idx * NS_EV, e = (I8_IN_EV & 1) ? idx : 1; kind = 2; N = EV_SRC_N; c0 = cb * 32 + 32 <= EV_SRC_N ? cb * 32 : EV_SRC_N - 32;
            src = A.in[IN_EVWIN] + (size_t)e * DM * EV_SRC_N; gain = A.in[IN_NORMG] + (size_t)(2 * e * 4 + 0) * DM;
            dst = ws + W_EVIN + (size_t)e * SZ_EVIN; cmx = (float*)(ws + WS_CTL + CTL_COLMAX_EV) + (size_t)e * EV_N; }
        if (tid < 32) slots[tid] = 0u;
        __syncthreads();
        const int cg = tid & 7;
        unsigned m0 = 0u, m1 = 0u;
        {
            const float* sp = src + (size_t)(tid >> 3) * N + c0 + 4 * cg;
#pragma unroll 1
            for (int h = 0; h < 2; ++h) {
                f32x4 v[16];
#pragma unroll
                for (int i = 0; i < 16; ++i) v[i] = __builtin_nontemporal_load((const f32x4*)(sp + (size_t)(64 * (16 * h + i)) * N));
#pragma unroll
                for (int i = 0; i < 16; ++i) { const int k = (tid >> 3) + 64 * (16 * h + i); const float g = gain ? gain[k] : 1.0f;
                    u32x2 w; w.x = cvt_pk_bf16(v[i][0] * g, v[i][1] * g); w.y = cvt_pk_bf16(v[i][2] * g, v[i][3] * g);
                    m0 = pkmax(m0, w.x & 0x7fff7fffu); m1 = pkmax(m1, w.y & 0x7fff7fffu);
                    *(LAS u32x2*)(lds + (k >> 2) * 264 + (k & 3) * 64 + cg * 8) = w; }
            }
        }
        u32x2 rg[4][8];
        {   const float* sp = src + (size_t)(2048 + 8 * (tid >> 3)) * N + c0 + 4 * cg;
#pragma unroll
            for (int jj = 0; jj < 2; ++jj) {
                f32x4 v[16];
#pragma unroll
                for (int i = 0; i < 16; ++i) v[i] = __builtin_nontemporal_load((const f32x4*)(sp + (size_t)(512 * (2 * jj + (i >> 3)) + (i & 7)) * N));
#pragma unroll
                for (int i = 0; i < 16; ++i) { const int k = 2048 + 8 * (tid >> 3) + 512 * (2 * jj + (i >> 3)) + (i & 7); const float g = gain ? gain[k] : 1.0f;
                    u32x2 w; w.x = cvt_pk_bf16(v[i][0] * g, v[i][1] * g); w.y = cvt_pk_bf16(v[i][2] * g, v[i][3] * g);
                    m0 = pkmax(m0, w.x & 0x7fff7fffu); m1 = pkmax(m1, w.y & 0x7fff7fffu);
                    rg[2 * jj + (i >> 3)][i & 7] = w; }
            }
        }
        atomicMax((unsigned*)(slots + 4 * cg + 0), m0 << 16); atomicMax((unsigned*)(slots + 4 * cg + 1), m0 & 0xffff0000u);
        atomicMax((unsigned*)(slots + 4 * cg + 2), m1 << 16); atomicMax((unsigned*)(slots + 4 * cg + 3), m1 & 0xffff0000u);
        __syncthreads();
        {
            const int ch = tid >> 1, hf = tid & 1;
            u32x2 w[8][4];
#pragma unroll
            for (int r = 0; r < 8; ++r) { const LAS u32x2* cp = (const LAS u32x2*)(lds + (2 * ch + (r >> 2)) * 264 + (r & 3) * 64 + hf * 32);
#pragma unroll
                for (int j = 0; j < 4; ++j) w[r][j] = cp[j]; }
#pragma unroll
            for (int n = 0; n < 16; ++n) {
                const float cm = __uint_as_float(slots[16 * hf + n]), inv = cm > 0.f ? 127.0f * __builtin_amdgcn_rcpf(cm) : 0.f;
                float x[8];
#pragma unroll
                for (int r = 0; r < 8; ++r) { const unsigned word = (n & 2) ? w[r][n >> 2].y : w[r][n >> 2].x; x[r] = ((n & 1) ? bf_hi(word) : bf_lo(word)) * inv; }
                u32x2 q; q.x = pk4_i8(x[0], x[1], x[2], x[3]); q.y = pk4_i8(x[4], x[5], x[6], x[7]);
                const int col = 16 * hf + n, drow = kind == 2 ? ev_dstcol(c0 + col) : rbase + col;
                __builtin_nontemporal_store(q, (u32x2*)(dst + (size_t)drow * LD8 + 8 * ch));
            }
        }
        {
#pragma unroll
            for (int c = 0; c < 4; ++c) {
                const float cm = __uint_as_float(slots[4 * cg + c]), inv = cm > 0.f ? 127.0f * __builtin_amdgcn_rcpf(cm) : 0.f;
                const int col = 4 * cg + c, drow = kind == 2 ? ev_dstcol(c0 + col) : rbase + col;
#pragma unroll
                for (int j = 0; j < 4; ++j) {
                    float x[8];
#pragma unroll
                    for (int r = 0; r < 8; ++r) { const unsigned word = (c & 2) ? rg[j][r].y : rg[j][r].x; x[r] = ((c & 1) ? bf_hi(word) : bf_lo(word)) * inv; }
                    u32x2 q; q.x = pk4_i8(x[0], x[1], x[2], x[3]); q.y = pk4_i8(x[4], x[5], x[6], x[7]);
                    __builtin_nontemporal_store(q, (u32x2*)(dst + (size_t)drow * LD8 + 2048 + 8 * ((tid >> 3) + 64 * j)));
                }
            }
        }
        if (tid < 32) { const int drow = kind == 2 ? ev_dstcol(c0 + tid) : rbase + tid; cmx[drow] = __uint_as_float(slots[tid]); }
    }
    __syncthreads();
    { const int gw = F.vcu * 8 + F.wave, NGW = F.G * 8;
      for (int r = gw; r < N_EV8 * (EV_N - EV_SRC_N); r += NGW) { const int idx = r / (EV_N - EV_SRC_N), row = EV_SRC_N + (r - idx * (EV_N - EV_SRC_N)), e = (I8_IN_EV & 1) ? idx : 1;
          unsigned char* d = ws + W_EVIN + (size_t)e * SZ_EVIN + (size_t)row * LD8; const u32x4 z = {0u, 0u, 0u, 0u};
#pragma unroll
          for (int j = 0; j < 4; ++j) *(u32x4*)(d + 16 * F.lane + 1024 * j) = z; } }
}
__device__ __forceinline__ void colmax_dn_pass(const Args& A, Frame& F) {
    const int gw = F.vcu * 8 + F.wave, NGW = F.G * 8, lane = F.lane;
    constexpr int NKC = DFF / 256, NCB = DM / 256;
    for (int item = gw; item < N_DN8 * NKC * NCB; item += NGW) {
        const int cb = item % NCB, q = item / NCB, kc = q % NKC, L = nth_layer(q / NKC, I8_DN);
        const float* src = A.in[IN_WDOWN] + (size_t)L * DFF * DM + (size_t)(kc * 256) * DM + cb * 256 + 4 * lane;
        f32x4 mx = {0.f, 0.f, 0.f, 0.f};
#pragma unroll 1
        for (int g = 0; g < 8; ++g) {
            f32x4 w[32];
#pragma unroll
            for (int i = 0; i < 32; ++i) w[i] = __builtin_nontemporal_load((const f32x4*)(src + (size_t)(g * 32 + i) * DM));
#pragma unroll
            for (int h = 1; h < 32; h <<= 1)
#pragma unroll
                for (int i = 0; i < 32; ++i) if (!(i & h)) { const f32x4 x = w[i], y = w[i | h]; w[i] = x + y; w[i | h] = x - y; }
#pragma unroll
            for (int i = 0; i < 32; ++i) { mx[0] = fmaxf(mx[0], fabsf(w[i][0])); mx[1] = fmaxf(mx[1], fabsf(w[i][1])); mx[2] = fmaxf(mx[2], fabsf(w[i][2])); mx[3] = fmaxf(mx[3], fabsf(w[i][3])); }
        }
        unsigned* dstp = (unsigned*)(F.ws + WS_CTL + CTL_COLMAX_DN) + (size_t)L * DM + cb * 256 + 4 * lane;
#pragma unroll
        for (int e = 0; e < 4; ++e) atomicMax(dstp + e, __float_as_uint(mx[e]));
    }
}
__device__ __forceinline__ void actq_load(u32x4 (&w)[22], const bf16_t* act, int row, int lane) {
    const char* src = (const char*)(act + (size_t)row * LD_FF);
#pragma unroll
    for (int j = 0; j < 22; ++j) { w[j] = (u32x4){0u, 0u, 0u, 0u}; if (8 * lane + 512 * j < DFF) w[j] = __builtin_nontemporal_load((const u32x4*)(src + 16 * lane + 1024 * j)); }
}
__device__ __forceinline__ void actq_row(u32x4 (&w)[22], unsigned char* act8, float* rsd, int row, int lane) {
    unsigned char* dst = act8 + (size_t)row * LD8F;
    unsigned amx2 = 0u;
#pragma unroll
    for (int j = 0; j < 22; ++j) {
        float v[8] = {bf_lo(w[j].x), bf_hi(w[j].x), bf_lo(w[j].y), bf_hi(w[j].y), bf_lo(w[j].z), bf_hi(w[j].z), bf_lo(w[j].w), bf_hi(w[j].w)};
        fwht8_32(v, lane);
        w[j].x = cvt_pk_bf16(v[0], v[1]); w[j].y = cvt_pk_bf16(v[2], v[3]); w[j].z = cvt_pk_bf16(v[4], v[5]); w[j].w = cvt_pk_bf16(v[6], v[7]);
        amx2 = pkmax(pkmax(amx2, w[j].x & 0x7fff7fffu), pkmax(w[j].y & 0x7fff7fffu, pkmax(w[j].z & 0x7fff7fffu, w[j].w & 0x7fff7fffu)));
    }
    const float m = wave_max(fmaxf(bf_lo(amx2), bf_hi(amx2)));
    const float inv = m > 0.f ? 127.0f * __builtin_amdgcn_rcpf(m) : 0.f;
#pragma unroll
    for (int j = 0; j < 22; ++j) { if (8 * lane + 512 * j < DFF) { u32x2 q;
        q.x = pk4_i8(bf_lo(w[j].x) * inv, bf_hi(w[j].x) * inv, bf_lo(w[j].y) * inv, bf_hi(w[j].y) * inv); q.y = pk4_i8(bf_lo(w[j].z) * inv, bf_hi(w[j].z) * inv, bf_lo(w[j].w) * inv, bf_hi(w[j].w) * inv);
        *(u32x2*)(dst + 8 * lane + 512 * j) = q; } }
    if (lane == 0) rsd[row] = m * (1.0f / (16129.0f * 32.0f));
}
__device__ __forceinline__ void actq_phase(Frame& F) {
    unsigned char* ws = F.ws;
    const int gw = F.vcu * 8 + F.wave, NGW = F.G * 8, lane = F.lane;
    const bf16_t* act = (const bf16_t*)(ws + WS_PROJ); unsigned char* act8 = ws + WS_ACT8; float* rsd = (float*)(ws + WS_RSD);
    u32x4 wA[22], wB[22];
    int row = gw;
    if (row < MPAD) actq_load(wA, act, row, lane);
    for (; row < MPAD; row += 2 * NGW) {
        const int r1 = row + NGW, r2 = r1 + NGW;
        if (r1 < MPAD) actq_load(wB, act, r1, lane);
        actq_row(wA, act8, rsd, row, lane);
        if (r2 < MPAD) actq_load(wA, act, r2, lane);
        if (r1 < MPAD) actq_row(wB, act8, rsd, r1, lane);
    }
}
__device__ __forceinline__ void oq_phase(Frame& F) {
    unsigned char* ws = F.ws;
    const int gw = F.vcu * 8 + F.wave, NGW = F.G * 8, lane = F.lane;
    const bf16_t* obuf = (const bf16_t*)(ws + WS_OBUF); unsigned char* a8 = ws + WS_A8; float* rs8 = (float*)(ws + WS_RS8);
    for (int row = gw; row < MPAD; row += NGW) {
        unsigned char* dst = a8 + (size_t)row * LD8;
        if (row >= MUSED) { const u32x4 z = {0u, 0u, 0u, 0u};
#pragma unroll
            for (int j = 0; j < 4; ++j) *(u32x4*)(dst + 16 * lane + 1024 * j) = z;
            if (lane == 0) rs8[row] = 0.f;
            continue; }
        const char* src = (const char*)(obuf + (size_t)row * LD_DM);
        u32x4 w[8]; unsigned amx2 = 0u;
#pragma unroll
        for (int j = 0; j < 8; ++j) w[j] = __builtin_nontemporal_load((const u32x4*)(src + 16 * lane + 1024 * j));
#pragma unroll
        for (int j = 0; j < 8; ++j) amx2 = pkmax(pkmax(amx2, w[j].x & 0x7fff7fffu), pkmax(w[j].y & 0x7fff7fffu, pkmax(w[j].z & 0x7fff7fffu, w[j].w & 0x7fff7fffu)));
        const float m = wave_max(fmaxf(bf_lo(amx2), bf_hi(amx2)));
        const float inv = m > 0.f ? 127.0f * __builtin_amdgcn_rcpf(m) : 0.f;
#pragma unroll
        for (int j = 0; j < 8; ++j) { u32x2 q;
            q.x = pk4_i8(bf_lo(w[j].x) * inv, bf_hi(w[j].x) * inv, bf_lo(w[j].y) * inv, bf_hi(w[j].y) * inv); q.y = pk4_i8(bf_lo(w[j].z) * inv, bf_hi(w[j].z) * inv, bf_lo(w[j].w) * inv, bf_hi(w[j].w) * inv);
            *(u32x2*)(dst + 8 * lane + 512 * j) = q; }
        if (lane == 0) rs8[row] = m * (1.0f / 16129.0f);
    }
}
__device__ __forceinline__ void p0_prologue(const Args& A, Frame& F) {
    const int gw = F.vcu * 8 + F.wave, NGW = F.G * 8;
    unsigned char* ws = F.ws;
    strip_phase(A, F);
    colmax_dn_pass(A, F);
    cvt_items<0>(A, F);
    { float* cosT = (float*)(ws + WS_COS); float* sinT = (float*)(ws + WS_SIN);
      for (int idx = gw * 64 + F.lane; idx < NPOS * 32; idx += NGW * 64) { const int pos = idx >> 5, i = idx & 31;
          const float inv = powf(10000.0f, -(float)i * (1.0f / 32.0f)); const float ang = (float)pos * inv;
          cosT[idx] = cosf(ang); sinT[idx] = sinf(ang); } }
    if (gw == 0) { float* prm = (float*)(ws + WS_PRM);
        for (int o = 0; o < 2; ++o) { const float* l = A.in[IN_ODLAM] + o * 4 * 128;
            const float s01 = wave_sum(l[F.lane] * l[128 + F.lane] + l[64 + F.lane] * l[192 + F.lane]);
            const float s23 = wave_sum(l[256 + F.lane] * l[384 + F.lane] + l[320 + F.lane] * l[448 + F.lane]);
            if (F.lane == 0) prm[o] = expf(s01) - expf(s23) + A.lam_init[o]; } }
    bf16_t* hbf = (bf16_t*)(ws + WS_HBF); float* rstd = (float*)(ws + WS_RSTD); unsigned char* a8 = ws + WS_OBUF; float* rs8 = (float*)(ws + WS_RS8);
    for (int row = gw; row < MPAD; row += NGW) {
        if (row < MUSED) { const float* src = row < MREAL ? A.in[IN_X] + (size_t)row * DM : A.in[IN_META] + (size_t)(row - MREAL) * DM;
            if constexpr (I8_IN_EV & 1) row_to_i8(src, a8 + (size_t)row * LD8, rs8 + row, F.lane); else row_to_bf16(src, hbf + (size_t)row * LD_DM, rstd + row, F.lane); }
        else { const u32x4 z = {0u, 0u, 0u, 0u};
#pragma unroll
            for (int j = 0; j < 8; ++j) *(u32x4*)(hbf + (size_t)row * LD_DM + 8 * F.lane + 512 * j) = z;
#pragma unroll
            for (int j = 0; j < 4; ++j) *(u32x4*)(a8 + (size_t)row * LD8 + 16 * F.lane + 1024 * j) = z;
            if (F.lane == 0) { rstd[row] = 0.f; rs8[row] = 0.f; } }
    }
}

__device__ __forceinline__ void ew_phase(const Args& A, Frame& F, int layer, int which) {
    unsigned char* ws = F.ws;
    const int gw = F.vcu * 8 + F.wave, NGW = F.G * 8, lane = F.lane;
    const float* gpost = A.in[IN_NORMG] + (size_t)(layer * 4 + (which ? 3 : 1)) * DM;
    const bool first = (layer == 0 && which == 0), last = (layer == DEPTH - 1 && which == 1);
    const bf16_t* mbuf = (const bf16_t*)(ws + WS_MBUF); bf16_t* hbf = (bf16_t*)(ws + WS_HBF);
    float* rstd = (float*)(ws + WS_RSTD); const float* statm = (const float*)(ws + WS_STATM);
    const bool q8 = (which == 0) || (layer + 1 < DEPTH && (((((layer + 1) & 1) ? I8_IN_ODD : I8_IN_EV) >> ((layer + 1) >> 1)) & 1));
    unsigned char* a8 = ws + (which == 0 ? WS_A8 : WS_OBUF); float* rs8 = (float*)(ws + WS_RS8);
    if (q8) {
        for (int row = MUSED + gw; row < MPAD; row += NGW) { const u32x4 z = {0u, 0u, 0u, 0u};
#pragma unroll
            for (int j = 0; j < 4; ++j) *(u32x4*)(a8 + (size_t)row * LD8 + 16 * lane + 1024 * j) = z;
            if (lane == 0) rs8[row] = 0.f; }
    }
    if (F.vcu < NMETA && !last) {
        const int r = F.vcu, row = MREAL + r, nS = which ? (DFF / 256) : (DM / 256), c0 = F.wave * 512 + 8 * lane;
        const float* part = (const float*)(ws + WS_PART) + (size_t)r * DM + c0;
        LAS float* red = (LAS float*)F.lds;
        f32x4 ma = {0.f, 0.f, 0.f, 0.f}, mb = {0.f, 0.f, 0.f, 0.f};
        if (!which && ((I8_OUT >> layer) & 1)) {
            i32x4 ia = {0, 0, 0, 0}, ib = {0, 0, 0, 0};
#pragma unroll 16
            for (int ks = 0; ks < DM / 256; ++ks) { ia += *(const i32x4*)(part + (size_t)ks * 16 * DM); ib += *(const i32x4*)(part + (size_t)ks * 16 * DM + 4); }
            const float* cs = (const float*)(ws + WS_CTL + CTL_COLMAX_OUT) + (size_t)layer * DM + c0; const float rsc = ((const float*)(ws + WS_RS8))[row];
            ma = __builtin_convertvector(ia, f32x4) * (*(const f32x4*)cs * rsc); mb = __builtin_convertvector(ib, f32x4) * (*(const f32x4*)(cs + 4) * rsc);
        } else if (which && ((I8_DN >> layer) & 1)) {
            i32x4 ia = {0, 0, 0, 0}, ib = {0, 0, 0, 0};
#pragma unroll 16
            for (int ks = 0; ks < DFF / 256; ++ks) { ia += *(const i32x4*)(part + (size_t)ks * 16 * DM); ib += *(const i32x4*)(part + (size_t)ks * 16 * DM + 4); }
            const float* cs = (const float*)(ws + WS_CTL + CTL_COLMAX_DN) + (size_t)layer * DM + c0; const float rsc = ((const float*)(ws + WS_RSD))[row];
            ma = __builtin_convertvector(ia, f32x4) * (*(const f32x4*)cs * rsc); mb = __builtin_convertvector(ib, f32x4) * (*(const f32x4*)(cs + 4) * rsc);
        } else {
#pragma unroll 16
        for (int ks = 0; ks < nS; ++ks) { ma += *(const f32x4*)(part + (size_t)ks * 16 * DM); mb += *(const f32x4*)(part + (size_t)ks * 16 * DM + 4); }
        }
        const float s1 = wave_sum(sq8(ma, mb));
        if (lane == 0) red[F.wave] = s1;
        __syncthreads();
        const float rm = __builtin_amdgcn_rsqf((((red[0] + red[1]) + (red[2] + red[3])) + ((red[4] + red[5]) + (red[6] + red[7]))) * (1.0f / DM) + EPS);
        f32x4 ha, hb;
        if (first) { ha = *(const f32x4*)(A.in[IN_META] + (size_t)r * DM + c0); hb = *(const f32x4*)(A.in[IN_META] + (size_t)r * DM + c0 + 4); }
        else { const u32x4 wh = *(const u32x4*)(hbf + (size_t)row * LD_DM + c0);
            ha = (f32x4){bf_lo(wh.x), bf_hi(wh.x), bf_lo(wh.y), bf_hi(wh.y)}; hb = (f32x4){bf_lo(wh.z), bf_hi(wh.z), bf_lo(wh.w), bf_hi(wh.w)}; }
        const f32x4 ga = *(const f32x4*)(gpost + c0), gb = *(const f32x4*)(gpost + c0 + 4);
        ha = ha + ma * rm * ga; hb = hb + mb * rm * gb;
        const float s2 = wave_sum(sq8(ha, hb));
        const float mxw = wave_max(fmaxf(fmaxf(fmaxf(fabsf(ha[0]), fabsf(ha[1])), fmaxf(fabsf(ha[2]), fabsf(ha[3]))), fmaxf(fmaxf(fabsf(hb[0]), fabsf(hb[1])), fmaxf(fabsf(hb[2]), fabsf(hb[3])))));
        if (lane == 0) { red[8 + F.wave] = s2; red[16 + F.wave] = mxw; }
        __syncthreads();
        store8(hbf + (size_t)row * LD_DM + c0, ha, hb);
        const float amx = fmaxf(fmaxf(fmaxf(red[16], red[17]), fmaxf(red[18], red[19])), fmaxf(fmaxf(red[20], red[21]), fmaxf(red[22], red[23])));
        if (q8) { const float inv = amx > 0.f ? 127.0f * __builtin_amdgcn_rcpf(amx) : 0.f;
            u32x2 q; q.x = pk4_i8(ha[0] * inv, ha[1] * inv, ha[2] * inv, ha[3] * inv); q.y = pk4_i8(hb[0] * inv, hb[1] * inv, hb[2] * inv, hb[3] * inv); *(u32x2*)(a8 + (size_t)row * LD8 + c0) = q; }
        if (F.tid == 0) { const float rr = __builtin_amdgcn_rsqf((((red[8] + red[9]) + (red[10] + red[11])) + ((red[12] + red[13]) + (red[14] + red[15]))) * (1.0f / DM) + EPS);
            rstd[row] = rr; if (q8) rs8[row] = rr * amx * (1.0f / 16129.0f); }
        __syncthreads();
    }
    u32x4 mv[8], ha[8], hb[8]; float sq = 0.f;
    unsigned v16 = (unsigned)lane * 16u, v32 = (unsigned)lane * 32u, v8 = (unsigned)lane * 8u;
    asm volatile("" : "+v"(v16), "+v"(v32), "+v"(v8));
    const char* const mbufc = (const char*)mbuf; const char* const hbfc = (const char*)hbf; const char* const xc = (const char*)A.in[IN_X]; const char* const gpc = (const char*)gpost;
#define EW_FETCH(j_, row_) do { mv[j_] = __builtin_nontemporal_load((const u32x4*)(mbufc + ((size_t)(row_) * (LD_DM * 2) + 1024 * (j_)) + opq(v16)));           \
        if (first) { ha[j_] = *(const u32x4*)(xc + ((size_t)(row_) * (DM * 4) + 2048 * (j_)) + opq(v32)); hb[j_] = *(const u32x4*)(xc + ((size_t)(row_) * (DM * 4) + 2048 * (j_) + 16) + opq(v32)); } \
        else { ha[j_] = *(const u32x4*)(hbfc + ((size_t)(row_) * (LD_DM * 2) + 1024 * (j_)) + opq(v16)); } } while (0)
    LAS u32x4* const wst = (LAS u32x4*)(F.lds + 1024 + F.wave * 8192) + lane;
    int row = gw;
    if (row < MREAL) {
#pragma unroll
        for (int j = 0; j < 8; ++j) EW_FETCH(j, row);
        sq = *(const float*)((const char*)statm + (size_t)row * 256 + opq((unsigned)lane * 4u)); }
    for (; row < MREAL; row += NGW) {
        asm volatile("" : "+v"(v16), "+v"(v32), "+v"(v8));
        unsigned amx2 = 0u;
        const float rm = __builtin_amdgcn_rsqf(wave_sum(sq) * (1.0f / DM) + EPS);
        const int nrow = row + NGW; const bool more = nrow < MREAL;
        if (more) sq = *(const float*)((const char*)statm + (size_t)nrow * 256 + opq((unsigned)lane * 4u));
        float ss2 = 0.f;
        char* const hbw = (char*)hbf + (size_t)row * (LD_DM * 2); char* const outw = (char*)A.out + (size_t)row * (DM * 4);
#pragma unroll
        for (int j = 0; j < 8; ++j) { const f32x4 g0 = *(const f32x4*)(gpc + 2048 * j + opq(v32)), g1 = *(const f32x4*)(gpc + (2048 * j + 16) + opq(v32));
            const f32x4 m0 = {bf_lo(mv[j].x), bf_hi(mv[j].x), bf_lo(mv[j].y), bf_hi(mv[j].y)}, m1 = {bf_lo(mv[j].z), bf_hi(mv[j].z), bf_lo(mv[j].w), bf_hi(mv[j].w)};
            f32x4 h0, h1;
            if (first) { h0 = (f32x4){__uint_as_float(ha[j].x), __uint_as_float(ha[j].y), __uint_as_float(ha[j].z), __uint_as_float(ha[j].w)}; h1 = (f32x4){__uint_as_float(hb[j].x), __uint_as_float(hb[j].y), __uint_as_float(hb[j].z), __uint_as_float(hb[j].w)}; }
            else { h0 = (f32x4){bf_lo(ha[j].x), bf_hi(ha[j].x), bf_lo(ha[j].y), bf_hi(ha[j].y)}; h1 = (f32x4){bf_lo(ha[j].z), bf_hi(ha[j].z), bf_lo(ha[j].w), bf_hi(ha[j].w)}; }
            const f32x4 n0 = h0 + m0 * rm * g0, n1 = h1 + m1 * rm * g1; ss2 += sq8(n0, n1);
            if (last) { *(f32x4*)(outw + 2048 * j + opq(v32)) = n0; *(f32x4*)(outw + (2048 * j + 16) + opq(v32)) = n1; }
            else { u32x4 wh; wh.x = cvt_pk_bf16(n0[0], n0[1]); wh.y = cvt_pk_bf16(n0[2], n0[3]); wh.z = cvt_pk_bf16(n1[0], n1[1]); wh.w = cvt_pk_bf16(n1[2], n1[3]);
                *(u32x4*)(hbw + 1024 * j + opq(v16)) = wh;
                if (q8) { wst[j * 64] = wh;
                    amx2 = pkmax(pkmax(amx2, wh.x & 0x7fff7fffu), pkmax(wh.y & 0x7fff7fffu, pkmax(wh.z & 0x7fff7fffu, wh.w & 0x7fff7fffu))); } }
            if (more) EW_FETCH(j, nrow);
        }
        if (!last) { ss2 = wave_sum(ss2); const float rr = __builtin_amdgcn_rsqf(ss2 * (1.0f / DM) + EPS);
            if (lane == 0) rstd[row] = rr;
            if (q8) { const float amax = wave_max(fmaxf(bf_lo(amx2), bf_hi(amx2))); const float inv = amax > 0.f ? 127.0f * __builtin_amdgcn_rcpf(amax) : 0.f;
                if (lane == 0) rs8[row] = rr * amax * (1.0f / 16129.0f);
                char* const a8w = (char*)a8 + (size_t)row * LD8;
#pragma unroll
                for (int j = 0; j < 8; ++j) { u32x2 q; const u32x4 w = wst[j * 64];
                    q.x = pk4_i8(bf_lo(w.x) * inv, bf_hi(w.x) * inv, bf_lo(w.y) * inv, bf_hi(w.y) * inv); q.y = pk4_i8(bf_lo(w.z) * inv, bf_hi(w.z) * inv, bf_lo(w.w) * inv, bf_hi(w.w) * inv);
                    *(u32x2*)(a8w + 512 * j + opq(v8)) = q; } } }
    }
#undef EW_FETCH
}

__device__ __forceinline__ float logsig(float x) { return fminf(x, 0.f) - 0.6931471805599453f * __builtin_amdgcn_logf(1.0f + __builtin_amdgcn_exp2f(-1.4426950408889634f * fabsf(x))); }
__device__ __forceinline__ void scan_phase(const Args& A, Frame& F, int e) {
    const int gw = (F.G - 1 - F.vcu) * 8 + F.wave, lane = F.lane;
    if (gw >= NB * 16) return;
    const int b = gw >> 4, h = gw & 15;
    const float* flogT = (const float*)(F.ws + WS_FLOG) + (size_t)h * MPAD; float* cumT = (float*)(F.ws + WS_CUM) + (size_t)h * MPAD;
    const float bf = A.in[IN_EVBF][e * 16 + h];
    float cm = 0.f, mine = 0.f;
#pragma unroll 1
    for (int m = 0; m < NMETA; ++m) { cm += logsig(flogT[META0 + m] + bf); if (lane == m) mine = cm; }
    if (b == 0) cumT[META0 + lane] = lane < NMETA ? mine : 0.f;
    const float* src = flogT + b * SEQ + lane * 64; float* dst = cumT + b * SEQ + lane * 64;
    float s = 0.f;
#pragma unroll 1
    for (int i = 0; i < 16; ++i) { const f32x4 v = *(const f32x4*)(src + 4 * i); s += (logsig(v[0] + bf) + logsig(v[1] + bf)) + (logsig(v[2] + bf) + logsig(v[3] + bf)); }
    float inc = s;
#pragma unroll
    for (int off = 1; off < 64; off <<= 1) { const float t = __shfl_up(inc, off); if (lane >= off) inc += t; }
    float run = cm + (inc - s);
#pragma unroll 1
    for (int i = 0; i < 16; ++i) { const f32x4 v = *(const f32x4*)(src + 4 * i); f32x4 o;
        run += logsig(v[0] + bf); o[0] = run; run += logsig(v[1] + bf); o[1] = run; run += logsig(v[2] + bf); o[2] = run; run += logsig(v[3] + bf); o[3] = run;
        *(f32x4*)(dst + 4 * i) = o; }
}

__device__ __forceinline__ void fixup_odd_meta(Frame& F, int e) {
    unsigned char* ws = F.ws;
    const float* part = (const float*)(ws + WS_PART); const float* rstd = (const float*)(ws + WS_RSTD); bf16_t* proj = (bf16_t*)(ws + WS_PROJ);
    const bool i8 = (I8_IN_ODD >> e) & 1;
    const float* cs = (const float*)(ws + WS_CTL + CTL_COLMAX_OD) + (size_t)e * OD_N; const float* rs8 = (const float*)(ws + WS_RS8);
    constexpr int CG = OD_N / 8;
    for (int item = F.vcu * 512 + F.tid; item < 256 * CG; item += F.G * 512) {
        const int r = item / CG, col = (item - r * CG) * 8;
        f32x4 a = {0.f, 0.f, 0.f, 0.f}, b = {0.f, 0.f, 0.f, 0.f};
        if (r < NMETA) {
            if (i8) { i32x4 ia = {0, 0, 0, 0}, ib = {0, 0, 0, 0};
#pragma unroll 16
                for (int ks = 0; ks < DM / 256; ++ks) { ia += *(const i32x4*)(part + (size_t)(ks * 16 + r) * OD_N + col); ib += *(const i32x4*)(part + (size_t)(ks * 16 + r) * OD_N + col + 4); }
                const float sc = rs8[META0 + r]; a = __builtin_convertvector(ia, f32x4) * (*(const f32x4*)(cs + col) * sc); b = __builtin_convertvector(ib, f32x4) * (*(const f32x4*)(cs + col + 4) * sc);
            } else {
#pragma unroll 16
            for (int ks = 0; ks < DM / 256; ++ks) { a += *(const f32x4*)(part + (size_t)(ks * 16 + r) * OD_N + col); b += *(const f32x4*)(part + (size_t)(ks * 16 + r) * OD_N + col + 4); }
            const float sc = rstd[META0 + r]; a = a * sc; b = b * sc;
            }
        }
        pg8::store8(proj + (size_t)(META0 + r) * LD_OD + col, a, b);
    }
}

__device__ __forceinline__ int t5_bucket(int d) {
    if (d < 16) return d;
    return 16 + (d >= 19) + (d >= 21) + (d >= 24) + (d >= 27) + (d >= 31) + (d >= 35) + (d >= 40) + (d >= 46) + (d >= 52) + (d >= 59) + (d >= 67) + (d >= 77) + (d >= 87) + (d >= 99) + (d >= 113);
}
__device__ __forceinline__ void attn_even_phase(Frame& F) {
    unsigned char* ws = F.ws; LAS char* lds = (LAS char*)F.lds;
    const bf16_t* proj = (const bf16_t*)(ws + WS_PROJ); const bf16_t* qbuf = (const bf16_t*)(ws + WS_QBUF); const bf16_t* kvbuf = (const bf16_t*)(ws + WS_KVBUF);
    bf16_t* obuf = (bf16_t*)(ws + WS_OBUF); const float* cumT = (const float*)(ws + WS_CUM);
    for (int i = F.vcu; i < 512 + 16; i += F.G) {
        const bool meta = i >= 512; const int bh = i >> 3, p = i & 7, b = meta ? 0 : bh >> 4, h = meta ? i - 512 : bh & 15, nblk = meta ? 1 : 2;
        for (int k = 0; k < nblk; ++k) {
            const int qb = meta ? 0 : (k == 0 ? 15 - p : p), qrow0 = meta ? META0 : b * SEQ + qb * 256;
            att::PassArgs a;
            a.Q = proj + (size_t)qrow0 * LD_EV + EV_QF + h * 128; a.ldq = LD_EV; a.Q2 = nullptr; a.ldq2 = 0;
            a.K = proj + EV_KF + h * 128; a.ldk = LD_EV; a.K2 = nullptr; a.ldk2 = 0; a.V = proj + EV_VF + h * 128; a.ldv = LD_EV;
            a.cum = cumT + (size_t)h * MPAD; a.krow0 = b * SEQ; a.qvp0 = meta ? 0 : 64 + qb * 256; a.NT = meta ? 1 : 4 * qb + 5; a.shift0 = 0;
            f32x16 o[4];
            att::attn_pass_dma<0>(a, lds, o, F.tid);
            att::store_o_bf16(o, obuf + (size_t)(qrow0 + F.wave * 32) * LD_DM + h * 128, LD_DM, F.tid);
        }
    }
    for (int i = F.vcu; i < 512 + 16; i += F.G) {
        const bool meta = i >= 512; const int bh = i >> 3, p = i & 7, b = meta ? 0 : bh >> 4, h = meta ? i - 512 : bh & 15, nblk = meta ? 1 : 2;
        for (int k = 0; k < nblk; ++k) {
            const int qb = meta ? 0 : (k == 0 ? 15 - p : p), qrow0 = meta ? META0 : b * SEQ + qb * 256;
            att::PassArgs a;
            a.Q = qbuf + (size_t)qrow0 * LD_UQ + h * 128; a.ldq = LD_UQ; a.Q2 = qbuf + (size_t)qrow0 * LD_UQ + 2048 + h * 64; a.ldq2 = LD_UQ;
            a.K = kvbuf + h * 128; a.ldk = LD_UKV; a.K2 = proj + EV_KR; a.ldk2 = LD_EV; a.V = kvbuf + 2048 + h * 128; a.ldv = LD_UKV;
            a.cum = nullptr; a.krow0 = b * SEQ; a.qvp0 = meta ? 0 : 64 + qb * 256; a.NT = meta ? 1 : 4 * qb + 5; a.shift0 = 0;
            f32x16 o[4];
            att::attn_pass_dma<1>(a, lds, o, F.tid);
            att::store_o_bf16(o, obuf + (size_t)(qrow0 + F.wave * 32) * LD_DM + 2048 + h * 128, LD_DM, F.tid);
        }
    }
}
__device__ __forceinline__ void attn_odd_phase(const Args& A, Frame& F, int o_idx) {
    unsigned char* ws = F.ws; LAS char* lds = (LAS char*)F.lds;
    const bf16_t* proj = (const bf16_t*)(ws + WS_PROJ); bf16_t* obuf = (bf16_t*)(ws + WS_OBUF);
    const float post = 1.0f - A.lam_init[o_idx];
    const float* subg = A.in[IN_ODSUBLN] + o_idx * 256; const float* relb = A.in[IN_RELB];
    float* S1base = (float*)(ws + WS_DSCR) + (size_t)(F.vcu & 255) * 65536;
    constexpr float INV_SCALE = 1.0f / att::Cfg<2>::SCALE;
    for (int i = F.vcu; i < 512 + 16; i += F.G) {
        const bool meta = i >= 512; const int bh = i >> 3, p = i & 7, b = meta ? 0 : bh >> 4, h = meta ? i - 512 : bh & 15, nblk = meta ? 1 : 2;
        for (int k = 0; k < nblk; ++k) {
            const int qb = meta ? 0 : (k == 0 ? 15 - p : p), qrow0 = meta ? META0 : b * SEQ + qb * 256;
            { int tt = F.tid; asm volatile("" : "+v"(tt));
              if (tt < 128) ((LAS float*)(lds + att::D_OFF_TBL))[tt] = tt <= 112 ? (relb[t5_bucket(tt) * 16 + h] - relb[31 * 16 + h]) * INV_SCALE : 0.f; }
            f32x16 o[8];
            for (int br = 0; br < 2; ++br) {
                att::PassArgs a;
                a.Q = proj + (size_t)qrow0 * LD_OD + h * 256 + br * 128; a.ldq = LD_OD; a.Q2 = nullptr; a.ldq2 = 0;
                a.K = proj + 4096 + h * 256 + br * 128; a.ldk = LD_OD; a.K2 = nullptr; a.ldk2 = 0; a.V = proj + 8192 + h * 256; a.ldv = LD_OD;
                a.cum = nullptr; a.krow0 = b * SEQ; a.qvp0 = meta ? 0 : 64 + qb * 256; a.NT = meta ? 1 : 4 * qb + 5; a.shift0 = meta ? 0 : 48;
                att::attn_pass_diff(a, lds, o, F.tid);
                if (br == 0) {
                    int tq = F.tid; asm volatile("" : "+v"(tq));
                    float* S1 = S1base + (size_t)tq * 4;
#pragma unroll
                    for (int d = 0; d < 8; ++d) {
#pragma unroll
                        for (int q = 0; q < 4; ++q) *(f32x4*)(S1 + (d * 4 + q) * 2048) = (f32x4){o[d][4 * q], o[d][4 * q + 1], o[d][4 * q + 2], o[d][4 * q + 3]}; }
                }
            }
            {
                int tq = F.tid; asm volatile("" : "+v"(tq));
                const float* S1 = S1base + (size_t)tq * 4;
                const float lam = ((const float*)(ws + WS_PRM))[o_idx];
                VM_WAIT();
#pragma unroll
                for (int d = 0; d < 8; ++d) {
#pragma unroll
                    for (int q = 0; q < 4; ++q) { const f32x4 s1 = *(const f32x4*)(S1 + (d * 4 + q) * 2048);
#pragma unroll
                        for (int j = 0; j < 4; ++j) o[d][4 * q + j] = s1[j] - lam * o[d][4 * q + j]; }
                    asm volatile("" ::: "memory"); }
            }
            int tq2 = F.tid; asm volatile("" : "+v"(tq2));
            const int r32 = tq2 & 31;
            float ssum[16];
#pragma unroll
            for (int r = 0; r < 16; ++r) { float t = 0.f;
#pragma unroll
                for (int d = 0; d < 8; ++d) t += o[d][r] * o[d][r];
#pragma unroll
                for (int off = 1; off < 32; off <<= 1) t += __shfl_xor(t, off);
                ssum[r] = __builtin_amdgcn_rsqf(t * (1.0f / 256.0f) + EPS) * post; }
#pragma unroll
            for (int d = 0; d < 8; ++d) { const float g = subg[d * 32 + r32];
#pragma unroll
                for (int r = 0; r < 16; ++r) o[d][r] *= ssum[r] * g; }
            bf16_t* Ow = obuf + (size_t)(qrow0 + F.wave * 32) * LD_DM + h * 256;
            att::store_o_bf16(o, Ow, LD_DM, F.tid);
            att::store_o_bf16(o + 4, Ow + 128, LD_DM, F.tid);
        }
    }
}
#ifdef PROBE_ATT
template <int PVAR>
__device__ __forceinline__ void attn_odd_phase_probe(const Args& A, Frame& F, int o_idx) {
    unsigned char* ws = F.ws; LAS char* lds = (LAS char*)F.lds;
    const bf16_t* proj = (const bf16_t*)(ws + WS_PROJ); bf16_t* obuf = (bf16_t*)(ws + WS_OBUF);
    const float post = 1.0f - A.lam_init[o_idx];
    const float* subg = A.in[IN_ODSUBLN] + o_idx * 256; const float* relb = A.in[IN_RELB];
    float* S1base = (float*)(ws + WS_DSCR) + (size_t)(F.vcu & 255) * 65536;
    constexpr float INV_SCALE = 1.0f / att::Cfg<2>::SCALE;
    for (int i = F.vcu; i < 512 + 16; i += F.G) {
        const bool meta = i >= 512; const int bh = i >> 3, p = i & 7, b = meta ? 0 : bh >> 4, h = meta ? i - 512 : bh & 15, nblk = meta ? 1 : 2;
        for (int k = 0; k < nblk; ++k) {
            const int qb = meta ? 0 : (k == 0 ? 15 - p : p), qrow0 = meta ? META0 : b * SEQ + qb * 256;
            { int tt = F.tid; asm volatile("" : "+v"(tt));
              if (tt < 128) ((LAS float*)(lds + att::D_OFF_TBL))[tt] = tt <= 112 ? (relb[t5_bucket(tt) * 16 + h] - relb[31 * 16 + h]) * INV_SCALE : 0.f; }
            f32x16 o[8];
            for (int br = 0; br < 2; ++br) {
                att::PassArgs a;
                a.Q = proj + (size_t)qrow0 * LD_OD + h * 256 + br * 128; a.ldq = LD_OD; a.Q2 = nullptr; a.ldq2 = 0;
                a.K = proj + 4096 + h * 256 + br * 128; a.ldk = LD_OD; a.K2 = nullptr; a.ldk2 = 0; a.V = proj + 8192 + h * 256; a.ldv = LD_OD;
                a.cum = nullptr; a.krow0 = b * SEQ; a.qvp0 = meta ? 0 : 64 + qb * 256; a.NT = meta ? 1 : 4 * qb + 5; a.shift0 = meta ? 0 : 48;
                if constexpr (PVAR == 0) att::attn_pass_diff(a, lds, o, F.tid); else att::attn_pass_diff_probe<PVAR>(a, lds, o, F.tid);
                if (br == 0) {
                    int tq = F.tid; asm volatile("" : "+v"(tq));
                    float* S1 = S1base + (size_t)tq * 4;
#pragma unroll
                    for (int d = 0; d < 8; ++d) {
#pragma unroll
                        for (int q = 0; q < 4; ++q) *(f32x4*)(S1 + (d * 4 + q) * 2048) = (f32x4){o[d][4 * q], o[d][4 * q + 1], o[d][4 * q + 2], o[d][4 * q + 3]}; }
                }
            }
            {
                int tq = F.tid; asm volatile("" : "+v"(tq));
                const float* S1 = S1base + (size_t)tq * 4;
                const float lam = ((const float*)(ws + WS_PRM))[o_idx];
                VM_WAIT();
#pragma unroll
                for (int d = 0; d < 8; ++d) {
#pragma unroll
                    for (int q = 0; q < 4; ++q) { const f32x4 s1 = *(const f32x4*)(S1 + (d * 4 + q) * 2048);
#pragma unroll
                        for (int j = 0; j < 4; ++j) o[d][4 * q + j] = s1[j] - lam * o[d][4 * q + j]; }
                    asm volatile("" ::: "memory"); }
            }
            int tq2 = F.tid; asm volatile("" : "+v"(tq2));
            const int r32 = tq2 & 31;
            float ssum[16];
#pragma unroll
            for (int r = 0; r < 16; ++r) { float t = 0.f;
#pragma unroll
                for (int d = 0; d < 8; ++d) t += o[d][r] * o[d][r];
#pragma unroll
                for (int off = 1; off < 32; off <<= 1) t += __shfl_xor(t, off);
                ssum[r] = __builtin_amdgcn_rsqf(t * (1.0f / 256.0f) + EPS) * post; }
#pragma unroll
            for (int d = 0; d < 8; ++d) { const float g = subg[d * 32 + r32];
#pragma unroll
                for (int r = 0; r < 16; ++r) o[d][r] *= ssum[r] * g; }
            bf16_t* Ow = obuf + (size_t)(qrow0 + F.wave * 32) * LD_DM + h * 256;
            att::store_o_bf16(o, Ow, LD_DM, F.tid);
            att::store_o_bf16(o + 4, Ow + 128, LD_DM, F.tid);
        }
    }
}
#endif

#ifndef PHM
#define PHM 1023
#endif
#ifndef P4SUB
#define P4SUB 7
#endif
constexpr int PPL = 10, N_PHASES = 2 + PPL * DEPTH;
__global__ void __launch_bounds__(512, 2) mega_fwd(Args args) {
    extern __shared__ __attribute__((aligned(16))) unsigned char lds_raw[];
    Frame F;
    F.lds = (LAS unsigned char*)lds_raw;
    const int wave_s = __builtin_amdgcn_readfirstlane((int)threadIdx.x >> 6);
    F.tid = opq_tid(wave_s); F.lane = F.tid & 63; F.wave = wave_s;
    F.G = gridDim.x; { const int bx = blockIdx.x; F.bx = bx; F.vcu = (F.G % 8 == 0) ? (bx % 8) * (F.G / 8) + bx / 8 : bx; }
    F.ws = args.ws;
    unsigned char* ws = args.ws;
    volatile LAS unsigned* MISC = (volatile LAS unsigned*)(F.lds + MISC_OFF);
    for (int u = F.tid; u < (LDS_BYTES - 135168) / 4; u += 512) ((LAS unsigned*)(F.lds + 135168))[u] = 0u;
    __syncthreads();
#if MK_ONE_LAUNCH
    XcdBarrier bar = xcd_barrier_post((unsigned*)(ws + WS_CTL) + CW_BAR, MISC + 8, F.tid);
#define IN(k) true
#else
    const int lo = args.ph_lo, hi = args.ph_hi;
    XcdBarrier bar; bar.bar = (unsigned*)(ws + WS_CTL) + CW_BAR; bar.x = 0; bar.st = nullptr;
    if (hi - lo > 1) bar = xcd_barrier_post((unsigned*)(ws + WS_CTL) + CW_BAR, MISC + 8, F.tid);
#define IN(k) (lo <= (k) && (k) < hi)
#endif
#define REFRESH() Frame Fp = F; { const int t_ = opq_tid(wave_s); Fp.tid = t_; Fp.lane = t_ & 63; size_t z_ = 0; asm volatile("" : "+s"(z_)); Fp.ws = args.ws + z_; Fp.vcu = opq_s(F.vcu); Fp.G = opq_s(F.G); Fp.bx = opq_s(F.bx); } unsigned char* ws = Fp.ws; (void)ws
#define SEAM(k, kn) do { if (IN(k) && IN(kn)) { XcdBarrier b_; size_t z_ = 0; asm volatile("" : "+s"(z_)); b_.bar = (unsigned*)(args.ws + z_ + WS_CTL) + CW_BAR; b_.x = xb_xcc_id(); b_.st = MISC + 8; xcd_barrier(b_, opq_tid(wave_s)); } } while (0)
#define PTRS() bf16_t* hbf = (bf16_t*)(ws + WS_HBF); bf16_t* proj = (bf16_t*)(ws + WS_PROJ); bf16_t* qbuf = (bf16_t*)(ws + WS_QBUF); bf16_t* kvbuf = (bf16_t*)(ws + WS_KVBUF); \
    bf16_t* obuf = (bf16_t*)(ws + WS_OBUF); bf16_t* mbuf = (bf16_t*)(ws + WS_MBUF); bf16_t* act = (bf16_t*)(ws + WS_PROJ); \
    pg8::EpiCtx ec; ec.O = nullptr; ec.ldc = 0; ec.rs = (const float*)(ws + WS_RSTD); ec.statq = (float*)(ws + WS_STATQ); ec.statkv = (float*)(ws + WS_STATKV); \
    ec.flogT = (float*)(ws + WS_FLOG); ec.cosT = (const float*)(ws + WS_COS); ec.sinT = (const float*)(ws + WS_SIN); ec.statm = (float*)(ws + WS_STATM); ec.part = (float*)(ws + WS_PART); ec.cs = nullptr; ec.amaxp = (float*)(ws + WS_AMAXP); \
    (void)hbf; (void)proj; (void)qbuf; (void)kvbuf; (void)obuf; (void)mbuf; (void)act

#if PHM & 1
    if (IN(0)) { p0_prologue(args, F); }
#endif
    SEAM(0, 1);
#if PHM & 1
    if (IN(1)) { REFRESH(); cvt_items<1>(args, Fp); }
#endif
    SEAM(1, 2);
#define LAYER() opq_s(layer0)
#define BASE() (2 + PPL * layer0)
#define EVEN() ((LAYER() & 1) == 0)
#define DN8() (((I8_DN >> LAYER()) & 1) != 0)
#define OUT8() (((I8_OUT >> LAYER()) & 1) != 0)
#define REFRESH_L() REFRESH(); const int layer = LAYER(), e = layer >> 1; (void)e; (void)layer
    for (int layer0 = 0; layer0 < DEPTH; ++layer0) {
#if PHM & 2
        if (IN(BASE())) {
            REFRESH_L(); PTRS();
            if (EVEN() && !((I8_IN_EV >> e) & 1)) {
                pg8::Gemm g{hbf, (const bf16_t*)(ws + W_EVIN + e * SZ_EVIN), LD_DM, LD_DM, DM}; pg8::StaticOrder S; S.init(MPAD, EV_N, Fp.G, Fp.bx);
                pg8::Epi<1> E{ec}; E.c.O = proj; E.c.ldc = LD_EV;
                pg8::gemm_phase<pg8::Epi<1>, pg8::StaticOrder, true, true>(Fp.lds, g, S, E, Fp.tid);
            } else if (EVEN()) {
                pg8::Gemm g{(const bf16_t*)(ws + WS_OBUF), (const bf16_t*)(ws + W_EVIN + e * SZ_EVIN), LD8 / 2, LD8 / 2, DM / 2}; pg8::StaticOrder S; S.init(MPAD, EV_N, Fp.G, Fp.bx);
                pg8::Epi<9> E{ec}; E.c.O = proj; E.c.ldc = LD_EV; E.c.rs = (const float*)(ws + WS_RS8); E.c.cs = (const float*)(ws + WS_CTL + CTL_COLMAX_EV) + (size_t)e * EV_N;
                pg8::gemm_phase<pg8::Epi<9>, pg8::StaticOrder, true, true, 2>(Fp.lds, g, S, E, Fp.tid);
            } else if ((I8_IN_ODD >> e) & 1) {
                pg8::Gemm g{(const bf16_t*)(ws + WS_OBUF), (const bf16_t*)(ws + W_GU + (size_t)layer * SZ_GU + W_OD8_OFF), LD8 / 2, LD8 / 2, DM / 2}; pg8::StaticOrder S; S.init(MREAL, OD_N, Fp.G, Fp.bx);
                pg8::Epi<8> E{ec}; E.c.O = proj; E.c.ldc = LD_OD; E.c.rs = (const float*)(ws + WS_RS8); E.c.cs = (const float*)(ws + WS_CTL + CTL_COLMAX_OD) + (size_t)e * OD_N;
                pg8::gemm_phase<pg8::Epi<8>, pg8::StaticOrder, true, true, 2>(Fp.lds, g, S, E, Fp.tid);
            } else {
                pg8::Gemm g{hbf, (const bf16_t*)(ws + W_ODIN + e * SZ_ODIN), LD_DM, LD_DM, DM}; pg8::StaticOrder S; S.init(MREAL, OD_N, Fp.G, Fp.bx);
                pg8::Epi<0> E{ec}; E.c.O = proj; E.c.ldc = LD_OD;
                pg8::gemm_phase<pg8::Epi<0>, pg8::StaticOrder, true, true>(Fp.lds, g, S, E, Fp.tid);
            }
        }
        if (!EVEN() && IN(BASE())) {
            REFRESH_L(); PTRS();
            if ((I8_IN_ODD >> e) & 1) {
                pg8::Gemm g{(const bf16_t*)(ws + WS_OBUF), (const bf16_t*)(ws + W_GU + (size_t)layer * SZ_GU + W_OD8_OFF), LD8 / 2, LD8 / 2, 128}; pg8::SplitKOrder S; S.init(MREAL / 256, OD_N, DM / 256, 128, Fp.G, Fp.bx);
                pg8::Epi<6> E{ec}; E.c.ldc = OD_N;
                pg8::gemm_phase<pg8::Epi<6>, pg8::SplitKOrder, true, false, 2>(Fp.lds, g, S, E, Fp.tid);
            } else {
                pg8::Gemm g{hbf, (const bf16_t*)(ws + W_ODIN + e * SZ_ODIN), LD_DM, LD_DM, 256}; pg8::SplitKOrder S; S.init(MREAL / 256, OD_N, DM / 256, 256, Fp.G, Fp.bx);
                pg8::Epi<6> E{ec}; E.c.ldc = OD_N;
                pg8::gemm_phase<pg8::Epi<6>, pg8::SplitKOrder, true, false>(Fp.lds, g, S, E, Fp.tid);
            }
        }
#endif
        SEAM(BASE(), BASE() + 1);
#if PHM & 4
        if (EVEN() && IN(BASE() + 1)) {
#if P4SUB & 1
            REFRESH_L();
            scan_phase(args, Fp, e);
#endif
#if P4SUB & 2
            {   REFRESH_L(); PTRS();
                pg8::Gemm g{proj + EV_CQ, (const bf16_t*)(ws + W_UQ + e * SZ_UQ), LD_EV, LD_QR, QRANK}; pg8::StaticOrder S; S.init(MPAD, UQ_N, Fp.G, Fp.bx);
                pg8::Epi<2> E{ec}; E.c.O = qbuf; E.c.ldc = LD_UQ; E.c.rs = (const float*)(ws + WS_STATQ);
                pg8::gemm_phase<pg8::Epi<2>, pg8::StaticOrder, true, true>(Fp.lds, g, S, E, Fp.tid); }
#endif
#if P4SUB & 4
            {   REFRESH_L(); PTRS();
                pg8::Gemm g{proj + EV_CKV, (const bf16_t*)(ws + W_UKV + e * SZ_UKV), LD_EV, LD_KV, KVK}; pg8::StaticOrder S; S.init(MPAD, UKV_N, Fp.G, Fp.bx);
                pg8::Epi<3> E{ec}; E.c.O = kvbuf; E.c.ldc = LD_UKV; E.c.rs = (const float*)(ws + WS_STATKV);
                pg8::gemm_phase<pg8::Epi<3>, pg8::StaticOrder, true, true>(Fp.lds, g, S, E, Fp.tid); }
#endif
        }
#endif
        if (!EVEN() && IN(BASE() + 1)) { REFRESH_L(); fixup_odd_meta(Fp, e); }
        SEAM(BASE() + 1, BASE() + 2);
#if PHM & 8
        if (IN(BASE() + 2) && EVEN()) { REFRESH_L(); attn_even_phase(Fp); }
#endif
#if PHM & 16
        if (IN(BASE() + 2) && !EVEN()) { REFRESH_L(); attn_odd_phase(args, Fp, e); }
#endif
        if (OUT8()) SEAM(BASE() + 2, BASE() + 3);
        if (OUT8() && IN(BASE() + 3)) { REFRESH_L(); oq_phase(Fp); }
        SEAM(OUT8() ? BASE() + 3 : BASE() + 2, BASE() + 4);
#if PHM & 32
        if (IN(BASE() + 4) && OUT8()) {
            REFRESH_L(); PTRS();
            const bf16_t* w8 = (const bf16_t*)(ws + (EVEN() ? W_EVOUT : W_ODOUT) + e * SZ_SQ);
            {   pg8::Gemm g{(const bf16_t*)(ws + WS_A8), w8, LD8 / 2, LD8 / 2, DM / 2}; pg8::StaticOrder S; S.init(MREAL, DM, Fp.G, Fp.bx);
                pg8::Epi<10> E{ec}; E.c.O = mbuf; E.c.ldc = LD_DM; E.c.rs = (const float*)(ws + WS_RS8); E.c.cs = (const float*)(ws + WS_CTL + CTL_COLMAX_OUT) + (size_t)layer * DM;
                pg8::gemm_phase<pg8::Epi<10>, pg8::StaticOrder, true, true, 2>(Fp.lds, g, S, E, Fp.tid); }
            {   REFRESH_L(); PTRS();
                const bf16_t* w8b = (const bf16_t*)(ws + (EVEN() ? W_EVOUT : W_ODOUT) + e * SZ_SQ);
                pg8::Gemm g{(const bf16_t*)(ws + WS_A8), w8b, LD8 / 2, LD8 / 2, 128}; pg8::SplitKOrder S; S.init(MREAL / 256, DM, DM / 256, 128, Fp.G, Fp.bx);
                pg8::Epi<6> E{ec}; E.c.ldc = DM;
                pg8::gemm_phase<pg8::Epi<6>, pg8::SplitKOrder, true, false, 2>(Fp.lds, g, S, E, Fp.tid); }
        }
        if (IN(BASE() + 4) && !OUT8()) {
            REFRESH_L(); PTRS();
            {   pg8::Gemm g{obuf, (const bf16_t*)(ws + (EVEN() ? W_EVOUT : W_ODOUT) + e * SZ_SQ), LD_DM, LD_DM, DM}; pg8::StaticOrder S; S.init(MREAL, DM, Fp.G, Fp.bx);
                pg8::Epi<4> E{ec}; E.c.O = mbuf; E.c.ldc = LD_DM;
                pg8::gemm_phase<pg8::Epi<4>, pg8::StaticOrder, true, true>(Fp.lds, g, S, E, Fp.tid); }
            {   REFRESH_L(); PTRS();
                pg8::Gemm g{obuf, (const bf16_t*)(ws + (EVEN() ? W_EVOUT : W_ODOUT) + e * SZ_SQ), LD_DM, LD_DM, 256}; pg8::SplitKOrder S; S.init(MREAL / 256, DM, DM / 256, 256, Fp.G, Fp.bx);
                pg8::Epi<6> E{ec}; E.c.ldc = DM;
                pg8::gemm_phase<pg8::Epi<6>, pg8::SplitKOrder, true, false>(Fp.lds, g, S, E, Fp.tid); }
        }
#endif
        SEAM(BASE() + 4, BASE() + 5);
#if PHM & 64
        if (IN(BASE() + 5)) { REFRESH_L(); ew_phase(args, Fp, layer, 0); }
#endif
        SEAM(BASE() + 5, BASE() + 6);
#if PHM & 128
        if (IN(BASE() + 6)) {
            REFRESH_L(); PTRS();
            pg8::Gemm g{(const bf16_t*)(ws + WS_A8), (const bf16_t*)(ws + W_GU + layer * SZ_GU), LD8 / 2, LD8 / 2, DM / 2}; pg8::StaticOrder S; S.init(MPAD, GU_N, Fp.G, Fp.bx, 4);
            pg8::Epi<7> E{ec}; E.c.O = act; E.c.ldc = LD_FF; E.c.rs = (const float*)(ws + WS_RS8); E.c.cs = (const float*)(ws + WS_CTL + CTL_COLMAX) + (size_t)layer * GU_N;
            pg8::gemm_phase<pg8::Epi<7>, pg8::StaticOrder, true, true, 2>(Fp.lds, g, S, E, Fp.tid);
        }
#endif
        if (DN8()) SEAM(BASE() + 6, BASE() + 7);
        if (DN8() && IN(BASE() + 7)) { REFRESH_L(); actq_phase(Fp); }
        SEAM(DN8() ? BASE() + 7 : BASE() + 6, BASE() + 8);
#if PHM & 256
        if (IN(BASE() + 8) && DN8()) {
            REFRESH_L(); PTRS();
            {   pg8::Gemm g{(const bf16_t*)(ws + WS_ACT8), (const bf16_t*)(ws + W_DN + layer * SZ_DN), LD8F / 2, LD8F / 2, DFF / 2}; pg8::StaticOrder S; S.init(MREAL, DM, Fp.G, Fp.bx);
                pg8::Epi<10> E{ec}; E.c.O = mbuf; E.c.ldc = LD_DM; E.c.rs = (const float*)(ws + WS_RSD); E.c.cs = (const float*)(ws + WS_CTL + CTL_COLMAX_DN) + (size_t)layer * DM;
                pg8::gemm_phase<pg8::Epi<10>, pg8::StaticOrder, true, true, 2>(Fp.lds, g, S, E, Fp.tid); }
            {   REFRESH_L(); PTRS();
                pg8::Gemm g{(const bf16_t*)(ws + WS_ACT8), (const bf16_t*)(ws + W_DN + layer * SZ_DN), LD8F / 2, LD8F / 2, 128}; pg8::SplitKOrder S; S.init(MREAL / 256, DM, DFF / 256, 128, Fp.G, Fp.bx);
                pg8::Epi<6> E{ec}; E.c.ldc = DM;
                pg8::gemm_phase<pg8::Epi<6>, pg8::SplitKOrder, true, false, 2>(Fp.lds, g, S, E, Fp.tid); }
        }
        if (IN(BASE() + 8) && !DN8()) {
            REFRESH_L(); PTRS();
            {   pg8::Gemm g{act, (const bf16_t*)(ws + W_DN + layer * SZ_DN), LD_FF, LD_FF, DFF}; pg8::StaticOrder S; S.init(MREAL, DM, Fp.G, Fp.bx);
                pg8::Epi<4> E{ec}; E.c.O = mbuf; E.c.ldc = LD_DM;
                pg8::gemm_phase<pg8::Epi<4>, pg8::StaticOrder, true, true>(Fp.lds, g, S, E, Fp.tid); }
            {   REFRESH_L(); PTRS();
                pg8::Gemm g{act, (const bf16_t*)(ws + W_DN + layer * SZ_DN), LD_FF, LD_FF, 256}; pg8::SplitKOrder S; S.init(MREAL / 256, DM, DFF / 256, 256, Fp.G, Fp.bx);
                pg8::Epi<6> E{ec}; E.c.ldc = DM;
                pg8::gemm_phase<pg8::Epi<6>, pg8::SplitKOrder, true, false>(Fp.lds, g, S, E, Fp.tid); }
        }
#endif
        SEAM(BASE() + 8, BASE() + 9);
#if PHM & 512
        if (IN(BASE() + 9)) { REFRESH_L(); ew_phase(args, Fp, layer, 1); }
#endif
        if (layer0 + 1 < DEPTH) SEAM(BASE() + 9, BASE() + 10);
    }
#ifdef PROBE_ATT
    if (IN(N_PHASES)) { REFRESH(); attn_odd_phase_probe<PROBE_ATT>(args, Fp, 1); }
#endif
#ifdef PROBE_EW
    if (IN(N_PHASES)) { REFRESH(); ew_phase(args, Fp, 1, 0); }
#endif
#ifdef PROBE_GEMM
    if (IN(N_PHASES)) {
        REFRESH(); PTRS();
#ifndef PROBE_LD
#define PROBE_LD LD_DM
#endif
        pg8::Gemm g{hbf, (const bf16_t*)(ws + W_GU), PROBE_LD, PROBE_LD, DM}; pg8::StaticOrder S; S.init(PROBE_LD ? MPAD : 256, PROBE_LD ? GU_N : 256 * 86 * 65, Fp.G, Fp.bx, PROBE_WGM);
        pg8::Epi<5> E{ec}; E.c.O = act; E.c.ldc = LD_FF;
        pg8::gemm_phase<pg8::Epi<5>, pg8::StaticOrder, PROBE_ALIGN, PROBE_SP2>(Fp.lds, g, S, E, Fp.tid);
    }
#endif
#undef PTRS
#undef REFRESH
#undef REFRESH_L
#undef LAYER
#undef BASE
#undef EVEN
#undef DN8
#undef OUT8
#undef IN
#undef SEAM
}

#ifndef MK_ONE_LAUNCH
#define MK_ONE_LAUNCH 1
#endif
extern "C" void kernel_launch(void* const* d_in, const int* in_sizes, int n_in, void* d_out, int out_size, void* d_ws, size_t ws_size, hipStream_t stream) {
    static int grid = 0;
    if (grid == 0) {
        if (n_in != 18 || in_sizes[0] != NB * SEQ * DM || out_size != NB * SEQ * DM || ws_size < WS_END) {
            fprintf(stderr, "kernel_launch: unexpected shapes or workspace (n_in %d, in0 %d, out %d, ws %zu < %zu); nothing launched\n", n_in, n_in > 0 ? in_sizes[0] : -1, out_size, ws_size, (size_t)WS_END); grid = -1; return; }
        int dev = 0, cus = 0;
        if (hipGetDevice(&dev) != hipSuccess || hipDeviceGetAttribute(&cus, hipDeviceAttributeMultiprocessorCount, dev) != hipSuccess || cus <= 0) { fprintf(stderr, "kernel_launch: device query failed\n"); grid = -1; return; }
        if (hipFuncSetAttribute((const void*)mega_fwd, hipFuncAttributeMaxDynamicSharedMemorySize, LDS_BYTES) != hipSuccess) { fprintf(stderr, "kernel_launch: hipFuncSetAttribute failed\n"); grid = -1; return; }
        int per_cu = 0;
        if (hipOccupancyMaxActiveBlocksPerMultiprocessor(&per_cu, (const void*)mega_fwd, 512, LDS_BYTES) != hipSuccess || per_cu < 1) fprintf(stderr, "kernel_launch: note: occupancy query reports %d workgroups per CU\n", per_cu);
        (void)hipGetLastError();
        grid = cus > 256 ? 256 : cus;
    }
    if (grid < 0) return;
    if (hipMemsetAsync((char*)d_ws + WS_CTL, 0, CTL_ZERO_BYTES, stream) != hipSuccess) { fprintf(stderr, "kernel_launch: memset failed\n"); return; }
    Args a{};
    for (int i = 0; i < 18; ++i) a.in[i] = (const float*)d_in[i];
    a.out = (float*)d_out; a.ws = (unsigned char*)d_ws;
    a.lam_init[0] = (float)(0.8 - 0.6 * exp(-0.3 * 1.0)); a.lam_init[1] = (float)(0.8 - 0.6 * exp(-0.3 * 3.0));
#if MK_ONE_LAUNCH
    a.ph_lo = 0; a.ph_hi = N_PHASES;
    hipLaunchKernelGGL(mega_fwd, dim3(grid), dim3(512), LDS_BYTES, stream, a);
#else
    for (int k = 0; k < N_PHASES; ++k) {
        a.ph_lo = k; a.ph_hi = k + 1;
        hipLaunchKernelGGL(mega_fwd, dim3(grid), dim3(512), LDS_BYTES, stream, a);
#ifdef PROBE_MASK
        { const int off = k < 2 ? 10 : ((k - 2) % PPL); if ((PROBE_MASK >> off) & 1) hipLaunchKernelGGL(mega_fwd, dim3(grid), dim3(512), LDS_BYTES, stream, a); }
#endif
    }
#if defined(PROBE_GEMM) || defined(PROBE_EW) || defined(PROBE_ATT)
    for (int r = 0; r < PROBE_REP; ++r) { a.ph_lo = N_PHASES; a.ph_hi = N_PHASES + 1; hipLaunchKernelGGL(mega_fwd, dim3(grid), dim3(512), LDS_BYTES, stream, a); }
#endif
#endif
}
```
